# Optimizing an MI355X kernel written in HIP

```python
import jax, jax.numpy as jnp
from jax import lax
import numpy as np

D_MODEL = 1024
BATCH = 16
SEQ = 2048
DEPTH = 1

GRID_W = 64
CTX_LEN = 256
FOURIER_WIDTH = 512
FOURIER_GROUPS = 4
FOURIER_GROUP_DIM = FOURIER_WIDTH // FOURIER_GROUPS
RWKV_WIDTH = 512
RWKV_HEAD_DIM = 64
RWKV_HEADS = RWKV_WIDTH // RWKV_HEAD_DIM
DECAY_LORA = 64
AAA_LORA = 64
GATE_LORA = 128
N_BRANCHES = 2
RWKV_SPLIT = (RWKV_WIDTH, RWKV_WIDTH, RWKV_WIDTH, DECAY_LORA, DECAY_LORA, AAA_LORA, AAA_LORA, GATE_LORA)
RWKV_COLS = sum(RWKV_SPLIT)
FOURIER_START = RWKV_COLS
GATE_START = RWKV_COLS + FOURIER_WIDTH
IN_COLS = GATE_START + N_BRANCHES * D_MODEL
D_FF = -(-8 * D_MODEL // (3 * 256)) * 256
NORM_EPS = 1e-6
GN_EPS = 64e-5

kernel_name = "hybrid_fourier_rwkv7_dit_block"


def _split(u, sizes):
    idx = [int(i) for i in np.cumsum(sizes)[:-1]]
    return jnp.split(u, idx, axis=-1)


def rmsnorm(u, g):
    uf = u.astype(jnp.float32)
    uf = uf * lax.rsqrt(jnp.mean(jnp.square(uf), axis=-1, keepdims=True) + NORM_EPS)
    return (uf * g.astype(jnp.float32)).astype(u.dtype)


def modulate(h, shift, scale):
    return h * (1.0 + scale) + shift


def centred_shift(u, mu_prev, mu_next):
    prev = jnp.pad(u, ((0, 0), (1, 0), (0, 0)))[:, :-1]
    nxt = jnp.pad(u, ((0, 0), (0, 1), (0, 0)))[:, 1:]
    return u + mu_prev * (prev - u) + mu_next * (nxt - u)


def _heads(t):
    return t.reshape(t.shape[0], t.shape[1], RWKV_HEADS, RWKV_HEAD_DIM)


def rwkv_inputs(u, lp):
    r, k, v, wd_f, wd_b, ad_f, ad_b, gd = _split(u, RWKV_SPLIT)
    kk = _heads(k * lp["k_k"]).astype(jnp.float32)
    kk = kk * lax.rsqrt(jnp.maximum(jnp.sum(jnp.square(kk), -1, keepdims=True), 1e-24))

    def direction(wd, w0, w2, ad, a0, a2):
        w = -jax.nn.softplus(-(w0 + jnp.tanh(wd) @ w2)) - 0.5
        decay = jnp.exp(-jnp.exp(w.astype(jnp.float32)))
        a = jax.nn.sigmoid(a0 + ad @ a2)
        kd = k * (1.0 + (a - 1.0) * lp["k_a"])
        return _heads(decay), _heads(a), _heads(kd)

    fwd = direction(wd_f, lp["w0_f"], lp["w2_f"], ad_f, lp["a0_f"], lp["a2_f"])
    bwd = direction(wd_b, lp["w0_b"], lp["w2_b"], ad_b, lp["a0_b"], lp["a2_b"])
    g = jax.nn.sigmoid(gd) @ lp["g2"]
    return {"r": _heads(r), "v": _heads(v), "kk": kk, "fwd": fwd, "bwd": bwd, "g": g}


def wkv_scan(r, decay, kd, v, kk, a, S0, reverse, emit):
    to_time = lambda t: jnp.moveaxis(t.astype(jnp.float32), 1, 0)
    xs = (to_time(r), to_time(decay), to_time(kd), to_time(v), to_time(kk), to_time(a))

    def step(S, inp):
        r_t, w_t, k_t, v_t, kk_t, a_t = inp
        sa = jnp.einsum("bhvk,bhk->bhv", S, -kk_t)
        S = (S * w_t[:, :, None, :] + sa[..., None] * (kk_t * a_t)[:, :, None, :]
             + v_t[..., None] * k_t[:, :, None, :])
        y = jnp.einsum("bhvk,bhk->bhv", S, r_t) if emit else None
        return S, y

    S, ys = lax.scan(step, S0, xs, reverse=reverse)
    return (jnp.moveaxis(ys, 0, 1) if emit else None), S


def bidir_wkv(q, Sf0, Sb0, emit):
    df, af, kf = q["fwd"]
    db, ab, kb = q["bwd"]
    yf, Sf = wkv_scan(q["r"], df, kf, q["v"], q["kk"], af, Sf0, False, emit)
    yb, Sb = wkv_scan(q["r"], db, kb, q["v"], q["kk"], ab, Sb0, True, emit)
    y = yf + yb if emit else None
    return y, Sf, Sb


def rwkv_output(y, q, lp):
    mean = jnp.mean(y, -1, keepdims=True)
    var = jnp.mean(jnp.square(y - mean), -1, keepdims=True)
    o = (y - mean) * lax.rsqrt(var + GN_EPS)
    o = o * lp["lnx_g"].reshape(RWKV_HEADS, RWKV_HEAD_DIM) + lp["lnx_b"].reshape(RWKV_HEADS, RWKV_HEAD_DIM)
    kd_sum = q["fwd"][2] + q["bwd"][2]
    bonus = jnp.sum(q["r"] * kd_sum * lp["r_k"], -1, keepdims=True) * q["v"]
    o = (o + bonus).astype(q["g"].dtype)
    o = o.reshape(o.shape[0], o.shape[1], RWKV_WIDTH) * q["g"]
    return o @ lp["w_up_r"]


def fourier_latent(u, rows):
    B = u.shape[0]
    uf = u.astype(jnp.float32).reshape(B, rows, GRID_W, FOURIER_GROUPS, FOURIER_GROUP_DIM)
    f = jnp.real(jnp.fft.fftn(uf, axes=(1, 2, 4), norm="ortho"))
    return f.reshape(B, rows * GRID_W, FOURIER_WIDTH).astype(u.dtype)


def fourier_context(u):
    B, L = u.shape[0], u.shape[1]
    uf = u.astype(jnp.float32).reshape(B, L, FOURIER_GROUPS, FOURIER_GROUP_DIM)
    f = jnp.real(jnp.fft.fftn(uf, axes=(1, 3), norm="ortho"))
    return f.reshape(B, L, FOURIER_WIDTH).astype(u.dtype)


def branch_merge(p, f_out, r_out, lp):
    gate_f, gate_r = _split(p[..., GATE_START:], (D_MODEL, D_MODEL))
    m = jax.nn.sigmoid(gate_f) * (f_out @ lp["w_up_f"]) + jax.nn.sigmoid(gate_r) * r_out
    return m @ lp["w_out"]


def swiglu(h, w_gu, w_down):
    gate, up = jnp.split(h @ w_gu, 2, axis=-1)
    return (jax.nn.silu(gate) * up) @ w_down


def trunk_layer(x, ctx, mod_x, mod_c, lp, update_ctx):
    rows = x.shape[1] // GRID_W
    B = x.shape[0]
    sh1, sc1, ga1, sh2, sc2, ga2 = jnp.split(mod_x, 6, axis=-1)
    csh1, csc1, cga1, csh2, csc2, cga2 = jnp.split(mod_c, 6, axis=-1)

    hx = modulate(rmsnorm(x, lp["norm1_g"]), sh1, sc1)
    px = hx @ lp["w_in"]
    qx = rwkv_inputs(centred_shift(px[..., :RWKV_COLS], lp["mu_prev"], lp["mu_next"]), lp)

    hc = modulate(rmsnorm(ctx, lp["norm1_g"]), csh1, csc1)
    pc = hc @ (lp["w_in"] if update_ctx else lp["w_in"][:, :RWKV_COLS])
    qc = rwkv_inputs(centred_shift(pc[..., :RWKV_COLS], lp["mu_prev"], lp["mu_next"]), lp)
    S0 = jnp.zeros((B, RWKV_HEADS, RWKV_HEAD_DIM, RWKV_HEAD_DIM), jnp.float32)
    yc, Sf, Sb = bidir_wkv(qc, S0, S0, update_ctx)
    yx, _, _ = bidir_wkv(qx, Sf, Sb, True)

    fx = fourier_latent(px[..., FOURIER_START:GATE_START], rows)
    x = x + ga1 * branch_merge(px, fx, rwkv_output(yx, qx, lp), lp)
    hx2 = modulate(rmsnorm(x, lp["norm2_g"]), sh2, sc2)
    x = x + ga2 * swiglu(hx2, lp["w_gu"], lp["w_down"])

    if update_ctx:
        fc = fourier_context(pc[..., FOURIER_START:GATE_START])
        ctx = ctx + cga1 * branch_merge(pc, fc, rwkv_output(yc, qc, lp), lp)
        hc2 = modulate(rmsnorm(ctx, lp["norm2_g"]), csh2, csc2)
        ctx = ctx + cga2 * swiglu(hc2, lp["w_gu"], lp["w_down"])
    return x, ctx


def setup_inputs(seed: int = 0) -> dict:
    key = jax.random.key(seed)
    ks = iter(jax.random.split(key, 40))
    L, D = DEPTH, D_MODEL

    def nrm(shape, scale):
        return scale * jax.random.normal(next(ks), shape, jnp.float32)

    def gain(shape):
        return 1.0 + nrm(shape, 0.02)

    ratio = jnp.linspace(0.0, 1.0, RWKV_WIDTH, dtype=jnp.float32)
    w0_base = -6.0 + 5.0 * ratio ** 0.9
    return {
        "x": nrm((BATCH, SEQ, D), 1.0),
        "c": nrm((BATCH, D), 1.0),
        "ctx": nrm((BATCH, CTX_LEN, D), 1.0),
        "c_ctx": nrm((D,), 1.0),
        "norm1_g": gain((L, D)),
        "norm2_g": gain((L, D)),
        "w_ada": nrm((L, D, 6 * D), D ** -0.5),
        "b_ada": nrm((L, 6 * D), 0.01),
        "w_in": nrm((L, D, IN_COLS), D ** -0.5),
        "mu_prev": jax.random.uniform(next(ks), (L, RWKV_COLS), jnp.float32, 0.0, 0.5),
        "mu_next": jax.random.uniform(next(ks), (L, RWKV_COLS), jnp.float32, 0.0, 0.5),
        "w0_f": w0_base + nrm((L, RWKV_WIDTH), 0.1),
        "w2_f": nrm((L, DECAY_LORA, RWKV_WIDTH), 0.5 * DECAY_LORA ** -0.5),
        "a0_f": nrm((L, RWKV_WIDTH), 0.1),
        "a2_f": nrm((L, AAA_LORA, RWKV_WIDTH), AAA_LORA ** -0.5),
        "w0_b": w0_base + nrm((L, RWKV_WIDTH), 0.1),
        "w2_b": nrm((L, DECAY_LORA, RWKV_WIDTH), 0.5 * DECAY_LORA ** -0.5),
        "a0_b": nrm((L, RWKV_WIDTH), 0.1),
        "a2_b": nrm((L, AAA_LORA, RWKV_WIDTH), AAA_LORA ** -0.5),
        "g2": nrm((L, GATE_LORA, RWKV_WIDTH), GATE_LORA ** -0.5),
        "k_k": 0.85 + nrm((L, RWKV_WIDTH), 0.02),
        "k_a": 1.0 + nrm((L, RWKV_WIDTH), 0.02),
        "r_k": nrm((L, RWKV_HEADS, RWKV_HEAD_DIM), 0.1),
        "lnx_g": gain((L, RWKV_WIDTH)),
        "lnx_b": nrm((L, RWKV_WIDTH), 0.01),
        "w_up_r": nrm((L, RWKV_WIDTH, D), RWKV_WIDTH ** -0.5),
        "w_up_f": nrm((L, FOURIER_WIDTH, D), FOURIER_WIDTH ** -0.5),
        "w_out": nrm((L, D, D), D ** -0.5),
        "w_gu": nrm((L, D, 2 * D_FF), D ** -0.5),
        "w_down": nrm((L, D_FF, D), D_FF ** -0.5),
        "final_norm_g": gain((D,)),
    }


def reference(x, c, ctx, c_ctx, norm1_g, norm2_g, w_ada, b_ada, w_in, mu_prev, mu_next,
              w0_f, w2_f, a0_f, a2_f, w0_b, w2_b, a0_b, a2_b, g2, k_k, k_a, r_k,
              lnx_g, lnx_b, w_up_r, w_up_f, w_out, w_gu, w_down, final_norm_g):
    for layer in range(DEPTH):
        lp = {
            "norm1_g": norm1_g[layer], "norm2_g": norm2_g[layer], "w_in": w_in[layer],
            "mu_prev": mu_prev[layer], "mu_next": mu_next[layer],
            "w0_f": w0_f[layer], "w2_f": w2_f[layer], "a0_f": a0_f[layer], "a2_f": a2_f[layer],
            "w0_b": w0_b[layer], "w2_b": w2_b[layer], "a0_b": a0_b[layer], "a2_b": a2_b[layer],
            "g2": g2[layer], "k_k": k_k[layer], "k_a": k_a[layer], "r_k": r_k[layer],
            "lnx_g": lnx_g[layer], "lnx_b": lnx_b[layer], "w_up_r": w_up_r[layer],
            "w_up_f": w_up_f[layer], "w_out": w_out[layer], "w_gu": w_gu[layer],
            "w_down": w_down[layer],
        }
        mod_x = (jax.nn.silu(c) @ w_ada[layer] + b_ada[layer])[:, None, :]
        mod_c = (jax.nn.silu(c_ctx) @ w_ada[layer] + b_ada[layer])[None, None, :]
        x, ctx = trunk_layer(x, ctx, mod_x, mod_c, lp, layer < DEPTH - 1)
    return rmsnorm(x, final_norm_g)
```

```cpp
#include <hip/hip_runtime.h>
#include <cstdio>
#include <cstdint>
#ifndef MK_REPEAT
#define MK_REPEAT 0x0
#endif
#ifndef MK_N_LAUNCHES
#define MK_N_LAUNCHES 1
#endif
namespace pg8 {
#define PG8_LAS __attribute__((address_space(3)))
typedef unsigned short bf16_t;
typedef short bf16x8 __attribute__((ext_vector_type(8)));
typedef float f32x4 __attribute__((ext_vector_type(4)));
typedef unsigned u32x4 __attribute__((ext_vector_type(4)));
constexpr int BM = 256, BK = 64, HALF = 128, HTB = HALF * BK * 2  , STAGE_BYTES = 8 * HTB, NXCD = 8, WGM = 8;

__host__ __device__ __forceinline__ int lds_byte(int r, int c) { const int st = (r >> 4) * 2 + (c >> 5), rr = r & 15, cc = c & 31, ob = rr * 64 + cc * 2; return st * 1024 + (ob ^ (((ob >> 9) & 1) << 5)); }
__host__ __device__ __forceinline__ void stage_rc(int b, int& R, int& C) { const int st = b / 1024, sb = b % 1024, swz = sb ^ (((sb >> 9) & 1) << 5); R = (st >> 1) * 16 + swz / 64; C = (st & 1) * 32 + (swz % 64) / 2; }
__host__ __device__ __forceinline__ int perm32(int rho) { const int n = rho >> 4, i = rho & 15; return 8 * (i >> 2) + 4 * n + (i & 3); }

struct Unit { int pm, pn; };
struct Gemm { const bf16_t* A; const bf16_t* Bt; int M, N, K; };

struct StaticOrder {
    int nM, nN, nwg, G, c;
    __host__ __device__ void init(int M, int N, int G_, int c_) { nM = M / BM; nN = N / BM; nwg = nM * nN; G = G_; c = c_; }
    __host__ __device__ bool next(int i, Unit& u) const {
        const long L = (long)i * G + c; if (L >= nwg) return false;
        int wgid = (int)L; { const int q = nwg / NXCD, r = nwg % NXCD, xcd = wgid % NXCD, off = wgid / NXCD; wgid = (xcd < r ? xcd * (q + 1) : r * (q + 1) + (xcd - r) * q) + off; }
        const int nig = WGM * nN, gid = wgid / nig, fm = gid * WGM, gsz = (nM - fm) < WGM ? (nM - fm) : WGM;
        u.pm = fm + ((wgid % nig) % gsz); u.pn = (wgid % nig) / gsz; return true;
    }
    __device__ __forceinline__ void a_ready(const Unit&) const {}
    __device__ __forceinline__ void done(const Unit&) const {}
};

__device__ __forceinline__ unsigned cvt_pk_bf16(float lo, float hi) { unsigned r; asm volatile("v_cvt_pk_bf16_f32 %0, %1, %2" : "=v"(r) : "v"(lo), "v"(hi)); return r; }
__device__ __forceinline__ float bf_lo(unsigned w) { return __uint_as_float(w << 16); }
__device__ __forceinline__ float bf_hi(unsigned w) { return __uint_as_float(w & 0xffff0000u); }
__device__ __forceinline__ float sigm(float x) { return __builtin_amdgcn_rcpf(1.0f + __expf(-x)); }
__device__ __forceinline__ f32x4 sigm4(f32x4 v) { return (f32x4){sigm(v[0]), sigm(v[1]), sigm(v[2]), sigm(v[3])}; }
__device__ __forceinline__ u32x4 pack8(f32x4 v0, f32x4 v1) { u32x4 w; w.x = cvt_pk_bf16(v0[0], v0[1]); w.y = cvt_pk_bf16(v0[2], v0[3]); w.z = cvt_pk_bf16(v1[0], v1[1]); w.w = cvt_pk_bf16(v1[2], v1[3]); return w; }
__device__ __forceinline__ void unpack8(u32x4 w, f32x4& v0, f32x4& v1) { v0 = (f32x4){bf_lo(w.x), bf_hi(w.x), bf_lo(w.y), bf_hi(w.y)}; v1 = (f32x4){bf_lo(w.z), bf_hi(w.z), bf_lo(w.w), bf_hi(w.w)}; }
template <int CTRL> __device__ __forceinline__ float dpp_rot(float src) { return __int_as_float(__builtin_amdgcn_mov_dpp(__float_as_int(src), CTRL, 0xF, 0xF, true)); }
template <size_t O_Z3, size_t O_GF, size_t O_GR, size_t O_R, size_t O_EB> struct EpiIn {
    static constexpr bool PERM = true, AFTER_DRAIN = false, HAS_MID = false; static constexpr int KSLICE = 0; static constexpr bool SKIP_B1 = true, HAS_PRE = true;
    static __device__ __forceinline__ bool skip_b1(int pn) { return pn == 7; }
    static constexpr size_t RKV_STRIDE = (size_t)36 * 1024 * 1024 / 2;
    unsigned char* ws; bf16_t* al; const float* mup; const float* mun; PG8_LAS float* xb; int row_off;
    __device__ __forceinline__ void pre(const Unit& u, int ui, int wid, int lane) const {
        if (u.pn >= 8) return;
        const int t = wid * 64 + lane, col = 256 * u.pn + (t & 255);
        const float* src = (t < 256 ? mup : mun) + (col < 1920 ? col : 0);
        __builtin_amdgcn_global_load_lds((const unsigned*)src, (PG8_LAS unsigned*)(xb + 2048 + (ui & 1) * 512 + wid * 64), 4, 0, 0);
    }
    __device__ __forceinline__ void operator()(const f32x4 (&acc)[2][2][4][2], const Unit& u, int wr, int wc, int fr, int fq, int ui) const {
        const int pn = u.pn;
        if (pn >= 8) {
            const int row0 = row_off + u.pm * BM + wr * 64 + fr;
            if (pn < 10) {
                bf16_t* base = (bf16_t*)(ws + O_Z3); const int col0 = (pn - 8) * 256 + wc * 32 + 8 * fq;
#pragma unroll
                for (int ai = 0; ai < 2; ++ai)
#pragma unroll
                    for (int m = 0; m < 4; ++m) { bf16_t* rowp = base + (size_t)(row0 + ai * HALF + m * 16) * 512 + col0;
#pragma unroll
                        for (int bj = 0; bj < 2; ++bj) *(u32x4*)(rowp + bj * HALF) = pack8(acc[ai][bj][m][0], acc[ai][bj][m][1]); }
            } else {
                bf16_t* gq = (bf16_t*)(ws + O_GF); bf16_t* gr = (bf16_t*)(ws + O_GR); const int col0 = (pn - 10) * 128 + wc * 32 + 8 * fq;
#pragma unroll
                for (int ai = 0; ai < 2; ++ai)
#pragma unroll
                    for (int m = 0; m < 4; ++m) { const size_t off = (size_t)(row0 + ai * HALF + m * 16) * 1024 + col0;
                        f32x4 qv[2], sv[2];
#pragma unroll
                        for (int n = 0; n < 2; ++n)
#pragma unroll
                            for (int e = 0; e < 4; ++e) { const float ef = __expf(-acc[ai][0][m][n][e]), er1 = 1.0f + __expf(-acc[ai][1][m][n][e]);
                                sv[n][e] = __builtin_amdgcn_rcpf(er1); qv[n][e] = __builtin_amdgcn_rcpf(1.0f + ef) * fminf(er1, 1e20f); }
                        *(u32x4*)(gq + off) = pack8(qv[0], qv[1]); *(u32x4*)(gr + off) = pack8(sv[0], sv[1]); }
            }
            return;
        }
        asm volatile("" : "+v"(fr), "+v"(fq));
        const int cw = wc * 32 + 8 * fq, tile = (row_off >> 8) + u.pm;
        float* eb = (float*)(ws + O_EB); bf16_t* rkv = (bf16_t*)(ws + O_R);
#pragma unroll
        for (int ai = 0; ai < 2; ++ai)
#pragma unroll
            for (int bj = 0; bj < 2; ++bj)
#pragma unroll
                for (int n = 0; n < 2; ++n) { PG8_LAS float* p0 = xb + ((2 * ai + wr) * 2) * 256 + 128 * bj + cw + 4 * n;
                    if (fr == 0) *(PG8_LAS f32x4*)p0 = acc[ai][bj][0][n];
                    if (fr == 15) *(PG8_LAS f32x4*)(p0 + 256) = acc[ai][bj][3][n]; }
        if (wr == 0 && fr < 2) {
#pragma unroll
            for (int bj = 0; bj < 2; ++bj)
#pragma unroll
                for (int n = 0; n < 2; ++n) *(f32x4*)(eb + ((size_t)tile * 4 + fr) * 2048 + 256 * pn + 128 * bj + cw + 4 * n) = acc[0][bj][0][n]; }
        if (wr == 1 && fr >= 14) {
#pragma unroll
            for (int bj = 0; bj < 2; ++bj)
#pragma unroll
                for (int n = 0; n < 2; ++n) *(f32x4*)(eb + ((size_t)tile * 4 + 2 + (fr - 14)) * 2048 + 256 * pn + 128 * bj + cw + 4 * n) = acc[1][bj][3][n]; }
        asm volatile("s_waitcnt lgkmcnt(0)" ::: "memory"); __builtin_amdgcn_s_barrier(); asm volatile("" ::: "memory");
        bf16_t* dst; int ldd, dcol;
        if (pn < 6) { dst = rkv + (size_t)(pn >> 1) * RKV_STRIDE; ldd = 512; dcol = (pn & 1) * 256; } else { dst = al; ldd = 384; dcol = (pn - 6) * 256; }
#pragma unroll
        for (int bj = 0; bj < 2; ++bj) {
            if (pn == 7 && bj == 1) continue;
            const int act = (pn == 6 && bj == 0) ? 1 : (pn == 7) ? 2 : 0;
            const PG8_LAS float* tab = xb + 2048 + (ui & 1) * 512 + 128 * bj + cw;
            const bool f0 = fr == 0, f15 = fr == 15; const f32x4 z4 = {0.f, 0.f, 0.f, 0.f};
#pragma unroll
            for (int ai = 0; ai < 2; ++ai) { const int q = 2 * ai + wr;
                unsigned pk[4][2][2];
#pragma unroll
                for (int n = 0; n < 2; ++n) {
                    const f32x4 mp = *(const PG8_LAS f32x4*)(tab + 4 * n), mn = *(const PG8_LAS f32x4*)(tab + 256 + 4 * n);
                    const f32x4 w0 = 1.0f - mp - mn, mpA = f0 ? z4 : mp, mpB = f0 ? mp : z4, mnA = f15 ? z4 : mn, mnB = f15 ? mn : z4;
                    f32x4 xp = z4, xn = z4;
                    if (q > 0) xp = *(const PG8_LAS f32x4*)(xb + ((q - 1) * 2 + 1) * 256 + 128 * bj + cw + 4 * n);
                    if (q < 3) xn = *(const PG8_LAS f32x4*)(xb + ((q + 1) * 2) * 256 + 128 * bj + cw + 4 * n);
                    f32x4 R1[4], L1[4];
#pragma unroll
                    for (int m = 0; m < 4; ++m)
#pragma unroll
                        for (int e = 0; e < 4; ++e) { R1[m][e] = dpp_rot<0x121>(acc[ai][bj][m][n][e]); L1[m][e] = dpp_rot<0x12F>(acc[ai][bj][m][n][e]); }
#pragma unroll
                    for (int m = 0; m < 4; ++m) {
                        f32x4 uu = w0 * acc[ai][bj][m][n] + mpA * R1[m] + mpB * (m > 0 ? R1[m > 0 ? m - 1 : 0] : xp) + mnA * L1[m] + mnB * (m < 3 ? L1[m < 3 ? m + 1 : 3] : xn);
                        if (act == 1) uu = 2.0f * sigm4(2.0f * uu) - 1.0f; else if (act == 2) uu = sigm4(uu);
                        pk[m][n][0] = cvt_pk_bf16(uu[0], uu[1]); pk[m][n][1] = cvt_pk_bf16(uu[2], uu[3]); }
                }
#pragma unroll
                for (int m = 0; m < 4; ++m) *(u32x4*)(dst + (size_t)(row_off + u.pm * BM + 128 * ai + 64 * wr + 16 * m + fr) * ldd + dcol + 128 * bj + cw) = (u32x4){pk[m][0][0], pk[m][0][1], pk[m][1][0], pk[m][1][1]};
            }
        }
    }
};
struct EpiLora {
    static constexpr bool PERM = true, AFTER_DRAIN = false, HAS_MID = false; static constexpr int KSLICE = 128; static constexpr bool SKIP_B1 = false, HAS_PRE = false;
    bf16_t* lp; const float* bias;
    static __device__ __forceinline__ int koff(int pn) { const int t = pn >> 1; return t >= 4 ? 256 : (t >= 2 ? 128 : 0); }
    __device__ __forceinline__ void operator()(const f32x4 (&acc)[2][2][4][2], const Unit& u, int wr, int wc, int fr, int fq) const {
        const int pn = u.pn, t = pn >> 1;
        const int row0 = u.pm * BM + wr * 64 + fr, col0 = pn * 256 + wc * 32 + 8 * fq;
        const float sc = t < 2 ? -0.6065306597f : 1.0f;
#pragma unroll
        for (int bj = 0; bj < 2; ++bj) { const f32x4 b0 = *(const f32x4*)(bias + col0 + bj * HALF), b1 = *(const f32x4*)(bias + col0 + bj * HALF + 4);
#pragma unroll
            for (int ai = 0; ai < 2; ++ai)
#pragma unroll
                for (int m = 0; m < 4; ++m) { f32x4 v0 = acc[ai][bj][m][0] + b0, v1 = acc[ai][bj][m][1] + b1;
                    if (t < 4) { v0 = sigm4(v0) * sc; v1 = sigm4(v1) * sc; }
                    *(u32x4*)(lp + (size_t)(row0 + ai * HALF + m * 16) * 2560 + col0 + bj * HALF) = pack8(v0, v1); } }
    }
};
struct EpiMerge2 {
    static constexpr bool PERM = true, AFTER_DRAIN = false, HAS_MID = true; static constexpr int KSLICE = 0; static constexpr bool SKIP_B1 = false, HAS_PRE = false;
    bf16_t* mb; const bf16_t* gf; const bf16_t* gr;
    __device__ __forceinline__ void mid(f32x4 (&acc)[2][2][4][2], const Unit& u, int wr, int wc, int fr, int fq) const {
        asm volatile("" : "+v"(fr), "+v"(fq));
        const int row0 = u.pm * BM + wr * 64 + fr, col0 = u.pn * BM + wc * 32 + 8 * fq;
        constexpr int DEPTH = 8;
        u32x4 fw[DEPTH];
#define PG8_GOFF(it_) ((size_t)(row0 + ((it_) >> 3) * HALF + (((it_) >> 1) & 3) * 16) * 1024 + col0 + ((it_) & 1) * HALF)
#pragma unroll
        for (int d = 0; d < DEPTH; ++d) fw[d] = *(const u32x4*)(gf + PG8_GOFF(d));
#pragma unroll
        for (int it = 0; it < 16; ++it) { const int ai = it >> 3, m = (it >> 1) & 3, bj = it & 1, sl = it % DEPTH;
            const u32x4 fwc = fw[sl];
            asm volatile("" ::: "memory");
            if (it + DEPTH < 16) fw[sl] = *(const u32x4*)(gf + PG8_GOFF(it + DEPTH));
            asm volatile("" ::: "memory");
            acc[ai][bj][m][0][0] *= bf_lo(fwc.x); acc[ai][bj][m][0][1] *= bf_hi(fwc.x); acc[ai][bj][m][0][2] *= bf_lo(fwc.y); acc[ai][bj][m][0][3] *= bf_hi(fwc.y);
            acc[ai][bj][m][1][0] *= bf_lo(fwc.z); acc[ai][bj][m][1][1] *= bf_hi(fwc.z); acc[ai][bj][m][1][2] *= bf_lo(fwc.w); acc[ai][bj][m][1][3] *= bf_hi(fwc.w); }
    }
    __device__ __forceinline__ void operator()(const f32x4 (&acc)[2][2][4][2], const Unit& u, int wr, int wc, int fr, int fq) const {
        const int row0 = u.pm * BM + wr * 64 + fr, col0 = u.pn * BM + wc * 32 + 8 * fq;
        constexpr int DEPTH = 8;
        u32x4 rw[DEPTH];
#pragma unroll
        for (int d = 0; d < DEPTH; ++d) rw[d] = *(const u32x4*)(gr + PG8_GOFF(d));
#pragma unroll
        for (int it = 0; it < 16; ++it) { const int ai = it >> 3, m = (it >> 1) & 3, bj = it & 1, sl = it % DEPTH;
            const u32x4 rwc = rw[sl];
            asm volatile("" ::: "memory");
            if (it + DEPTH < 16) rw[sl] = *(const u32x4*)(gr + PG8_GOFF(it + DEPTH));
            asm volatile("" ::: "memory");
            f32x4 g0, g1; unpack8(rwc, g0, g1);
#pragma unroll
            for (int e = 0; e < 4; ++e) { g0[e] = fmaxf(g0[e], 1e-20f); g1[e] = fmaxf(g1[e], 1e-20f); }
            *(u32x4*)(mb + PG8_GOFF(it)) = pack8(g0 * acc[ai][bj][m][0], g1 * acc[ai][bj][m][1]); }
#undef PG8_GOFF
    }
};
struct EpiResid {
    static constexpr bool PERM = false, AFTER_DRAIN = false, HAS_MID = false; static constexpr int KSLICE = 0; static constexpr bool SKIP_B1 = false, HAS_PRE = false;
    const float* base; float* out; const float* gate;
    __device__ __forceinline__ void operator()(const f32x4 (&acc)[2][2][4][2], const Unit& u, int wr, int wc, int fr, int fq) const {
        const int row0 = u.pm * BM + wr * 64 + fr, col0 = u.pn * BM + wc * 32 + 4 * fq; const float* gp = gate + (size_t)(u.pm >> 3) * 6144 + col0;
        f32x4 gv[2][2];
#pragma unroll
        for (int bj = 0; bj < 2; ++bj)
#pragma unroll
            for (int n = 0; n < 2; ++n) gv[bj][n] = *(const f32x4*)(gp + bj * HALF + n * 16);
        f32x4 cur[2][2], nxt[2][2];
#pragma unroll
        for (int bj = 0; bj < 2; ++bj)
#pragma unroll
            for (int n = 0; n < 2; ++n) cur[bj][n] = *(const f32x4*)(base + (size_t)row0 * 1024 + col0 + bj * HALF + n * 16);
#pragma unroll
        for (int g8 = 0; g8 < 8; ++g8) { const int ai = g8 >> 2, m = g8 & 3; const size_t off = (size_t)(row0 + ai * HALF + m * 16) * 1024 + col0;
            if (g8 + 1 < 8) { const int ai2 = (g8 + 1) >> 2, m2 = (g8 + 1) & 3; const size_t off2 = (size_t)(row0 + ai2 * HALF + m2 * 16) * 1024 + col0;
#pragma unroll
                for (int bj = 0; bj < 2; ++bj)
#pragma unroll
                    for (int n = 0; n < 2; ++n) nxt[bj][n] = *(const f32x4*)(base + off2 + bj * HALF + n * 16); }
            asm volatile("" ::: "memory");
#pragma unroll
            for (int bj = 0; bj < 2; ++bj)
#pragma unroll
                for (int n = 0; n < 2; ++n) *(f32x4*)(out + off + bj * HALF + n * 16) = cur[bj][n] + gv[bj][n] * acc[ai][bj][m][n];
            asm volatile("" ::: "memory");
#pragma unroll
            for (int bj = 0; bj < 2; ++bj)
#pragma unroll
                for (int n = 0; n < 2; ++n) cur[bj][n] = nxt[bj][n];
        }
    }
};
struct EpiDelta {
    static constexpr bool PERM = true, AFTER_DRAIN = false, HAS_MID = false; static constexpr int KSLICE = 0; static constexpr bool SKIP_B1 = false, HAS_PRE = false;
    bf16_t* dlt; const float* gate;
    __device__ __forceinline__ void operator()(const f32x4 (&acc)[2][2][4][2], const Unit& u, int wr, int wc, int fr, int fq) const {
        const int row0 = u.pm * BM + wr * 64 + fr, col0 = u.pn * BM + wc * 32 + 8 * fq; const float* gp = gate + (size_t)(u.pm >> 3) * 6144 + col0;
        f32x4 gv[2][2];
#pragma unroll
        for (int bj = 0; bj < 2; ++bj)
#pragma unroll
            for (int n = 0; n < 2; ++n) gv[bj][n] = *(const f32x4*)(gp + bj * HALF + 4 * n);
#pragma unroll
        for (int ai = 0; ai < 2; ++ai)
#pragma unroll
            for (int m = 0; m < 4; ++m) { bf16_t* rowp = dlt + (size_t)(row0 + ai * HALF + m * 16) * 1024 + col0;
#pragma unroll
                for (int bj = 0; bj < 2; ++bj) *(u32x4*)(rowp + bj * HALF) = pack8(acc[ai][bj][m][0] * gv[bj][0], acc[ai][bj][m][1] * gv[bj][1]); }
    }
};
struct EpiSwiglu {
    static constexpr bool PERM = true, AFTER_DRAIN = false, HAS_MID = false; static constexpr int KSLICE = 0; static constexpr bool SKIP_B1 = false, HAS_PRE = false;
    bf16_t* act;
    __device__ __forceinline__ void operator()(const f32x4 (&acc)[2][2][4][2], const Unit& u, int wr, int wc, int fr, int fq) const {
        const int row0 = u.pm * BM + wr * 64 + fr, col0 = u.pn * 128 + wc * 32 + 8 * fq;
#pragma unroll
        for (int ai = 0; ai < 2; ++ai)
#pragma unroll
            for (int m = 0; m < 4; ++m) { const f32x4 g0 = acc[ai][0][m][0], g1 = acc[ai][0][m][1];
                *(u32x4*)(act + (size_t)(row0 + ai * HALF + m * 16) * 2816 + col0) = pack8(g0 * sigm4(g0) * acc[ai][1][m][0], g1 * sigm4(g1) * acc[ai][1][m][1]); }
    }
};

template <class Epi, class Sched, bool ALIGN_EPI = false, bool SP2 = false>
__device__ __forceinline__ void gemm_phase(PG8_LAS unsigned char* lds, const Gemm g, const Sched& S, const Epi& E) {
    int tid_ = threadIdx.x; asm volatile("" : "+v"(tid_));
    const int tid = tid_, wid = __builtin_amdgcn_readfirstlane(tid >> 6), lane = tid & 63, wr = wid >> 2, wc = wid & 3, fr = lane & 15, fq = lane >> 4;
    int nt_ = Epi::KSLICE ? Epi::KSLICE / BK : g.K / BK; asm volatile("" : "+s"(nt_));
    const int K = g.K, nt = nt_;
    unsigned voffA[2], voffB[2];
#pragma unroll
    for (int i = 0; i < 2; ++i) { int R, C; stage_rc(tid * 16 + i * 8192, R, C); const int Rb = Epi::PERM ? ((R & ~31) + perm32(R & 31)) : R;
        voffA[i] = (unsigned)(R * K + C) * 2u; voffB[i] = (unsigned)(Rb * K + C) * 2u; }
    const size_t kstep = (size_t)(BK * 2);
    const size_t hstep = (size_t)HALF * K * 2;
    const size_t tstep = 2 * hstep;
    const unsigned ldsw = (unsigned)wid * 1024u;
    const int aoff = lds_byte(wr * 64 + fr, fq * 8), boff = lds_byte(wc * 32 + fr, fq * 8);
#define PG8_SA(b, h) (((b) * 2 + (h)) * HTB)
#define PG8_SB(b, h) ((4 + (b) * 2 + (h)) * HTB)
#define PG8_STAGE(bufoff, gbase, voff) do { _Pragma("unroll") for (int _i = 0; _i < 2; ++_i) \
        __builtin_amdgcn_global_load_lds((const unsigned*)((const char*)(gbase) + (voff)[_i]), (PG8_LAS unsigned*)(lds + (bufoff) + ldsw + _i * 8192), 16, 0, 0); } while (0)
#define PG8_LDA(dst, b, h) do { _Pragma("unroll") for (int m = 0; m < 4; ++m) _Pragma("unroll") for (int k = 0; k < 2; ++k) dst[m][k] = *(const PG8_LAS bf16x8*)(lds + PG8_SA(b, h) + aoff + m * 2048 + k * 1024); } while (0)
#define PG8_LDB(dst, b, h) do { _Pragma("unroll") for (int n = 0; n < 2; ++n) _Pragma("unroll") for (int k = 0; k < 2; ++k) dst[n][k] = *(const PG8_LAS bf16x8*)(lds + PG8_SB(b, h) + boff + n * 2048 + k * 1024); } while (0)
#define PG8_MMA(ai, bj, At, Bt) do { __builtin_amdgcn_s_setprio(1); _Pragma("unroll") for (int m = 0; m < 4; ++m) _Pragma("unroll") for (int n = 0; n < 2; ++n) _Pragma("unroll") for (int k = 0; k < 2; ++k) \
        acc[ai][bj][m][n] = __builtin_amdgcn_mfma_f32_16x16x32_bf16(Bt[n][k], At[m][k], acc[ai][bj][m][n], 0, 0, 0); __builtin_amdgcn_s_setprio(0); } while (0)
#define PG8_MMA1(ai, At) do { if constexpr (Epi::SKIP_B1) { if (!skb) PG8_MMA(ai, 1, At, B1); } else PG8_MMA(ai, 1, At, B1); } while (0)
#define PG8_WAIT_V(n) asm volatile("s_waitcnt vmcnt(" #n ")" ::: "memory")
#define PG8_WAIT_L(n) asm volatile("s_waitcnt lgkmcnt(" #n ")" ::: "memory")
#define PG8_BAR __builtin_amdgcn_s_barrier()
#define PG8_SCHED __builtin_amdgcn_sched_barrier(0)
    Unit cur, nxt; int ui = 0;
    if (!S.next(0, cur)) return;
    bool skb = false; if constexpr (Epi::SKIP_B1) skb = Epi::skip_b1(cur.pn);
    if constexpr (Epi::HAS_PRE) E.pre(cur, 0, wid, lane);
    f32x4 acc[2][2][4][2];
#pragma unroll
    for (int a = 0; a < 2; ++a)
#pragma unroll
        for (int b = 0; b < 2; ++b)
#pragma unroll
            for (int m = 0; m < 4; ++m)
#pragma unroll
                for (int n = 0; n < 2; ++n) acc[a][b][m][n] = (f32x4){0.f, 0.f, 0.f, 0.f};
    bf16x8 At[4][2], B0[2][2], B1[2][2];
    const char* cA = (const char*)g.A + (size_t)cur.pm * tstep; const char* cB = (const char*)g.Bt + (size_t)cur.pn * tstep;
    if constexpr (Epi::KSLICE != 0) { const int ko = Epi::koff(cur.pn) * 2; cA += ko; cB += ko; }
    S.a_ready(cur);
    if constexpr (SP2) {
        PG8_STAGE(PG8_SB(0, 0), cB, voffB); PG8_STAGE(PG8_SB(0, 1), cB + hstep, voffB); PG8_STAGE(PG8_SA(0, 0), cA, voffA); PG8_STAGE(PG8_SA(0, 1), cA + hstep, voffA);
        if (wr == 1) PG8_BAR;
        PG8_WAIT_V(2); PG8_BAR;
        PG8_STAGE(PG8_SB(1, 0), cB + kstep, voffB); PG8_STAGE(PG8_SA(1, 0), cA + kstep, voffA); PG8_STAGE(PG8_SB(1, 1), cB + hstep + kstep, voffB);
        PG8_WAIT_V(6); PG8_BAR;
    } else {
        PG8_STAGE(PG8_SB(0, 0), cB, voffB); PG8_STAGE(PG8_SA(0, 0), cA, voffA); PG8_STAGE(PG8_SB(0, 1), cB + hstep, voffB); PG8_STAGE(PG8_SA(0, 1), cA + hstep, voffA);
        if (wr == 1) PG8_BAR;
        PG8_WAIT_V(4); PG8_BAR;
        PG8_STAGE(PG8_SB(1, 0), cB + kstep, voffB); PG8_STAGE(PG8_SA(1, 0), cA + kstep, voffA); PG8_STAGE(PG8_SB(1, 1), cB + hstep + kstep, voffB);
        PG8_WAIT_V(6); PG8_BAR;
    }
    for (;;) {
        const bool has_next = S.next(ui + 1, nxt);
        const char* nA = has_next ? (const char*)g.A + (size_t)nxt.pm * tstep : cA; const char* nB = has_next ? (const char*)g.Bt + (size_t)nxt.pn * tstep : cB;
        if constexpr (Epi::KSLICE != 0) { if (has_next) { const int ko = Epi::koff(nxt.pn) * 2; nA += ko; nB += ko; } }
#pragma unroll 1
        for (int t = 0; t < nt; t += 2) {
            const bool last = (t == nt - 2);
            const char* a1 = cA + (size_t)(t + 1) * kstep;
            const char* a2 = last ? nA : cA + (size_t)(t + 2) * kstep; const char* b2 = last ? nB : cB + (size_t)(t + 2) * kstep;
            const char* a3 = a2 + kstep; const char* b3 = b2 + kstep;
            if (last && has_next) S.a_ready(nxt);
            if constexpr (SP2) {
            PG8_LDB(B0, 0, 0); PG8_LDB(B1, 0, 1); PG8_SCHED; PG8_LDA(At, 0, 0); PG8_STAGE(PG8_SA(1, 1), a1 + hstep, voffA);
            PG8_WAIT_V(8); PG8_WAIT_L(0); PG8_BAR; PG8_MMA(0, 0, At, B0); PG8_MMA1(0, At); PG8_BAR; PG8_SCHED;
            PG8_LDA(At, 0, 1); PG8_STAGE(PG8_SB(0, 0), b2, voffB); PG8_STAGE(PG8_SB(0, 1), b2 + hstep, voffB); PG8_STAGE(PG8_SA(0, 0), a2, voffA);
            PG8_WAIT_V(8); PG8_WAIT_L(0); PG8_BAR; PG8_MMA(1, 0, At, B0); PG8_MMA1(1, At); PG8_BAR; PG8_SCHED;
            PG8_LDB(B0, 1, 0); PG8_LDB(B1, 1, 1); PG8_SCHED; PG8_LDA(At, 1, 0); PG8_STAGE(PG8_SA(0, 1), a2 + hstep, voffA);
            PG8_WAIT_V(8); PG8_WAIT_L(0); PG8_BAR; PG8_MMA(0, 0, At, B0); PG8_MMA1(0, At); PG8_BAR; PG8_SCHED;
            PG8_LDA(At, 1, 1); PG8_STAGE(PG8_SB(1, 0), b3, voffB); PG8_STAGE(PG8_SB(1, 1), b3 + hstep, voffB); PG8_STAGE(PG8_SA(1, 0), a3, voffA);
            PG8_WAIT_V(8); PG8_WAIT_L(0); PG8_BAR; PG8_MMA(1, 0, At, B0); PG8_MMA1(1, At); PG8_BAR; PG8_SCHED;
            } else {
            PG8_LDB(B0, 0, 0); PG8_SCHED; PG8_LDA(At, 0, 0); PG8_STAGE(PG8_SA(1, 1), a1 + hstep, voffA);
            PG8_WAIT_L(8); PG8_BAR; PG8_WAIT_L(0); PG8_MMA(0, 0, At, B0); PG8_BAR; PG8_SCHED;
            PG8_LDB(B1, 0, 1); PG8_STAGE(PG8_SB(0, 0), b2, voffB);
            PG8_BAR; PG8_WAIT_L(0); PG8_MMA(0, 1, At, B1); PG8_BAR;
            PG8_LDA(At, 0, 1); PG8_STAGE(PG8_SA(0, 0), a2, voffA);
            PG8_BAR; PG8_WAIT_L(0); PG8_MMA(1, 0, At, B0); PG8_BAR; PG8_SCHED;
            PG8_STAGE(PG8_SB(0, 1), b2 + hstep, voffB);
            PG8_WAIT_V(6); PG8_BAR; PG8_MMA(1, 1, At, B1); PG8_BAR;
            PG8_LDB(B0, 1, 0); PG8_SCHED; PG8_LDA(At, 1, 0); PG8_STAGE(PG8_SA(0, 1), a2 + hstep, voffA);
            PG8_WAIT_L(8); PG8_BAR; PG8_WAIT_L(0); PG8_MMA(0, 0, At, B0); PG8_BAR; PG8_SCHED;
            PG8_LDB(B1, 1, 1); PG8_STAGE(PG8_SB(1, 0), b3, voffB);
            PG8_BAR; PG8_WAIT_L(0); PG8_MMA(0, 1, At, B1); PG8_BAR;
            PG8_LDA(At, 1, 1); PG8_STAGE(PG8_SA(1, 0), a3, voffA);
            PG8_BAR; PG8_WAIT_L(0); PG8_MMA(1, 0, At, B0); PG8_BAR; PG8_SCHED;
            PG8_STAGE(PG8_SB(1, 1), b3 + hstep, voffB);
            PG8_WAIT_V(6); PG8_BAR; PG8_MMA(1, 1, At, B1); PG8_BAR;
            }
            if constexpr (Epi::HAS_MID) { if (t == (nt >> 1) - 2) {
                if constexpr (ALIGN_EPI) { if (wr == 0) PG8_BAR; }
                E.mid(acc, cur, wr, wc, fr, fq);
                if constexpr (ALIGN_EPI) { if (wr == 1) PG8_BAR; } } }
        }
        if constexpr (ALIGN_EPI) { if (wr == 0) PG8_BAR; }
        if constexpr (!Epi::AFTER_DRAIN) { if constexpr (Epi::HAS_PRE) E(acc, cur, wr, wc, fr, fq, ui); else E(acc, cur, wr, wc, fr, fq); S.done(cur); }
        if (!has_next) break;
#pragma unroll
        for (int a = 0; a < 2; ++a)
#pragma unroll
            for (int b = 0; b < 2; ++b)
#pragma unroll
                for (int m = 0; m < 4; ++m)
#pragma unroll
                    for (int n = 0; n < 2; ++n) acc[a][b][m][n] = (f32x4){0.f, 0.f, 0.f, 0.f};
        cur = nxt; cA = nA; cB = nB; ++ui; if constexpr (Epi::SKIP_B1) skb = Epi::skip_b1(cur.pn);
        if constexpr (Epi::HAS_PRE) E.pre(cur, ui, wid, lane);
        if constexpr (ALIGN_EPI) { if (wr == 1) PG8_BAR; }
    }
    PG8_WAIT_V(0);
    if constexpr (!ALIGN_EPI) { if (wr == 0) PG8_BAR; }
    PG8_BAR;
    if constexpr (Epi::AFTER_DRAIN) { E.fused(acc, cur, wr, wc, fr, fq, lds, wid, lane); S.done(cur); }
#undef PG8_SA
#undef PG8_SB
#undef PG8_STAGE
#undef PG8_LDA
#undef PG8_LDB
#undef PG8_MMA
#undef PG8_MMA1
#undef PG8_WAIT_V
#undef PG8_WAIT_L
#undef PG8_BAR
#undef PG8_SCHED
}
}
constexpr int NWAVES = 8;
constexpr int N_LAUNCHES = MK_N_LAUNCHES;
constexpr int NPH = 16;
constexpr int D = 1024, NB = 16, SEQ = 2048, CTXL = 256, MX = NB * SEQ, MC = NB * CTXL, MT = MX + MC;
constexpr int RW = 512, NH = 8, HD = 64, RCOLS = 1920, RPAD = 2048, INCOLS = 4480, NIN = 4608, DFF = 2816, LK = 384, LN = 2560, MODW = 6144;
constexpr float NORM_EPS = 1e-6f, GN_EPS = 64e-5f;
constexpr size_t MiB = 1u << 20;
constexpr size_t WS_CTL = 0, CTL_ZERO_BYTES = 64 * 1024;
constexpr size_t WS_MOD = 1 * MiB, WS_LB = WS_MOD + 512 * 1024;
constexpr size_t WS_WIN = 2 * MiB, WS_WLORA = 12 * MiB, WS_WUPF = 14 * MiB, WS_WUPR = 15 * MiB, WS_WOUT = 16 * MiB;
constexpr size_t WS_A = 18 * MiB, WS_B = 82 * MiB, WS_C = 146 * MiB, WS_D = 210 * MiB, WS_E = 390 * MiB, WS_END = 512 * MiB;
constexpr size_t WS_GF = WS_A, WS_HX2 = WS_A, WS_GR = WS_B, WS_WGU = WS_E, WS_WDOWN = WS_E + 11 * MiB, WS_D1 = WS_B, WS_D2 = WS_A;
constexpr size_t WS_Z3 = WS_C, WS_FXO = WS_C;
constexpr size_t WS_PXR = WS_D, WS_LP = WS_D, WS_MB = WS_D, WS_ACT = WS_D;
constexpr size_t WS_EB = WS_E + 114 * MiB;
constexpr size_t WS_HX = WS_D, WS_Y2 = WS_E, WS_R = WS_E, WS_K = WS_E + 36 * MiB, WS_V = WS_E + 72 * MiB, WS_SBT = WS_E + 110 * MiB;
static_assert(WS_K - WS_R == 36 * MiB && WS_V - WS_K == 36 * MiB, "EpiIn::RKV_STRIDE");
static_assert(WS_LP + (size_t)MT * LN * 2 <= WS_E && WS_ACT + (size_t)MX * DFF * 2 <= WS_E && WS_V + (size_t)MT * RW * 2 <= WS_END && WS_HX + (size_t)MT * D * 2 <= WS_END, "d_ws map");
constexpr int CW_TMO = 0, CW_BAR = 4096, CW_BADMAP = 8192;
constexpr int RING_OFF = 0, RING_BYTES = 131072, LDSCTL_OFF = RING_BYTES, MISC_OFF = LDSCTL_OFF + 320, LDS_BYTES = 147456;
constexpr int XB_OFF = RING_BYTES + 4096;

#define GAS __attribute__((address_space(1)))
#define LAS __attribute__((address_space(3)))
typedef unsigned short bf16;
typedef unsigned v4u __attribute__((ext_vector_type(4)));
typedef unsigned v2u __attribute__((ext_vector_type(2)));
typedef float f32x4 __attribute__((ext_vector_type(4)));
typedef GAS unsigned gu32;
#define RLX_AGENT __ATOMIC_RELAXED, __HIP_MEMORY_SCOPE_AGENT
#define LDS_WAIT() asm volatile("s_waitcnt lgkmcnt(0)" ::: "memory")
#define VM_WAIT() asm volatile("s_waitcnt vmcnt(0)" ::: "memory")
__device__ __forceinline__ unsigned f2bf(float f) { unsigned u = __builtin_bit_cast(unsigned, f); return (u + 0x7fffu + ((u >> 16) & 1u)) >> 16; }
__device__ __forceinline__ unsigned pk2(float lo, float hi) { return f2bf(lo) | (f2bf(hi) << 16); }
__device__ __forceinline__ float bflo(unsigned w) { return __uint_as_float(w << 16); }
__device__ __forceinline__ float bfhi(unsigned w) { return __uint_as_float(w & 0xffff0000u); }
__device__ __forceinline__ float sigf(float x) { return 1.0f / (1.0f + __expf(-x)); }
__device__ __forceinline__ void unpk8(v4u w, float (&f)[8]) { f[0] = bflo(w.x); f[1] = bfhi(w.x); f[2] = bflo(w.y); f[3] = bfhi(w.y); f[4] = bflo(w.z); f[5] = bfhi(w.z); f[6] = bflo(w.w); f[7] = bfhi(w.w); }
__device__ __forceinline__ v4u pk8(const float (&f)[8]) { v4u o; o.x = pk2(f[0], f[1]); o.y = pk2(f[2], f[3]); o.z = pk2(f[4], f[5]); o.w = pk2(f[6], f[7]); return o; }

#define XB_TMO      128
#define XB_XCNT(j)  (256  + 64 * (j))
#define XB_XSUB(j)  (1280 + 64 * (j))
#define XB_XGEN(j)  (2304 + 64 * (j))
#define XB_TOP      3328
#define XB_TOPGEN   3392
#define XCD_BAR_WORDS 3456
#define XB_SPIN_CAP (1u << 18)

__device__ __forceinline__ unsigned xb_ld(unsigned* p)              { return __hip_atomic_load(p, __ATOMIC_RELAXED, __HIP_MEMORY_SCOPE_AGENT); }
__device__ __forceinline__ unsigned xb_add(unsigned* p, unsigned v) { return __hip_atomic_fetch_add(p, v, __ATOMIC_RELAXED, __HIP_MEMORY_SCOPE_AGENT); }
__device__ __forceinline__ unsigned xb_xcc_id() { return (unsigned)__builtin_amdgcn_s_getreg((3 << 11) | 20) & 0xFu; }
#define XB_SPIN(cond, bar) do { unsigned _sp = 0; while (cond) { __builtin_amdgcn_s_sleep(1); \
    if ((++_sp & 255u) == 0u) { if (xb_ld(&(bar)[XB_TMO])) break; if (_sp > XB_SPIN_CAP) { atomicAdd(&(bar)[XB_TMO], 1u); break; } } } } while (0)

struct XcdBarrier {
    unsigned* bar; unsigned x;
    volatile LAS unsigned* st;
};

__device__ __forceinline__ XcdBarrier xcd_barrier_post(unsigned* bar, volatile LAS unsigned* st) {
    XcdBarrier b; b.bar = bar; b.x = xb_xcc_id(); b.st = st;
    if (threadIdx.x == 0) (void)xb_add(&bar[XB_XCNT(b.x)], 1u);
    return b;
}
__device__ __forceinline__ void xcd_barrier_complete(unsigned* bar, unsigned x, unsigned& nloc, unsigned& nx) {
    const unsigned G = gridDim.x * gridDim.y * gridDim.z;
    unsigned sum, cnt, mine, sp = 0u;
    for (;;) {
        sum = 0u; cnt = 0u; mine = 0u;
#pragma unroll
        for (unsigned j = 0; j < 16; ++j) { const unsigned c = xb_ld(&bar[XB_XCNT(j)]); sum += c; cnt += (c > 0u) ? 1u : 0u; mine = (j == x) ? c : mine; }
        if (sum == G) break;
        __builtin_amdgcn_s_sleep(1);
        if ((++sp & 255u) == 0u) { if (xb_ld(&bar[XB_TMO])) break; if (sp > XB_SPIN_CAP) { atomicAdd(&bar[XB_TMO], 1u); break; } }
    }
    nloc = mine > 0u ? mine : 1u; nx = cnt > 0u ? cnt : 1u;
}

__device__ __forceinline__ void xcd_barrier(const XcdBarrier& b) {
    asm volatile("s_waitcnt vmcnt(0)" ::: "memory");
    __syncthreads();
    if (threadIdx.x == 0) {
        unsigned* bar = b.bar;
        __builtin_amdgcn_s_waitcnt(0);
        unsigned nloc = b.st[0], nx = b.st[1];
        if (nloc == 0u) { xcd_barrier_complete(bar, b.x, nloc, nx); b.st[0] = nloc; b.st[1] = nx; }
        const unsigned old = xb_add(&bar[XB_XSUB(b.x)], 1u);
        const unsigned gen = old / nloc;
        if (old + 1u == (gen + 1u) * nloc) {
            __builtin_amdgcn_fence(__ATOMIC_RELEASE, "agent");
            asm volatile("s_waitcnt vmcnt(0)" ::: "memory");
            const unsigned og = xb_add(&bar[XB_TOP], 1u);
            const unsigned tg = og / nx;
            if (og + 1u == (tg + 1u) * nx) xb_add(&bar[XB_TOPGEN], 1u);
            else XB_SPIN(xb_ld(&bar[XB_TOPGEN]) == tg, bar);
            __builtin_amdgcn_fence(__ATOMIC_ACQUIRE, "agent");
            xb_add(&bar[XB_XGEN(b.x)], 1u);
            asm volatile("s_waitcnt vmcnt(0)" ::: "memory");
        } else {
            XB_SPIN(xb_ld(&bar[XB_XGEN(b.x)]) == gen, bar);
            __builtin_amdgcn_fence(__ATOMIC_ACQUIRE, "agent");
            asm volatile("s_waitcnt vmcnt(0)" ::: "memory");
        }
    }
    __syncthreads();
}
__device__ __forceinline__ void xcd_barrier_local(const XcdBarrier& b) {
    asm volatile("s_waitcnt vmcnt(0)" ::: "memory");
    __syncthreads();
    if (threadIdx.x == 0) {
        unsigned* bar = b.bar;
        __builtin_amdgcn_s_waitcnt(0);
        const unsigned nloc = b.st[0] ? b.st[0] : 1u;
        const unsigned old = xb_add(&bar[XB_XSUB(b.x)], 1u);
        const unsigned gen = old / nloc;
        if (old + 1u == (gen + 1u) * nloc) (void)xb_add(&bar[XB_XGEN(b.x)], 1u);
        else XB_SPIN(xb_ld(&bar[XB_XGEN(b.x)]) == gen, bar);
        __builtin_amdgcn_fence(__ATOMIC_ACQUIRE, "agent");
        asm volatile("s_waitcnt vmcnt(0)" ::: "memory");
    }
    __syncthreads();
}
struct Args { const float* in[31]; float* out; unsigned char* ws; int ph_lo, ph_hi, li, pad; };
enum In { I_X = 0, I_C, I_CTX, I_CCTX, I_N1G, I_N2G, I_WADA, I_BADA, I_WIN, I_MUP, I_MUN, I_W0F, I_W2F, I_A0F, I_A2F, I_W0B, I_W2B, I_A0B, I_A2B, I_G2, I_KK, I_KA, I_RK, I_LNG, I_LNB, I_WUPR, I_WUPF, I_WOUT, I_WGU, I_WDOWN, I_FNG };
struct Frame { LAS unsigned char* lds; volatile LAS unsigned* MISC; gu32* ctl; int tid, lane, wave, vcu, G; };

__device__ __forceinline__ void refresh_tid(Frame& F) { int t = threadIdx.x; asm volatile("" : "+v"(t)); F.tid = t; F.lane = t & 63; }
__device__ __forceinline__ float wave_sum(float v) {
#pragma unroll
    for (int o = 1; o < 64; o <<= 1) v += __shfl_xor(v, o);
    return v;
}
__device__ __forceinline__ float red8(float v) { v += __shfl_xor(v, 1); v += __shfl_xor(v, 2); v += __shfl_xor(v, 4); return v; }

__device__ __forceinline__ void tr_item(const float* W, int ldw, int k0, int n0, bf16* WTrow0, int ldk, LAS float* scr, int lane) {
    float tv[32];
#pragma unroll
    for (int i = 0; i < 32; ++i) tv[i] = __builtin_nontemporal_load(W + (size_t)(k0 + 2 * i + (lane >> 5)) * ldw + n0 + (lane & 31));
#pragma unroll
    for (int i = 0; i < 32; ++i) scr[(2 * i + (lane >> 5)) * 33 + (lane & 31)] = tv[i];
    LDS_WAIT(); asm volatile("" ::: "memory");
    const int c = lane & 7;
#pragma unroll
    for (int j = 0; j < 4; ++j) { const int n = (lane >> 3) + 8 * j; const LAS float* s = scr + (8 * c) * 33 + n;
        v4u o; o.x = pk2(s[0 * 33], s[1 * 33]); o.y = pk2(s[2 * 33], s[3 * 33]); o.z = pk2(s[4 * 33], s[5 * 33]); o.w = pk2(s[6 * 33], s[7 * 33]);
        *(GAS v4u*)(WTrow0 + (size_t)n * ldk + k0 + 8 * c) = o; }
    LDS_WAIT(); asm volatile("" ::: "memory");
}

__device__ __forceinline__ void p0_weights(const Frame& F, const Args& a) {
    unsigned char* ws = a.ws;
    bf16* Win_t = (bf16*)(ws + WS_WIN); bf16* Wlora_t = (bf16*)(ws + WS_WLORA); bf16* Wupf_t = (bf16*)(ws + WS_WUPF); bf16* Wupr_t = (bf16*)(ws + WS_WUPR); bf16* Wout_t = (bf16*)(ws + WS_WOUT);
    LAS float* scr = (LAS float*)(F.lds + RING_OFF + F.wave * 16384);
    const int gw = F.vcu * NWAVES + F.wave, NGW = F.G * NWAVES, lane = F.lane;
    constexpr int E0 = 960, E1 = E0 + 1280, E2 = E1 + 256, E3 = E2 + 256, E4 = E3 + 512, E5 = E4 + 128, E6 = E5 + 2560;
    for (int it = gw; it < E6; it += NGW) {
        if (it < E0) { const int kb = it / 60, nb = it % 60; tr_item(a.in[I_WIN], INCOLS, 64 * kb, 32 * nb, Win_t + (size_t)(32 * nb) * D, D, scr, lane); }
        else if (it < E1) { const int r = it - E0, kb = r / 80, nb = r % 80;
            int drow = 2048 + 32 * nb; if (nb >= 16) { const int gj = 32 * ((nb - 16) & 31); drow = 2560 + (gj >> 7) * 256 + (gj & 127) + (nb >= 48 ? 128 : 0); }
            tr_item(a.in[I_WIN] + 1920, INCOLS, 64 * kb, 32 * nb, Win_t + (size_t)drow * D, D, scr, lane); }
        else if (it < E2) { const int r = it - E1, kb = r >> 5, nb = r & 31; tr_item(a.in[I_WUPF], D, 64 * kb, 32 * nb, Wupf_t + (size_t)(32 * nb) * 1024, 1024, scr, lane); }
        else if (it < E3) { const int r = it - E2, kb = r >> 5, nb = r & 31; tr_item(a.in[I_WUPR], D, 64 * kb, 32 * nb, Wupf_t + (size_t)(32 * nb) * 1024 + 512, 1024, scr, lane); }
        else if (it < E4) { const int r = it - E3, kb = r >> 5, nb = r & 31; tr_item(a.in[I_WOUT], D, 64 * kb, 32 * nb, Wout_t + (size_t)(32 * nb) * D, D, scr, lane); }
        else if (it < E5) { const int row = RCOLS + (it - E4); GAS v4u* p = (GAS v4u*)(Win_t + (size_t)row * D + 16 * lane); p[0] = (v4u){0u, 0u, 0u, 0u}; p[1] = (v4u){0u, 0u, 0u, 0u}; }
        else { const int n = it - E5, t = n >> 9, nn = n & 511, koff = t < 4 ? 64 * t : 256, klen = t < 4 ? 64 : 128;
            const float* src = t == 0 ? a.in[I_W2F] : t == 1 ? a.in[I_W2B] : t == 2 ? a.in[I_A2F] : t == 3 ? a.in[I_A2B] : a.in[I_G2];
            float v[6];
#pragma unroll
            for (int e = 0; e < 6; ++e) { const int kk = 6 * lane + e - koff; v[e] = (kk >= 0 && kk < klen) ? src[(size_t)kk * 512 + nn] : 0.f; }
            GAS unsigned* p = (GAS unsigned*)(Wlora_t + (size_t)n * LK + 6 * lane); p[0] = pk2(v[0], v[1]); p[1] = pk2(v[2], v[3]); p[2] = pk2(v[4], v[5]); }
    }
    if (blockIdx.x == 0) { float* LB = (float*)(a.ws + WS_LB);
        for (int i = F.tid; i < LN; i += NWAVES * 64) { const int t = i >> 9, nn = i & 511; LB[i] = t == 0 ? a.in[I_W0F][nn] : t == 1 ? a.in[I_W0B][nn] : t == 2 ? a.in[I_A0F][nn] : t == 3 ? a.in[I_A0B][nn] : 0.f; } }
    __syncthreads();
    LAS float* L = (LAS float*)(F.lds + RING_OFF);
    for (int it = blockIdx.x; it < 192; it += F.G) {
        {
            const int n0 = it * 32;
            LAS float* sc = L; LAS float* red = L + 17 * 1024;
            for (int idx = F.tid; idx < 17 * 1024; idx += 512) { const int b = idx >> 10, k = idx & 1023; const float cv = b < 16 ? a.in[I_C][b * 1024 + k] : a.in[I_CCTX][k]; sc[idx] = cv * sigf(cv); }
            __syncthreads();
            const int col = F.tid & 31, ks = F.tid >> 5;
            float acc[17];
#pragma unroll
            for (int b = 0; b < 17; ++b) acc[b] = 0.f;
            for (int k8 = 0; k8 < 64; k8 += 16) { float wv[16];
#pragma unroll
                for (int j = 0; j < 16; ++j) wv[j] = __builtin_nontemporal_load(a.in[I_WADA] + (size_t)(ks * 64 + k8 + j) * MODW + n0 + col);
#pragma unroll
                for (int j = 0; j < 16; ++j) { const int k = ks * 64 + k8 + j;
#pragma unroll
                    for (int b = 0; b < 17; ++b) acc[b] += sc[b * 1024 + k] * wv[j]; } }
#pragma unroll
            for (int b = 0; b < 17; ++b) red[(ks * 17 + b) * 32 + col] = acc[b];
            __syncthreads();
            for (int o = F.tid; o < 17 * 32; o += NWAVES * 64) { const int b = o >> 5, c2 = o & 31; float s = a.in[I_BADA][n0 + c2];
                for (int k2 = 0; k2 < 16; ++k2) s += red[(k2 * 17 + b) * 32 + c2];
                ((float*)(a.ws + WS_MOD))[b * MODW + n0 + c2] = s; }
            __syncthreads();
        }
    }
}
__device__ __forceinline__ void p_weights2(const Frame& F, const Args& a) {
    bf16* Wgu_t = (bf16*)(a.ws + WS_WGU); bf16* Wdown_t = (bf16*)(a.ws + WS_WDOWN);
    LAS float* scr = (LAS float*)(F.lds + RING_OFF + F.wave * 16384);
    const int gw = F.vcu * NWAVES + F.wave, NGW = F.G * NWAVES;
    for (int it = gw; it < 2816 + 1408; it += NGW) {
        if (it < 2816) { const int kb = it / 176, nb = it % 176, n0 = 32 * nb; const int np = n0 < DFF ? n0 : n0 - DFF; const int drow = (np >> 7) * 256 + (np & 127) + (n0 < DFF ? 0 : 128);
            tr_item(a.in[I_WGU], 2 * DFF, 64 * kb, n0, Wgu_t + (size_t)drow * D, D, scr, F.lane); }
        else { const int r = it - 2816, kb = r >> 5, nb = r & 31; tr_item(a.in[I_WDOWN], D, 64 * kb, 32 * nb, Wdown_t + (size_t)(32 * nb) * DFF, DFF, scr, F.lane); }
    }
}
template <int KIND> __device__ __forceinline__ void norm_mod_rows(const Args& a, int m0, int m1, const float* g, bf16* O, int lane) {
    if (m0 >= m1) return;
    const float* MODp = (const float*)(a.ws + WS_MOD);
    f32x4 gg[4];
#pragma unroll
    for (int j = 0; j < 4; ++j) gg[j] = ((const f32x4*)g)[lane + 64 * j];
    auto rowp = [&](int m) -> const GAS f32x4* { const float* p = (KIND == 1 || m < MX) ? a.in[I_X] + (size_t)m * D : a.in[I_CTX] + (size_t)(m - MX) * D; return (const GAS f32x4*)p + lane; };
    const bf16* D1 = (const bf16*)(a.ws + WS_D1);
    f32x4 cur[4], nxt[4], ss[4], cc[4]; v2u cd[4], nd[4]; int bcur = -1;
    { const GAS f32x4* p = rowp(m0);
#pragma unroll
      for (int j = 0; j < 4; ++j) { cur[j] = __builtin_nontemporal_load(p + 64 * j); if (KIND == 1) cd[j] = __builtin_nontemporal_load((const GAS v2u*)(D1 + (size_t)m0 * D) + lane + 64 * j); } }
    for (int m = m0; m < m1; ++m) {
        if (m + 1 < m1) { const GAS f32x4* p = rowp(m + 1);
#pragma unroll
            for (int j = 0; j < 4; ++j) { nxt[j] = __builtin_nontemporal_load(p + 64 * j); if (KIND == 1) nd[j] = __builtin_nontemporal_load((const GAS v2u*)(D1 + (size_t)(m + 1) * D) + lane + 64 * j); } }
        if (KIND == 1) {
#pragma unroll
            for (int j = 0; j < 4; ++j) cur[j] = cur[j] + (f32x4){bflo(cd[j].x), bfhi(cd[j].x), bflo(cd[j].y), bfhi(cd[j].y)}; }
        const int b = KIND == 0 ? (m < MX ? (m >> 11) : 16) : (m >> 11);
        if (b != bcur) { bcur = b; const float* md = MODp + (size_t)b * MODW + (KIND == 0 ? 0 : 3072);
#pragma unroll
            for (int j = 0; j < 4; ++j) { ss[j] = ((const f32x4*)md)[lane + 64 * j]; cc[j] = ((const f32x4*)(md + 1024))[lane + 64 * j] + 1.0f; } }
        float s2 = 0.f;
#pragma unroll
        for (int j = 0; j < 4; ++j) s2 += (cur[j].x * cur[j].x + cur[j].y * cur[j].y) + (cur[j].z * cur[j].z + cur[j].w * cur[j].w);
        const float rstd = 1.0f / sqrtf(wave_sum(s2) * (1.f / D) + NORM_EPS);
        GAS v2u* o8 = (GAS v2u*)(O + (size_t)m * D) + lane;
#pragma unroll
        for (int j = 0; j < 4; ++j) { const f32x4 o = (cur[j] * rstd) * gg[j] * cc[j] + ss[j]; v2u w; w.x = pk2(o.x, o.y); w.y = pk2(o.z, o.w); o8[64 * j] = w; }
#pragma unroll
        for (int j = 0; j < 4; ++j) { cur[j] = nxt[j]; cd[j] = nd[j]; }
    }
}
typedef short bf16x8v __attribute__((ext_vector_type(8)));
__device__ __forceinline__ unsigned offb(unsigned row, unsigned ch) { return 256u * row + 16u * (ch ^ (((row & 3u) << 2) | ((row >> 2) & 3u))); }
__device__ __forceinline__ void tr_read8(unsigned a0, unsigned a1, v2u (&r0)[4], v2u (&r1)[4]) {
    asm volatile("ds_read_b64_tr_b16 %0, %8\n\tds_read_b64_tr_b16 %1, %8 offset:8192\n\tds_read_b64_tr_b16 %2, %8 offset:16384\n\tds_read_b64_tr_b16 %3, %8 offset:24576\n\t"
                 "ds_read_b64_tr_b16 %4, %9\n\tds_read_b64_tr_b16 %5, %9 offset:8192\n\tds_read_b64_tr_b16 %6, %9 offset:16384\n\tds_read_b64_tr_b16 %7, %9 offset:24576\n\ts_waitcnt lgkmcnt(0)"
                 : "=&v"(r0[0]), "=&v"(r0[1]), "=&v"(r0[2]), "=&v"(r0[3]), "=&v"(r1[0]), "=&v"(r1[1]), "=&v"(r1[2]), "=&v"(r1[3]) : "v"(a0), "v"(a1) : "memory");
}
__device__ __forceinline__ void tr_read4(unsigned a0, unsigned a1, v2u (&r0)[2], v2u (&r1)[2]) {
    asm volatile("ds_read_b64_tr_b16 %0, %4\n\tds_read_b64_tr_b16 %1, %4 offset:8192\n\tds_read_b64_tr_b16 %2, %5\n\tds_read_b64_tr_b16 %3, %5 offset:8192\n\ts_waitcnt lgkmcnt(0)"
                 : "=&v"(r0[0]), "=&v"(r0[1]), "=&v"(r1[0]), "=&v"(r1[1]) : "v"(a0), "v"(a1) : "memory");
}
__device__ __forceinline__ bf16x8v mk_b(v2u lo, v2u hi) { v4u w = {lo.x, lo.y, hi.x, hi.y}; return __builtin_bit_cast(bf16x8v, w); }
__device__ __forceinline__ void dft_pass_a(const Frame& F, const bf16* PXF, bf16* Y2) {
    constexpr int RSW = 272;
    const int w = F.wave, l = F.lane, lr = l & 15, g4 = l >> 4, q = (l & 15) >> 2, p = l & 3;
    const unsigned ldsb = (unsigned)(size_t)(F.lds + RING_OFF);
    LAS unsigned char* IN = F.lds + RING_OFF; LAS bf16* OUT = (LAS bf16*)(F.lds + RING_OFF + 32768); LAS unsigned char* RAW = F.lds + RING_OFF + 65536;
    bf16x8v afr[4], af0[2][4];
    { const int m = 16 * w + lr, ri = m >> 6, k2 = m & 63;
#pragma unroll
      for (int ks = 0; ks < 4; ++ks) { unsigned pk[4];
#pragma unroll
          for (int e2 = 0; e2 < 4; ++e2) { float vv[2];
#pragma unroll
              for (int h = 0; h < 2; ++h) { const int k = 32 * ks + 8 * g4 + 2 * e2 + h, rj = k >> 6, n2 = k & 63, idx = (k2 * n2) & 63; const float rev = (float)idx * (1.0f / 64.0f), sn = __builtin_amdgcn_sinf(rev), cs = __builtin_amdgcn_cosf(rev); vv[h] = (ri == rj) ? cs : (ri == 0 ? sn : -sn); }
              pk[e2] = pk2(vv[0], vv[1]); }
          afr[ks] = __builtin_bit_cast(bf16x8v, (v4u){pk[0], pk[1], pk[2], pk[3]}); } }
#pragma unroll
    for (int mt = 0; mt < 2; ++mt) { const int m = 32 * w + 16 * mt + lr, ri = m >> 7, k3 = m & 127;
#pragma unroll
      for (int ks = 0; ks < 4; ++ks) { unsigned pk[4];
#pragma unroll
          for (int e2 = 0; e2 < 4; ++e2) { float vv[2];
#pragma unroll
              for (int h = 0; h < 2; ++h) { const int n3 = 32 * ks + 8 * g4 + 2 * e2 + h, idx = (k3 * n3) & 127; const float rev = (float)idx * (1.0f / 128.0f), sn = __builtin_amdgcn_sinf(rev), cs = __builtin_amdgcn_cosf(rev); vv[h] = ri == 0 ? cs : -sn; }
              pk[e2] = pk2(vv[0], vv[1]); }
          af0[mt][ks] = __builtin_bit_cast(bf16x8v, (v4u){pk[0], pk[1], pk[2], pk[3]}); } }
    unsigned rb[2], mk[2];
#pragma unroll
    for (int t = 0; t < 2; ++t) { const unsigned row = 8 * g4 + 4 * t + q; rb[t] = ldsb + 256u * row + 8u * (p & 1); mk[t] = ((row & 3u) << 2) | ((row >> 2) & 3u); }
    const unsigned hb = p >> 1;
    v4u pre[2];
    { const int it = blockIdx.x; if (it < 2048) { const int jc = it & 3, n1 = (it >> 2) & 31, b = it >> 7;
#pragma unroll
        for (int i = 0; i < 2; ++i) { const int cid = F.tid + 512 * i, row = cid >> 4, ch = cid & 15; pre[i] = __builtin_nontemporal_load((const GAS v4u*)(PXF + (size_t)(b * 2048 + n1 * 64 + row) * 512 + jc * 128 + ch * 8)); } } }
    for (int it = blockIdx.x; it < 2048; it += F.G) {
        const int jc = it & 3, n1 = (it >> 2) & 31, b = it >> 7;
        __syncthreads();
#pragma unroll
        for (int i = 0; i < 2; ++i) { const int cid = F.tid + 512 * i, row = cid >> 4, ch = cid & 15; *(LAS v4u*)(RAW + row * RSW + ch * 16) = pre[i]; }
        { const int itn = it + F.G; if (itn < 2048) { const int jcn = itn & 3, n1n = (itn >> 2) & 31, bn = itn >> 7;
#pragma unroll
            for (int i = 0; i < 2; ++i) { const int cid = F.tid + 512 * i, row = cid >> 4, ch = cid & 15; pre[i] = __builtin_nontemporal_load((const GAS v4u*)(PXF + (size_t)(bn * 2048 + n1n * 64 + row) * 512 + jcn * 128 + ch * 8)); } } }
        __syncthreads();
#pragma unroll
        for (int nt = 0; nt < 4; ++nt) {
            bf16x8v bx[4];
#pragma unroll
            for (int ks = 0; ks < 4; ++ks) bx[ks] = *(const LAS bf16x8v*)(RAW + (16 * nt + lr) * RSW + (32 * ks + 8 * g4) * 2);
#pragma unroll
            for (int mt = 0; mt < 2; ++mt) { f32x4 acc = {0.f, 0.f, 0.f, 0.f};
#pragma unroll
                for (int ks = 0; ks < 4; ++ks) acc = __builtin_amdgcn_mfma_f32_16x16x32_bf16(af0[mt][ks], bx[ks], acc, 0, 0, 0);
                const int m0 = 32 * w + 16 * mt + 4 * g4, ri = m0 >> 7, c0 = m0 & 127, row = ri * 64 + 16 * nt + lr;
                *(LAS v2u*)(IN + offb(row, c0 >> 3) + 8 * ((c0 >> 2) & 1)) = (v2u){pk2(acc[0], acc[1]), pk2(acc[2], acc[3])}; }
        }
        __syncthreads();
#pragma unroll 2
        for (int c = 0; c < 8; ++c) {
            v2u r0[4], r1[4];
            tr_read8(rb[0] + 16u * ((2u * c + hb) ^ mk[0]), rb[1] + 16u * ((2u * c + hb) ^ mk[1]), r0, r1);
            f32x4 acc = {0.f, 0.f, 0.f, 0.f};
#pragma unroll
            for (int ks = 0; ks < 4; ++ks) acc = __builtin_amdgcn_mfma_f32_16x16x32_bf16(afr[ks], mk_b(r0[ks], r1[ks]), acc, 0, 0, 0);
#pragma unroll
            for (int r = 0; r < 4; ++r) OUT[(16 * w + 4 * g4 + r) * 128 + 16 * c + lr] = (bf16)f2bf(acc[r]);
        }
        __syncthreads();
#pragma unroll
        for (int i = 0; i < 4; ++i) { const int cid = F.tid + 512 * i, row = cid >> 4, ch = cid & 15, ri = row >> 6, k2 = row & 63;
            *(GAS v4u*)(Y2 + (size_t)(b * 2048 + n1 * 64 + k2) * 1024 + ri * 512 + jc * 128 + ch * 8) = *(const LAS v4u*)(OUT + row * 128 + ch * 8); }
    }
}
__device__ __forceinline__ void dft_pass_b(const Frame& F, const bf16* Y2, bf16* FX) {
    const int w = F.wave, l = F.lane, lr = l & 15, g4 = l >> 4, q = (l & 15) >> 2, p = l & 3;
    const int g = w >> 1, c0 = (w & 1) * 4;
    const unsigned ldsb = (unsigned)(size_t)(F.lds + RING_OFF) + 16384u * g;
    LAS unsigned char* IN = F.lds + RING_OFF; LAS bf16* OUT = (LAS bf16*)(F.lds + RING_OFF + 65536);
    bf16x8v afr[2][2];
#pragma unroll
    for (int mt = 0; mt < 2; ++mt) { const int k1 = 16 * mt + lr;
#pragma unroll
      for (int ks = 0; ks < 2; ++ks) { unsigned pk[4];
#pragma unroll
          for (int e2 = 0; e2 < 4; ++e2) { float vv[2];
#pragma unroll
              for (int h = 0; h < 2; ++h) { const int k = 32 * ks + 8 * g4 + 2 * e2 + h, ri = k >> 5, n1 = k & 31, idx = (k1 * n1) & 31; const float rev = (float)idx * (1.0f / 32.0f), sn = __builtin_amdgcn_sinf(rev), cs = __builtin_amdgcn_cosf(rev); vv[h] = (ri == 0 ? cs : sn); }
              pk[e2] = pk2(vv[0], vv[1]); }
          afr[mt][ks] = __builtin_bit_cast(bf16x8v, (v4u){pk[0], pk[1], pk[2], pk[3]}); } }
    unsigned rb[2], mk[2];
#pragma unroll
    for (int t = 0; t < 2; ++t) { const unsigned row = 8 * g4 + 4 * t + q; rb[t] = ldsb + 256u * row + 8u * (p & 1); mk[t] = ((row & 3u) << 2) | ((row >> 2) & 3u); }
    const unsigned hb = p >> 1;
    v4u pre[8];
    { const int it = blockIdx.x; if (it < 1024) { const int k2 = it & 63, b = it >> 6;
#pragma unroll
        for (int i = 0; i < 8; ++i) { const int cid = F.tid + 512 * i, row = cid >> 6, c64 = cid & 63; pre[i] = __builtin_nontemporal_load((const GAS v4u*)(Y2 + (size_t)(b * 2048 + (row & 31) * 64 + k2) * 1024 + (row >> 5) * 512 + c64 * 8)); } } }
    for (int it = blockIdx.x; it < 1024; it += F.G) {
        const int k2 = it & 63, b = it >> 6;
        __syncthreads();
#pragma unroll
        for (int i = 0; i < 8; ++i) { const int cid = F.tid + 512 * i, row = cid >> 6, c64 = cid & 63, gg = c64 >> 4, ch = c64 & 15; *(LAS v4u*)(IN + 16384 * gg + offb(row, ch)) = pre[i]; }
        { const int itn = it + F.G; if (itn < 1024) { const int k2n = itn & 63, bn = itn >> 6;
#pragma unroll
            for (int i = 0; i < 8; ++i) { const int cid = F.tid + 512 * i, row = cid >> 6, c64 = cid & 63; pre[i] = __builtin_nontemporal_load((const GAS v4u*)(Y2 + (size_t)(bn * 2048 + (row & 31) * 64 + k2n) * 1024 + (row >> 5) * 512 + c64 * 8)); } } }
        __syncthreads();
#pragma unroll
        for (int cc = 0; cc < 4; ++cc) { const int c = c0 + cc;
            v2u r0[2], r1[2];
            tr_read4(rb[0] + 16u * ((2u * c + hb) ^ mk[0]), rb[1] + 16u * ((2u * c + hb) ^ mk[1]), r0, r1);
#pragma unroll
            for (int mt = 0; mt < 2; ++mt) { f32x4 acc = {0.f, 0.f, 0.f, 0.f};
#pragma unroll
                for (int ks = 0; ks < 2; ++ks) acc = __builtin_amdgcn_mfma_f32_16x16x32_bf16(afr[mt][ks], mk_b(r0[ks], r1[ks]), acc, 0, 0, 0);
#pragma unroll
                for (int r = 0; r < 4; ++r) OUT[(16 * mt + 4 * g4 + r) * 512 + g * 128 + 16 * c + lr] = (bf16)f2bf(acc[r] * (1.0f / 512.0f)); }
        }
        __syncthreads();
#pragma unroll
        for (int i = 0; i < 4; ++i) { const int cid = F.tid + 512 * i, row = cid >> 6, ch = cid & 63;
            *(GAS v4u*)(FX + (size_t)(b * 2048 + row * 64 + k2) * 1024 + ch * 8) = *(const LAS v4u*)(OUT + row * 512 + ch * 8); }
    }
}
template <int CTRL> __device__ __forceinline__ float dpp_add(float x) { const int v = __builtin_amdgcn_update_dpp(__float_as_int(x), __float_as_int(x), CTRL, 0xF, 0xF, false); return x + __int_as_float(v); }
__device__ __forceinline__ void edge_rows(const Frame& F, const Args& a) {
    const float* EB = (const float*)(a.ws + WS_EB); bf16* RB = (bf16*)(a.ws + WS_R); bf16* KB = (bf16*)(a.ws + WS_K); bf16* VB = (bf16*)(a.ws + WS_V); bf16* AL = (bf16*)a.out;
    const int gw = F.vcu * NWAVES + F.wave, lane = F.lane;
    if (gw >= 8 * (MT / 256)) return;
    const int tile = gw >> 3, last = (gw >> 2) & 1, j = gw & 3, col = 512 * j + 8 * lane;
    if (col >= RCOLS) return;
    const bool lat = tile < MX / 256, s0 = lat ? (tile & 7) == 0 : true, s1 = lat ? (tile & 7) == 7 : true;
    const int m = tile * 256 + (last ? 255 : 0);
    const float* cp = EB + ((size_t)tile * 4 + (last ? 3 : 0)) * 2048 + col;
    const float* pp = (last ? EB + ((size_t)tile * 4 + 2) * 2048 : EB + ((size_t)(tile > 0 ? tile - 1 : 0) * 4 + 3) * 2048) + col;
    const float* np = (last ? EB + ((size_t)(tile + 1 < MT / 256 ? tile + 1 : tile) * 4 + 0) * 2048 : EB + ((size_t)tile * 4 + 1) * 2048) + col;
    const bool hp = last ? true : !s0, hn = last ? !s1 : true;
    const f32x4 z = {0.f, 0.f, 0.f, 0.f};
    f32x4 c4[2], p4[2], n4[2], mp4[2], mn4[2];
#pragma unroll
    for (int h = 0; h < 2; ++h) { c4[h] = ((const f32x4*)cp)[h]; p4[h] = hp ? ((const f32x4*)pp)[h] : z; n4[h] = hn ? ((const f32x4*)np)[h] : z; mp4[h] = ((const f32x4*)(a.in[I_MUP] + col))[h]; mn4[h] = ((const f32x4*)(a.in[I_MUN] + col))[h]; }
    float u[8];
#pragma unroll
    for (int e = 0; e < 8; ++e) { const float c = c4[e >> 2][e & 3]; u[e] = c + mp4[e >> 2][e & 3] * (p4[e >> 2][e & 3] - c) + mn4[e >> 2][e & 3] * (n4[e >> 2][e & 3] - c); }
    if (j == 0) *(GAS v4u*)(RB + (size_t)m * RW + 8 * lane) = pk8(u);
    else if (j == 1) *(GAS v4u*)(KB + (size_t)m * RW + 8 * lane) = pk8(u);
    else if (j == 2) *(GAS v4u*)(VB + (size_t)m * RW + 8 * lane) = pk8(u);
    else {
        if (lane < 16) {
#pragma unroll
            for (int e = 0; e < 8; ++e) u[e] = 2.0f * sigf(2.0f * u[e]) - 1.0f;
        } else if (lane >= 32) {
#pragma unroll
            for (int e = 0; e < 8; ++e) u[e] = sigf(u[e]);
        }
        *(GAS v4u*)(AL + (size_t)m * LK + 8 * lane) = pk8(u);
    }
}
__device__ __forceinline__ int scan_row(int s, int b, int dir) { if (s < CTXL) { const int t = dir ? (CTXL - 1 - s) : s; return MX + b * CTXL + t; } const int s2 = s - CTXL; const int t = dir ? (SEQ - 1 - s2) : s2; return b * SEQ + t; }
__device__ __forceinline__ float red16(float x) { x = dpp_add<0xB1>(x); x = dpp_add<0x4E>(x); x = dpp_add<0x141>(x); x = dpp_add<0x140>(x); return x; }
typedef float f32x2 __attribute__((ext_vector_type(2)));
__device__ __forceinline__ float fm_(float a, float b, float c) { float d; asm("v_fma_f32 %0, %1, %2, %3" : "=v"(d) : "v"(a), "v"(b), "v"(c)); return d; }
__device__ __forceinline__ float ml_(float a, float b) { float d; asm("v_mul_f32 %0, %1, %2" : "=v"(d) : "v"(a), "v"(b)); return d; }
__device__ __forceinline__ void red16x2(float& a, float& b) {
    asm volatile("s_nop 1\n\t"
        "v_add_f32_dpp %0, %0, %0 quad_perm:[1,0,3,2] row_mask:0xf bank_mask:0xf\n\tv_add_f32_dpp %1, %1, %1 quad_perm:[1,0,3,2] row_mask:0xf bank_mask:0xf\n\ts_nop 0\n\t"
        "v_add_f32_dpp %0, %0, %0 quad_perm:[2,3,0,1] row_mask:0xf bank_mask:0xf\n\tv_add_f32_dpp %1, %1, %1 quad_perm:[2,3,0,1] row_mask:0xf bank_mask:0xf\n\ts_nop 0\n\t"
        "v_add_f32_dpp %0, %0, %0 row_half_mirror row_mask:0xf bank_mask:0xf\n\tv_add_f32_dpp %1, %1, %1 row_half_mirror row_mask:0xf bank_mask:0xf\n\ts_nop 0\n\t"
        "v_add_f32_dpp %0, %0, %0 row_mirror row_mask:0xf bank_mask:0xf\n\tv_add_f32_dpp %1, %1, %1 row_mirror row_mask:0xf bank_mask:0xf\n\ts_nop 0"
        : "+v"(a), "+v"(b));
}
typedef short bf16x8v_ __attribute__((ext_vector_type(8)));
namespace sc {
constexpr int C = 16, NCHUNK = (CTXL + SEQ) / C, CTXCHUNK = CTXL / C, NSLOT = 5;
constexpr int RS = 144, ARR = 16 * RS, ES = 272;
constexpr int O_P = 0, O_RT = ARR, O_NPT = 2 * ARR, O_DPT = 3 * ARR, O_VT = 4 * ARR, O_DM = 5 * ARR, O_NR = O_DM + 512, O_DR = O_NR + 512, O_LINV = O_DR + 512, O_LC = O_LINV + 512, SLOT_B = O_LC + 256;
constexpr int PRIVP = NSLOT * SLOT_B, O_NN = 0, O_DD = ARR, O_EW = 2 * ARR, O_NF = O_EW + 16 * ES, PRIVP_B = O_NF + 1024;
constexpr int ZERO_OFF = PRIVP + 4 * PRIVP_B;
constexpr int FLAG_OFF = ZERO_OFF + 1024;
constexpr int KC_OFF = FLAG_OFF + 64;
static_assert(SLOT_B % 16 == 0 && PRIVP_B % 16 == 0 && KC_OFF + 1024 <= RING_BYTES, "scan LDS map");
}
__device__ __forceinline__ unsigned cvtpk(float lo, float hi) { unsigned r; asm volatile("v_cvt_pk_bf16_f32 %0, %1, %2" : "=v"(r) : "v"(lo), "v"(hi)); return r; }
__device__ __forceinline__ float bf1(unsigned short x) { return __uint_as_float((unsigned)x << 16); }
__device__ __forceinline__ unsigned short tobf(float f) { return (unsigned short)f2bf(f); }
__device__ __forceinline__ unsigned short tobf1(float f) { return (unsigned short)cvtpk(f, f); }
__device__ __forceinline__ bf16x8v_ tr_frag1(unsigned a) { v2u r0, r1;
    asm volatile("ds_read_b64_tr_b16 %0, %2\n\tds_read_b64_tr_b16 %1, %2 offset:512\n\ts_waitcnt lgkmcnt(0)" : "=&v"(r0), "=&v"(r1) : "v"(a) : "memory"); return mk_b(r0, r1); }
__device__ __forceinline__ void tr_frag4(unsigned a, bf16x8v_ (&f)[4]) { v2u r[8];
    asm volatile("ds_read_b64_tr_b16 %0, %8\n\tds_read_b64_tr_b16 %1, %8 offset:512\n\tds_read_b64_tr_b16 %2, %8 offset:32\n\tds_read_b64_tr_b16 %3, %8 offset:544\n\t"
                 "ds_read_b64_tr_b16 %4, %8 offset:64\n\tds_read_b64_tr_b16 %5, %8 offset:576\n\tds_read_b64_tr_b16 %6, %8 offset:96\n\tds_read_b64_tr_b16 %7, %8 offset:608\n\ts_waitcnt lgkmcnt(0)"
                 : "=&v"(r[0]), "=&v"(r[1]), "=&v"(r[2]), "=&v"(r[3]), "=&v"(r[4]), "=&v"(r[5]), "=&v"(r[6]), "=&v"(r[7]) : "v"(a) : "memory");
    f[0] = mk_b(r[0], r[1]); f[1] = mk_b(r[2], r[3]); f[2] = mk_b(r[4], r[5]); f[3] = mk_b(r[6], r[7]); }
__device__ __forceinline__ void scan_phase(const Frame& F, const Args& a) {
    using namespace sc;
    const bf16* RB = (const bf16*)(a.ws + WS_R); const bf16* KB = (const bf16*)(a.ws + WS_K); const bf16* VB = (const bf16*)(a.ws + WS_V); const bf16* LP = (const bf16*)(a.ws + WS_LP);
    LAS unsigned char* L = F.lds + RING_OFF;
    const int l = F.lane, lr = l & 15, g = l >> 4;
    for (int chain = blockIdx.x; chain < 256; chain += F.G) {
        const int b = chain >> 4, h = (chain >> 1) & 7, dir = chain & 1;
        bf16* Yg = (bf16*)a.out + (dir ? (size_t)MX * RW : 0);
        float* SBTg = (float*)(a.ws + WS_SBT);
        if (F.tid < 256 + 16) ((LAS unsigned*)(L + ZERO_OFF))[F.tid] = 0u;
        if (F.tid >= 64 && F.tid < 320) { const int i_ = F.tid - 64, k_ = h * 64 + (i_ & 63);
            ((LAS float*)(L + KC_OFF))[i_] = i_ < 64 ? a.in[I_KK][k_] : i_ < 128 ? a.in[I_KA][k_] : i_ < 192 ? a.in[I_RK][k_] * a.in[I_KA][k_] : (dir == 0 ? a.in[I_RK][k_] * (2.0f - 2.0f * a.in[I_KA][k_]) : 0.f); }
        __syncthreads();
        if (F.wave >= 4) {
            const int p = F.wave - 4;
            LAS unsigned char* PV = L + PRIVP + p * PRIVP_B;
            const int t1 = l >> 2, kq = l & 3, hc1 = h * 64 + 16 * kq;
            v4u raw[10];
#define SC_PREFETCH(cc) do { const int m_ = scan_row((cc) * C + t1, b, dir); const GAS v4u* q0 = (const GAS v4u*)(RB + (size_t)m_ * RW + hc1); const GAS v4u* q1 = (const GAS v4u*)(KB + (size_t)m_ * RW + hc1); const GAS v4u* q2 = (const GAS v4u*)(VB + (size_t)m_ * RW + hc1); \
                const GAS v4u* q3 = (const GAS v4u*)(LP + (size_t)m_ * LN + dir * 512 + hc1); const GAS v4u* q4 = (const GAS v4u*)(LP + (size_t)m_ * LN + 1024 + dir * 512 + hc1); \
                raw[0] = __builtin_nontemporal_load(q0); raw[1] = __builtin_nontemporal_load(q0 + 1); raw[2] = __builtin_nontemporal_load(q1); raw[3] = __builtin_nontemporal_load(q1 + 1); raw[4] = __builtin_nontemporal_load(q2); raw[5] = __builtin_nontemporal_load(q2 + 1); \
                raw[6] = __builtin_nontemporal_load(q3); raw[7] = __builtin_nontemporal_load(q3 + 1); raw[8] = __builtin_nontemporal_load(q4); raw[9] = __builtin_nontemporal_load(q4 + 1); } while (0)
            if (p < NCHUNK) SC_PREFETCH(p);
            volatile LAS unsigned* RDY = (volatile LAS unsigned*)(L + FLAG_OFF); volatile LAS unsigned* DONE = RDY + NSLOT;
            for (int c = p; c < NCHUNK; c += 4) {
                if (c >= NSLOT) { unsigned spins = 0; while (*DONE < 4u * (unsigned)(c - NSLOT + 1)) { __builtin_amdgcn_s_sleep(2); if (++spins > (1u << 22)) break; } asm volatile("" ::: "memory"); }
#pragma unroll 1
                for (int f = 1; f <= 3; ++f) {
                {
                    LAS unsigned char* SL = L + (c % NSLOT) * SLOT_B;
                    if (f == 1) {
                        float r16[16], k16[16], e16[16], a16[16];
                        { float t8[8]; unpk8(raw[0], t8); for (int e = 0; e < 8; ++e) r16[e] = t8[e]; unpk8(raw[1], t8); for (int e = 0; e < 8; ++e) r16[8 + e] = t8[e];
                          unpk8(raw[2], t8); for (int e = 0; e < 8; ++e) k16[e] = t8[e]; unpk8(raw[3], t8); for (int e = 0; e < 8; ++e) k16[8 + e] = t8[e];
                          unpk8(raw[6], t8); for (int e = 0; e < 8; ++e) e16[e] = t8[e]; unpk8(raw[7], t8); for (int e = 0; e < 8; ++e) e16[8 + e] = t8[e];
                          unpk8(raw[8], t8); for (int e = 0; e < 8; ++e) a16[e] = t8[e]; unpk8(raw[9], t8); for (int e = 0; e < 8; ++e) a16[8 + e] = t8[e]; }
                        const int ro = t1 * RS + kq * 32;
                        *(LAS v4u*)(SL + O_VT + ro) = raw[4]; *(LAS v4u*)(SL + O_VT + ro + 16) = raw[5];
#pragma unroll
                        for (int e4 = 0; e4 < 4; ++e4) *(LAS f32x4*)(PV + O_EW + t1 * ES + kq * 64 + e4 * 16) = (f32x4){e16[4 * e4], e16[4 * e4 + 1], e16[4 * e4 + 2], e16[4 * e4 + 3]};
                        if (c + 4 < NCHUNK) SC_PREFETCH(c + 4);
                        float kkc[16], kac[16];
#pragma unroll
                        for (int e4 = 0; e4 < 4; ++e4) { const f32x4 q0 = *(const LAS f32x4*)(L + KC_OFF + (16 * kq + 4 * e4) * 4), q1 = *(const LAS f32x4*)(L + KC_OFF + 256 + (16 * kq + 4 * e4) * 4);
#pragma unroll
                            for (int e = 0; e < 4; ++e) { kkc[4 * e4 + e] = q0[e]; kac[4 * e4 + e] = q1[e]; } }
                        float kk16[16], nb16[16], kd16[16]; float ss = 0.f;
#pragma unroll
                        for (int e = 0; e < 16; ++e) { kk16[e] = k16[e] * kkc[e]; ss += kk16[e] * kk16[e]; }
                        ss = dpp_add<0xB1>(ss); ss = dpp_add<0x4E>(ss);
                        const float rn = 1.0f / sqrtf(fmaxf(ss, 1e-24f));
#pragma unroll
                        for (int e = 0; e < 16; ++e) { kk16[e] *= rn; nb16[e] = -kk16[e] * a16[e]; }
                        { float sb = 0.f;
#pragma unroll
                          for (int e4 = 0; e4 < 4; ++e4) { const f32x4 q2 = *(const LAS f32x4*)(L + KC_OFF + 512 + (16 * kq + 4 * e4) * 4), q3 = *(const LAS f32x4*)(L + KC_OFF + 768 + (16 * kq + 4 * e4) * 4);
#pragma unroll
                              for (int e = 0; e < 4; ++e) { const int x = 4 * e4 + e; const float ka_ = k16[x] * a16[x]; kd16[x] = k16[x] + (ka_ - k16[x]) * kac[x]; sb += (r16[x] * k16[x]) * (q2[e] * a16[x] + q3[e]); } }
                          sb = dpp_add<0xB1>(sb); sb = dpp_add<0x4E>(sb);
                          if (c >= CTXCHUNK && kq == 0) SBTg[((size_t)scan_row(c * C + t1, b, dir) * 8 + h) * 4 + 1 + dir] = sb; }
                        asm volatile("s_waitcnt lgkmcnt(0)" ::: "memory");
                        {
                          LAS float* Ep = (LAS float*)(PV + O_EW) + l; float cs = 0.f;
#pragma unroll
                          for (int t = 0; t < 16; ++t) { cs += Ep[t * (ES / 4)]; Ep[t * (ES / 4)] = cs; }
                          ((LAS float*)(SL + O_LC))[l] = __expf(cs); }
                        asm volatile("s_waitcnt lgkmcnt(0)" ::: "memory");
                        unsigned pP[8], pR[8], pN[8], pD[8], pNP[8], pDP[8];
#pragma unroll
                        for (int e4 = 0; e4 < 4; ++e4) { const f32x4 cs4 = *(const LAS f32x4*)(PV + O_EW + t1 * ES + kq * 64 + e4 * 16);
                            const f32x4 cm4 = *(const LAS f32x4*)(L + (t1 > 0 ? PRIVP + p * PRIVP_B + O_EW + (t1 - 1) * ES + kq * 64 + e4 * 16 : ZERO_OFF)); const f32x4 lc4 = *(const LAS f32x4*)(SL + O_LC + kq * 64 + e4 * 16);
                            float vP[4], vR[4], vN[4], vD[4], vNP[4], vDP[4];
#pragma unroll
                            for (int e = 0; e < 4; ++e) { const int x = 4 * e4 + e; const float pc = __expf(cs4[e]), pm = __expf(cm4[e]), ic = __builtin_amdgcn_rcpf(pc);
                                vP[e] = kk16[x] * pm; vR[e] = r16[x] * pc; vN[e] = nb16[x] * ic; vD[e] = kd16[x] * ic; vNP[e] = vN[e] * lc4[e]; vDP[e] = vD[e] * lc4[e]; }
                            pP[2 * e4] = cvtpk(vP[0], vP[1]); pP[2 * e4 + 1] = cvtpk(vP[2], vP[3]); pR[2 * e4] = cvtpk(vR[0], vR[1]); pR[2 * e4 + 1] = cvtpk(vR[2], vR[3]);
                            pN[2 * e4] = cvtpk(vN[0], vN[1]); pN[2 * e4 + 1] = cvtpk(vN[2], vN[3]); pD[2 * e4] = cvtpk(vD[0], vD[1]); pD[2 * e4 + 1] = cvtpk(vD[2], vD[3]);
                            pNP[2 * e4] = cvtpk(vNP[0], vNP[1]); pNP[2 * e4 + 1] = cvtpk(vNP[2], vNP[3]); pDP[2 * e4] = cvtpk(vDP[0], vDP[1]); pDP[2 * e4 + 1] = cvtpk(vDP[2], vDP[3]); }
                        *(LAS v4u*)(SL + O_P + ro) = (v4u){pP[0], pP[1], pP[2], pP[3]}; *(LAS v4u*)(SL + O_P + ro + 16) = (v4u){pP[4], pP[5], pP[6], pP[7]};
                        *(LAS v4u*)(SL + O_RT + ro) = (v4u){pR[0], pR[1], pR[2], pR[3]}; *(LAS v4u*)(SL + O_RT + ro + 16) = (v4u){pR[4], pR[5], pR[6], pR[7]};
                        *(LAS v4u*)(PV + O_NN + ro) = (v4u){pN[0], pN[1], pN[2], pN[3]}; *(LAS v4u*)(PV + O_NN + ro + 16) = (v4u){pN[4], pN[5], pN[6], pN[7]};
                        *(LAS v4u*)(PV + O_DD + ro) = (v4u){pD[0], pD[1], pD[2], pD[3]}; *(LAS v4u*)(PV + O_DD + ro + 16) = (v4u){pD[4], pD[5], pD[6], pD[7]};
                        *(LAS v4u*)(SL + O_NPT + ro) = (v4u){pNP[0], pNP[1], pNP[2], pNP[3]}; *(LAS v4u*)(SL + O_NPT + ro + 16) = (v4u){pNP[4], pNP[5], pNP[6], pNP[7]};
                        *(LAS v4u*)(SL + O_DPT + ro) = (v4u){pDP[0], pDP[1], pDP[2], pDP[3]}; *(LAS v4u*)(SL + O_DPT + ro + 16) = (v4u){pDP[4], pDP[5], pDP[6], pDP[7]};
                    } else if (f == 2) {
                        bf16x8v_ ap[2], ar[2], bn[2], bd[2];
#pragma unroll
                        for (int ks = 0; ks < 2; ++ks) { const int o = lr * RS + ks * 64 + g * 16; ap[ks] = *(const LAS bf16x8v_*)(SL + O_P + o); ar[ks] = *(const LAS bf16x8v_*)(SL + O_RT + o); bn[ks] = *(const LAS bf16x8v_*)(PV + O_NN + o); bd[ks] = *(const LAS bf16x8v_*)(PV + O_DD + o); }
                        f32x4 cN = {0.f, 0.f, 0.f, 0.f}, cDm = cN, cNr = cN, cDr = cN;
#pragma unroll
                        for (int ks = 0; ks < 2; ++ks) { cN = __builtin_amdgcn_mfma_f32_16x16x32_bf16(ap[ks], bn[ks], cN, 0, 0, 0); cDm = __builtin_amdgcn_mfma_f32_16x16x32_bf16(ap[ks], bd[ks], cDm, 0, 0, 0);
                            cNr = __builtin_amdgcn_mfma_f32_16x16x32_bf16(ar[ks], bn[ks], cNr, 0, 0, 0); cDr = __builtin_amdgcn_mfma_f32_16x16x32_bf16(ar[ks], bd[ks], cDr, 0, 0, 0); }
                        *(LAS f32x4*)(PV + O_NF + (lr * 16 + 4 * g) * 4) = (f32x4){lr < 4 * g ? cN[0] : 0.f, lr < 4 * g + 1 ? cN[1] : 0.f, lr < 4 * g + 2 ? cN[2] : 0.f, lr < 4 * g + 3 ? cN[3] : 0.f};
#pragma unroll
                        for (int r = 0; r < 4; ++r) { const int t = 4 * g + r, j = lr; const bool lo = j < t, le = j <= t;
                            ((LAS unsigned short*)(SL + O_DM))[t * 16 + j] = tobf1(lo ? cDm[r] : 0.f); ((LAS unsigned short*)(SL + O_NR))[t * 16 + j] = tobf1(le ? cNr[r] : 0.f); ((LAS unsigned short*)(SL + O_DR))[t * 16 + j] = tobf1(le ? cDr[r] : 0.f); }
                    } else {
                        const LAS f32x4* NFTp = (const LAS f32x4*)(PV + O_NF); float acc[16];
#pragma unroll
                        for (int t = 0; t < 16; ++t) acc[t] = (t == lr) ? 1.0f : 0.0f;
                        f32x4 col[4];
#pragma unroll
                        for (int q4 = 0; q4 < 4; ++q4) col[q4] = NFTp[q4];
#pragma unroll
                        for (int j = 0; j < 16; ++j) { const float Lj = acc[j]; ((LAS unsigned short*)(SL + O_LINV))[j * 16 + lr] = tobf1(Lj);
                            f32x4 nxt[4];
                            if (j + 1 < 16) {
#pragma unroll
                                for (int q4 = 0; q4 < 4; ++q4) nxt[q4] = NFTp[(j + 1) * 4 + q4]; }
#pragma unroll
                            for (int t = j + 1; t < 16; ++t) acc[t] += col[t >> 2][t & 3] * Lj;
                            if (j + 1 < 16) {
#pragma unroll
                                for (int q4 = 0; q4 < 4; ++q4) col[q4] = nxt[q4]; } }
                    }
                }
                asm volatile("s_waitcnt lgkmcnt(0)" ::: "memory");
                }
                if (l == 0) RDY[c % NSLOT] = (unsigned)(c + 1);
            }
#undef SC_PREFETCH
        } else {
            const int w = F.wave, irow = 16 * w + lr, q = lr >> 2, pp = l & 3;
            f32x4 S[4];
#pragma unroll
            for (int kt = 0; kt < 4; ++kt) S[kt] = (f32x4){0.f, 0.f, 0.f, 0.f};
            volatile LAS unsigned* RDY = (volatile LAS unsigned*)(L + FLAG_OFF); LAS unsigned* DONE = (LAS unsigned*)(L + FLAG_OFF) + NSLOT;
            const unsigned ldsb_ = (unsigned)(size_t)L, lanetr_ = (unsigned)((4 * g + q) * RS + 8 * pp);
            for (int c = 0; c < NCHUNK; ++c) {
                { unsigned spins = 0; while (RDY[c % NSLOT] != (unsigned)(c + 1)) { __builtin_amdgcn_s_sleep(1); if (++spins > (1u << 22)) break; } asm volatile("" ::: "memory"); }
                {
                    LAS unsigned char* SL = L + (c % NSLOT) * SLOT_B; const unsigned slb_ = ldsb_ + (unsigned)((c % NSLOT) * SLOT_B);
                    asm volatile("s_nop 7" : "+v"(S[0]), "+v"(S[1]), "+v"(S[2]), "+v"(S[3]));
                    bf16x8v_ bS[2], aP[2], aR[2];
#pragma unroll
                    for (int ks = 0; ks < 2; ++ks) { bS[ks] = __builtin_bit_cast(bf16x8v_, (v4u){cvtpk(S[2 * ks][0], S[2 * ks][1]), cvtpk(S[2 * ks][2], S[2 * ks][3]), cvtpk(S[2 * ks + 1][0], S[2 * ks + 1][1]), cvtpk(S[2 * ks + 1][2], S[2 * ks + 1][3])});
                        const int o = lr * RS + (32 * ks + 4 * g) * 2;
                        aP[ks] = mk_b(*(const LAS v2u*)(SL + O_P + o), *(const LAS v2u*)(SL + O_P + o + 32)); aR[ks] = mk_b(*(const LAS v2u*)(SL + O_RT + o), *(const LAS v2u*)(SL + O_RT + o + 32)); }
                    const v2u z2 = {0u, 0u}; const int o16 = lr * 32 + g * 8;
                    const bf16x8v_ aDm = mk_b(*(const LAS v2u*)(SL + O_DM + o16), z2), aNr = mk_b(*(const LAS v2u*)(SL + O_NR + o16), z2), aDr = mk_b(*(const LAS v2u*)(SL + O_DR + o16), z2), aLi = mk_b(*(const LAS v2u*)(SL + O_LINV + o16), z2);
                    v2u trv, trn[4], trd[4];
                    asm volatile("ds_read_b64_tr_b16 %0, %9\n\t"
                                 "ds_read_b64_tr_b16 %1, %10\n\tds_read_b64_tr_b16 %2, %10 offset:32\n\tds_read_b64_tr_b16 %3, %10 offset:64\n\tds_read_b64_tr_b16 %4, %10 offset:96\n\t"
                                 "ds_read_b64_tr_b16 %5, %11\n\tds_read_b64_tr_b16 %6, %11 offset:32\n\tds_read_b64_tr_b16 %7, %11 offset:64\n\tds_read_b64_tr_b16 %8, %11 offset:96\n\ts_waitcnt lgkmcnt(0)"
                                 : "=&v"(trv), "=&v"(trn[0]), "=&v"(trn[1]), "=&v"(trn[2]), "=&v"(trn[3]), "=&v"(trd[0]), "=&v"(trd[1]), "=&v"(trd[2]), "=&v"(trd[3])
                                 : "v"(slb_ + (unsigned)(O_VT + 32 * w) + lanetr_), "v"(slb_ + (unsigned)O_NPT + lanetr_), "v"(slb_ + (unsigned)O_DPT + lanetr_) : "memory");
                    const bf16x8v_ bV = mk_b(trv, z2);
                    f32x4 W = {0.f, 0.f, 0.f, 0.f};
                    W = __builtin_amdgcn_mfma_f32_16x16x32_bf16(aP[0], bS[0], W, 0, 0, 0); W = __builtin_amdgcn_mfma_f32_16x16x32_bf16(aP[1], bS[1], W, 0, 0, 0); W = __builtin_amdgcn_mfma_f32_16x16x32_bf16(aDm, bV, W, 0, 0, 0);
                    asm volatile("s_nop 7\n\ts_nop 7" : "+v"(W));
                    const bf16x8v_ bW = __builtin_bit_cast(bf16x8v_, (v4u){cvtpk(W[0], W[1]), cvtpk(W[2], W[3]), 0u, 0u});
                    f32x4 Z = {0.f, 0.f, 0.f, 0.f};
                    Z = __builtin_amdgcn_mfma_f32_16x16x32_bf16(aLi, bW, Z, 0, 0, 0);
                    asm volatile("s_nop 7\n\ts_nop 7" : "+v"(Z));
                    const bf16x8v_ bZ = __builtin_bit_cast(bf16x8v_, (v4u){cvtpk(Z[0], Z[1]), cvtpk(Z[2], Z[3]), 0u, 0u});
                    if (c >= CTXCHUNK) {
                        f32x4 Y = {0.f, 0.f, 0.f, 0.f};
                        Y = __builtin_amdgcn_mfma_f32_16x16x32_bf16(aR[0], bS[0], Y, 0, 0, 0); Y = __builtin_amdgcn_mfma_f32_16x16x32_bf16(aR[1], bS[1], Y, 0, 0, 0);
                        Y = __builtin_amdgcn_mfma_f32_16x16x32_bf16(aNr, bZ, Y, 0, 0, 0); Y = __builtin_amdgcn_mfma_f32_16x16x32_bf16(aDr, bV, Y, 0, 0, 0);
#pragma unroll
                        for (int r = 0; r < 4; ++r) { const int m = scan_row(c * C + 4 * g + r, b, dir); Yg[(size_t)m * RW + h * 64 + irow] = tobf(Y[r]); }
                    }
#pragma unroll
                    for (int kt = 0; kt < 4; ++kt) { const f32x4 lc = *(const LAS f32x4*)(SL + O_LC + (16 * kt + 4 * g) * 4);
                        f32x4 sv = S[kt] * lc; sv = __builtin_amdgcn_mfma_f32_16x16x32_bf16(mk_b(trn[kt], z2), bZ, sv, 0, 0, 0); sv = __builtin_amdgcn_mfma_f32_16x16x32_bf16(mk_b(trd[kt], z2), bV, sv, 0, 0, 0); S[kt] = sv; }
                }
                asm volatile("s_waitcnt lgkmcnt(0)" ::: "memory");
                if (l == 0) __hip_atomic_fetch_add(DONE, 1u, __ATOMIC_RELAXED, __HIP_MEMORY_SCOPE_WORKGROUP);
            }
        }
        __syncthreads();
    }
}
__device__ __forceinline__ void rwkv_out_phase(const Frame& F, const Args& a) {
    const bf16* RB = (const bf16*)(a.ws + WS_R); const bf16* KB = (const bf16*)(a.ws + WS_K); const bf16* VB = (const bf16*)(a.ws + WS_V); const bf16* LP = (const bf16*)(a.ws + WS_LP); bf16* O = (bf16*)(a.ws + WS_FXO) + 512;
    const bf16* YF = (const bf16*)a.out; const bf16* YBk = (const bf16*)a.out + (size_t)MX * RW;
    const int gw = F.vcu * NWAVES + F.wave, NGW = F.G * NWAVES, col = 8 * F.lane;
    float lg[8], lb[8];
#pragma unroll
    for (int e = 0; e < 8; ++e) { lg[e] = a.in[I_LNG][col + e]; lb[e] = a.in[I_LNB][col + e]; }
    const float* SBT = (const float*)(a.ws + WS_SBT);
    for (int m = gw; m < MX; m += NGW) {
        float y[8], v[8], gg[8], o[8];
        { float yb8[8]; unpk8(__builtin_nontemporal_load((const GAS v4u*)(YF + (size_t)m * RW + col)), y); unpk8(__builtin_nontemporal_load((const GAS v4u*)(YBk + (size_t)m * RW + col)), yb8);
#pragma unroll
          for (int e = 0; e < 8; ++e) y[e] += yb8[e]; }
        unpk8(__builtin_nontemporal_load((const GAS v4u*)(VB + (size_t)m * RW + col)), v); unpk8(__builtin_nontemporal_load((const GAS v4u*)(LP + (size_t)m * LN + 2048 + col)), gg);
        const f32x4 sb4 = __builtin_nontemporal_load((const GAS f32x4*)(SBT + ((size_t)m * 8 + (F.lane >> 3)) * 4));
        float s = 0.f;
#pragma unroll
        for (int e = 0; e < 8; ++e) s += y[e];
        const float mean = red8(s) * (1.0f / 64.0f);
        float qv = 0.f; const float bs = sb4[1] + sb4[2];
#pragma unroll
        for (int e = 0; e < 8; ++e) { y[e] -= mean; qv += y[e] * y[e]; }
        const float rstd = 1.0f / sqrtf(red8(qv) * (1.0f / 64.0f) + GN_EPS);
#pragma unroll
        for (int e = 0; e < 8; ++e) o[e] = ((y[e] * rstd * lg[e] + lb[e]) + bs * v[e]) * gg[e];
        *(GAS v4u*)(O + (size_t)m * 1024 + col) = pk8(o);
    }
}
__global__ void __launch_bounds__(NWAVES * 64, 2) mk_fwd(Args args) {
    extern __shared__ __attribute__((aligned(16))) unsigned char lds[];
    Frame F;
    F.lds = (LAS unsigned char*)lds;
    F.MISC = (volatile LAS unsigned*)(F.lds + MISC_OFF);
    F.tid = threadIdx.x; F.lane = F.tid & 63; F.wave = __builtin_amdgcn_readfirstlane(F.tid >> 6);
    F.G = gridDim.x; { const int bx = blockIdx.x; F.vcu = (F.G % 8 == 0) ? (bx % 8) * (F.G / 8) + bx / 8 : bx; }
    F.ctl = (gu32*)(args.ws + WS_CTL);
    for (int u = F.tid; u < (LDS_BYTES - LDSCTL_OFF) / 4; u += NWAVES * 64) ((LAS unsigned*)(F.lds + LDSCTL_OFF))[u] = 0u;
    __syncthreads();
    XcdBarrier bar; bar.bar = (unsigned*)(F.ctl + CW_BAR); bar.x = 0; bar.st = nullptr;
    if (N_LAUNCHES == 1) bar = xcd_barrier_post((unsigned*)(F.ctl + CW_BAR), F.MISC + 8);
    if (N_LAUNCHES == 1 && threadIdx.x == 0 && (bar.x != (blockIdx.x & 7u) || (gridDim.x & 7u) != 0u)) (void)xb_add((unsigned*)(F.ctl + CW_BADMAP), 1u);
#define GRID_BAR() do { if (N_LAUNCHES == 1) xcd_barrier(bar); } while (0)
    const int lo = args.ph_lo, hi = args.ph_hi;
#define IN(k) (refresh_tid(F), lo <= (k) && (k) < hi)
#define INP(k) (lo <= (k) && (k) < hi)
#define SEAM(k) do { if (INP(k) && INP((k) + 1)) GRID_BAR(); } while (0)
#define SEAM_L(k) do { if (INP(k) && INP((k) + 1)) { if (N_LAUNCHES == 1) { if (F.MISC[10]) xcd_barrier_local(bar); else xcd_barrier(bar); } } } while (0)
#define WSP(T, off) ((T*)(args.ws + (off)))
#define MOD WSP(float, WS_MOD)
#define Win_t WSP(bf16, WS_WIN)
#define Wlora_t WSP(bf16, WS_WLORA)
#define Wupf_t WSP(bf16, WS_WUPF)
#define Wupr_t WSP(bf16, WS_WUPR)
#define Wout_t WSP(bf16, WS_WOUT)
#define Wgu_t WSP(bf16, WS_WGU)
#define Wdown_t WSP(bf16, WS_WDOWN)
#define HX WSP(bf16, WS_HX)
#define PXR WSP(bf16, WS_PXR)
#define Z3 WSP(bf16, WS_Z3)
#define GF WSP(bf16, WS_GF)
#define GR WSP(bf16, WS_GR)
#define Y2 ((bf16*)((unsigned char*)args.out + 32 * MiB))
#define FX WSP(bf16, WS_FXO)
#define AL ((bf16*)args.out)
#define LP WSP(bf16, WS_LP)
#define MB WSP(bf16, WS_MB)
#define HX2 WSP(bf16, WS_HX2)
#define ACT WSP(bf16, WS_ACT)
    const int gw = F.vcu * NWAVES + F.wave, NGW = F.G * NWAVES;
    using EpiIn1 = pg8::EpiIn<WS_Z3, WS_GF, WS_GR, WS_R, WS_EB>;

    for (int rep_ = 0; rep_ < 1 + ((MK_REPEAT >> 0) & 1); ++rep_)
    if (IN(0)) { p0_weights(F, args); } SEAM(0);
    if (N_LAUNCHES == 1) {
        if (threadIdx.x == 0) F.MISC[10] = (xb_ld((unsigned*)(F.ctl + CW_BADMAP)) == 0u) ? 1u : 0u;
        __syncthreads(); }
    for (int rep_ = 0; rep_ < 1 + ((MK_REPEAT >> 1) & 1); ++rep_)
    if (IN(1)) {
        { constexpr int RPW = (MT + 2047) / 2048; const int rpw = (MT + NGW - 1) / NGW; (void)RPW; const int m0 = gw * rpw, m1 = (m0 + rpw < MT) ? m0 + rpw : MT; norm_mod_rows<0>(args, m0, m1, args.in[I_N1G], HX, F.lane); }
    } SEAM(1);
    for (int rep_ = 0; rep_ < 1 + ((MK_REPEAT >> 2) & 1); ++rep_)
    if (IN(2)) {
        { pg8::Gemm g{HX, Win_t, MX, NIN, D}; pg8::StaticOrder S; S.init(MX, NIN, F.G, (int)blockIdx.x); EpiIn1 E{args.ws, (bf16*)args.out, args.in[I_MUP], args.in[I_MUN], (LAS float*)(F.lds + XB_OFF), 0};
          pg8::gemm_phase<EpiIn1, pg8::StaticOrder, true, true>(F.lds + RING_OFF, g, S, E); }
        { pg8::Gemm g{HX + (size_t)MX * D, Win_t, MC, RPAD, D}; pg8::StaticOrder S; S.init(MC, RPAD, F.G, (int)blockIdx.x); EpiIn1 E{args.ws, (bf16*)args.out, args.in[I_MUP], args.in[I_MUN], (LAS float*)(F.lds + XB_OFF), MX};
          pg8::gemm_phase<EpiIn1, pg8::StaticOrder, true, true>(F.lds + RING_OFF, g, S, E); }
    } SEAM(2);
    for (int rep_ = 0; rep_ < 1 + ((MK_REPEAT >> 3) & 1); ++rep_)
    if (IN(3)) { edge_rows(F, args); dft_pass_a(F, Z3, Y2); } SEAM(3);
    for (int rep_ = 0; rep_ < 1 + ((MK_REPEAT >> 7) & 1); ++rep_)
    if (IN(7)) { dft_pass_b(F, Y2, FX); __syncthreads();
        pg8::Gemm g{AL, Wlora_t, MT, LN, LK}; pg8::StaticOrder S; S.init(MT, LN, F.G, (int)blockIdx.x); pg8::EpiLora E{LP, WSP(const float, WS_LB)};
        pg8::gemm_phase<pg8::EpiLora, pg8::StaticOrder, true, true>(F.lds + RING_OFF, g, S, E); } SEAM(7);
    for (int rep_ = 0; rep_ < 1 + ((MK_REPEAT >> 8) & 1); ++rep_)
    if (IN(8)) { scan_phase(F, args); } SEAM(8);
    for (int rep_ = 0; rep_ < 1 + ((MK_REPEAT >> 9) & 1); ++rep_)
    if (IN(9)) { rwkv_out_phase(F, args); } SEAM(9);
    for (int rep_ = 0; rep_ < 1 + ((MK_REPEAT >> 10) & 1); ++rep_)
    if (IN(10)) { pg8::Gemm g{FX, Wupf_t, MX, D, D}; pg8::StaticOrder S; S.init(MX, D, F.G, (int)blockIdx.x); pg8::EpiMerge2 E{MB, GF, GR};
        pg8::gemm_phase<pg8::EpiMerge2, pg8::StaticOrder, true, true>(F.lds + RING_OFF, g, S, E); } SEAM_L(10);
    for (int rep_ = 0; rep_ < 1 + ((MK_REPEAT >> 11) & 1); ++rep_)
    if (IN(11)) { pg8::Gemm g{MB, Wout_t, MX, D, D}; pg8::StaticOrder S; S.init(MX, D, F.G, (int)blockIdx.x); pg8::EpiDelta E{WSP(bf16, WS_D1), MOD + 2048};
        pg8::gemm_phase<pg8::EpiDelta, pg8::StaticOrder, true, true>(F.lds + RING_OFF, g, S, E); } SEAM_L(11);
    for (int rep_ = 0; rep_ < 1 + ((MK_REPEAT >> 12) & 1); ++rep_)
    if (IN(12)) {
        p_weights2(F, args);
        { const int rpw = (MX + NGW - 1) / NGW; const int m0 = gw * rpw, m1 = (m0 + rpw < MX) ? m0 + rpw : MX; norm_mod_rows<1>(args, m0, m1, args.in[I_N2G], HX2, F.lane); }
    } SEAM(12);
    for (int rep_ = 0; rep_ < 1 + ((MK_REPEAT >> 13) & 1); ++rep_)
    if (IN(13)) { pg8::Gemm g{HX2, Wgu_t, MX, 2 * DFF, D}; pg8::StaticOrder S; S.init(MX, 2 * DFF, F.G, (int)blockIdx.x); pg8::EpiSwiglu E{ACT};
        pg8::gemm_phase<pg8::EpiSwiglu, pg8::StaticOrder, true, true>(F.lds + RING_OFF, g, S, E); } SEAM_L(13);
    for (int rep_ = 0; rep_ < 1 + ((MK_REPEAT >> 14) & 1); ++rep_)
    if (IN(14)) { pg8::Gemm g{ACT, Wdown_t, MX, D, DFF}; pg8::StaticOrder S; S.init(MX, D, F.G, (int)blockIdx.x); pg8::EpiDelta E{WSP(bf16, WS_D2), MOD + 5120};
        pg8::gemm_phase<pg8::EpiDelta, pg8::StaticOrder, true, true>(F.lds + RING_OFF, g, S, E); } SEAM_L(14);
    for (int rep_ = 0; rep_ < 1 + ((MK_REPEAT >> 15) & 1); ++rep_)
    if (IN(15)) {
        const int wpx = (F.G % 8 == 0) ? NGW / 8 : NGW, rpx = (F.G % 8 == 0) ? MX / 8 : MX, xg = gw / wpx, lw = gw % wpx;
        for (int m = xg * rpx + lw; m < (xg + 1) * rpx; m += wpx) {
            GAS f32x4* xr = (GAS f32x4*)(args.out + (size_t)m * D) + F.lane; const GAS f32x4* xin = (const GAS f32x4*)(args.in[I_X] + (size_t)m * D) + F.lane;
            const GAS v2u* dr = (const GAS v2u*)(WSP(bf16, WS_D2) + (size_t)m * D) + F.lane; const GAS v2u* d1r = (const GAS v2u*)(WSP(bf16, WS_D1) + (size_t)m * D) + F.lane; f32x4 v[4]; float s2 = 0.f;
#pragma unroll
            for (int j = 0; j < 4; ++j) { const v2u dd = __builtin_nontemporal_load(dr + 64 * j), d1 = __builtin_nontemporal_load(d1r + 64 * j); v[j] = (__builtin_nontemporal_load(xin + 64 * j) + (f32x4){bflo(d1.x), bfhi(d1.x), bflo(d1.y), bfhi(d1.y)}) + (f32x4){bflo(dd.x), bfhi(dd.x), bflo(dd.y), bfhi(dd.y)}; s2 += (v[j].x * v[j].x + v[j].y * v[j].y) + (v[j].z * v[j].z + v[j].w * v[j].w); }
            const float rstd = 1.0f / sqrtf(wave_sum(s2) * (1.f / D) + NORM_EPS);
#pragma unroll
            for (int j = 0; j < 4; ++j) xr[64 * j] = (v[j] * rstd) * ((const f32x4*)args.in[I_FNG])[F.lane + 64 * j];
        }
    }
#undef IN
#undef SEAM
#undef GRID_BAR
}

extern "C" void kernel_launch(void* const* d_in, const int* in_sizes, int n_in, void* d_out, int out_size, void* d_ws, size_t ws_size, hipStream_t stream) {
    static int grid = 0;
    if (grid == 0) {
        if (n_in != 31 || in_sizes[0] != MX * D || out_size != MX * D || ws_size < WS_END) { fprintf(stderr, "kernel_launch: shape/workspace mismatch (n_in %d, in0 %d, out %d, ws %zu); nothing launched\n", n_in, n_in > 0 ? in_sizes[0] : -1, out_size, ws_size); grid = -1; return; }
        int dev = 0, cus = 0;
        if (hipGetDevice(&dev) != hipSuccess || hipDeviceGetAttribute(&cus, hipDeviceAttributeMultiprocessorCount, dev) != hipSuccess) { grid = -1; return; }
        if (hipFuncSetAttribute((const void*)mk_fwd, hipFuncAttributeMaxDynamicSharedMemorySize, LDS_BYTES) != hipSuccess) { fprintf(stderr, "kernel_launch: hipFuncSetAttribute failed\n"); grid = -1; return; }
        (void)hipGetLastError();
        grid = cus;
    }
    if (grid < 0) return;
    if (hipMemsetAsync((char*)d_ws + WS_CTL, 0, CTL_ZERO_BYTES, stream) != hipSuccess) return;
    Args a{};
    for (int i = 0; i < 31; ++i) a.in[i] = (const float*)d_in[i];
    a.out = (float*)d_out; a.ws = (unsigned char*)d_ws;
    if (N_LAUNCHES == 1) { a.ph_lo = 0; a.ph_hi = NPH; a.li = 0; hipLaunchKernelGGL(mk_fwd, dim3(grid), dim3(NWAVES * 64), LDS_BYTES, stream, a); }
    else for (int p = 0; p < NPH; ++p) { a.ph_lo = p; a.ph_hi = p + 1; a.li = p; hipLaunchKernelGGL(mk_fwd, dim3(grid), dim3(NWAVES * 64), LDS_BYTES, stream, a); }
}
```

```cpp
#include <hip/hip_runtime.h>
#include <cstdio>
#include <cstdint>
#ifndef MK_REPEAT
#define MK_REPEAT 0x0
#endif
#ifndef MK_N_LAUNCHES
#define MK_N_LAUNCHES 1
#endif
namespace pg8 {
#define PG8_LAS __attribute__((address_space(3)))
typedef unsigned short bf16_t;
typedef short bf16x8 __attribute__((ext_vector_type(8)));
typedef float f32x4 __attribute__((ext_vector_type(4)));
typedef unsigned u32x4 __attribute__((ext_vector_type(4)));
constexpr int BM = 256, BK = 64, HALF = 128, HTB = HALF * BK * 2  , STAGE_BYTES = 8 * HTB, NXCD = 8, WGM = 8;

__host__ __device__ __forceinline__ int lds_byte(int r, int c) { const int st = (r >> 4) * 2 + (c >> 5), rr = r & 15, cc = c & 31, ob = rr * 64 + cc * 2; return st * 1024 + (ob ^ (((ob >> 9) & 1) << 5)); }
__host__ __device__ __forceinline__ void stage_rc(int b, int& R, int& C) { const int st = b / 1024, sb = b % 1024, swz = sb ^ (((sb >> 9) & 1) << 5); R = (st >> 1) * 16 + swz / 64; C = (st & 1) * 32 + (swz % 64) / 2; }
__host__ __device__ __forceinline__ int perm32(int rho) { const int n = rho >> 4, i = rho & 15; return 8 * (i >> 2) + 4 * n + (i & 3); }

struct Unit { int pm, pn; };
struct Gemm { const bf16_t* A; const bf16_t* Bt; int M, N, K; };

struct StaticOrder {
    int nM, nN, nwg, G, c;
    __host__ __device__ void init(int M, int N, int G_, int c_) { nM = M / BM; nN = N / BM; nwg = nM * nN; G = G_; c = c_; }
    __host__ __device__ bool next(int i, Unit& u) const {
        const long L = (long)i * G + c; if (L >= nwg) return false;
        int wgid = (int)L; { const int q = nwg / NXCD, r = nwg % NXCD, xcd = wgid % NXCD, off = wgid / NXCD; wgid = (xcd < r ? xcd * (q + 1) : r * (q + 1) + (xcd - r) * q) + off; }
        const int nig = WGM * nN, gid = wgid / nig, fm = gid * WGM, gsz = (nM - fm) < WGM ? (nM - fm) : WGM;
        u.pm = fm + ((wgid % nig) % gsz); u.pn = (wgid % nig) / gsz; return true;
    }
    __device__ __forceinline__ void a_ready(const Unit&) const {}
    __device__ __forceinline__ void done(const Unit&) const {}
};

__device__ __forceinline__ unsigned cvt_pk_bf16(float lo, float hi) { unsigned r; asm volatile("v_cvt_pk_bf16_f32 %0, %1, %2" : "=v"(r) : "v"(lo), "v"(hi)); return r; }
__device__ __forceinline__ float bf_lo(unsigned w) { return __uint_as_float(w << 16); }
__device__ __forceinline__ float bf_hi(unsigned w) { return __uint_as_float(w & 0xffff0000u); }
__device__ __forceinline__ float sigm(float x) { return __builtin_amdgcn_rcpf(1.0f + __expf(-x)); }
__device__ __forceinline__ f32x4 sigm4(f32x4 v) { return (f32x4){sigm(v[0]), sigm(v[1]), sigm(v[2]), sigm(v[3])}; }
__device__ __forceinline__ u32x4 pack8(f32x4 v0, f32x4 v1) { u32x4 w; w.x = cvt_pk_bf16(v0[0], v0[1]); w.y = cvt_pk_bf16(v0[2], v0[3]); w.z = cvt_pk_bf16(v1[0], v1[1]); w.w = cvt_pk_bf16(v1[2], v1[3]); return w; }
__device__ __forceinline__ void unpack8(u32x4 w, f32x4& v0, f32x4& v1) { v0 = (f32x4){bf_lo(w.x), bf_hi(w.x), bf_lo(w.y), bf_hi(w.y)}; v1 = (f32x4){bf_lo(w.z), bf_hi(w.z), bf_lo(w.w), bf_hi(w.w)}; }
template <int CTRL> __device__ __forceinline__ float dpp_rot(float src) { return __int_as_float(__builtin_amdgcn_mov_dpp(__float_as_int(src), CTRL, 0xF, 0xF, true)); }
template <size_t O_Z3, size_t O_GF, size_t O_GR, size_t O_R, size_t O_EB> struct EpiIn {
    static constexpr bool PERM = true, AFTER_DRAIN = false, HAS_MID = false; static constexpr int KSLICE = 0; static constexpr bool SKIP_B1 = true, HAS_PRE = true;
    static __device__ __forceinline__ bool skip_b1(int pn) { return pn == 7; }
    static constexpr size_t RKV_STRIDE = (size_t)36 * 1024 * 1024 / 2;
    unsigned char* ws; bf16_t* al; const float* mup; const float* mun; PG8_LAS float* xb; int row_off;
    __device__ __forceinline__ void pre(const Unit& u, int ui, int wid, int lane) const {
        if (u.pn >= 8) return;
        const int t = wid * 64 + lane, col = 256 * u.pn + (t & 255);
        const float* src = (t < 256 ? mup : mun) + (col < 1920 ? col : 0);
        __builtin_amdgcn_global_load_lds((const unsigned*)src, (PG8_LAS unsigned*)(xb + 2048 + (ui & 1) * 512 + wid * 64), 4, 0, 0);
    }
    __device__ __forceinline__ void operator()(const f32x4 (&acc)[2][2][4][2], const Unit& u, int wr, int wc, int fr, int fq, int ui) const {
        const int pn = u.pn;
        if (pn >= 8) {
            const int row0 = row_off + u.pm * BM + wr * 64 + fr;
            if (pn < 10) {
                bf16_t* base = (bf16_t*)(ws + O_Z3); const int col0 = (pn - 8) * 256 + wc * 32 + 8 * fq;
#pragma unroll
                for (int ai = 0; ai < 2; ++ai)
#pragma unroll
                    for (int m = 0; m < 4; ++m) { bf16_t* rowp = base + (size_t)(row0 + ai * HALF + m * 16) * 512 + col0;
#pragma unroll
                        for (int bj = 0; bj < 2; ++bj) *(u32x4*)(rowp + bj * HALF) = pack8(acc[ai][bj][m][0], acc[ai][bj][m][1]); }
            } else {
                bf16_t* gq = (bf16_t*)(ws + O_GF); bf16_t* gr = (bf16_t*)(ws + O_GR); const int col0 = (pn - 10) * 128 + wc * 32 + 8 * fq;
#pragma unroll
                for (int ai = 0; ai < 2; ++ai)
#pragma unroll
                    for (int m = 0; m < 4; ++m) { const size_t off = (size_t)(row0 + ai * HALF + m * 16) * 1024 + col0;
                        f32x4 qv[2], sv[2];
#pragma unroll
                        for (int n = 0; n < 2; ++n)
#pragma unroll
                            for (int e = 0; e < 4; ++e) { const float ef = __expf(-acc[ai][0][m][n][e]), er1 = 1.0f + __expf(-acc[ai][1][m][n][e]);
                                sv[n][e] = __builtin_amdgcn_rcpf(er1); qv[n][e] = __builtin_amdgcn_rcpf(1.0f + ef) * fminf(er1, 1e20f); }
                        *(u32x4*)(gq + off) = pack8(qv[0], qv[1]); *(u32x4*)(gr + off) = pack8(sv[0], sv[1]); }
            }
            return;
        }
        asm volatile("" : "+v"(fr), "+v"(fq));
        const int cw = wc * 32 + 8 * fq, tile = (row_off >> 8) + u.pm;
        float* eb = (float*)(ws + O_EB); bf16_t* rkv = (bf16_t*)(ws + O_R);
#pragma unroll
        for (int ai = 0; ai < 2; ++ai)
#pragma unroll
            for (int bj = 0; bj < 2; ++bj)
#pragma unroll
                for (int n = 0; n < 2; ++n) { PG8_LAS float* p0 = xb + ((2 * ai + wr) * 2) * 256 + 128 * bj + cw + 4 * n;
                    if (fr == 0) *(PG8_LAS f32x4*)p0 = acc[ai][bj][0][n];
                    if (fr == 15) *(PG8_LAS f32x4*)(p0 + 256) = acc[ai][bj][3][n]; }
        if (wr == 0 && fr < 2) {
#pragma unroll
            for (int bj = 0; bj < 2; ++bj)
#pragma unroll
                for (int n = 0; n < 2; ++n) *(f32x4*)(eb + ((size_t)tile * 4 + fr) * 2048 + 256 * pn + 128 * bj + cw + 4 * n) = acc[0][bj][0][n]; }
        if (wr == 1 && fr >= 14) {
#pragma unroll
            for (int bj = 0; bj < 2; ++bj)
#pragma unroll
                for (int n = 0; n < 2; ++n) *(f32x4*)(eb + ((size_t)tile * 4 + 2 + (fr - 14)) * 2048 + 256 * pn + 128 * bj + cw + 4 * n) = acc[1][bj][3][n]; }
        asm volatile("s_waitcnt lgkmcnt(0)" ::: "memory"); __builtin_amdgcn_s_barrier(); asm volatile("" ::: "memory");
        bf16_t* dst; int ldd, dcol;
        if (pn < 6) { dst = rkv + (size_t)(pn >> 1) * RKV_STRIDE; ldd = 512; dcol = (pn & 1) * 256; } else { dst = al; ldd = 384; dcol = (pn - 6) * 256; }
#pragma unroll
        for (int bj = 0; bj < 2; ++bj) {
            if (pn == 7 && bj == 1) continue;
            const int act = (pn == 6 && bj == 0) ? 1 : (pn == 7) ? 2 : 0;
            const PG8_LAS float* tab = xb + 2048 + (ui & 1) * 512 + 128 * bj + cw;
            const bool f0 = fr == 0, f15 = fr == 15; const f32x4 z4 = {0.f, 0.f, 0.f, 0.f};
#pragma unroll
            for (int ai = 0; ai < 2; ++ai) { const int q = 2 * ai + wr;
                unsigned pk[4][2][2];
#pragma unroll
                for (int n = 0; n < 2; ++n) {
                    const f32x4 mp = *(const PG8_LAS f32x4*)(tab + 4 * n), mn = *(const PG8_LAS f32x4*)(tab + 256 + 4 * n);
                    const f32x4 w0 = 1.0f - mp - mn, mpA = f0 ? z4 : mp, mpB = f0 ? mp : z4, mnA = f15 ? z4 : mn, mnB = f15 ? mn : z4;
                    f32x4 xp = z4, xn = z4;
                    if (q > 0) xp = *(const PG8_LAS f32x4*)(xb + ((q - 1) * 2 + 1) * 256 + 128 * bj + cw + 4 * n);
                    if (q < 3) xn = *(const PG8_LAS f32x4*)(xb + ((q + 1) * 2) * 256 + 128 * bj + cw + 4 * n);
                    f32x4 R1[4], L1[4];
#pragma unroll
                    for (int m = 0; m < 4; ++m)
#pragma unroll
                        for (int e = 0; e < 4; ++e) { R1[m][e] = dpp_rot<0x121>(acc[ai][bj][m][n][e]); L1[m][e] = dpp_rot<0x12F>(acc[ai][bj][m][n][e]); }
#pragma unroll
                    for (int m = 0; m < 4; ++m) {
                        f32x4 uu = w0 * acc[ai][bj][m][n] + mpA * R1[m] + mpB * (m > 0 ? R1[m > 0 ? m - 1 : 0] : xp) + mnA * L1[m] + mnB * (m < 3 ? L1[m < 3 ? m + 1 : 3] : xn);
                        if (act == 1) uu = 2.0f * sigm4(2.0f * uu) - 1.0f; else if (act == 2) uu = sigm4(uu);
                        pk[m][n][0] = cvt_pk_bf16(uu[0], uu[1]); pk[m][n][1] = cvt_pk_bf16(uu[2], uu[3]); }
                }
#pragma unroll
                for (int m = 0; m < 4; ++m) *(u32x4*)(dst + (size_t)(row_off + u.pm * BM + 128 * ai + 64 * wr + 16 * m + fr) * ldd + dcol + 128 * bj + cw) = (u32x4){pk[m][0][0], pk[m][0][1], pk[m][1][0], pk[m][1][1]};
            }
        }
    }
};
struct EpiLora {
    static constexpr bool PERM = true, AFTER_DRAIN = false, HAS_MID = false; static constexpr int KSLICE = 128; static constexpr bool SKIP_B1 = false, HAS_PRE = false;
    bf16_t* lp; const float* bias;
    static __device__ __forceinline__ int koff(int pn) { const int t = pn >> 1; return t >= 4 ? 256 : (t >= 2 ? 128 : 0); }
    __device__ __forceinline__ void operator()(const f32x4 (&acc)[2][2][4][2], const Unit& u, int wr, int wc, int fr, int fq) const {
        const int pn = u.pn, t = pn >> 1;
        const int row0 = u.pm * BM + wr * 64 + fr, col0 = pn * 256 + wc * 32 + 8 * fq;
        const float sc = t < 2 ? -0.6065306597f : 1.0f;
#pragma unroll
        for (int bj = 0; bj < 2; ++bj) { const f32x4 b0 = *(const f32x4*)(bias + col0 + bj * HALF), b1 = *(const f32x4*)(bias + col0 + bj * HALF + 4);
#pragma unroll
            for (int ai = 0; ai < 2; ++ai)
#pragma unroll
                for (int m = 0; m < 4; ++m) { f32x4 v0 = acc[ai][bj][m][0] + b0, v1 = acc[ai][bj][m][1] + b1;
                    if (t < 4) { v0 = sigm4(v0) * sc; v1 = sigm4(v1) * sc; }
                    *(u32x4*)(lp + (size_t)(row0 + ai * HALF + m * 16) * 2560 + col0 + bj * HALF) = pack8(v0, v1); } }
    }
};
struct EpiMerge2 {
    static constexpr bool PERM = true, AFTER_DRAIN = false, HAS_MID = true; static constexpr int KSLICE = 0; static constexpr bool SKIP_B1 = false, HAS_PRE = false;
    bf16_t* mb; const bf16_t* gf; const bf16_t* gr;
    __device__ __forceinline__ void mid(f32x4 (&acc)[2][2][4][2], const Unit& u, int wr, int wc, int fr, int fq) const {
        asm volatile("" : "+v"(fr), "+v"(fq));
        const int row0 = u.pm * BM + wr * 64 + fr, col0 = u.pn * BM + wc * 32 + 8 * fq;
        constexpr int DEPTH = 8;
        u32x4 fw[DEPTH];
#define PG8_GOFF(it_) ((size_t)(row0 + ((it_) >> 3) * HALF + (((it_) >> 1) & 3) * 16) * 1024 + col0 + ((it_) & 1) * HALF)
#pragma unroll
        for (int d = 0; d < DEPTH; ++d) fw[d] = *(const u32x4*)(gf + PG8_GOFF(d));
#pragma unroll
        for (int it = 0; it < 16; ++it) { const int ai = it >> 3, m = (it >> 1) & 3, bj = it & 1, sl = it % DEPTH;
            const u32x4 fwc = fw[sl];
            asm volatile("" ::: "memory");
            if (it + DEPTH < 16) fw[sl] = *(const u32x4*)(gf + PG8_GOFF(it + DEPTH));
            asm volatile("" ::: "memory");
            acc[ai][bj][m][0][0] *= bf_lo(fwc.x); acc[ai][bj][m][0][1] *= bf_hi(fwc.x); acc[ai][bj][m][0][2] *= bf_lo(fwc.y); acc[ai][bj][m][0][3] *= bf_hi(fwc.y);
            acc[ai][bj][m][1][0] *= bf_lo(fwc.z); acc[ai][bj][m][1][1] *= bf_hi(fwc.z); acc[ai][bj][m][1][2] *= bf_lo(fwc.w); acc[ai][bj][m][1][3] *= bf_hi(fwc.w); }
    }
    __device__ __forceinline__ void operator()(const f32x4 (&acc)[2][2][4][2], const Unit& u, int wr, int wc, int fr, int fq) const {
        const int row0 = u.pm * BM + wr * 64 + fr, col0 = u.pn * BM + wc * 32 + 8 * fq;
        constexpr int DEPTH = 8;
        u32x4 rw[DEPTH];
#pragma unroll
        for (int d = 0; d < DEPTH; ++d) rw[d] = *(const u32x4*)(gr + PG8_GOFF(d));
#pragma unroll
        for (int it = 0; it < 16; ++it) { const int ai = it >> 3, m = (it >> 1) & 3, bj = it & 1, sl = it % DEPTH;
            const u32x4 rwc = rw[sl];
            asm volatile("" ::: "memory");
            if (it + DEPTH < 16) rw[sl] = *(const u32x4*)(gr + PG8_GOFF(it + DEPTH));
            asm volatile("" ::: "memory");
            f32x4 g0, g1; unpack8(rwc, g0, g1);
#pragma unroll
            for (int e = 0; e < 4; ++e) { g0[e] = fmaxf(g0[e], 1e-20f); g1[e] = fmaxf(g1[e], 1e-20f); }
            *(u32x4*)(mb + PG8_GOFF(it)) = pack8(g0 * acc[ai][bj][m][0], g1 * acc[ai][bj][m][1]); }
#undef PG8_GOFF
    }
};
struct EpiResid {
    static constexpr bool PERM = false, AFTER_DRAIN = false, HAS_MID = false; static constexpr int KSLICE = 0; static constexpr bool SKIP_B1 = false, HAS_PRE = false;
    const float* base; float* out; const float* gate;
    __device__ __forceinline__ void operator()(const f32x4 (&acc)[2][2][4][2], const Unit& u, int wr, int wc, int fr, int fq) const {
        const int row0 = u.pm * BM + wr * 64 + fr, col0 = u.pn * BM + wc * 32 + 4 * fq; const float* gp = gate + (size_t)(u.pm >> 3) * 6144 + col0;
        f32x4 gv[2][2];
#pragma unroll
        for (int bj = 0; bj < 2; ++bj)
#pragma unroll
            for (int n = 0; n < 2; ++n) gv[bj][n] = *(const f32x4*)(gp + bj * HALF + n * 16);
        f32x4 cur[2][2], nxt[2][2];
#pragma unroll
        for (int bj = 0; bj < 2; ++bj)
#pragma unroll
            for (int n = 0; n < 2; ++n) cur[bj][n] = *(const f32x4*)(base + (size_t)row0 * 1024 + col0 + bj * HALF + n * 16);
#pragma unroll
        for (int g8 = 0; g8 < 8; ++g8) { const int ai = g8 >> 2, m = g8 & 3; const size_t off = (size_t)(row0 + ai * HALF + m * 16) * 1024 + col0;
            if (g8 + 1 < 8) { const int ai2 = (g8 + 1) >> 2, m2 = (g8 + 1) & 3; const size_t off2 = (size_t)(row0 + ai2 * HALF + m2 * 16) * 1024 + col0;
#pragma unroll
                for (int bj = 0; bj < 2; ++bj)
#pragma unroll
                    for (int n = 0; n < 2; ++n) nxt[bj][n] = *(const f32x4*)(base + off2 + bj * HALF + n * 16); }
            asm volatile("" ::: "memory");
#pragma unroll
            for (int bj = 0; bj < 2; ++bj)
#pragma unroll
                for (int n = 0; n < 2; ++n) *(f32x4*)(out + off + bj * HALF + n * 16) = cur[bj][n] + gv[bj][n] * acc[ai][bj][m][n];
            asm volatile("" ::: "memory");
#pragma unroll
            for (int bj = 0; bj < 2; ++bj)
#pragma unroll
                for (int n = 0; n < 2; ++n) cur[bj][n] = nxt[bj][n];
        }
    }
};
struct EpiDelta {
    static constexpr bool PERM = true, AFTER_DRAIN = false, HAS_MID = false; static constexpr int KSLICE = 0; static constexpr bool SKIP_B1 = false, HAS_PRE = false;
    bf16_t* dlt; const float* gate;
    __device__ __forceinline__ void operator()(const f32x4 (&acc)[2][2][4][2], const Unit& u, int wr, int wc, int fr, int fq) const {
        const int row0 = u.pm * BM + wr * 64 + fr, col0 = u.pn * BM + wc * 32 + 8 * fq; const float* gp = gate + (size_t)(u.pm >> 3) * 6144 + col0;
        f32x4 gv[2][2];
#pragma unroll
        for (int bj = 0; bj < 2; ++bj)
#pragma unroll
            for (int n = 0; n < 2; ++n) gv[bj][n] = *(const f32x4*)(gp + bj * HALF + 4 * n);
#pragma unroll
        for (int ai = 0; ai < 2; ++ai)
#pragma unroll
            for (int m = 0; m < 4; ++m) { bf16_t* rowp = dlt + (size_t)(row0 + ai * HALF + m * 16) * 1024 + col0;
#pragma unroll
                for (int bj = 0; bj < 2; ++bj) *(u32x4*)(rowp + bj * HALF) = pack8(acc[ai][bj][m][0] * gv[bj][0], acc[ai][bj][m][1] * gv[bj][1]); }
    }
};
struct EpiSwiglu {
    static constexpr bool PERM = true, AFTER_DRAIN = false, HAS_MID = false; static constexpr int KSLICE = 0; static constexpr bool SKIP_B1 = false, HAS_PRE = false;
    bf16_t* act;
    __device__ __forceinline__ void operator()(const f32x4 (&acc)[2][2][4][2], const Unit& u, int wr, int wc, int fr, int fq) const {
        const int row0 = u.pm * BM + wr * 64 + fr, col0 = u.pn * 128 + wc * 32 + 8 * fq;
#pragma unroll
        for (int ai = 0; ai < 2; ++ai)
#pragma unroll
            for (int m = 0; m < 4; ++m) { const f32x4 g0 = acc[ai][0][m][0], g1 = acc[ai][0][m][1];
                *(u32x4*)(act + (size_t)(row0 + ai * HALF + m * 16) * 2816 + col0) = pack8(g0 * sigm4(g0) * acc[ai][1][m][0], g1 * sigm4(g1) * acc[ai][1][m][1]); }
    }
};

template <class Epi, class Sched, bool ALIGN_EPI = false, bool SP2 = false>
__device__ __forceinline__ void gemm_phase(PG8_LAS unsigned char* lds, const Gemm g, const Sched& S, const Epi& E) {
    int tid_ = threadIdx.x; asm volatile("" : "+v"(tid_));
    const int tid = tid_, wid = __builtin_amdgcn_readfirstlane(tid >> 6), lane = tid & 63, wr = wid >> 2, wc = wid & 3, fr = lane & 15, fq = lane >> 4;
    int nt_ = Epi::KSLICE ? Epi::KSLICE / BK : g.K / BK; asm volatile("" : "+s"(nt_));
    const int K = g.K, nt = nt_;
    unsigned voffA[2], voffB[2];
#pragma unroll
    for (int i = 0; i < 2; ++i) { int R, C; stage_rc(tid * 16 + i * 8192, R, C); const int Rb = Epi::PERM ? ((R & ~31) + perm32(R & 31)) : R;
        voffA[i] = (unsigned)(R * K + C) * 2u; voffB[i] = (unsigned)(Rb * K + C) * 2u; }
    const size_t kstep = (size_t)(BK * 2);
    const size_t hstep = (size_t)HALF * K * 2;
    const size_t tstep = 2 * hstep;
    const unsigned ldsw = (unsigned)wid * 1024u;
    const int aoff = lds_byte(wr * 64 + fr, fq * 8), boff = lds_byte(wc * 32 + fr, fq * 8);
#define PG8_SA(b, h) (((b) * 2 + (h)) * HTB)
#define PG8_SB(b, h) ((4 + (b) * 2 + (h)) * HTB)
#define PG8_STAGE(bufoff, gbase, voff) do { _Pragma("unroll") for (int _i = 0; _i < 2; ++_i) \
        __builtin_amdgcn_global_load_lds((const unsigned*)((const char*)(gbase) + (voff)[_i]), (PG8_LAS unsigned*)(lds + (bufoff) + ldsw + _i * 8192), 16, 0, 0); } while (0)
#define PG8_LDA(dst, b, h) do { _Pragma("unroll") for (int m = 0; m < 4; ++m) _Pragma("unroll") for (int k = 0; k < 2; ++k) dst[m][k] = *(const PG8_LAS bf16x8*)(lds + PG8_SA(b, h) + aoff + m * 2048 + k * 1024); } while (0)
#define PG8_LDB(dst, b, h) do { _Pragma("unroll") for (int n = 0; n < 2; ++n) _Pragma("unroll") for (int k = 0; k < 2; ++k) dst[n][k] = *(const PG8_LAS bf16x8*)(lds + PG8_SB(b, h) + boff + n * 2048 + k * 1024); } while (0)
#define PG8_MMA(ai, bj, At, Bt) do { __builtin_amdgcn_s_setprio(1); _Pragma("unroll") for (int m = 0; m < 4; ++m) _Pragma("unroll") for (int n = 0; n < 2; ++n) _Pragma("unroll") for (int k = 0; k < 2; ++k) \
        acc[ai][bj][m][n] = __builtin_amdgcn_mfma_f32_16x16x32_bf16(Bt[n][k], At[m][k], acc[ai][bj][m][n], 0, 0, 0); __builtin_amdgcn_s_setprio(0); } while (0)
#define PG8_MMA1(ai, At) do { if constexpr (Epi::SKIP_B1) { if (!skb) PG8_MMA(ai, 1, At, B1); } else PG8_MMA(ai, 1, At, B1); } while (0)
#define PG8_WAIT_V(n) asm volatile("s_waitcnt vmcnt(" #n ")" ::: "memory")
#define PG8_WAIT_L(n) asm volatile("s_waitcnt lgkmcnt(" #n ")" ::: "memory")
#define PG8_BAR __builtin_amdgcn_s_barrier()
#define PG8_SCHED __builtin_amdgcn_sched_barrier(0)
    Unit cur, nxt; int ui = 0;
    if (!S.next(0, cur)) return;
    bool skb = false; if constexpr (Epi::SKIP_B1) skb = Epi::skip_b1(cur.pn);
    if constexpr (Epi::HAS_PRE) E.pre(cur, 0, wid, lane);
    f32x4 acc[2][2][4][2];
#pragma unroll
    for (int a = 0; a < 2; ++a)
#pragma unroll
        for (int b = 0; b < 2; ++b)
#pragma unroll
            for (int m = 0; m < 4; ++m)
#pragma unroll
                for (int n = 0; n < 2; ++n) acc[a][b][m][n] = (f32x4){0.f, 0.f, 0.f, 0.f};
    bf16x8 At[4][2], B0[2][2], B1[2][2];
    const char* cA = (const char*)g.A + (size_t)cur.pm * tstep; const char* cB = (const char*)g.Bt + (size_t)cur.pn * tstep;
    if constexpr (Epi::KSLICE != 0) { const int ko = Epi::koff(cur.pn) * 2; cA += ko; cB += ko; }
    S.a_ready(cur);
    if constexpr (SP2) {
        PG8_STAGE(PG8_SB(0, 0), cB, voffB); PG8_STAGE(PG8_SB(0, 1), cB + hstep, voffB); PG8_STAGE(PG8_SA(0, 0), cA, voffA); PG8_STAGE(PG8_SA(0, 1), cA + hstep, voffA);
        if (wr == 1) PG8_BAR;
        PG8_WAIT_V(2); PG8_BAR;
        PG8_STAGE(PG8_SB(1, 0), cB + kstep, voffB); PG8_STAGE(PG8_SA(1, 0), cA + kstep, voffA); PG8_STAGE(PG8_SB(1, 1), cB + hstep + kstep, voffB);
        PG8_WAIT_V(6); PG8_BAR;
    } else {
        PG8_STAGE(PG8_SB(0, 0), cB, voffB); PG8_STAGE(PG8_SA(0, 0), cA, voffA); PG8_STAGE(PG8_SB(0, 1), cB + hstep, voffB); PG8_STAGE(PG8_SA(0, 1), cA + hstep, voffA);
        if (wr == 1) PG8_BAR;
        PG8_WAIT_V(4); PG8_BAR;
        PG8_STAGE(PG8_SB(1, 0), cB + kstep, voffB); PG8_STAGE(PG8_SA(1, 0), cA + kstep, voffA); PG8_STAGE(PG8_SB(1, 1), cB + hstep + kstep, voffB);
        PG8_WAIT_V(6); PG8_BAR;
    }
    for (;;) {
        const bool has_next = S.next(ui + 1, nxt);
        const char* nA = has_next ? (const char*)g.A + (size_t)nxt.pm * tstep : cA; const char* nB = has_next ? (const char*)g.Bt + (size_t)nxt.pn * tstep : cB;
        if constexpr (Epi::KSLICE != 0) { if (has_next) { const int ko = Epi::koff(nxt.pn) * 2; nA += ko; nB += ko; } }
#pragma unroll 1
        for (int t = 0; t < nt; t += 2) {
            const bool last = (t == nt - 2);
            const char* a1 = cA + (size_t)(t + 1) * kstep;
            const char* a2 = last ? nA : cA + (size_t)(t + 2) * kstep; const char* b2 = last ? nB : cB + (size_t)(t + 2) * kstep;
            const char* a3 = a2 + kstep; const char* b3 = b2 + kstep;
            if (last && has_next) S.a_ready(nxt);
            if constexpr (SP2) {
            PG8_LDB(B0, 0, 0); PG8_LDB(B1, 0, 1); PG8_SCHED; PG8_LDA(At, 0, 0); PG8_STAGE(PG8_SA(1, 1), a1 + hstep, voffA);
            PG8_WAIT_V(8); PG8_WAIT_L(0); PG8_BAR; PG8_MMA(0, 0, At, B0); PG8_MMA1(0, At); PG8_BAR; PG8_SCHED;
            PG8_LDA(At, 0, 1); PG8_STAGE(PG8_SB(0, 0), b2, voffB); PG8_STAGE(PG8_SB(0, 1), b2 + hstep, voffB); PG8_STAGE(PG8_SA(0, 0), a2, voffA);
            PG8_WAIT_V(8); PG8_WAIT_L(0); PG8_BAR; PG8_MMA(1, 0, At, B0); PG8_MMA1(1, At); PG8_BAR; PG8_SCHED;
            PG8_LDB(B0, 1, 0); PG8_LDB(B1, 1, 1); PG8_SCHED; PG8_LDA(At, 1, 0); PG8_STAGE(PG8_SA(0, 1), a2 + hstep, voffA);
            PG8_WAIT_V(8); PG8_WAIT_L(0); PG8_BAR; PG8_MMA(0, 0, At, B0); PG8_MMA1(0, At); PG8_BAR; PG8_SCHED;
            PG8_LDA(At, 1, 1); PG8_STAGE(PG8_SB(1, 0), b3, voffB); PG8_STAGE(PG8_SB(1, 1), b3 + hstep, voffB); PG8_STAGE(PG8_SA(1, 0), a3, voffA);
            PG8_WAIT_V(8); PG8_WAIT_L(0); PG8_BAR; PG8_MMA(1, 0, At, B0); PG8_MMA1(1, At); PG8_BAR; PG8_SCHED;
            } else {
            PG8_LDB(B0, 0, 0); PG8_SCHED; PG8_LDA(At, 0, 0); PG8_STAGE(PG8_SA(1, 1), a1 + hstep, voffA);
            PG8_WAIT_L(8); PG8_BAR; PG8_WAIT_L(0); PG8_MMA(0, 0, At, B0); PG8_BAR; PG8_SCHED;
            PG8_LDB(B1, 0, 1); PG8_STAGE(PG8_SB(0, 0), b2, voffB);
            PG8_BAR; PG8_WAIT_L(0); PG8_MMA(0, 1, At, B1); PG8_BAR;
            PG8_LDA(At, 0, 1); PG8_STAGE(PG8_SA(0, 0), a2, voffA);
            PG8_BAR; PG8_WAIT_L(0); PG8_MMA(1, 0, At, B0); PG8_BAR; PG8_SCHED;
            PG8_STAGE(PG8_SB(0, 1), b2 + hstep, voffB);
            PG8_WAIT_V(6); PG8_BAR; PG8_MMA(1, 1, At, B1); PG8_BAR;
            PG8_LDB(B0, 1, 0); PG8_SCHED; PG8_LDA(At, 1, 0); PG8_STAGE(PG8_SA(0, 1), a2 + hstep, voffA);
            PG8_WAIT_L(8); PG8_BAR; PG8_WAIT_L(0); PG8_MMA(0, 0, At, B0); PG8_BAR; PG8_SCHED;
            PG8_LDB(B1, 1, 1); PG8_STAGE(PG8_SB(1, 0), b3, voffB);
            PG8_BAR; PG8_WAIT_L(0); PG8_MMA(0, 1, At, B1); PG8_BAR;
            PG8_LDA(At, 1, 1); PG8_STAGE(PG8_SA(1, 0), a3, voffA);
            PG8_BAR; PG8_WAIT_L(0); PG8_MMA(1, 0, At, B0); PG8_BAR; PG8_SCHED;
            PG8_STAGE(PG8_SB(1, 1), b3 + hstep, voffB);
            PG8_WAIT_V(6); PG8_BAR; PG8_MMA(1, 1, At, B1); PG8_BAR;
            }
            if constexpr (Epi::HAS_MID) { if (t == (nt >> 1) - 2) {
                if constexpr (ALIGN_EPI) { if (wr == 0) PG8_BAR; }
                E.mid(acc, cur, wr, wc, fr, fq);
                if constexpr (ALIGN_EPI) { if (wr == 1) PG8_BAR; } } }
        }
        if constexpr (ALIGN_EPI) { if (wr == 0) PG8_BAR; }
        if constexpr (!Epi::AFTER_DRAIN) { if constexpr (Epi::HAS_PRE) E(acc, cur, wr, wc, fr, fq, ui); else E(acc, cur, wr, wc, fr, fq); S.done(cur); }
        if (!has_next) break;
#pragma unroll
        for (int a = 0; a < 2; ++a)
#pragma unroll
            for (int b = 0; b < 2; ++b)
#pragma unroll
                for (int m = 0; m < 4; ++m)
#pragma unroll
                    for (int n = 0; n < 2; ++n) acc[a][b][m][n] = (f32x4){0.f, 0.f, 0.f, 0.f};
        cur = nxt; cA = nA; cB = nB; ++ui; if constexpr (Epi::SKIP_B1) skb = Epi::skip_b1(cur.pn);
        if constexpr (Epi::HAS_PRE) E.pre(cur, ui, wid, lane);
        if constexpr (ALIGN_EPI) { if (wr == 1) PG8_BAR; }
    }
    PG8_WAIT_V(0);
    if constexpr (!ALIGN_EPI) { if (wr == 0) PG8_BAR; }
    PG8_BAR;
    if constexpr (Epi::AFTER_DRAIN) { E.fused(acc, cur, wr, wc, fr, fq, lds, wid, lane); S.done(cur); }
#undef PG8_SA
#undef PG8_SB
#undef PG8_STAGE
#undef PG8_LDA
#undef PG8_LDB
#undef PG8_MMA
#undef PG8_MMA1
#undef PG8_WAIT_V
#undef PG8_WAIT_L
#undef PG8_BAR
#undef PG8_SCHED
}
}
constexpr int NWAVES = 8;
constexpr int N_LAUNCHES = MK_N_LAUNCHES;
constexpr int NPH = 16;
constexpr int D = 1024, NB = 16, SEQ = 2048, CTXL = 256, MX = NB * SEQ, MC = NB * CTXL, MT = MX + MC;
constexpr int RW = 512, NH = 8, HD = 64, RCOLS = 1920, RPAD = 2048, INCOLS = 4480, NIN = 4608, DFF = 2816, LK = 384, LN = 2560, MODW = 6144;
constexpr float NORM_EPS = 1e-6f, GN_EPS = 64e-5f;
constexpr size_t MiB = 1u << 20;
constexpr size_t WS_CTL = 0, CTL_ZERO_BYTES = 64 * 1024;
constexpr size_t WS_MOD = 1 * MiB, WS_LB = WS_MOD + 512 * 1024;
constexpr size_t WS_WIN = 2 * MiB, WS_WLORA = 12 * MiB, WS_WUPF = 14 * MiB, WS_WUPR = 15 * MiB, WS_WOUT = 16 * MiB;
constexpr size_t WS_A = 18 * MiB, WS_B = 82 * MiB, WS_C = 146 * MiB, WS_D = 210 * MiB, WS_E = 390 * MiB, WS_END = 512 * MiB;
constexpr size_t WS_GF = WS_A, WS_HX2 = WS_A, WS_GR = WS_B, WS_WGU = WS_E, WS_WDOWN = WS_E + 11 * MiB, WS_D1 = WS_B, WS_D2 = WS_A;
constexpr size_t WS_Z3 = WS_C, WS_FXO = WS_C;
constexpr size_t WS_PXR = WS_D, WS_LP = WS_D, WS_MB = WS_D, WS_ACT = WS_D;
constexpr size_t WS_EB = WS_E + 114 * MiB;
constexpr size_t WS_HX = WS_D, WS_Y2 = WS_E, WS_R = WS_E, WS_K = WS_E + 36 * MiB, WS_V = WS_E + 72 * MiB, WS_SBT = WS_E + 110 * MiB;
static_assert(WS_K - WS_R == 36 * MiB && WS_V - WS_K == 36 * MiB, "EpiIn::RKV_STRIDE");
static_assert(WS_LP + (size_t)MT * LN * 2 <= WS_E && WS_ACT + (size_t)MX * DFF * 2 <= WS_E && WS_V + (size_t)MT * RW * 2 <= WS_END && WS_HX + (size_t)MT * D * 2 <= WS_END, "d_ws map");
constexpr int CW_TMO = 0, CW_BAR = 4096, CW_BADMAP = 8192;
constexpr int RING_OFF = 0, RING_BYTES = 131072, LDSCTL_OFF = RING_BYTES, MISC_OFF = LDSCTL_OFF + 320, LDS_BYTES = 147456;
constexpr int XB_OFF = RING_BYTES + 4096;

#define GAS __attribute__((address_space(1)))
#define LAS __attribute__((address_space(3)))
typedef unsigned short bf16;
typedef unsigned v4u __attribute__((ext_vector_type(4)));
typedef unsigned v2u __attribute__((ext_vector_type(2)));
typedef float f32x4 __attribute__((ext_vector_type(4)));
typedef GAS unsigned gu32;
#define RLX_AGENT __ATOMIC_RELAXED, __HIP_MEMORY_SCOPE_AGENT
#define LDS_WAIT() asm volatile("s_waitcnt lgkmcnt(0)" ::: "memory")
#define VM_WAIT() asm volatile("s_waitcnt vmcnt(0)" ::: "memory")
__device__ __forceinline__ unsigned f2bf(float f) { unsigned u = __builtin_bit_cast(unsigned, f); return (u + 0x7fffu + ((u >> 16) & 1u)) >> 16; }
__device__ __forceinline__ unsigned pk2(float lo, float hi) { return f2bf(lo) | (f2bf(hi) << 16); }
__device__ __forceinline__ float bflo(unsigned w) { return __uint_as_float(w << 16); }
__device__ __forceinline__ float bfhi(unsigned w) { return __uint_as_float(w & 0xffff0000u); }
__device__ __forceinline__ float sigf(float x) { return 1.0f / (1.0f + __expf(-x)); }
__device__ __forceinline__ void unpk8(v4u w, float (&f)[8]) { f[0] = bflo(w.x); f[1] = bfhi(w.x); f[2] = bflo(w.y); f[3] = bfhi(w.y); f[4] = bflo(w.z); f[5] = bfhi(w.z); f[6] = bflo(w.w); f[7] = bfhi(w.w); }
__device__ __forceinline__ v4u pk8(const float (&f)[8]) { v4u o; o.x = pk2(f[0], f[1]); o.y = pk2(f[2], f[3]); o.z = pk2(f[4], f[5]); o.w = pk2(f[6], f[7]); return o; }

#define XB_TMO      128
#define XB_XCNT(j)  (256  + 64 * (j))
#define XB_XSUB(j)  (1280 + 64 * (j))
#define XB_XGEN(j)  (2304 + 64 * (j))
#define XB_TOP      3328
#define XB_TOPGEN   3392
#define XCD_BAR_WORDS 3456
#define XB_SPIN_CAP (1u << 18)

__device__ __forceinline__ unsigned xb_ld(unsigned* p)              { return __hip_atomic_load(p, __ATOMIC_RELAXED, __HIP_MEMORY_SCOPE_AGENT); }
__device__ __forceinline__ unsigned xb_add(unsigned* p, unsigned v) { return __hip_atomic_fetch_add(p, v, __ATOMIC_RELAXED, __HIP_MEMORY_SCOPE_AGENT); }
__device__ __forceinline__ unsigned xb_xcc_id() { return (unsigned)__builtin_amdgcn_s_getreg((3 << 11) | 20) & 0xFu; }
#define XB_SPIN(cond, bar) do { unsigned _sp = 0; while (cond) { __builtin_amdgcn_s_sleep(1); \
    if ((++_sp & 255u) == 0u) { if (xb_ld(&(bar)[XB_TMO])) break; if (_sp > XB_SPIN_CAP) { atomicAdd(&(bar)[XB_TMO], 1u); break; } } } } while (0)

struct XcdBarrier {
    unsigned* bar; unsigned x;
    volatile LAS unsigned* st;
};

__device__ __forceinline__ XcdBarrier xcd_barrier_post(unsigned* bar, volatile LAS unsigned* st) {
    XcdBarrier b; b.bar = bar; b.x = xb_xcc_id(); b.st = st;
    if (threadIdx.x == 0) (void)xb_add(&bar[XB_XCNT(b.x)], 1u);
    return b;
}
__device__ __forceinline__ void xcd_barrier_complete(unsigned* bar, unsigned x, unsigned& nloc, unsigned& nx) {
    const unsigned G = gridDim.x * gridDim.y * gridDim.z;
    unsigned sum, cnt, mine, sp = 0u;
    for (;;) {
        sum = 0u; cnt = 0u; mine = 0u;
#pragma unroll
        for (unsigned j = 0; j < 16; ++j) { const unsigned c = xb_ld(&bar[XB_XCNT(j)]); sum += c; cnt += (c > 0u) ? 1u : 0u; mine = (j == x) ? c : mine; }
        if (sum == G) break;
        __builtin_amdgcn_s_sleep(1);
        if ((++sp & 255u) == 0u) { if (xb_ld(&bar[XB_TMO])) break; if (sp > XB_SPIN_CAP) { atomicAdd(&bar[XB_TMO], 1u); break; } }
    }
    nloc = mine > 0u ? mine : 1u; nx = cnt > 0u ? cnt : 1u;
}

__device__ __forceinline__ void xcd_barrier(const XcdBarrier& b) {
    asm volatile("s_waitcnt vmcnt(0)" ::: "memory");
    __syncthreads();
    if (threadIdx.x == 0) {
        unsigned* bar = b.bar;
        __builtin_amdgcn_s_waitcnt(0);
        unsigned nloc = b.st[0], nx = b.st[1];
        if (nloc == 0u) { xcd_barrier_complete(bar, b.x, nloc, nx); b.st[0] = nloc; b.st[1] = nx; }
        const unsigned old = xb_add(&bar[XB_XSUB(b.x)], 1u);
        const unsigned gen = old / nloc;
        if (old + 1u == (gen + 1u) * nloc) {
            __builtin_amdgcn_fence(__ATOMIC_RELEASE, "agent");
            asm volatile("s_waitcnt vmcnt(0)" ::: "memory");
            const unsigned og = xb_add(&bar[XB_TOP], 1u);
            const unsigned tg = og / nx;
            if (og + 1u == (tg + 1u) * nx) xb_add(&bar[XB_TOPGEN], 1u);
            else XB_SPIN(xb_ld(&bar[XB_TOPGEN]) == tg, bar);
            __builtin_amdgcn_fence(__ATOMIC_ACQUIRE, "agent");
            xb_add(&bar[XB_XGEN(b.x)], 1u);
            asm volatile("s_waitcnt vmcnt(0)" ::: "memory");
        } else {
            XB_SPIN(xb_ld(&bar[XB_XGEN(b.x)]) == gen, bar);
            __builtin_amdgcn_fence(__ATOMIC_ACQUIRE, "agent");
            asm volatile("s_waitcnt vmcnt(0)" ::: "memory");
        }
    }
    __syncthreads();
}
__device__ __forceinline__ void xcd_barrier_local(const XcdBarrier& b) {
    asm volatile("s_waitcnt vmcnt(0)" ::: "memory");
    __syncthreads();
    if (threadIdx.x == 0) {
        unsigned* bar = b.bar;
        __builtin_amdgcn_s_waitcnt(0);
        const unsigned nloc = b.st[0] ? b.st[0] : 1u;
        const unsigned old = xb_add(&bar[XB_XSUB(b.x)], 1u);
        const unsigned gen = old / nloc;
        if (old + 1u == (gen + 1u) * nloc) (void)xb_add(&bar[XB_XGEN(b.x)], 1u);
        else XB_SPIN(xb_ld(&bar[XB_XGEN(b.x)]) == gen, bar);
        __builtin_amdgcn_fence(__ATOMIC_ACQUIRE, "agent");
        asm volatile("s_waitcnt vmcnt(0)" ::: "memory");
    }
    __syncthreads();
}
struct Args { const float* in[31]; float* out; unsigned char* ws; int ph_lo, ph_hi, li, pad; };
enum In { I_X = 0, I_C, I_CTX, I_CCTX, I_N1G, I_N2G, I_WADA, I_BADA, I_WIN, I_MUP, I_MUN, I_W0F, I_W2F, I_A0F, I_A2F, I_W0B, I_W2B, I_A0B, I_A2B, I_G2, I_KK, I_KA, I_RK, I_LNG, I_LNB, I_WUPR, I_WUPF, I_WOUT, I_WGU, I_WDOWN, I_FNG };
struct Frame { LAS unsigned char* lds; volatile LAS unsigned* MISC; gu32* ctl; int tid, lane, wave, vcu, G; };

__device__ __forceinline__ void refresh_tid(Frame& F) { int t = threadIdx.x; asm volatile("" : "+v"(t)); F.tid = t; F.lane = t & 63; }
__device__ __forceinline__ float wave_sum(float v) {
#pragma unroll
    for (int o = 1; o < 64; o <<= 1) v += __shfl_xor(v, o);
    return v;
}
__device__ __forceinline__ float red8(float v) { v += __shfl_xor(v, 1); v += __shfl_xor(v, 2); v += __shfl_xor(v, 4); return v; }

__device__ __forceinline__ void tr_item(const float* W, int ldw, int k0, int n0, bf16* WTrow0, int ldk, LAS float* scr, int lane) {
    float tv[32];
#pragma unroll
    for (int i = 0; i < 32; ++i) tv[i] = __builtin_nontemporal_load(W + (size_t)(k0 + 2 * i + (lane >> 5)) * ldw + n0 + (lane & 31));
#pragma unroll
    for (int i = 0; i < 32; ++i) scr[(2 * i + (lane >> 5)) * 33 + (lane & 31)] = tv[i];
    LDS_WAIT(); asm volatile("" ::: "memory");
    const int c = lane & 7;
#pragma unroll
    for (int j = 0; j < 4; ++j) { const int n = (lane >> 3) + 8 * j; const LAS float* s = scr + (8 * c) * 33 + n;
        v4u o; o.x = pk2(s[0 * 33], s[1 * 33]); o.y = pk2(s[2 * 33], s[3 * 33]); o.z = pk2(s[4 * 33], s[5 * 33]); o.w = pk2(s[6 * 33], s[7 * 33]);
        *(GAS v4u*)(WTrow0 + (size_t)n * ldk + k0 + 8 * c) = o; }
    LDS_WAIT(); asm volatile("" ::: "memory");
}

__device__ __forceinline__ void p0_weights(const Frame& F, const Args& a) {
    unsigned char* ws = a.ws;
    bf16* Win_t = (bf16*)(ws + WS_WIN); bf16* Wlora_t = (bf16*)(ws + WS_WLORA); bf16* Wupf_t = (bf16*)(ws + WS_WUPF); bf16* Wupr_t = (bf16*)(ws + WS_WUPR); bf16* Wout_t = (bf16*)(ws + WS_WOUT);
    LAS float* scr = (LAS float*)(F.lds + RING_OFF + F.wave * 16384);
    const int gw = F.vcu * NWAVES + F.wave, NGW = F.G * NWAVES, lane = F.lane;
    constexpr int E0 = 960, E1 = E0 + 1280, E2 = E1 + 256, E3 = E2 + 256, E4 = E3 + 512, E5 = E4 + 128, E6 = E5 + 2560;
    for (int it = gw; it < E6; it += NGW) {
        if (it < E0) { const int kb = it / 60, nb = it % 60; tr_item(a.in[I_WIN], INCOLS, 64 * kb, 32 * nb, Win_t + (size_t)(32 * nb) * D, D, scr, lane); }
        else if (it < E1) { const int r = it - E0, kb = r / 80, nb = r % 80;
            int drow = 2048 + 32 * nb; if (nb >= 16) { const int gj = 32 * ((nb - 16) & 31); drow = 2560 + (gj >> 7) * 256 + (gj & 127) + (nb >= 48 ? 128 : 0); }
            tr_item(a.in[I_WIN] + 1920, INCOLS, 64 * kb, 32 * nb, Win_t + (size_t)drow * D, D, scr, lane); }
        else if (it < E2) { const int r = it - E1, kb = r >> 5, nb = r & 31; tr_item(a.in[I_WUPF], D, 64 * kb, 32 * nb, Wupf_t + (size_t)(32 * nb) * 1024, 1024, scr, lane); }
        else if (it < E3) { const int r = it - E2, kb = r >> 5, nb = r & 31; tr_item(a.in[I_WUPR], D, 64 * kb, 32 * nb, Wupf_t + (size_t)(32 * nb) * 1024 + 512, 1024, scr, lane); }
        else if (it < E4) { const int r = it - E3, kb = r >> 5, nb = r & 31; tr_item(a.in[I_WOUT], D, 64 * kb, 32 * nb, Wout_t + (size_t)(32 * nb) * D, D, scr, lane); }
        else if (it < E5) { const int row = RCOLS + (it - E4); GAS v4u* p = (GAS v4u*)(Win_t + (size_t)row * D + 16 * lane); p[0] = (v4u){0u, 0u, 0u, 0u}; p[1] = (v4u){0u, 0u, 0u, 0u}; }
        else { const int n = it - E5, t = n >> 9, nn = n & 511, koff = t < 4 ? 64 * t : 256, klen = t < 4 ? 64 : 128;
            const float* src = t == 0 ? a.in[I_W2F] : t == 1 ? a.in[I_W2B] : t == 2 ? a.in[I_A2F] : t == 3 ? a.in[I_A2B] : a.in[I_G2];
            float v[6];
#pragma unroll
            for (int e = 0; e < 6; ++e) { const int kk = 6 * lane + e - koff; v[e] = (kk >= 0 && kk < klen) ? src[(size_t)kk * 512 + nn] : 0.f; }
            GAS unsigned* p = (GAS unsigned*)(Wlora_t + (size_t)n * LK + 6 * lane); p[0] = pk2(v[0], v[1]); p[1] = pk2(v[2], v[3]); p[2] = pk2(v[4], v[5]); }
    }
    if (blockIdx.x == 0) { float* LB = (float*)(a.ws + WS_LB);
        for (int i = F.tid; i < LN; i += NWAVES * 64) { const int t = i >> 9, nn = i & 511; LB[i] = t == 0 ? a.in[I_W0F][nn] : t == 1 ? a.in[I_W0B][nn] : t == 2 ? a.in[I_A0F][nn] : t == 3 ? a.in[I_A0B][nn] : 0.f; } }
    __syncthreads();
    LAS float* L = (LAS float*)(F.lds + RING_OFF);
    for (int it = blockIdx.x; it < 192; it += F.G) {
        {
            const int n0 = it * 32;
            LAS float* sc = L; LAS float* red = L + 17 * 1024;
            { float cvv[34];
#pragma unroll
              for (int i = 0; i < 34; ++i) { const int idx = F.tid + 512 * i, b = idx >> 10, k = idx & 1023; cvv[i] = b < 16 ? a.in[I_C][b * 1024 + k] : a.in[I_CCTX][k]; }
#pragma unroll
              for (int i = 0; i < 34; ++i) sc[F.tid + 512 * i] = cvv[i] * sigf(cvv[i]); }
            __syncthreads();
            const int col = F.tid & 31, ks = F.tid >> 5;
            float acc[17];
#pragma unroll
            for (int b = 0; b < 17; ++b) acc[b] = 0.f;
            for (int k8 = 0; k8 < 64; k8 += 16) { float wv[16];
#pragma unroll
                for (int j = 0; j < 16; ++j) wv[j] = __builtin_nontemporal_load(a.in[I_WADA] + (size_t)(ks * 64 + k8 + j) * MODW + n0 + col);
#pragma unroll
                for (int j = 0; j < 16; ++j) { const int k = ks * 64 + k8 + j;
#pragma unroll
                    for (int b = 0; b < 17; ++b) acc[b] += sc[b * 1024 + k] * wv[j]; } }
#pragma unroll
            for (int b = 0; b < 17; ++b) red[(ks * 17 + b) * 32 + col] = acc[b];
            __syncthreads();
            for (int o = F.tid; o < 17 * 32; o += NWAVES * 64) { const int b = o >> 5, c2 = o & 31; float s = a.in[I_BADA][n0 + c2];
                for (int k2 = 0; k2 < 16; ++k2) s += red[(k2 * 17 + b) * 32 + c2];
                ((float*)(a.ws + WS_MOD))[b * MODW + n0 + c2] = s; }
            __syncthreads();
        }
    }
}
__device__ __forceinline__ void p_weights2(const Frame& F, const Args& a) {
    bf16* Wgu_t = (bf16*)(a.ws + WS_WGU); bf16* Wdown_t = (bf16*)(a.ws + WS_WDOWN);
    LAS float* scr = (LAS float*)(F.lds + RING_OFF + F.wave * 16384);
    const int gw = F.vcu * NWAVES + F.wave, NGW = F.G * NWAVES;
    for (int it = gw; it < 2816 + 1408; it += NGW) {
        if (it < 2816) { const int kb = it / 176, nb = it % 176, n0 = 32 * nb; const int np = n0 < DFF ? n0 : n0 - DFF; const int drow = (np >> 7) * 256 + (np & 127) + (n0 < DFF ? 0 : 128);
            tr_item(a.in[I_WGU], 2 * DFF, 64 * kb, n0, Wgu_t + (size_t)drow * D, D, scr, F.lane); }
        else { const int r = it - 2816, kb = r >> 5, nb = r & 31; tr_item(a.in[I_WDOWN], D, 64 * kb, 32 * nb, Wdown_t + (size_t)(32 * nb) * DFF, DFF, scr, F.lane); }
    }
}
template <int KIND> __device__ __forceinline__ void norm_mod_rows(const Args& a, int m0, int m1, const float* g, bf16* O, int lane) {
    if (m0 >= m1) return;
    const float* MODp = (const float*)(a.ws + WS_MOD);
    f32x4 gg[4];
#pragma unroll
    for (int j = 0; j < 4; ++j) gg[j] = ((const f32x4*)g)[lane + 64 * j];
    auto rowp = [&](int m) -> const GAS f32x4* { const float* p = (KIND == 1 || m < MX) ? a.in[I_X] + (size_t)m * D : a.in[I_CTX] + (size_t)(m - MX) * D; return (const GAS f32x4*)p + lane; };
    const bf16* D1 = (const bf16*)(a.ws + WS_D1);
    f32x4 cur[4], nxt[4], ss[4], cc[4]; v2u cd[4], nd[4]; int bcur = -1;
    { const GAS f32x4* p = rowp(m0);
#pragma unroll
      for (int j = 0; j < 4; ++j) { cur[j] = __builtin_nontemporal_load(p + 64 * j); if (KIND == 1) cd[j] = __builtin_nontemporal_load((const GAS v2u*)(D1 + (size_t)m0 * D) + lane + 64 * j); } }
    for (int m = m0; m < m1; ++m) {
        if (m + 1 < m1) { const GAS f32x4* p = rowp(m + 1);
#pragma unroll
            for (int j = 0; j < 4; ++j) { nxt[j] = __builtin_nontemporal_load(p + 64 * j); if (KIND == 1) nd[j] = __builtin_nontemporal_load((const GAS v2u*)(D1 + (size_t)(m + 1) * D) + lane + 64 * j); } }
        if (KIND == 1) {
#pragma unroll
            for (int j = 0; j < 4; ++j) cur[j] = cur[j] + (f32x4){bflo(cd[j].x), bfhi(cd[j].x), bflo(cd[j].y), bfhi(cd[j].y)}; }
        const int b = KIND == 0 ? (m < MX ? (m >> 11) : 16) : (m >> 11);
        if (b != bcur) { bcur = b; const float* md = MODp + (size_t)b * MODW + (KIND == 0 ? 0 : 3072);
#pragma unroll
            for (int j = 0; j < 4; ++j) { ss[j] = ((const f32x4*)md)[lane + 64 * j]; cc[j] = ((const f32x4*)(md + 1024))[lane + 64 * j] + 1.0f; } }
        float s2 = 0.f;
#pragma unroll
        for (int j = 0; j < 4; ++j) s2 += (cur[j].x * cur[j].x + cur[j].y * cur[j].y) + (cur[j].z * cur[j].z + cur[j].w * cur[j].w);
        const float rstd = 1.0f / sqrtf(wave_sum(s2) * (1.f / D) + NORM_EPS);
        GAS v2u* o8 = (GAS v2u*)(O + (size_t)m * D) + lane;
#pragma unroll
        for (int j = 0; j < 4; ++j) { const f32x4 o = (cur[j] * rstd) * gg[j] * cc[j] + ss[j]; v2u w; w.x = pk2(o.x, o.y); w.y = pk2(o.z, o.w); o8[64 * j] = w; }
#pragma unroll
        for (int j = 0; j < 4; ++j) { cur[j] = nxt[j]; cd[j] = nd[j]; }
    }
}
typedef short bf16x8v __attribute__((ext_vector_type(8)));
__device__ __forceinline__ unsigned offb(unsigned row, unsigned ch) { return 256u * row + 16u * (ch ^ (((row & 3u) << 2) | ((row >> 2) & 3u))); }
__device__ __forceinline__ void tr_read8(unsigned a0, unsigned a1, v2u (&r0)[4], v2u (&r1)[4]) {
    asm volatile("ds_read_b64_tr_b16 %0, %8\n\tds_read_b64_tr_b16 %1, %8 offset:8192\n\tds_read_b64_tr_b16 %2, %8 offset:16384\n\tds_read_b64_tr_b16 %3, %8 offset:24576\n\t"
                 "ds_read_b64_tr_b16 %4, %9\n\tds_read_b64_tr_b16 %5, %9 offset:8192\n\tds_read_b64_tr_b16 %6, %9 offset:16384\n\tds_read_b64_tr_b16 %7, %9 offset:24576\n\ts_waitcnt lgkmcnt(0)"
                 : "=&v"(r0[0]), "=&v"(r0[1]), "=&v"(r0[2]), "=&v"(r0[3]), "=&v"(r1[0]), "=&v"(r1[1]), "=&v"(r1[2]), "=&v"(r1[3]) : "v"(a0), "v"(a1) : "memory");
}
__device__ __forceinline__ void tr_read4(unsigned a0, unsigned a1, v2u (&r0)[2], v2u (&r1)[2]) {
    asm volatile("ds_read_b64_tr_b16 %0, %4\n\tds_read_b64_tr_b16 %1, %4 offset:8192\n\tds_read_b64_tr_b16 %2, %5\n\tds_read_b64_tr_b16 %3, %5 offset:8192\n\ts_waitcnt lgkmcnt(0)"
                 : "=&v"(r0[0]), "=&v"(r0[1]), "=&v"(r1[0]), "=&v"(r1[1]) : "v"(a0), "v"(a1) : "memory");
}
__device__ __forceinline__ bf16x8v mk_b(v2u lo, v2u hi) { v4u w = {lo.x, lo.y, hi.x, hi.y}; return __builtin_bit_cast(bf16x8v, w); }
__device__ __forceinline__ void dft_pass_a(const Frame& F, const bf16* PXF, bf16* Y2) {
    constexpr int RSW = 272;
    const int w = F.wave, l = F.lane, lr = l & 15, g4 = l >> 4, q = (l & 15) >> 2, p = l & 3;
    const unsigned ldsb = (unsigned)(size_t)(F.lds + RING_OFF);
    LAS unsigned char* IN = F.lds + RING_OFF; LAS bf16* OUT = (LAS bf16*)(F.lds + RING_OFF + 32768); LAS unsigned char* RAW = F.lds + RING_OFF + 65536;
    bf16x8v afr[4], af0[2][4];
    { const int m = 16 * w + lr, ri = m >> 6, k2 = m & 63;
#pragma unroll
      for (int ks = 0; ks < 4; ++ks) { unsigned pk[4];
#pragma unroll
          for (int e2 = 0; e2 < 4; ++e2) { float vv[2];
#pragma unroll
              for (int h = 0; h < 2; ++h) { const int k = 32 * ks + 8 * g4 + 2 * e2 + h, rj = k >> 6, n2 = k & 63, idx = (k2 * n2) & 63; const float rev = (float)idx * (1.0f / 64.0f), sn = __builtin_amdgcn_sinf(rev), cs = __builtin_amdgcn_cosf(rev); vv[h] = (ri == rj) ? cs : (ri == 0 ? sn : -sn); }
              pk[e2] = pk2(vv[0], vv[1]); }
          afr[ks] = __builtin_bit_cast(bf16x8v, (v4u){pk[0], pk[1], pk[2], pk[3]}); } }
#pragma unroll
    for (int mt = 0; mt < 2; ++mt) { const int m = 32 * w + 16 * mt + lr, ri = m >> 7, k3 = m & 127;
#pragma unroll
      for (int ks = 0; ks < 4; ++ks) { unsigned pk[4];
#pragma unroll
          for (int e2 = 0; e2 < 4; ++e2) { float vv[2];
#pragma unroll
              for (int h = 0; h < 2; ++h) { const int n3 = 32 * ks + 8 * g4 + 2 * e2 + h, idx = (k3 * n3) & 127; const float rev = (float)idx * (1.0f / 128.0f), sn = __builtin_amdgcn_sinf(rev), cs = __builtin_amdgcn_cosf(rev); vv[h] = ri == 0 ? cs : -sn; }
              pk[e2] = pk2(vv[0], vv[1]); }
          af0[mt][ks] = __builtin_bit_cast(bf16x8v, (v4u){pk[0], pk[1], pk[2], pk[3]}); } }
    unsigned rb[2], mk[2];
#pragma unroll
    for (int t = 0; t < 2; ++t) { const unsigned row = 8 * g4 + 4 * t + q; rb[t] = ldsb + 256u * row + 8u * (p & 1); mk[t] = ((row & 3u) << 2) | ((row >> 2) & 3u); }
    const unsigned hb = p >> 1;
    v4u pre[2];
    { const int it = blockIdx.x; if (it < 2048) { const int jc = it & 3, n1 = (it >> 2) & 31, b = it >> 7;
#pragma unroll
        for (int i = 0; i < 2; ++i) { const int cid = F.tid + 512 * i, row = cid >> 4, ch = cid & 15; pre[i] = __builtin_nontemporal_load((const GAS v4u*)(PXF + (size_t)(b * 2048 + n1 * 64 + row) * 512 + jc * 128 + ch * 8)); } } }
    for (int it = blockIdx.x; it < 2048; it += F.G) {
        const int jc = it & 3, n1 = (it >> 2) & 31, b = it >> 7;
        __syncthreads();
#pragma unroll
        for (int i = 0; i < 2; ++i) { const int cid = F.tid + 512 * i, row = cid >> 4, ch = cid & 15; *(LAS v4u*)(RAW + row * RSW + ch * 16) = pre[i]; }
        { const int itn = it + F.G; if (itn < 2048) { const int jcn = itn & 3, n1n = (itn >> 2) & 31, bn = itn >> 7;
#pragma unroll
            for (int i = 0; i < 2; ++i) { const int cid = F.tid + 512 * i, row = cid >> 4, ch = cid & 15; pre[i] = __builtin_nontemporal_load((const GAS v4u*)(PXF + (size_t)(bn * 2048 + n1n * 64 + row) * 512 + jcn * 128 + ch * 8)); } } }
        __syncthreads();
#pragma unroll
        for (int nt = 0; nt < 4; ++nt) {
            bf16x8v bx[4];
#pragma unroll
            for (int ks = 0; ks < 4; ++ks) bx[ks] = *(const LAS bf16x8v*)(RAW + (16 * nt + lr) * RSW + (32 * ks + 8 * g4) * 2);
#pragma unroll
            for (int mt = 0; mt < 2; ++mt) { f32x4 acc = {0.f, 0.f, 0.f, 0.f};
#pragma unroll
                for (int ks = 0; ks < 4; ++ks) acc = __builtin_amdgcn_mfma_f32_16x16x32_bf16(af0[mt][ks], bx[ks], acc, 0, 0, 0);
                const int m0 = 32 * w + 16 * mt + 4 * g4, ri = m0 >> 7, c0 = m0 & 127, row = ri * 64 + 16 * nt + lr;
                *(LAS v2u*)(IN + offb(row, c0 >> 3) + 8 * ((c0 >> 2) & 1)) = (v2u){pk2(acc[0], acc[1]), pk2(acc[2], acc[3])}; }
        }
        __syncthreads();
#pragma unroll 2
        for (int c = 0; c < 8; ++c) {
            v2u r0[4], r1[4];
            tr_read8(rb[0] + 16u * ((2u * c + hb) ^ mk[0]), rb[1] + 16u * ((2u * c + hb) ^ mk[1]), r0, r1);
            f32x4 acc = {0.f, 0.f, 0.f, 0.f};
#pragma unroll
            for (int ks = 0; ks < 4; ++ks) acc = __builtin_amdgcn_mfma_f32_16x16x32_bf16(afr[ks], mk_b(r0[ks], r1[ks]), acc, 0, 0, 0);
#pragma unroll
            for (int r = 0; r < 4; ++r) OUT[(16 * w + 4 * g4 + r) * 128 + 16 * c + lr] = (bf16)f2bf(acc[r]);
        }
        __syncthreads();
#pragma unroll
        for (int i = 0; i < 4; ++i) { const int cid = F.tid + 512 * i, row = cid >> 4, ch = cid & 15, ri = row >> 6, k2 = row & 63;
            *(GAS v4u*)(Y2 + (size_t)(b * 2048 + n1 * 64 + k2) * 1024 + ri * 512 + jc * 128 + ch * 8) = *(const LAS v4u*)(OUT + row * 128 + ch * 8); }
    }
}
__device__ __forceinline__ void dft_pass_b(const Frame& F, const bf16* Y2, bf16* FX) {
    const int w = F.wave, l = F.lane, lr = l & 15, g4 = l >> 4, q = (l & 15) >> 2, p = l & 3;
    const int g = w >> 1, c0 = (w & 1) * 4;
    const unsigned ldsb = (unsigned)(size_t)(F.lds + RING_OFF) + 16384u * g;
    LAS unsigned char* IN = F.lds + RING_OFF; LAS bf16* OUT = (LAS bf16*)(F.lds + RING_OFF + 65536);
    bf16x8v afr[2][2];
#pragma unroll
    for (int mt = 0; mt < 2; ++mt) { const int k1 = 16 * mt + lr;
#pragma unroll
      for (int ks = 0; ks < 2; ++ks) { unsigned pk[4];
#pragma unroll
          for (int e2 = 0; e2 < 4; ++e2) { float vv[2];
#pragma unroll
              for (int h = 0; h < 2; ++h) { const int k = 32 * ks + 8 * g4 + 2 * e2 + h, ri = k >> 5, n1 = k & 31, idx = (k1 * n1) & 31; const float rev = (float)idx * (1.0f / 32.0f), sn = __builtin_amdgcn_sinf(rev), cs = __builtin_amdgcn_cosf(rev); vv[h] = (ri == 0 ? cs : sn); }
              pk[e2] = pk2(vv[0], vv[1]); }
          afr[mt][ks] = __builtin_bit_cast(bf16x8v, (v4u){pk[0], pk[1], pk[2], pk[3]}); } }
    unsigned rb[2], mk[2];
#pragma unroll
    for (int t = 0; t < 2; ++t) { const unsigned row = 8 * g4 + 4 * t + q; rb[t] = ldsb + 256u * row + 8u * (p & 1); mk[t] = ((row & 3u) << 2) | ((row >> 2) & 3u); }
    const unsigned hb = p >> 1;
    v4u pre[8];
    { const int it = blockIdx.x; if (it < 1024) { const int k2 = it & 63, b = it >> 6;
#pragma unroll
        for (int i = 0; i < 8; ++i) { const int cid = F.tid + 512 * i, row = cid >> 6, c64 = cid & 63; pre[i] = __builtin_nontemporal_load((const GAS v4u*)(Y2 + (size_t)(b * 2048 + (row & 31) * 64 + k2) * 1024 + (row >> 5) * 512 + c64 * 8)); } } }
    for (int it = blockIdx.x; it < 1024; it += F.G) {
        const int k2 = it & 63, b = it >> 6;
        __syncthreads();
#pragma unroll
        for (int i = 0; i < 8; ++i) { const int cid = F.tid + 512 * i, row = cid >> 6, c64 = cid & 63, gg = c64 >> 4, ch = c64 & 15; *(LAS v4u*)(IN + 16384 * gg + offb(row, ch)) = pre[i]; }
        { const int itn = it + F.G; if (itn < 1024) { const int k2n = itn & 63, bn = itn >> 6;
#pragma unroll
            for (int i = 0; i < 8; ++i) { const int cid = F.tid + 512 * i, row = cid >> 6, c64 = cid & 63; pre[i] = __builtin_nontemporal_load((const GAS v4u*)(Y2 + (size_t)(bn * 2048 + (row & 31) * 64 + k2n) * 1024 + (row >> 5) * 512 + c64 * 8)); } } }
        __syncthreads();
#pragma unroll
        for (int cc = 0; cc < 4; ++cc) { const int c = c0 + cc;
            v2u r0[2], r1[2];
            tr_read4(rb[0] + 16u * ((2u * c + hb) ^ mk[0]), rb[1] + 16u * ((2u * c + hb) ^ mk[1]), r0, r1);
#pragma unroll
            for (int mt = 0; mt < 2; ++mt) { f32x4 acc = {0.f, 0.f, 0.f, 0.f};
#pragma unroll
                for (int ks = 0; ks < 2; ++ks) acc = __builtin_amdgcn_mfma_f32_16x16x32_bf16(afr[mt][ks], mk_b(r0[ks], r1[ks]), acc, 0, 0, 0);
#pragma unroll
                for (int r = 0; r < 4; ++r) OUT[(16 * mt + 4 * g4 + r) * 512 + g * 128 + 16 * c + lr] = (bf16)f2bf(acc[r] * (1.0f / 512.0f)); }
        }
        __syncthreads();
#pragma unroll
        for (int i = 0; i < 4; ++i) { const int cid = F.tid + 512 * i, row = cid >> 6, ch = cid & 63;
            *(GAS v4u*)(FX + (size_t)(b * 2048 + row * 64 + k2) * 1024 + ch * 8) = *(const LAS v4u*)(OUT + row * 512 + ch * 8); }
    }
}
template <int CTRL> __device__ __forceinline__ float dpp_add(float x) { const int v = __builtin_amdgcn_update_dpp(__float_as_int(x), __float_as_int(x), CTRL, 0xF, 0xF, false); return x + __int_as_float(v); }
__device__ __forceinline__ void edge_rows(const Frame& F, const Args& a) {
    const float* EB = (const float*)(a.ws + WS_EB); bf16* RB = (bf16*)(a.ws + WS_R); bf16* KB = (bf16*)(a.ws + WS_K); bf16* VB = (bf16*)(a.ws + WS_V); bf16* AL = (bf16*)a.out;
    const int gw = F.vcu * NWAVES + F.wave, lane = F.lane;
    if (gw >= 8 * (MT / 256)) return;
    const int tile = gw >> 3, last = (gw >> 2) & 1, j = gw & 3, col = 512 * j + 8 * lane;
    if (col >= RCOLS) return;
    const bool lat = tile < MX / 256, s0 = lat ? (tile & 7) == 0 : true, s1 = lat ? (tile & 7) == 7 : true;
    const int m = tile * 256 + (last ? 255 : 0);
    const float* cp = EB + ((size_t)tile * 4 + (last ? 3 : 0)) * 2048 + col;
    const float* pp = (last ? EB + ((size_t)tile * 4 + 2) * 2048 : EB + ((size_t)(tile > 0 ? tile - 1 : 0) * 4 + 3) * 2048) + col;
    const float* np = (last ? EB + ((size_t)(tile + 1 < MT / 256 ? tile + 1 : tile) * 4 + 0) * 2048 : EB + ((size_t)tile * 4 + 1) * 2048) + col;
    const bool hp = last ? true : !s0, hn = last ? !s1 : true;
    const f32x4 z = {0.f, 0.f, 0.f, 0.f};
    f32x4 c4[2], p4[2], n4[2], mp4[2], mn4[2];
#pragma unroll
    for (int h = 0; h < 2; ++h) { c4[h] = ((const f32x4*)cp)[h]; p4[h] = hp ? ((const f32x4*)pp)[h] : z; n4[h] = hn ? ((const f32x4*)np)[h] : z; mp4[h] = ((const f32x4*)(a.in[I_MUP] + col))[h]; mn4[h] = ((const f32x4*)(a.in[I_MUN] + col))[h]; }
    float u[8];
#pragma unroll
    for (int e = 0; e < 8; ++e) { const float c = c4[e >> 2][e & 3]; u[e] = c + mp4[e >> 2][e & 3] * (p4[e >> 2][e & 3] - c) + mn4[e >> 2][e & 3] * (n4[e >> 2][e & 3] - c); }
    if (j == 0) *(GAS v4u*)(RB + (size_t)m * RW + 8 * lane) = pk8(u);
    else if (j == 1) *(GAS v4u*)(KB + (size_t)m * RW + 8 * lane) = pk8(u);
    else if (j == 2) *(GAS v4u*)(VB + (size_t)m * RW + 8 * lane) = pk8(u);
    else {
        if (lane < 16) {
#pragma unroll
            for (int e = 0; e < 8; ++e) u[e] = 2.0f * sigf(2.0f * u[e]) - 1.0f;
        } else if (lane >= 32) {
#pragma unroll
            for (int e = 0; e < 8; ++e) u[e] = sigf(u[e]);
        }
        *(GAS v4u*)(AL + (size_t)m * LK + 8 * lane) = pk8(u);
    }
}
__device__ __forceinline__ int scan_row(int s, int b, int dir) { if (s < CTXL) { const int t = dir ? (CTXL - 1 - s) : s; return MX + b * CTXL + t; } const int s2 = s - CTXL; const int t = dir ? (SEQ - 1 - s2) : s2; return b * SEQ + t; }
__device__ __forceinline__ float red16(float x) { x = dpp_add<0xB1>(x); x = dpp_add<0x4E>(x); x = dpp_add<0x141>(x); x = dpp_add<0x140>(x); return x; }
typedef float f32x2 __attribute__((ext_vector_type(2)));
__device__ __forceinline__ float fm_(float a, float b, float c) { float d; asm("v_fma_f32 %0, %1, %2, %3" : "=v"(d) : "v"(a), "v"(b), "v"(c)); return d; }
__device__ __forceinline__ float ml_(float a, float b) { float d; asm("v_mul_f32 %0, %1, %2" : "=v"(d) : "v"(a), "v"(b)); return d; }
__device__ __forceinline__ void red16x2(float& a, float& b) {
    asm volatile("s_nop 1\n\t"
        "v_add_f32_dpp %0, %0, %0 quad_perm:[1,0,3,2] row_mask:0xf bank_mask:0xf\n\tv_add_f32_dpp %1, %1, %1 quad_perm:[1,0,3,2] row_mask:0xf bank_mask:0xf\n\ts_nop 0\n\t"
        "v_add_f32_dpp %0, %0, %0 quad_perm:[2,3,0,1] row_mask:0xf bank_mask:0xf\n\tv_add_f32_dpp %1, %1, %1 quad_perm:[2,3,0,1] row_mask:0xf bank_mask:0xf\n\ts_nop 0\n\t"
        "v_add_f32_dpp %0, %0, %0 row_half_mirror row_mask:0xf bank_mask:0xf\n\tv_add_f32_dpp %1, %1, %1 row_half_mirror row_mask:0xf bank_mask:0xf\n\ts_nop 0\n\t"
        "v_add_f32_dpp %0, %0, %0 row_mirror row_mask:0xf bank_mask:0xf\n\tv_add_f32_dpp %1, %1, %1 row_mirror row_mask:0xf bank_mask:0xf\n\ts_nop 0"
        : "+v"(a), "+v"(b));
}
typedef short bf16x8v_ __attribute__((ext_vector_type(8)));
namespace sc {
constexpr int C = 16, NCHUNK = (CTXL + SEQ) / C, CTXCHUNK = CTXL / C, NSLOT = 5;
constexpr int RS = 144, ARR = 16 * RS, ES = 272;
constexpr int O_P = 0, O_RT = ARR, O_NPT = 2 * ARR, O_DPT = 3 * ARR, O_VT = 4 * ARR, O_DM = 5 * ARR, O_NR = O_DM + 512, O_DR = O_NR + 512, O_LINV = O_DR + 512, O_LC = O_LINV + 512, SLOT_B = O_LC + 256;
constexpr int PRIVP = NSLOT * SLOT_B, O_NN = 0, O_DD = ARR, O_EW = 2 * ARR, O_NF = O_EW + 16 * ES, PRIVP_B = O_NF + 1024;
constexpr int ZERO_OFF = PRIVP + 4 * PRIVP_B;
constexpr int FLAG_OFF = ZERO_OFF + 1024;
constexpr int KC_OFF = FLAG_OFF + 64;
static_assert(SLOT_B % 16 == 0 && PRIVP_B % 16 == 0 && KC_OFF + 1024 <= RING_BYTES, "scan LDS map");
}
__device__ __forceinline__ unsigned cvtpk(float lo, float hi) { unsigned r; asm volatile("v_cvt_pk_bf16_f32 %0, %1, %2" : "=v"(r) : "v"(lo), "v"(hi)); return r; }
__device__ __forceinline__ float bf1(unsigned short x) { return __uint_as_float((unsigned)x << 16); }
__device__ __forceinline__ unsigned short tobf(float f) { return (unsigned short)f2bf(f); }
__device__ __forceinline__ unsigned short tobf1(float f) { return (unsigned short)cvtpk(f, f); }
__device__ __forceinline__ bf16x8v_ tr_frag1(unsigned a) { v2u r0, r1;
    asm volatile("ds_read_b64_tr_b16 %0, %2\n\tds_read_b64_tr_b16 %1, %2 offset:512\n\ts_waitcnt lgkmcnt(0)" : "=&v"(r0), "=&v"(r1) : "v"(a) : "memory"); return mk_b(r0, r1); }
__device__ __forceinline__ void tr_frag4(unsigned a, bf16x8v_ (&f)[4]) { v2u r[8];
    asm volatile("ds_read_b64_tr_b16 %0, %8\n\tds_read_b64_tr_b16 %1, %8 offset:512\n\tds_read_b64_tr_b16 %2, %8 offset:32\n\tds_read_b64_tr_b16 %3, %8 offset:544\n\t"
                 "ds_read_b64_tr_b16 %4, %8 offset:64\n\tds_read_b64_tr_b16 %5, %8 offset:576\n\tds_read_b64_tr_b16 %6, %8 offset:96\n\tds_read_b64_tr_b16 %7, %8 offset:608\n\ts_waitcnt lgkmcnt(0)"
                 : "=&v"(r[0]), "=&v"(r[1]), "=&v"(r[2]), "=&v"(r[3]), "=&v"(r[4]), "=&v"(r[5]), "=&v"(r[6]), "=&v"(r[7]) : "v"(a) : "memory");
    f[0] = mk_b(r[0], r[1]); f[1] = mk_b(r[2], r[3]); f[2] = mk_b(r[4], r[5]); f[3] = mk_b(r[6], r[7]); }
__device__ __forceinline__ void scan_phase(const Frame& F, const Args& a) {
    using namespace sc;
    const bf16* RB = (const bf16*)(a.ws + WS_R); const bf16* KB = (const bf16*)(a.ws + WS_K); const bf16* VB = (const bf16*)(a.ws + WS_V); const bf16* LP = (const bf16*)(a.ws + WS_LP);
    LAS unsigned char* L = F.lds + RING_OFF;
    const int l = F.lane, lr = l & 15, g = l >> 4;
    for (int chain = blockIdx.x; chain < 256; chain += F.G) {
        const int b = chain >> 4, h = (chain >> 1) & 7, dir = chain & 1;
        bf16* Yg = (bf16*)a.out + (dir ? (size_t)MX * RW : 0);
        float* SBTg = (float*)(a.ws + WS_SBT);
        if (F.tid < 256 + 16) ((LAS unsigned*)(L + ZERO_OFF))[F.tid] = 0u;
        if (F.tid >= 64 && F.tid < 320) { const int i_ = F.tid - 64, k_ = h * 64 + (i_ & 63);
            ((LAS float*)(L + KC_OFF))[i_] = i_ < 64 ? a.in[I_KK][k_] : i_ < 128 ? a.in[I_KA][k_] : i_ < 192 ? a.in[I_RK][k_] * a.in[I_KA][k_] : (dir == 0 ? a.in[I_RK][k_] * (2.0f - 2.0f * a.in[I_KA][k_]) : 0.f); }
        __syncthreads();
        if (F.wave >= 4) {
            const int p = F.wave - 4;
            LAS unsigned char* PV = L + PRIVP + p * PRIVP_B;
            const int t1 = l >> 2, kq = l & 3, hc1 = h * 64 + 16 * kq;
            v4u raw[10];
#define SC_PREFETCH(cc) do { const int m_ = scan_row((cc) * C + t1, b, dir); const GAS v4u* q0 = (const GAS v4u*)(RB + (size_t)m_ * RW + hc1); const GAS v4u* q1 = (const GAS v4u*)(KB + (size_t)m_ * RW + hc1); const GAS v4u* q2 = (const GAS v4u*)(VB + (size_t)m_ * RW + hc1); \
                const GAS v4u* q3 = (const GAS v4u*)(LP + (size_t)m_ * LN + dir * 512 + hc1); const GAS v4u* q4 = (const GAS v4u*)(LP + (size_t)m_ * LN + 1024 + dir * 512 + hc1); \
                raw[0] = __builtin_nontemporal_load(q0); raw[1] = __builtin_nontemporal_load(q0 + 1); raw[2] = __builtin_nontemporal_load(q1); raw[3] = __builtin_nontemporal_load(q1 + 1); raw[4] = __builtin_nontemporal_load(q2); raw[5] = __builtin_nontemporal_load(q2 + 1); \
                raw[6] = __builtin_nontemporal_load(q3); raw[7] = __builtin_nontemporal_load(q3 + 1); raw[8] = __builtin_nontemporal_load(q4); raw[9] = __builtin_nontemporal_load(q4 + 1); } while (0)
            if (p < NCHUNK) SC_PREFETCH(p);
            volatile LAS unsigned* RDY = (volatile LAS unsigned*)(L + FLAG_OFF); volatile LAS unsigned* DONE = RDY + NSLOT;
            for (int c = p; c < NCHUNK; c += 4) {
                if (c >= NSLOT) { unsigned spins = 0; while (*DONE < 4u * (unsigned)(c - NSLOT + 1)) { __builtin_amdgcn_s_sleep(2); if (++spins > (1u << 22)) break; } asm volatile("" ::: "memory"); }
#pragma unroll 1
                for (int f = 1; f <= 3; ++f) {
                {
                    LAS unsigned char* SL = L + (c % NSLOT) * SLOT_B;
                    if (f == 1) {
                        float r16[16], k16[16], e16[16], a16[16];
                        { float t8[8]; unpk8(raw[0], t8); for (int e = 0; e < 8; ++e) r16[e] = t8[e]; unpk8(raw[1], t8); for (int e = 0; e < 8; ++e) r16[8 + e] = t8[e];
                          unpk8(raw[2], t8); for (int e = 0; e < 8; ++e) k16[e] = t8[e]; unpk8(raw[3], t8); for (int e = 0; e < 8; ++e) k16[8 + e] = t8[e];
                          unpk8(raw[6], t8); for (int e = 0; e < 8; ++e) e16[e] = t8[e]; unpk8(raw[7], t8); for (int e = 0; e < 8; ++e) e16[8 + e] = t8[e];
                          unpk8(raw[8], t8); for (int e = 0; e < 8; ++e) a16[e] = t8[e]; unpk8(raw[9], t8); for (int e = 0; e < 8; ++e) a16[8 + e] = t8[e]; }
                        const int ro = t1 * RS + kq * 32;
                        *(LAS v4u*)(SL + O_VT + ro) = raw[4]; *(LAS v4u*)(SL + O_VT + ro + 16) = raw[5];
#pragma unroll
                        for (int e4 = 0; e4 < 4; ++e4) *(LAS f32x4*)(PV + O_EW + t1 * ES + kq * 64 + e4 * 16) = (f32x4){e16[4 * e4], e16[4 * e4 + 1], e16[4 * e4 + 2], e16[4 * e4 + 3]};
                        if (c + 4 < NCHUNK) SC_PREFETCH(c + 4);
                        float kkc[16], kac[16];
#pragma unroll
                        for (int e4 = 0; e4 < 4; ++e4) { const f32x4 q0 = *(const LAS f32x4*)(L + KC_OFF + (16 * kq + 4 * e4) * 4), q1 = *(const LAS f32x4*)(L + KC_OFF + 256 + (16 * kq + 4 * e4) * 4);
#pragma unroll
                            for (int e = 0; e < 4; ++e) { kkc[4 * e4 + e] = q0[e]; kac[4 * e4 + e] = q1[e]; } }
                        float kk16[16], nb16[16], kd16[16]; float ss = 0.f;
#pragma unroll
                        for (int e = 0; e < 16; ++e) { kk16[e] = k16[e] * kkc[e]; ss += kk16[e] * kk16[e]; }
                        ss = dpp_add<0xB1>(ss); ss = dpp_add<0x4E>(ss);
                        const float rn = 1.0f / sqrtf(fmaxf(ss, 1e-24f));
#pragma unroll
                        for (int e = 0; e < 16; ++e) { kk16[e] *= rn; nb16[e] = -kk16[e] * a16[e]; }
                        { float sb = 0.f;
#pragma unroll
                          for (int e4 = 0; e4 < 4; ++e4) { const f32x4 q2 = *(const LAS f32x4*)(L + KC_OFF + 512 + (16 * kq + 4 * e4) * 4), q3 = *(const LAS f32x4*)(L + KC_OFF + 768 + (16 * kq + 4 * e4) * 4);
#pragma unroll
                              for (int e = 0; e < 4; ++e) { const int x = 4 * e4 + e; const float ka_ = k16[x] * a16[x]; kd16[x] = k16[x] + (ka_ - k16[x]) * kac[x]; sb += (r16[x] * k16[x]) * (q2[e] * a16[x] + q3[e]); } }
                          sb = dpp_add<0xB1>(sb); sb = dpp_add<0x4E>(sb);
                          if (c >= CTXCHUNK && kq == 0) SBTg[((size_t)scan_row(c * C + t1, b, dir) * 8 + h) * 4 + 1 + dir] = sb; }
                        asm volatile("s_waitcnt lgkmcnt(0)" ::: "memory");
                        {
                          LAS float* Ep = (LAS float*)(PV + O_EW) + l; float cs = 0.f;
#pragma unroll
                          for (int t = 0; t < 16; ++t) { cs += Ep[t * (ES / 4)]; Ep[t * (ES / 4)] = cs; }
                          ((LAS float*)(SL + O_LC))[l] = __expf(cs); }
                        asm volatile("s_waitcnt lgkmcnt(0)" ::: "memory");
                        unsigned pP[8], pR[8], pN[8], pD[8], pNP[8], pDP[8];
#pragma unroll
                        for (int e4 = 0; e4 < 4; ++e4) { const f32x4 cs4 = *(const LAS f32x4*)(PV + O_EW + t1 * ES + kq * 64 + e4 * 16);
                            const f32x4 cm4 = *(const LAS f32x4*)(L + (t1 > 0 ? PRIVP + p * PRIVP_B + O_EW + (t1 - 1) * ES + kq * 64 + e4 * 16 : ZERO_OFF)); const f32x4 lc4 = *(const LAS f32x4*)(SL + O_LC + kq * 64 + e4 * 16);
                            float vP[4], vR[4], vN[4], vD[4], vNP[4], vDP[4];
#pragma unroll
                            for (int e = 0; e < 4; ++e) { const int x = 4 * e4 + e; const float pc = __expf(cs4[e]), pm = __expf(cm4[e]), ic = __builtin_amdgcn_rcpf(pc);
                                vP[e] = kk16[x] * pm; vR[e] = r16[x] * pc; vN[e] = nb16[x] * ic; vD[e] = kd16[x] * ic; vNP[e] = vN[e] * lc4[e]; vDP[e] = vD[e] * lc4[e]; }
                            pP[2 * e4] = cvtpk(vP[0], vP[1]); pP[2 * e4 + 1] = cvtpk(vP[2], vP[3]); pR[2 * e4] = cvtpk(vR[0], vR[1]); pR[2 * e4 + 1] = cvtpk(vR[2], vR[3]);
                            pN[2 * e4] = cvtpk(vN[0], vN[1]); pN[2 * e4 + 1] = cvtpk(vN[2], vN[3]); pD[2 * e4] = cvtpk(vD[0], vD[1]); pD[2 * e4 + 1] = cvtpk(vD[2], vD[3]);
                            pNP[2 * e4] = cvtpk(vNP[0], vNP[1]); pNP[2 * e4 + 1] = cvtpk(vNP[2], vNP[3]); pDP[2 * e4] = cvtpk(vDP[0], vDP[1]); pDP[2 * e4 + 1] = cvtpk(vDP[2], vDP[3]); }
                        *(LAS v4u*)(SL + O_P + ro) = (v4u){pP[0], pP[1], pP[2], pP[3]}; *(LAS v4u*)(SL + O_P + ro + 16) = (v4u){pP[4], pP[5], pP[6], pP[7]};
                        *(LAS v4u*)(SL + O_RT + ro) = (v4u){pR[0], pR[1], pR[2], pR[3]}; *(LAS v4u*)(SL + O_RT + ro + 16) = (v4u){pR[4], pR[5], pR[6], pR[7]};
                        *(LAS v4u*)(PV + O_NN + ro) = (v4u){pN[0], pN[1], pN[2], pN[3]}; *(LAS v4u*)(PV + O_NN + ro + 16) = (v4u){pN[4], pN[5], pN[6], pN[7]};
                        *(LAS v4u*)(PV + O_DD + ro) = (v4u){pD[0], pD[1], pD[2], pD[3]}; *(LAS v4u*)(PV + O_DD + ro + 16) = (v4u){pD[4], pD[5], pD[6], pD[7]};
                        *(LAS v4u*)(SL + O_NPT + ro) = (v4u){pNP[0], pNP[1], pNP[2], pNP[3]}; *(LAS v4u*)(SL + O_NPT + ro + 16) = (v4u){pNP[4], pNP[5], pNP[6], pNP[7]};
                        *(LAS v4u*)(SL + O_DPT + ro) = (v4u){pDP[0], pDP[1], pDP[2], pDP[3]}; *(LAS v4u*)(SL + O_DPT + ro + 16) = (v4u){pDP[4], pDP[5], pDP[6], pDP[7]};
                    } else if (f == 2) {
                        bf16x8v_ ap[2], ar[2], bn[2], bd[2];
#pragma unroll
                        for (int ks = 0; ks < 2; ++ks) { const int o = lr * RS + ks * 64 + g * 16; ap[ks] = *(const LAS bf16x8v_*)(SL + O_P + o); ar[ks] = *(const LAS bf16x8v_*)(SL + O_RT + o); bn[ks] = *(const LAS bf16x8v_*)(PV + O_NN + o); bd[ks] = *(const LAS bf16x8v_*)(PV + O_DD + o); }
                        f32x4 cN = {0.f, 0.f, 0.f, 0.f}, cDm = cN, cNr = cN, cDr = cN;
#pragma unroll
                        for (int ks = 0; ks < 2; ++ks) { cN = __builtin_amdgcn_mfma_f32_16x16x32_bf16(ap[ks], bn[ks], cN, 0, 0, 0); cDm = __builtin_amdgcn_mfma_f32_16x16x32_bf16(ap[ks], bd[ks], cDm, 0, 0, 0);
                            cNr = __builtin_amdgcn_mfma_f32_16x16x32_bf16(ar[ks], bn[ks], cNr, 0, 0, 0); cDr = __builtin_amdgcn_mfma_f32_16x16x32_bf16(ar[ks], bd[ks], cDr, 0, 0, 0); }
                        *(LAS f32x4*)(PV + O_NF + (lr * 16 + 4 * g) * 4) = (f32x4){lr < 4 * g ? cN[0] : 0.f, lr < 4 * g + 1 ? cN[1] : 0.f, lr < 4 * g + 2 ? cN[2] : 0.f, lr < 4 * g + 3 ? cN[3] : 0.f};
#pragma unroll
                        for (int r = 0; r < 4; ++r) { const int t = 4 * g + r, j = lr; const bool lo = j < t, le = j <= t;
                            ((LAS unsigned short*)(SL + O_DM))[t * 16 + j] = tobf1(lo ? cDm[r] : 0.f); ((LAS unsigned short*)(SL + O_NR))[t * 16 + j] = tobf1(le ? cNr[r] : 0.f); ((LAS unsigned short*)(SL + O_DR))[t * 16 + j] = tobf1(le ? cDr[r] : 0.f); }
                    } else {
                        const LAS f32x4* NFTp = (const LAS f32x4*)(PV + O_NF); float acc[16];
#pragma unroll
                        for (int t = 0; t < 16; ++t) acc[t] = (t == lr) ? 1.0f : 0.0f;
                        f32x4 col[4];
#pragma unroll
                        for (int q4 = 0; q4 < 4; ++q4) col[q4] = NFTp[q4];
#pragma unroll
                        for (int j = 0; j < 16; ++j) { const float Lj = acc[j]; ((LAS unsigned short*)(SL + O_LINV))[j * 16 + lr] = tobf1(Lj);
                            f32x4 nxt[4];
                            if (j + 1 < 16) {
#pragma unroll
                                for (int q4 = 0; q4 < 4; ++q4) nxt[q4] = NFTp[(j + 1) * 4 + q4]; }
#pragma unroll
                            for (int t = j + 1; t < 16; ++t) acc[t] += col[t >> 2][t & 3] * Lj;
                            if (j + 1 < 16) {
#pragma unroll
                                for (int q4 = 0; q4 < 4; ++q4) col[q4] = nxt[q4]; } }
                    }
                }
                asm volatile("s_waitcnt lgkmcnt(0)" ::: "memory");
                }
                if (l == 0) RDY[c % NSLOT] = (unsigned)(c + 1);
            }
#undef SC_PREFETCH
        } else {
            const int w = F.wave, irow = 16 * w + lr, q = lr >> 2, pp = l & 3;
            f32x4 S[4];
#pragma unroll
            for (int kt = 0; kt < 4; ++kt) S[kt] = (f32x4){0.f, 0.f, 0.f, 0.f};
            volatile LAS unsigned* RDY = (volatile LAS unsigned*)(L + FLAG_OFF); LAS unsigned* DONE = (LAS unsigned*)(L + FLAG_OFF) + NSLOT;
            const unsigned ldsb_ = (unsigned)(size_t)L, lanetr_ = (unsigned)((4 * g + q) * RS + 8 * pp);
            for (int c = 0; c < NCHUNK; ++c) {
                { unsigned spins = 0; while (RDY[c % NSLOT] != (unsigned)(c + 1)) { __builtin_amdgcn_s_sleep(1); if (++spins > (1u << 22)) break; } asm volatile("" ::: "memory"); }
                {
                    LAS unsigned char* SL = L + (c % NSLOT) * SLOT_B; const unsigned slb_ = ldsb_ + (unsigned)((c % NSLOT) * SLOT_B);
                    asm volatile("s_nop 7" : "+v"(S[0]), "+v"(S[1]), "+v"(S[2]), "+v"(S[3]));
                    bf16x8v_ bS[2], aP[2], aR[2];
#pragma unroll
                    for (int ks = 0; ks < 2; ++ks) { bS[ks] = __builtin_bit_cast(bf16x8v_, (v4u){cvtpk(S[2 * ks][0], S[2 * ks][1]), cvtpk(S[2 * ks][2], S[2 * ks][3]), cvtpk(S[2 * ks + 1][0], S[2 * ks + 1][1]), cvtpk(S[2 * ks + 1][2], S[2 * ks + 1][3])});
                        const int o = lr * RS + (32 * ks + 4 * g) * 2;
                        aP[ks] = mk_b(*(const LAS v2u*)(SL + O_P + o), *(const LAS v2u*)(SL + O_P + o + 32)); aR[ks] = mk_b(*(const LAS v2u*)(SL + O_RT + o), *(const LAS v2u*)(SL + O_RT + o + 32)); }
                    const v2u z2 = {0u, 0u}; const int o16 = lr * 32 + g * 8;
                    const bf16x8v_ aDm = mk_b(*(const LAS v2u*)(SL + O_DM + o16), z2), aNr = mk_b(*(const LAS v2u*)(SL + O_NR + o16), z2), aDr = mk_b(*(const LAS v2u*)(SL + O_DR + o16), z2), aLi = mk_b(*(const LAS v2u*)(SL + O_LINV + o16), z2);
                    v2u trv, trn[4], trd[4];
                    asm volatile("ds_read_b64_tr_b16 %0, %9\n\t"
                                 "ds_read_b64_tr_b16 %1, %10\n\tds_read_b64_tr_b16 %2, %10 offset:32\n\tds_read_b64_tr_b16 %3, %10 offset:64\n\tds_read_b64_tr_b16 %4, %10 offset:96\n\t"
                                 "ds_read_b64_tr_b16 %5, %11\n\tds_read_b64_tr_b16 %6, %11 offset:32\n\tds_read_b64_tr_b16 %7, %11 offset:64\n\tds_read_b64_tr_b16 %8, %11 offset:96\n\ts_waitcnt lgkmcnt(0)"
                                 : "=&v"(trv), "=&v"(trn[0]), "=&v"(trn[1]), "=&v"(trn[2]), "=&v"(trn[3]), "=&v"(trd[0]), "=&v"(trd[1]), "=&v"(trd[2]), "=&v"(trd[3])
                                 : "v"(slb_ + (unsigned)(O_VT + 32 * w) + lanetr_), "v"(slb_ + (unsigned)O_NPT + lanetr_), "v"(slb_ + (unsigned)O_DPT + lanetr_) : "memory");
                    const bf16x8v_ bV = mk_b(trv, z2);
                    f32x4 W = {0.f, 0.f, 0.f, 0.f};
                    W = __builtin_amdgcn_mfma_f32_16x16x32_bf16(aP[0], bS[0], W, 0, 0, 0); W = __builtin_amdgcn_mfma_f32_16x16x32_bf16(aP[1], bS[1], W, 0, 0, 0); W = __builtin_amdgcn_mfma_f32_16x16x32_bf16(aDm, bV, W, 0, 0, 0);
                    asm volatile("s_nop 7\n\ts_nop 7" : "+v"(W));
                    const bf16x8v_ bW = __builtin_bit_cast(bf16x8v_, (v4u){cvtpk(W[0], W[1]), cvtpk(W[2], W[3]), 0u, 0u});
                    f32x4 Z = {0.f, 0.f, 0.f, 0.f};
                    Z = __builtin_amdgcn_mfma_f32_16x16x32_bf16(aLi, bW, Z, 0, 0, 0);
                    asm volatile("s_nop 7\n\ts_nop 7" : "+v"(Z));
                    const bf16x8v_ bZ = __builtin_bit_cast(bf16x8v_, (v4u){cvtpk(Z[0], Z[1]), cvtpk(Z[2], Z[3]), 0u, 0u});
                    if (c >= CTXCHUNK) {
                        f32x4 Y = {0.f, 0.f, 0.f, 0.f};
                        Y = __builtin_amdgcn_mfma_f32_16x16x32_bf16(aR[0], bS[0], Y, 0, 0, 0); Y = __builtin_amdgcn_mfma_f32_16x16x32_bf16(aR[1], bS[1], Y, 0, 0, 0);
                        Y = __builtin_amdgcn_mfma_f32_16x16x32_bf16(aNr, bZ, Y, 0, 0, 0); Y = __builtin_amdgcn_mfma_f32_16x16x32_bf16(aDr, bV, Y, 0, 0, 0);
#pragma unroll
                        for (int r = 0; r < 4; ++r) { const int m = scan_row(c * C + 4 * g + r, b, dir); Yg[(size_t)m * RW + h * 64 + irow] = tobf(Y[r]); }
                    }
#pragma unroll
                    for (int kt = 0; kt < 4; ++kt) { const f32x4 lc = *(const LAS f32x4*)(SL + O_LC + (16 * kt + 4 * g) * 4);
                        f32x4 sv = S[kt] * lc; sv = __builtin_amdgcn_mfma_f32_16x16x32_bf16(mk_b(trn[kt], z2), bZ, sv, 0, 0, 0); sv = __builtin_amdgcn_mfma_f32_16x16x32_bf16(mk_b(trd[kt], z2), bV, sv, 0, 0, 0); S[kt] = sv; }
                }
                asm volatile("s_waitcnt lgkmcnt(0)" ::: "memory");
                if (l == 0) __hip_atomic_fetch_add(DONE, 1u, __ATOMIC_RELAXED, __HIP_MEMORY_SCOPE_WORKGROUP);
            }
        }
        __syncthreads();
    }
}
__device__ __forceinline__ void rwkv_out_phase(const Frame& F, const Args& a) {
    const bf16* RB = (const bf16*)(a.ws + WS_R); const bf16* KB = (const bf16*)(a.ws + WS_K); const bf16* VB = (const bf16*)(a.ws + WS_V); const bf16* LP = (const bf16*)(a.ws + WS_LP); bf16* O = (bf16*)(a.ws + WS_FXO) + 512;
    const bf16* YF = (const bf16*)a.out; const bf16* YBk = (const bf16*)a.out + (size_t)MX * RW;
    const int gw = F.vcu * NWAVES + F.wave, NGW = F.G * NWAVES, col = 8 * F.lane;
    float lg[8], lb[8];
#pragma unroll
    for (int e = 0; e < 8; ++e) { lg[e] = a.in[I_LNG][col + e]; lb[e] = a.in[I_LNB][col + e]; }
    const float* SBT = (const float*)(a.ws + WS_SBT);
    for (int m = gw; m < MX; m += NGW) {
        float y[8], v[8], gg[8], o[8];
        { float yb8[8]; unpk8(__builtin_nontemporal_load((const GAS v4u*)(YF + (size_t)m * RW + col)), y); unpk8(__builtin_nontemporal_load((const GAS v4u*)(YBk + (size_t)m * RW + col)), yb8);
#pragma unroll
          for (int e = 0; e < 8; ++e) y[e] += yb8[e]; }
        unpk8(__builtin_nontemporal_load((const GAS v4u*)(VB + (size_t)m * RW + col)), v); unpk8(__builtin_nontemporal_load((const GAS v4u*)(LP + (size_t)m * LN + 2048 + col)), gg);
        const f32x4 sb4 = __builtin_nontemporal_load((const GAS f32x4*)(SBT + ((size_t)m * 8 + (F.lane >> 3)) * 4));
        float s = 0.f;
#pragma unroll
        for (int e = 0; e < 8; ++e) s += y[e];
        const float mean = red8(s) * (1.0f / 64.0f);
        float qv = 0.f; const float bs = sb4[1] + sb4[2];
#pragma unroll
        for (int e = 0; e < 8; ++e) { y[e] -= mean; qv += y[e] * y[e]; }
        const float rstd = 1.0f / sqrtf(red8(qv) * (1.0f / 64.0f) + GN_EPS);
#pragma unroll
        for (int e = 0; e < 8; ++e) o[e] = ((y[e] * rstd * lg[e] + lb[e]) + bs * v[e]) * gg[e];
        *(GAS v4u*)(O + (size_t)m * 1024 + col) = pk8(o);
    }
}
__global__ void __launch_bounds__(NWAVES * 64, 2) mk_fwd(Args args) {
    extern __shared__ __attribute__((aligned(16))) unsigned char lds[];
    Frame F;
    F.lds = (LAS unsigned char*)lds;
    F.MISC = (volatile LAS unsigned*)(F.lds + MISC_OFF);
    F.tid = threadIdx.x; F.lane = F.tid & 63; F.wave = __builtin_amdgcn_readfirstlane(F.tid >> 6);
    F.G = gridDim.x; { const int bx = blockIdx.x; F.vcu = (F.G % 8 == 0) ? (bx % 8) * (F.G / 8) + bx / 8 : bx; }
    F.ctl = (gu32*)(args.ws + WS_CTL);
    for (int u = F.tid; u < (LDS_BYTES - LDSCTL_OFF) / 4; u += NWAVES * 64) ((LAS unsigned*)(F.lds + LDSCTL_OFF))[u] = 0u;
    __syncthreads();
    XcdBarrier bar; bar.bar = (unsigned*)(F.ctl + CW_BAR); bar.x = 0; bar.st = nullptr;
    if (N_LAUNCHES == 1) bar = xcd_barrier_post((unsigned*)(F.ctl + CW_BAR), F.MISC + 8);
    if (N_LAUNCHES == 1 && threadIdx.x == 0 && (bar.x != (blockIdx.x & 7u) || (gridDim.x & 7u) != 0u)) (void)xb_add((unsigned*)(F.ctl + CW_BADMAP), 1u);
#define GRID_BAR() do { if (N_LAUNCHES == 1) xcd_barrier(bar); } while (0)
    const int lo = args.ph_lo, hi = args.ph_hi;
#define IN(k) (refresh_tid(F), lo <= (k) && (k) < hi)
#define INP(k) (lo <= (k) && (k) < hi)
#define SEAM(k) do { if (INP(k) && INP((k) + 1)) GRID_BAR(); } while (0)
#define SEAM_L(k) do { if (INP(k) && INP((k) + 1)) { if (N_LAUNCHES == 1) { if (F.MISC[10]) xcd_barrier_local(bar); else xcd_barrier(bar); } } } while (0)
#define WSP(T, off) ((T*)(args.ws + (off)))
#define MOD WSP(float, WS_MOD)
#define Win_t WSP(bf16, WS_WIN)
#define Wlora_t WSP(bf16, WS_WLORA)
#define Wupf_t WSP(bf16, WS_WUPF)
#define Wupr_t WSP(bf16, WS_WUPR)
#define Wout_t WSP(bf16, WS_WOUT)
#define Wgu_t WSP(bf16, WS_WGU)
#define Wdown_t WSP(bf16, WS_WDOWN)
#define HX WSP(bf16, WS_HX)
#define PXR WSP(bf16, WS_PXR)
#define Z3 WSP(bf16, WS_Z3)
#define GF WSP(bf16, WS_GF)
#define GR WSP(bf16, WS_GR)
#define Y2 ((bf16*)((unsigned char*)args.out + 32 * MiB))
#define FX WSP(bf16, WS_FXO)
#define AL ((bf16*)args.out)
#define LP WSP(bf16, WS_LP)
#define MB WSP(bf16, WS_MB)
#define HX2 WSP(bf16, WS_HX2)
#define ACT WSP(bf16, WS_ACT)
    const int gw = F.vcu * NWAVES + F.wave, NGW = F.G * NWAVES;
    using EpiIn1 = pg8::EpiIn<WS_Z3, WS_GF, WS_GR, WS_R, WS_EB>;

    for (int rep_ = 0; rep_ < 1 + ((MK_REPEAT >> 0) & 1); ++rep_)
    if (IN(0)) { p0_weights(F, args); } SEAM(0);
    if (N_LAUNCHES == 1) {
        if (threadIdx.x == 0) F.MISC[10] = (xb_ld((unsigned*)(F.ctl + CW_BADMAP)) == 0u) ? 1u : 0u;
        __syncthreads(); }
    for (int rep_ = 0; rep_ < 1 + ((MK_REPEAT >> 1) & 1); ++rep_)
    if (IN(1)) {
        { constexpr int RPW = (MT + 2047) / 2048; const int rpw = (MT + NGW - 1) / NGW; (void)RPW; const int m0 = gw * rpw, m1 = (m0 + rpw < MT) ? m0 + rpw : MT; norm_mod_rows<0>(args, m0, m1, args.in[I_N1G], HX, F.lane); }
    } SEAM(1);
    for (int rep_ = 0; rep_ < 1 + ((MK_REPEAT >> 2) & 1); ++rep_)
    if (IN(2)) {
        { pg8::Gemm g{HX, Win_t, MX, NIN, D}; pg8::StaticOrder S; S.init(MX, NIN, F.G, (int)blockIdx.x); EpiIn1 E{args.ws, (bf16*)args.out, args.in[I_MUP], args.in[I_MUN], (LAS float*)(F.lds + XB_OFF), 0};
          pg8::gemm_phase<EpiIn1, pg8::StaticOrder, true, true>(F.lds + RING_OFF, g, S, E); }
        { pg8::Gemm g{HX + (size_t)MX * D, Win_t, MC, RPAD, D}; pg8::StaticOrder S; S.init(MC, RPAD, F.G, (int)blockIdx.x); EpiIn1 E{args.ws, (bf16*)args.out, args.in[I_MUP], args.in[I_MUN], (LAS float*)(F.lds + XB_OFF), MX};
          pg8::gemm_phase<EpiIn1, pg8::StaticOrder, true, true>(F.lds + RING_OFF, g, S, E); }
    } SEAM(2);
    for (int rep_ = 0; rep_ < 1 + ((MK_REPEAT >> 3) & 1); ++rep_)
    if (IN(3)) { edge_rows(F, args); dft_pass_a(F, Z3, Y2); } SEAM(3);
    for (int rep_ = 0; rep_ < 1 + ((MK_REPEAT >> 7) & 1); ++rep_)
    if (IN(7)) { dft_pass_b(F, Y2, FX); __syncthreads();
        pg8::Gemm g{AL, Wlora_t, MT, LN, LK}; pg8::StaticOrder S; S.init(MT, LN, F.G, (int)blockIdx.x); pg8::EpiLora E{LP, WSP(const float, WS_LB)};
        pg8::gemm_phase<pg8::EpiLora, pg8::StaticOrder, true, true>(F.lds + RING_OFF, g, S, E); } SEAM(7);
    for (int rep_ = 0; rep_ < 1 + ((MK_REPEAT >> 8) & 1); ++rep_)
    if (IN(8)) { scan_phase(F, args); } SEAM(8);
    for (int rep_ = 0; rep_ < 1 + ((MK_REPEAT >> 9) & 1); ++rep_)
    if (IN(9)) { rwkv_out_phase(F, args); } SEAM(9);
    for (int rep_ = 0; rep_ < 1 + ((MK_REPEAT >> 10) & 1); ++rep_)
    if (IN(10)) { pg8::Gemm g{FX, Wupf_t, MX, D, D}; pg8::StaticOrder S; S.init(MX, D, F.G, (int)blockIdx.x); pg8::EpiMerge2 E{MB, GF, GR};
        pg8::gemm_phase<pg8::EpiMerge2, pg8::StaticOrder, true, true>(F.lds + RING_OFF, g, S, E); } SEAM_L(10);
    for (int rep_ = 0; rep_ < 1 + ((MK_REPEAT >> 11) & 1); ++rep_)
    if (IN(11)) { pg8::Gemm g{MB, Wout_t, MX, D, D}; pg8::StaticOrder S; S.init(MX, D, F.G, (int)blockIdx.x); pg8::EpiDelta E{WSP(bf16, WS_D1), MOD + 2048};
        pg8::gemm_phase<pg8::EpiDelta, pg8::StaticOrder, true, true>(F.lds + RING_OFF, g, S, E); } SEAM_L(11);
    for (int rep_ = 0; rep_ < 1 + ((MK_REPEAT >> 12) & 1); ++rep_)
    if (IN(12)) {
        p_weights2(F, args);
        { const int rpw = (MX + NGW - 1) / NGW; const int m0 = gw * rpw, m1 = (m0 + rpw < MX) ? m0 + rpw : MX; norm_mod_rows<1>(args, m0, m1, args.in[I_N2G], HX2, F.lane); }
    } SEAM(12);
    for (int rep_ = 0; rep_ < 1 + ((MK_REPEAT >> 13) & 1); ++rep_)
    if (IN(13)) { pg8::Gemm g{HX2, Wgu_t, MX, 2 * DFF, D}; pg8::StaticOrder S; S.init(MX, 2 * DFF, F.G, (int)blockIdx.x); pg8::EpiSwiglu E{ACT};
        pg8::gemm_phase<pg8::EpiSwiglu, pg8::StaticOrder, true, true>(F.lds + RING_OFF, g, S, E); } SEAM_L(13);
    for (int rep_ = 0; rep_ < 1 + ((MK_REPEAT >> 14) & 1); ++rep_)
    if (IN(14)) { pg8::Gemm g{ACT, Wdown_t, MX, D, DFF}; pg8::StaticOrder S; S.init(MX, D, F.G, (int)blockIdx.x); pg8::EpiDelta E{WSP(bf16, WS_D2), MOD + 5120};
        pg8::gemm_phase<pg8::EpiDelta, pg8::StaticOrder, true, true>(F.lds + RING_OFF, g, S, E); } SEAM_L(14);
    for (int rep_ = 0; rep_ < 1 + ((MK_REPEAT >> 15) & 1); ++rep_)
    if (IN(15)) {
        const int wpx = (F.G % 8 == 0) ? NGW / 8 : NGW, rpx = (F.G % 8 == 0) ? MX / 8 : MX, xg = gw / wpx, lw = gw % wpx;
        for (int m = xg * rpx + lw; m < (xg + 1) * rpx; m += wpx) {
            GAS f32x4* xr = (GAS f32x4*)(args.out + (size_t)m * D) + F.lane; const GAS f32x4* xin = (const GAS f32x4*)(args.in[I_X] + (size_t)m * D) + F.lane;
            const GAS v2u* dr = (const GAS v2u*)(WSP(bf16, WS_D2) + (size_t)m * D) + F.lane; const GAS v2u* d1r = (const GAS v2u*)(WSP(bf16, WS_D1) + (size_t)m * D) + F.lane; f32x4 v[4]; float s2 = 0.f;
#pragma unroll
            for (int j = 0; j < 4; ++j) { const v2u dd = __builtin_nontemporal_load(dr + 64 * j), d1 = __builtin_nontemporal_load(d1r + 64 * j); v[j] = (__builtin_nontemporal_load(xin + 64 * j) + (f32x4){bflo(d1.x), bfhi(d1.x), bflo(d1.y), bfhi(d1.y)}) + (f32x4){bflo(dd.x), bfhi(dd.x), bflo(dd.y), bfhi(dd.y)}; s2 += (v[j].x * v[j].x + v[j].y * v[j].y) + (v[j].z * v[j].z + v[j].w * v[j].w); }
            const float rstd = 1.0f / sqrtf(wave_sum(s2) * (1.f / D) + NORM_EPS);
#pragma unroll
            for (int j = 0; j < 4; ++j) xr[64 * j] = (v[j] * rstd) * ((const f32x4*)args.in[I_FNG])[F.lane + 64 * j];
        }
    }
#undef IN
#undef SEAM
#undef GRID_BAR
}

extern "C" void kernel_launch(void* const* d_in, const int* in_sizes, int n_in, void* d_out, int out_size, void* d_ws, size_t ws_size, hipStream_t stream) {
    static int grid = 0;
    if (grid == 0) {
        if (n_in != 31 || in_sizes[0] != MX * D || out_size != MX * D || ws_size < WS_END) { fprintf(stderr, "kernel_launch: shape/workspace mismatch (n_in %d, in0 %d, out %d, ws %zu); nothing launched\n", n_in, n_in > 0 ? in_sizes[0] : -1, out_size, ws_size); grid = -1; return; }
        int dev = 0, cus = 0;
        if (hipGetDevice(&dev) != hipSuccess || hipDeviceGetAttribute(&cus, hipDeviceAttributeMultiprocessorCount, dev) != hipSuccess) { grid = -1; return; }
        if (hipFuncSetAttribute((const void*)mk_fwd, hipFuncAttributeMaxDynamicSharedMemorySize, LDS_BYTES) != hipSuccess) { fprintf(stderr, "kernel_launch: hipFuncSetAttribute failed\n"); grid = -1; return; }
        (void)hipGetLastError();
        grid = cus;
    }
    if (grid < 0) return;
    if (hipMemsetAsync((char*)d_ws + WS_CTL, 0, CTL_ZERO_BYTES, stream) != hipSuccess) return;
    Args a{};
    for (int i = 0; i < 31; ++i) a.in[i] = (const float*)d_in[i];
    a.out = (float*)d_out; a.ws = (unsigned char*)d_ws;
    if (N_LAUNCHES == 1) { a.ph_lo = 0; a.ph_hi = NPH; a.li = 0; hipLaunchKernelGGL(mk_fwd, dim3(grid), dim3(NWAVES * 64), LDS_BYTES, stream, a); }
    else for (int p = 0; p < NPH; ++p) { a.ph_lo = p; a.ph_hi = p + 1; a.li = p; hipLaunchKernelGGL(mk_fwd, dim3(grid), dim3(NWAVES * 64), LDS_BYTES, stream, a); }
}
```

```cpp
#include <hip/hip_runtime.h>
#include <cstdio>
#include <cstdint>
#ifndef MK_REPEAT
#define MK_REPEAT 0x0
#endif
#ifndef MK_N_LAUNCHES
#define MK_N_LAUNCHES 1
#endif
namespace pg8 {
#define PG8_LAS __attribute__((address_space(3)))
typedef unsigned short bf16_t;
typedef short bf16x8 __attribute__((ext_vector_type(8)));
typedef float f32x4 __attribute__((ext_vector_type(4)));
typedef unsigned u32x4 __attribute__((ext_vector_type(4)));
constexpr int BM = 256, BK = 64, HALF = 128, HTB = HALF * BK * 2  , STAGE_BYTES = 8 * HTB, NXCD = 8, WGM = 8;

__host__ __device__ __forceinline__ int lds_byte(int r, int c) { const int st = (r >> 4) * 2 + (c >> 5), rr = r & 15, cc = c & 31, ob = rr * 64 + cc * 2; return st * 1024 + (ob ^ (((ob >> 9) & 1) << 5)); }
__host__ __device__ __forceinline__ void stage_rc(int b, int& R, int& C) { const int st = b / 1024, sb = b % 1024, swz = sb ^ (((sb >> 9) & 1) << 5); R = (st >> 1) * 16 + swz / 64; C = (st & 1) * 32 + (swz % 64) / 2; }
__host__ __device__ __forceinline__ int perm32(int rho) { const int n = rho >> 4, i = rho & 15; return 8 * (i >> 2) + 4 * n + (i & 3); }

struct Unit { int pm, pn; };
struct Gemm { const bf16_t* A; const bf16_t* Bt; int M, N, K; };

struct StaticOrder {
    int nM, nN, nwg, G, c;
    __host__ __device__ void init(int M, int N, int G_, int c_) { nM = M / BM; nN = N / BM; nwg = nM * nN; G = G_; c = c_; }
    __host__ __device__ bool next(int i, Unit& u) const {
        const long L = (long)i * G + c; if (L >= nwg) return false;
        int wgid = (int)L; { const int q = nwg / NXCD, r = nwg % NXCD, xcd = wgid % NXCD, off = wgid / NXCD; wgid = (xcd < r ? xcd * (q + 1) : r * (q + 1) + (xcd - r) * q) + off; }
        const int nig = WGM * nN, gid = wgid / nig, fm = gid * WGM, gsz = (nM - fm) < WGM ? (nM - fm) : WGM;
        u.pm = fm + ((wgid % nig) % gsz); u.pn = (wgid % nig) / gsz; return true;
    }
    __device__ __forceinline__ void a_ready(const Unit&) const {}
    __device__ __forceinline__ void done(const Unit&) const {}
};

__device__ __forceinline__ unsigned cvt_pk_bf16(float lo, float hi) { unsigned r; asm volatile("v_cvt_pk_bf16_f32 %0, %1, %2" : "=v"(r) : "v"(lo), "v"(hi)); return r; }
__device__ __forceinline__ float bf_lo(unsigned w) { return __uint_as_float(w << 16); }
__device__ __forceinline__ float bf_hi(unsigned w) { return __uint_as_float(w & 0xffff0000u); }
__device__ __forceinline__ float sigm(float x) { return __builtin_amdgcn_rcpf(1.0f + __expf(-x)); }
__device__ __forceinline__ f32x4 sigm4(f32x4 v) { return (f32x4){sigm(v[0]), sigm(v[1]), sigm(v[2]), sigm(v[3])}; }
__device__ __forceinline__ u32x4 pack8(f32x4 v0, f32x4 v1) { u32x4 w; w.x = cvt_pk_bf16(v0[0], v0[1]); w.y = cvt_pk_bf16(v0[2], v0[3]); w.z = cvt_pk_bf16(v1[0], v1[1]); w.w = cvt_pk_bf16(v1[2], v1[3]); return w; }
__device__ __forceinline__ void unpack8(u32x4 w, f32x4& v0, f32x4& v1) { v0 = (f32x4){bf_lo(w.x), bf_hi(w.x), bf_lo(w.y), bf_hi(w.y)}; v1 = (f32x4){bf_lo(w.z), bf_hi(w.z), bf_lo(w.w), bf_hi(w.w)}; }
template <int CTRL> __device__ __forceinline__ float dpp_rot(float src) { return __int_as_float(__builtin_amdgcn_mov_dpp(__float_as_int(src), CTRL, 0xF, 0xF, true)); }
template <size_t O_Z3, size_t O_GF, size_t O_GR, size_t O_R, size_t O_EB> struct EpiIn {
    static constexpr bool PERM = true, AFTER_DRAIN = false, HAS_MID = false; static constexpr int KSLICE = 0; static constexpr bool SKIP_B1 = true, HAS_PRE = true;
    static __device__ __forceinline__ bool skip_b1(int pn) { return pn == 7; }
    static constexpr size_t RKV_STRIDE = (size_t)36 * 1024 * 1024 / 2;
    unsigned char* ws; bf16_t* al; const float* mup; const float* mun; PG8_LAS float* xb; int row_off;
    __device__ __forceinline__ void pre(const Unit& u, int ui, int wid, int lane) const {
        if (u.pn >= 8) return;
        const int t = wid * 64 + lane, col = 256 * u.pn + (t & 255);
        const float* src = (t < 256 ? mup : mun) + (col < 1920 ? col : 0);
        __builtin_amdgcn_global_load_lds((const unsigned*)src, (PG8_LAS unsigned*)(xb + 2048 + (ui & 1) * 512 + wid * 64), 4, 0, 0);
    }
    __device__ __forceinline__ void operator()(const f32x4 (&acc)[2][2][4][2], const Unit& u, int wr, int wc, int fr, int fq, int ui) const {
        const int pn = u.pn;
        if (pn >= 8) {
            const int row0 = row_off + u.pm * BM + wr * 64 + fr;
            if (pn < 10) {
                bf16_t* base = (bf16_t*)(ws + O_Z3); const int col0 = (pn - 8) * 256 + wc * 32 + 8 * fq;
#pragma unroll
                for (int ai = 0; ai < 2; ++ai)
#pragma unroll
                    for (int m = 0; m < 4; ++m) { bf16_t* rowp = base + (size_t)(row0 + ai * HALF + m * 16) * 512 + col0;
#pragma unroll
                        for (int bj = 0; bj < 2; ++bj) *(u32x4*)(rowp + bj * HALF) = pack8(acc[ai][bj][m][0], acc[ai][bj][m][1]); }
            } else {
                bf16_t* gq = (bf16_t*)(ws + O_GF); bf16_t* gr = (bf16_t*)(ws + O_GR); const int col0 = (pn - 10) * 128 + wc * 32 + 8 * fq;
#pragma unroll
                for (int ai = 0; ai < 2; ++ai)
#pragma unroll
                    for (int m = 0; m < 4; ++m) { const size_t off = (size_t)(row0 + ai * HALF + m * 16) * 1024 + col0;
                        f32x4 qv[2], sv[2];
#pragma unroll
                        for (int n = 0; n < 2; ++n)
#pragma unroll
                            for (int e = 0; e < 4; ++e) { const float ef = __expf(-acc[ai][0][m][n][e]), er1 = 1.0f + __expf(-acc[ai][1][m][n][e]);
                                sv[n][e] = __builtin_amdgcn_rcpf(er1); qv[n][e] = __builtin_amdgcn_rcpf(1.0f + ef) * fminf(er1, 1e20f); }
                        *(u32x4*)(gq + off) = pack8(qv[0], qv[1]); *(u32x4*)(gr + off) = pack8(sv[0], sv[1]); }
            }
            return;
        }
        asm volatile("" : "+v"(fr), "+v"(fq));
        const int cw = wc * 32 + 8 * fq, tile = (row_off >> 8) + u.pm;
        float* eb = (float*)(ws + O_EB); bf16_t* rkv = (bf16_t*)(ws + O_R);
#pragma unroll
        for (int ai = 0; ai < 2; ++ai)
#pragma unroll
            for (int bj = 0; bj < 2; ++bj)
#pragma unroll
                for (int n = 0; n < 2; ++n) { PG8_LAS float* p0 = xb + ((2 * ai + wr) * 2) * 256 + 128 * bj + cw + 4 * n;
                    if (fr == 0) *(PG8_LAS f32x4*)p0 = acc[ai][bj][0][n];
                    if (fr == 15) *(PG8_LAS f32x4*)(p0 + 256) = acc[ai][bj][3][n]; }
        if (wr == 0 && fr < 2) {
#pragma unroll
            for (int bj = 0; bj < 2; ++bj)
#pragma unroll
                for (int n = 0; n < 2; ++n) *(f32x4*)(eb + ((size_t)tile * 4 + fr) * 2048 + 256 * pn + 128 * bj + cw + 4 * n) = acc[0][bj][0][n]; }
        if (wr == 1 && fr >= 14) {
#pragma unroll
            for (int bj = 0; bj < 2; ++bj)
#pragma unroll
                for (int n = 0; n < 2; ++n) *(f32x4*)(eb + ((size_t)tile * 4 + 2 + (fr - 14)) * 2048 + 256 * pn + 128 * bj + cw + 4 * n) = acc[1][bj][3][n]; }
        asm volatile("s_waitcnt lgkmcnt(0)" ::: "memory"); __builtin_amdgcn_s_barrier(); asm volatile("" ::: "memory");
        bf16_t* dst; int ldd, dcol;
        if (pn < 6) { dst = rkv + (size_t)(pn >> 1) * RKV_STRIDE; ldd = 512; dcol = (pn & 1) * 256; } else { dst = al; ldd = 384; dcol = (pn - 6) * 256; }
#pragma unroll
        for (int bj = 0; bj < 2; ++bj) {
            if (pn == 7 && bj == 1) continue;
            const int act = (pn == 6 && bj == 0) ? 1 : (pn == 7) ? 2 : 0;
            const PG8_LAS float* tab = xb + 2048 + (ui & 1) * 512 + 128 * bj + cw;
            const bool f0 = fr == 0, f15 = fr == 15; const f32x4 z4 = {0.f, 0.f, 0.f, 0.f};
#pragma unroll
            for (int ai = 0; ai < 2; ++ai) { const int q = 2 * ai + wr;
                unsigned pk[4][2][2];
#pragma unroll
                for (int n = 0; n < 2; ++n) {
                    const f32x4 mp = *(const PG8_LAS f32x4*)(tab + 4 * n), mn = *(const PG8_LAS f32x4*)(tab + 256 + 4 * n);
                    const f32x4 w0 = 1.0f - mp - mn, mpA = f0 ? z4 : mp, mpB = f0 ? mp : z4, mnA = f15 ? z4 : mn, mnB = f15 ? mn : z4;
                    f32x4 xp = z4, xn = z4;
                    if (q > 0) xp = *(const PG8_LAS f32x4*)(xb + ((q - 1) * 2 + 1) * 256 + 128 * bj + cw + 4 * n);
                    if (q < 3) xn = *(const PG8_LAS f32x4*)(xb + ((q + 1) * 2) * 256 + 128 * bj + cw + 4 * n);
                    f32x4 R1[4], L1[4];
#pragma unroll
                    for (int m = 0; m < 4; ++m)
#pragma unroll
                        for (int e = 0; e < 4; ++e) { R1[m][e] = dpp_rot<0x121>(acc[ai][bj][m][n][e]); L1[m][e] = dpp_rot<0x12F>(acc[ai][bj][m][n][e]); }
#pragma unroll
                    for (int m = 0; m < 4; ++m) {
                        f32x4 uu = w0 * acc[ai][bj][m][n] + mpA * R1[m] + mpB * (m > 0 ? R1[m > 0 ? m - 1 : 0] : xp) + mnA * L1[m] + mnB * (m < 3 ? L1[m < 3 ? m + 1 : 3] : xn);
                        if (act == 1) uu = 2.0f * sigm4(2.0f * uu) - 1.0f; else if (act == 2) uu = sigm4(uu);
                        pk[m][n][0] = cvt_pk_bf16(uu[0], uu[1]); pk[m][n][1] = cvt_pk_bf16(uu[2], uu[3]); }
                }
#pragma unroll
                for (int m = 0; m < 4; ++m) *(u32x4*)(dst + (size_t)(row_off + u.pm * BM + 128 * ai + 64 * wr + 16 * m + fr) * ldd + dcol + 128 * bj + cw) = (u32x4){pk[m][0][0], pk[m][0][1], pk[m][1][0], pk[m][1][1]};
            }
        }
    }
};
struct EpiLora {
    static constexpr bool PERM = true, AFTER_DRAIN = false, HAS_MID = false; static constexpr int KSLICE = 128; static constexpr bool SKIP_B1 = false, HAS_PRE = false;
    bf16_t* lp; const float* bias;
    static __device__ __forceinline__ int koff(int pn) { const int t = pn >> 1; return t >= 4 ? 256 : (t >= 2 ? 128 : 0); }
    __device__ __forceinline__ void operator()(const f32x4 (&acc)[2][2][4][2], const Unit& u, int wr, int wc, int fr, int fq) const {
        const int pn = u.pn, t = pn >> 1;
        const int row0 = u.pm * BM + wr * 64 + fr, col0 = pn * 256 + wc * 32 + 8 * fq;
        const float sc = t < 2 ? -0.6065306597f : 1.0f;
#pragma unroll
        for (int bj = 0; bj < 2; ++bj) { const f32x4 b0 = *(const f32x4*)(bias + col0 + bj * HALF), b1 = *(const f32x4*)(bias + col0 + bj * HALF + 4);
#pragma unroll
            for (int ai = 0; ai < 2; ++ai)
#pragma unroll
                for (int m = 0; m < 4; ++m) { f32x4 v0 = acc[ai][bj][m][0] + b0, v1 = acc[ai][bj][m][1] + b1;
                    if (t < 4) { v0 = sigm4(v0) * sc; v1 = sigm4(v1) * sc; }
                    *(u32x4*)(lp + (size_t)(row0 + ai * HALF + m * 16) * 2560 + col0 + bj * HALF) = pack8(v0, v1); } }
    }
};
struct EpiMerge2 {
    static constexpr bool PERM = true, AFTER_DRAIN = false, HAS_MID = true; static constexpr int KSLICE = 0; static constexpr bool SKIP_B1 = false, HAS_PRE = false;
    bf16_t* mb; const bf16_t* gf; const bf16_t* gr;
    __device__ __forceinline__ void mid(f32x4 (&acc)[2][2][4][2], const Unit& u, int wr, int wc, int fr, int fq) const {
        asm volatile("" : "+v"(fr), "+v"(fq));
        const int row0 = u.pm * BM + wr * 64 + fr, col0 = u.pn * BM + wc * 32 + 8 * fq;
        constexpr int DEPTH = 8;
        u32x4 fw[DEPTH];
#define PG8_GOFF(it_) ((size_t)(row0 + ((it_) >> 3) * HALF + (((it_) >> 1) & 3) * 16) * 1024 + col0 + ((it_) & 1) * HALF)
#pragma unroll
        for (int d = 0; d < DEPTH; ++d) fw[d] = *(const u32x4*)(gf + PG8_GOFF(d));
#pragma unroll
        for (int it = 0; it < 16; ++it) { const int ai = it >> 3, m = (it >> 1) & 3, bj = it & 1, sl = it % DEPTH;
            const u32x4 fwc = fw[sl];
            asm volatile("" ::: "memory");
            if (it + DEPTH < 16) fw[sl] = *(const u32x4*)(gf + PG8_GOFF(it + DEPTH));
            asm volatile("" ::: "memory");
            acc[ai][bj][m][0][0] *= bf_lo(fwc.x); acc[ai][bj][m][0][1] *= bf_hi(fwc.x); acc[ai][bj][m][0][2] *= bf_lo(fwc.y); acc[ai][bj][m][0][3] *= bf_hi(fwc.y);
            acc[ai][bj][m][1][0] *= bf_lo(fwc.z); acc[ai][bj][m][1][1] *= bf_hi(fwc.z); acc[ai][bj][m][1][2] *= bf_lo(fwc.w); acc[ai][bj][m][1][3] *= bf_hi(fwc.w); }
    }
    __device__ __forceinline__ void operator()(const f32x4 (&acc)[2][2][4][2], const Unit& u, int wr, int wc, int fr, int fq) const {
        const int row0 = u.pm * BM + wr * 64 + fr, col0 = u.pn * BM + wc * 32 + 8 * fq;
        constexpr int DEPTH = 8;
        u32x4 rw[DEPTH];
#pragma unroll
        for (int d = 0; d < DEPTH; ++d) rw[d] = *(const u32x4*)(gr + PG8_GOFF(d));
#pragma unroll
        for (int it = 0; it < 16; ++it) { const int ai = it >> 3, m = (it >> 1) & 3, bj = it & 1, sl = it % DEPTH;
            const u32x4 rwc = rw[sl];
            asm volatile("" ::: "memory");
            if (it + DEPTH < 16) rw[sl] = *(const u32x4*)(gr + PG8_GOFF(it + DEPTH));
            asm volatile("" ::: "memory");
            f32x4 g0, g1; unpack8(rwc, g0, g1);
#pragma unroll
            for (int e = 0; e < 4; ++e) { g0[e] = fmaxf(g0[e], 1e-20f); g1[e] = fmaxf(g1[e], 1e-20f); }
            *(u32x4*)(mb + PG8_GOFF(it)) = pack8(g0 * acc[ai][bj][m][0], g1 * acc[ai][bj][m][1]); }
#undef PG8_GOFF
    }
};
struct EpiResid {
    static constexpr bool PERM = false, AFTER_DRAIN = false, HAS_MID = false; static constexpr int KSLICE = 0; static constexpr bool SKIP_B1 = false, HAS_PRE = false;
    const float* base; float* out; const float* gate;
    __device__ __forceinline__ void operator()(const f32x4 (&acc)[2][2][4][2], const Unit& u, int wr, int wc, int fr, int fq) const {
        const int row0 = u.pm * BM + wr * 64 + fr, col0 = u.pn * BM + wc * 32 + 4 * fq; const float* gp = gate + (size_t)(u.pm >> 3) * 6144 + col0;
        f32x4 gv[2][2];
#pragma unroll
        for (int bj = 0; bj < 2; ++bj)
#pragma unroll
            for (int n = 0; n < 2; ++n) gv[bj][n] = *(const f32x4*)(gp + bj * HALF + n * 16);
        f32x4 cur[2][2], nxt[2][2];
#pragma unroll
        for (int bj = 0; bj < 2; ++bj)
#pragma unroll
            for (int n = 0; n < 2; ++n) cur[bj][n] = *(const f32x4*)(base + (size_t)row0 * 1024 + col0 + bj * HALF + n * 16);
#pragma unroll
        for (int g8 = 0; g8 < 8; ++g8) { const int ai = g8 >> 2, m = g8 & 3; const size_t off = (size_t)(row0 + ai * HALF + m * 16) * 1024 + col0;
            if (g8 + 1 < 8) { const int ai2 = (g8 + 1) >> 2, m2 = (g8 + 1) & 3; const size_t off2 = (size_t)(row0 + ai2 * HALF + m2 * 16) * 1024 + col0;
#pragma unroll
                for (int bj = 0; bj < 2; ++bj)
#pragma unroll
                    for (int n = 0; n < 2; ++n) nxt[bj][n] = *(const f32x4*)(base + off2 + bj * HALF + n * 16); }
            asm volatile("" ::: "memory");
#pragma unroll
            for (int bj = 0; bj < 2; ++bj)
#pragma unroll
                for (int n = 0; n < 2; ++n) *(f32x4*)(out + off + bj * HALF + n * 16) = cur[bj][n] + gv[bj][n] * acc[ai][bj][m][n];
            asm volatile("" ::: "memory");
#pragma unroll
            for (int bj = 0; bj < 2; ++bj)
#pragma unroll
                for (int n = 0; n < 2; ++n) cur[bj][n] = nxt[bj][n];
        }
    }
};
struct EpiDelta {
    static constexpr bool PERM = true, AFTER_DRAIN = false, HAS_MID = false; static constexpr int KSLICE = 0; static constexpr bool SKIP_B1 = false, HAS_PRE = false;
    bf16_t* dlt; const float* gate;
    __device__ __forceinline__ void operator()(const f32x4 (&acc)[2][2][4][2], const Unit& u, int wr, int wc, int fr, int fq) const {
        const int row0 = u.pm * BM + wr * 64 + fr, col0 = u.pn * BM + wc * 32 + 8 * fq; const float* gp = gate + (size_t)(u.pm >> 3) * 6144 + col0;
        f32x4 gv[2][2];
#pragma unroll
        for (int bj = 0; bj < 2; ++bj)
#pragma unroll
            for (int n = 0; n < 2; ++n) gv[bj][n] = *(const f32x4*)(gp + bj * HALF + 4 * n);
#pragma unroll
        for (int ai = 0; ai < 2; ++ai)
#pragma unroll
            for (int m = 0; m < 4; ++m) { bf16_t* rowp = dlt + (size_t)(row0 + ai * HALF + m * 16) * 1024 + col0;
#pragma unroll
                for (int bj = 0; bj < 2; ++bj) *(u32x4*)(rowp + bj * HALF) = pack8(acc[ai][bj][m][0] * gv[bj][0], acc[ai][bj][m][1] * gv[bj][1]); }
    }
};
struct EpiSwiglu {
    static constexpr bool PERM = true, AFTER_DRAIN = false, HAS_MID = false; static constexpr int KSLICE = 0; static constexpr bool SKIP_B1 = false, HAS_PRE = false;
    bf16_t* act;
    __device__ __forceinline__ void operator()(const f32x4 (&acc)[2][2][4][2], const Unit& u, int wr, int wc, int fr, int fq) const {
        const int row0 = u.pm * BM + wr * 64 + fr, col0 = u.pn * 128 + wc * 32 + 8 * fq;
#pragma unroll
        for (int ai = 0; ai < 2; ++ai)
#pragma unroll
            for (int m = 0; m < 4; ++m) { const f32x4 g0 = acc[ai][0][m][0], g1 = acc[ai][0][m][1];
                *(u32x4*)(act + (size_t)(row0 + ai * HALF + m * 16) * 2816 + col0) = pack8(g0 * sigm4(g0) * acc[ai][1][m][0], g1 * sigm4(g1) * acc[ai][1][m][1]); }
    }
};

template <class Epi, class Sched, bool ALIGN_EPI = false, bool SP2 = false>
__device__ __forceinline__ void gemm_phase(PG8_LAS unsigned char* lds, const Gemm g, const Sched& S, const Epi& E) {
    int tid_ = threadIdx.x; asm volatile("" : "+v"(tid_));
    const int tid = tid_, wid = __builtin_amdgcn_readfirstlane(tid >> 6), lane = tid & 63, wr = wid >> 2, wc = wid & 3, fr = lane & 15, fq = lane >> 4;
    int nt_ = Epi::KSLICE ? Epi::KSLICE / BK : g.K / BK; asm volatile("" : "+s"(nt_));
    const int K = g.K, nt = nt_;
    unsigned voffA[2], voffB[2];
#pragma unroll
    for (int i = 0; i < 2; ++i) { int R, C; stage_rc(tid * 16 + i * 8192, R, C); const int Rb = Epi::PERM ? ((R & ~31) + perm32(R & 31)) : R;
        voffA[i] = (unsigned)(R * K + C) * 2u; voffB[i] = (unsigned)(Rb * K + C) * 2u; }
    const size_t kstep = (size_t)(BK * 2);
    const size_t hstep = (size_t)HALF * K * 2;
    const size_t tstep = 2 * hstep;
    const unsigned ldsw = (unsigned)wid * 1024u;
    const int aoff = lds_byte(wr * 64 + fr, fq * 8), boff = lds_byte(wc * 32 + fr, fq * 8);
#define PG8_SA(b, h) (((b) * 2 + (h)) * HTB)
#define PG8_SB(b, h) ((4 + (b) * 2 + (h)) * HTB)
#define PG8_STAGE(bufoff, gbase, voff) do { _Pragma("unroll") for (int _i = 0; _i < 2; ++_i) \
        __builtin_amdgcn_global_load_lds((const unsigned*)((const char*)(gbase) + (voff)[_i]), (PG8_LAS unsigned*)(lds + (bufoff) + ldsw + _i * 8192), 16, 0, 0); } while (0)
#define PG8_LDA(dst, b, h) do { _Pragma("unroll") for (int m = 0; m < 4; ++m) _Pragma("unroll") for (int k = 0; k < 2; ++k) dst[m][k] = *(const PG8_LAS bf16x8*)(lds + PG8_SA(b, h) + aoff + m * 2048 + k * 1024); } while (0)
#define PG8_LDB(dst, b, h) do { _Pragma("unroll") for (int n = 0; n < 2; ++n) _Pragma("unroll") for (int k = 0; k < 2; ++k) dst[n][k] = *(const PG8_LAS bf16x8*)(lds + PG8_SB(b, h) + boff + n * 2048 + k * 1024); } while (0)
#define PG8_MMA(ai, bj, At, Bt) do { __builtin_amdgcn_s_setprio(1); _Pragma("unroll") for (int m = 0; m < 4; ++m) _Pragma("unroll") for (int n = 0; n < 2; ++n) _Pragma("unroll") for (int k = 0; k < 2; ++k) \
        acc[ai][bj][m][n] = __builtin_amdgcn_mfma_f32_16x16x32_bf16(Bt[n][k], At[m][k], acc[ai][bj][m][n], 0, 0, 0); __builtin_amdgcn_s_setprio(0); } while (0)
#define PG8_MMA1(ai, At) do { if constexpr (Epi::SKIP_B1) { if (!skb) PG8_MMA(ai, 1, At, B1); } else PG8_MMA(ai, 1, At, B1); } while (0)
#define PG8_WAIT_V(n) asm volatile("s_waitcnt vmcnt(" #n ")" ::: "memory")
#define PG8_WAIT_L(n) asm volatile("s_waitcnt lgkmcnt(" #n ")" ::: "memory")
#define PG8_BAR __builtin_amdgcn_s_barrier()
#define PG8_SCHED __builtin_amdgcn_sched_barrier(0)
    Unit cur, nxt; int ui = 0;
    if (!S.next(0, cur)) return;
    bool skb = false; if constexpr (Epi::SKIP_B1) skb = Epi::skip_b1(cur.pn);
    if constexpr (Epi::HAS_PRE) E.pre(cur, 0, wid, lane);
    f32x4 acc[2][2][4][2];
#pragma unroll
    for (int a = 0; a < 2; ++a)
#pragma unroll
        for (int b = 0; b < 2; ++b)
#pragma unroll
            for (int m = 0; m < 4; ++m)
#pragma unroll
                for (int n = 0; n < 2; ++n) acc[a][b][m][n] = (f32x4){0.f, 0.f, 0.f, 0.f};
    bf16x8 At[4][2], B0[2][2], B1[2][2];
    const char* cA = (const char*)g.A + (size_t)cur.pm * tstep; const char* cB = (const char*)g.Bt + (size_t)cur.pn * tstep;
    if constexpr (Epi::KSLICE != 0) { const int ko = Epi::koff(cur.pn) * 2; cA += ko; cB += ko; }
    S.a_ready(cur);
    if constexpr (SP2) {
        PG8_STAGE(PG8_SB(0, 0), cB, voffB); PG8_STAGE(PG8_SB(0, 1), cB + hstep, voffB); PG8_STAGE(PG8_SA(0, 0), cA, voffA); PG8_STAGE(PG8_SA(0, 1), cA + hstep, voffA);
        if (wr == 1) PG8_BAR;
        PG8_WAIT_V(2); PG8_BAR;
        PG8_STAGE(PG8_SB(1, 0), cB + kstep, voffB); PG8_STAGE(PG8_SA(1, 0), cA + kstep, voffA); PG8_STAGE(PG8_SB(1, 1), cB + hstep + kstep, voffB);
        PG8_WAIT_V(6); PG8_BAR;
    } else {
        PG8_STAGE(PG8_SB(0, 0), cB, voffB); PG8_STAGE(PG8_SA(0, 0), cA, voffA); PG8_STAGE(PG8_SB(0, 1), cB + hstep, voffB); PG8_STAGE(PG8_SA(0, 1), cA + hstep, voffA);
        if (wr == 1) PG8_BAR;
        PG8_WAIT_V(4); PG8_BAR;
        PG8_STAGE(PG8_SB(1, 0), cB + kstep, voffB); PG8_STAGE(PG8_SA(1, 0), cA + kstep, voffA); PG8_STAGE(PG8_SB(1, 1), cB + hstep + kstep, voffB);
        PG8_WAIT_V(6); PG8_BAR;
    }
    for (;;) {
        const bool has_next = S.next(ui + 1, nxt);
        const char* nA = has_next ? (const char*)g.A + (size_t)nxt.pm * tstep : cA; const char* nB = has_next ? (const char*)g.Bt + (size_t)nxt.pn * tstep : cB;
        if constexpr (Epi::KSLICE != 0) { if (has_next) { const int ko = Epi::koff(nxt.pn) * 2; nA += ko; nB += ko; } }
#pragma unroll 1
        for (int t = 0; t < nt; t += 2) {
            const bool last = (t == nt - 2);
            const char* a1 = cA + (size_t)(t + 1) * kstep;
            const char* a2 = last ? nA : cA + (size_t)(t + 2) * kstep; const char* b2 = last ? nB : cB + (size_t)(t + 2) * kstep;
            const char* a3 = a2 + kstep; const char* b3 = b2 + kstep;
            if (last && has_next) S.a_ready(nxt);
            if constexpr (SP2) {
            PG8_LDB(B0, 0, 0); PG8_LDB(B1, 0, 1); PG8_SCHED; PG8_LDA(At, 0, 0); PG8_STAGE(PG8_SA(1, 1), a1 + hstep, voffA);
            PG8_WAIT_V(8); PG8_WAIT_L(0); PG8_BAR; PG8_MMA(0, 0, At, B0); PG8_MMA1(0, At); PG8_BAR; PG8_SCHED;
            PG8_LDA(At, 0, 1); PG8_STAGE(PG8_SB(0, 0), b2, voffB); PG8_STAGE(PG8_SB(0, 1), b2 + hstep, voffB); PG8_STAGE(PG8_SA(0, 0), a2, voffA);
            PG8_WAIT_V(8); PG8_WAIT_L(0); PG8_BAR; PG8_MMA(1, 0, At, B0); PG8_MMA1(1, At); PG8_BAR; PG8_SCHED;
            PG8_LDB(B0, 1, 0); PG8_LDB(B1, 1, 1); PG8_SCHED; PG8_LDA(At, 1, 0); PG8_STAGE(PG8_SA(0, 1), a2 + hstep, voffA);
            PG8_WAIT_V(8); PG8_WAIT_L(0); PG8_BAR; PG8_MMA(0, 0, At, B0); PG8_MMA1(0, At); PG8_BAR; PG8_SCHED;
            PG8_LDA(At, 1, 1); PG8_STAGE(PG8_SB(1, 0), b3, voffB); PG8_STAGE(PG8_SB(1, 1), b3 + hstep, voffB); PG8_STAGE(PG8_SA(1, 0), a3, voffA);
            PG8_WAIT_V(8); PG8_WAIT_L(0); PG8_BAR; PG8_MMA(1, 0, At, B0); PG8_MMA1(1, At); PG8_BAR; PG8_SCHED;
            } else {
            PG8_LDB(B0, 0, 0); PG8_SCHED; PG8_LDA(At, 0, 0); PG8_STAGE(PG8_SA(1, 1), a1 + hstep, voffA);
            PG8_WAIT_L(8); PG8_BAR; PG8_WAIT_L(0); PG8_MMA(0, 0, At, B0); PG8_BAR; PG8_SCHED;
            PG8_LDB(B1, 0, 1); PG8_STAGE(PG8_SB(0, 0), b2, voffB);
            PG8_BAR; PG8_WAIT_L(0); PG8_MMA(0, 1, At, B1); PG8_BAR;
            PG8_LDA(At, 0, 1); PG8_STAGE(PG8_SA(0, 0), a2, voffA);
            PG8_BAR; PG8_WAIT_L(0); PG8_MMA(1, 0, At, B0); PG8_BAR; PG8_SCHED;
            PG8_STAGE(PG8_SB(0, 1), b2 + hstep, voffB);
            PG8_WAIT_V(6); PG8_BAR; PG8_MMA(1, 1, At, B1); PG8_BAR;
            PG8_LDB(B0, 1, 0); PG8_SCHED; PG8_LDA(At, 1, 0); PG8_STAGE(PG8_SA(0, 1), a2 + hstep, voffA);
            PG8_WAIT_L(8); PG8_BAR; PG8_WAIT_L(0); PG8_MMA(0, 0, At, B0); PG8_BAR; PG8_SCHED;
            PG8_LDB(B1, 1, 1); PG8_STAGE(PG8_SB(1, 0), b3, voffB);
            PG8_BAR; PG8_WAIT_L(0); PG8_MMA(0, 1, At, B1); PG8_BAR;
            PG8_LDA(At, 1, 1); PG8_STAGE(PG8_SA(1, 0), a3, voffA);
            PG8_BAR; PG8_WAIT_L(0); PG8_MMA(1, 0, At, B0); PG8_BAR; PG8_SCHED;
            PG8_STAGE(PG8_SB(1, 1), b3 + hstep, voffB);
            PG8_WAIT_V(6); PG8_BAR; PG8_MMA(1, 1, At, B1); PG8_BAR;
            }
            if constexpr (Epi::HAS_MID) { if (t == (nt >> 1) - 2) {
                if constexpr (ALIGN_EPI) { if (wr == 0) PG8_BAR; }
                E.mid(acc, cur, wr, wc, fr, fq);
                if constexpr (ALIGN_EPI) { if (wr == 1) PG8_BAR; } } }
        }
        if constexpr (ALIGN_EPI) { if (wr == 0) PG8_BAR; }
        if constexpr (!Epi::AFTER_DRAIN) { if constexpr (Epi::HAS_PRE) E(acc, cur, wr, wc, fr, fq, ui); else E(acc, cur, wr, wc, fr, fq); S.done(cur); }
        if (!has_next) break;
#pragma unroll
        for (int a = 0; a < 2; ++a)
#pragma unroll
            for (int b = 0; b < 2; ++b)
#pragma unroll
                for (int m = 0; m < 4; ++m)
#pragma unroll
                    for (int n = 0; n < 2; ++n) acc[a][b][m][n] = (f32x4){0.f, 0.f, 0.f, 0.f};
        cur = nxt; cA = nA; cB = nB; ++ui; if constexpr (Epi::SKIP_B1) skb = Epi::skip_b1(cur.pn);
        if constexpr (Epi::HAS_PRE) E.pre(cur, ui, wid, lane);
        if constexpr (ALIGN_EPI) { if (wr == 1) PG8_BAR; }
    }
    PG8_WAIT_V(0);
    if constexpr (!ALIGN_EPI) { if (wr == 0) PG8_BAR; }
    PG8_BAR;
    if constexpr (Epi::AFTER_DRAIN) { E.fused(acc, cur, wr, wc, fr, fq, lds, wid, lane); S.done(cur); }
#undef PG8_SA
#undef PG8_SB
#undef PG8_STAGE
#undef PG8_LDA
#undef PG8_LDB
#undef PG8_MMA
#undef PG8_MMA1
#undef PG8_WAIT_V
#undef PG8_WAIT_L
#undef PG8_BAR
#undef PG8_SCHED
}
}
constexpr int NWAVES = 8;
constexpr int N_LAUNCHES = MK_N_LAUNCHES;
constexpr int NPH = 16;
constexpr int D = 1024, NB = 16, SEQ = 2048, CTXL = 256, MX = NB * SEQ, MC = NB * CTXL, MT = MX + MC;
constexpr int RW = 512, NH = 8, HD = 64, RCOLS = 1920, RPAD = 2048, INCOLS = 4480, NIN = 4608, DFF = 2816, LK = 384, LN = 2560, MODW = 6144;
constexpr float NORM_EPS = 1e-6f, GN_EPS = 64e-5f;
constexpr size_t MiB = 1u << 20;
constexpr size_t WS_CTL = 0, CTL_ZERO_BYTES = 64 * 1024;
constexpr size_t WS_MOD = 1 * MiB, WS_LB = WS_MOD + 512 * 1024;
constexpr size_t WS_WIN = 2 * MiB, WS_WLORA = 12 * MiB, WS_WUPF = 14 * MiB, WS_WUPR = 15 * MiB, WS_WOUT = 16 * MiB;
constexpr size_t WS_A = 18 * MiB, WS_B = 82 * MiB, WS_C = 146 * MiB, WS_D = 210 * MiB, WS_E = 390 * MiB, WS_END = 512 * MiB;
constexpr size_t WS_GF = WS_A, WS_HX2 = WS_A, WS_GR = WS_B, WS_WGU = WS_E, WS_WDOWN = WS_E + 11 * MiB, WS_D1 = WS_B, WS_D2 = WS_A;
constexpr size_t WS_Z3 = WS_C, WS_FXO = WS_C;
constexpr size_t WS_PXR = WS_D, WS_LP = WS_D, WS_MB = WS_D, WS_ACT = WS_D;
constexpr size_t WS_EB = WS_E + 114 * MiB;
constexpr size_t WS_HX = WS_D, WS_Y2 = WS_E, WS_R = WS_E, WS_K = WS_E + 36 * MiB, WS_V = WS_E + 72 * MiB, WS_SBT = WS_E + 110 * MiB;
static_assert(WS_K - WS_R == 36 * MiB && WS_V - WS_K == 36 * MiB, "EpiIn::RKV_STRIDE");
static_assert(WS_LP + (size_t)MT * LN * 2 <= WS_E && WS_ACT + (size_t)MX * DFF * 2 <= WS_E && WS_V + (size_t)MT * RW * 2 <= WS_END && WS_HX + (size_t)MT * D * 2 <= WS_END, "d_ws map");
constexpr int CW_TMO = 0, CW_BAR = 4096, CW_BADMAP = 8192;
constexpr int RING_OFF = 0, RING_BYTES = 131072, LDSCTL_OFF = RING_BYTES, MISC_OFF = LDSCTL_OFF + 320, LDS_BYTES = 147456;
constexpr int XB_OFF = RING_BYTES + 4096;

#define GAS __attribute__((address_space(1)))
#define LAS __attribute__((address_space(3)))
typedef unsigned short bf16;
typedef unsigned v4u __attribute__((ext_vector_type(4)));
typedef unsigned v2u __attribute__((ext_vector_type(2)));
typedef float f32x4 __attribute__((ext_vector_type(4)));
typedef GAS unsigned gu32;
#define RLX_AGENT __ATOMIC_RELAXED, __HIP_MEMORY_SCOPE_AGENT
#define LDS_WAIT() asm volatile("s_waitcnt lgkmcnt(0)" ::: "memory")
#define VM_WAIT() asm volatile("s_waitcnt vmcnt(0)" ::: "memory")
__device__ __forceinline__ unsigned f2bf(float f) { unsigned u = __builtin_bit_cast(unsigned, f); return (u + 0x7fffu + ((u >> 16) & 1u)) >> 16; }
__device__ __forceinline__ unsigned pk2(float lo, float hi) { return f2bf(lo) | (f2bf(hi) << 16); }
__device__ __forceinline__ float bflo(unsigned w) { return __uint_as_float(w << 16); }
__device__ __forceinline__ float bfhi(unsigned w) { return __uint_as_float(w & 0xffff0000u); }
__device__ __forceinline__ float sigf(float x) { return 1.0f / (1.0f + __expf(-x)); }
__device__ __forceinline__ void unpk8(v4u w, float (&f)[8]) { f[0] = bflo(w.x); f[1] = bfhi(w.x); f[2] = bflo(w.y); f[3] = bfhi(w.y); f[4] = bflo(w.z); f[5] = bfhi(w.z); f[6] = bflo(w.w); f[7] = bfhi(w.w); }
__device__ __forceinline__ v4u pk8(const float (&f)[8]) { v4u o; o.x = pk2(f[0], f[1]); o.y = pk2(f[2], f[3]); o.z = pk2(f[4], f[5]); o.w = pk2(f[6], f[7]); return o; }

#define XB_TMO      128
#define XB_XCNT(j)  (256  + 64 * (j))
#define XB_XSUB(j)  (1280 + 64 * (j))
#define XB_XGEN(j)  (2304 + 64 * (j))
#define XB_TOP      3328
#define XB_TOPGEN   3392
#define XCD_BAR_WORDS 3456
#define XB_SPIN_CAP (1u << 18)

__device__ __forceinline__ unsigned xb_ld(unsigned* p)              { return __hip_atomic_load(p, __ATOMIC_RELAXED, __HIP_MEMORY_SCOPE_AGENT); }
__device__ __forceinline__ unsigned xb_add(unsigned* p, unsigned v) { return __hip_atomic_fetch_add(p, v, __ATOMIC_RELAXED, __HIP_MEMORY_SCOPE_AGENT); }
__device__ __forceinline__ unsigned xb_xcc_id() { return (unsigned)__builtin_amdgcn_s_getreg((3 << 11) | 20) & 0xFu; }
#define XB_SPIN(cond, bar) do { unsigned _sp = 0; while (cond) { __builtin_amdgcn_s_sleep(1); \
    if ((++_sp & 255u) == 0u) { if (xb_ld(&(bar)[XB_TMO])) break; if (_sp > XB_SPIN_CAP) { atomicAdd(&(bar)[XB_TMO], 1u); break; } } } } while (0)

struct XcdBarrier {
    unsigned* bar; unsigned x;
    volatile LAS unsigned* st;
};

__device__ __forceinline__ XcdBarrier xcd_barrier_post(unsigned* bar, volatile LAS unsigned* st) {
    XcdBarrier b; b.bar = bar; b.x = xb_xcc_id(); b.st = st;
    if (threadIdx.x == 0) (void)xb_add(&bar[XB_XCNT(b.x)], 1u);
    return b;
}
__device__ __forceinline__ void xcd_barrier_complete(unsigned* bar, unsigned x, unsigned& nloc, unsigned& nx) {
    const unsigned G = gridDim.x * gridDim.y * gridDim.z;
    unsigned sum, cnt, mine, sp = 0u;
    for (;;) {
        sum = 0u; cnt = 0u; mine = 0u;
#pragma unroll
        for (unsigned j = 0; j < 16; ++j) { const unsigned c = xb_ld(&bar[XB_XCNT(j)]); sum += c; cnt += (c > 0u) ? 1u : 0u; mine = (j == x) ? c : mine; }
        if (sum == G) break;
        __builtin_amdgcn_s_sleep(1);
        if ((++sp & 255u) == 0u) { if (xb_ld(&bar[XB_TMO])) break; if (sp > XB_SPIN_CAP) { atomicAdd(&bar[XB_TMO], 1u); break; } }
    }
    nloc = mine > 0u ? mine : 1u; nx = cnt > 0u ? cnt : 1u;
}

__device__ __forceinline__ void xcd_barrier(const XcdBarrier& b) {
    asm volatile("s_waitcnt vmcnt(0)" ::: "memory");
    __syncthreads();
    if (threadIdx.x == 0) {
        unsigned* bar = b.bar;
        __builtin_amdgcn_s_waitcnt(0);
        unsigned nloc = b.st[0], nx = b.st[1];
        if (nloc == 0u) { xcd_barrier_complete(bar, b.x, nloc, nx); b.st[0] = nloc; b.st[1] = nx; }
        const unsigned old = xb_add(&bar[XB_XSUB(b.x)], 1u);
        const unsigned gen = old / nloc;
        if (old + 1u == (gen + 1u) * nloc) {
            __builtin_amdgcn_fence(__ATOMIC_RELEASE, "agent");
            asm volatile("s_waitcnt vmcnt(0)" ::: "memory");
            const unsigned og = xb_add(&bar[XB_TOP], 1u);
            const unsigned tg = og / nx;
            if (og + 1u == (tg + 1u) * nx) xb_add(&bar[XB_TOPGEN], 1u);
            else XB_SPIN(xb_ld(&bar[XB_TOPGEN]) == tg, bar);
            __builtin_amdgcn_fence(__ATOMIC_ACQUIRE, "agent");
            xb_add(&bar[XB_XGEN(b.x)], 1u);
            asm volatile("s_waitcnt vmcnt(0)" ::: "memory");
        } else {
            XB_SPIN(xb_ld(&bar[XB_XGEN(b.x)]) == gen, bar);
            __builtin_amdgcn_fence(__ATOMIC_ACQUIRE, "agent");
            asm volatile("s_waitcnt vmcnt(0)" ::: "memory");
        }
    }
    __syncthreads();
}
__device__ __forceinline__ void xcd_barrier_local(const XcdBarrier& b) {
    asm volatile("s_waitcnt vmcnt(0)" ::: "memory");
    __syncthreads();
    if (threadIdx.x == 0) {
        unsigned* bar = b.bar;
        __builtin_amdgcn_s_waitcnt(0);
        const unsigned nloc = b.st[0] ? b.st[0] : 1u;
        const unsigned old = xb_add(&bar[XB_XSUB(b.x)], 1u);
        const unsigned gen = old / nloc;
        if (old + 1u == (gen + 1u) * nloc) (void)xb_add(&bar[XB_XGEN(b.x)], 1u);
        else XB_SPIN(xb_ld(&bar[XB_XGEN(b.x)]) == gen, bar);
        __builtin_amdgcn_fence(__ATOMIC_ACQUIRE, "agent");
        asm volatile("s_waitcnt vmcnt(0)" ::: "memory");
    }
    __syncthreads();
}
struct Args { const float* in[31]; float* out; unsigned char* ws; int ph_lo, ph_hi, li, pad; };
enum In { I_X = 0, I_C, I_CTX, I_CCTX, I_N1G, I_N2G, I_WADA, I_BADA, I_WIN, I_MUP, I_MUN, I_W0F, I_W2F, I_A0F, I_A2F, I_W0B, I_W2B, I_A0B, I_A2B, I_G2, I_KK, I_KA, I_RK, I_LNG, I_LNB, I_WUPR, I_WUPF, I_WOUT, I_WGU, I_WDOWN, I_FNG };
struct Frame { LAS unsigned char* lds; volatile LAS unsigned* MISC; gu32* ctl; int tid, lane, wave, vcu, G; };

__device__ __forceinline__ void refresh_tid(Frame& F) { int t = threadIdx.x; asm volatile("" : "+v"(t)); F.tid = t; F.lane = t & 63; }
__device__ __forceinline__ float wave_sum(float v) {
#pragma unroll
    for (int o = 1; o < 64; o <<= 1) v += __shfl_xor(v, o);
    return v;
}
__device__ __forceinline__ float red8(float v) { v += __shfl_xor(v, 1); v += __shfl_xor(v, 2); v += __shfl_xor(v, 4); return v; }

__device__ __forceinline__ void tr_item(const float* W, int ldw, int k0, int n0, bf16* WTrow0, int ldk, LAS float* scr, int lane) {
    float tv[32];
#pragma unroll
    for (int i = 0; i < 32; ++i) tv[i] = __builtin_nontemporal_load(W + (size_t)(k0 + 2 * i + (lane >> 5)) * ldw + n0 + (lane & 31));
#pragma unroll
    for (int i = 0; i < 32; ++i) scr[(2 * i + (lane >> 5)) * 33 + (lane & 31)] = tv[i];
    LDS_WAIT(); asm volatile("" ::: "memory");
    const int c = lane & 7;
#pragma unroll
    for (int j = 0; j < 4; ++j) { const int n = (lane >> 3) + 8 * j; const LAS float* s = scr + (8 * c) * 33 + n;
        v4u o; o.x = pk2(s[0 * 33], s[1 * 33]); o.y = pk2(s[2 * 33], s[3 * 33]); o.z = pk2(s[4 * 33], s[5 * 33]); o.w = pk2(s[6 * 33], s[7 * 33]);
        *(GAS v4u*)(WTrow0 + (size_t)n * ldk + k0 + 8 * c) = o; }
    LDS_WAIT(); asm volatile("" ::: "memory");
}

__device__ __forceinline__ void p0_weights(const Frame& F, const Args& a) {
    unsigned char* ws = a.ws;
    bf16* Win_t = (bf16*)(ws + WS_WIN); bf16* Wlora_t = (bf16*)(ws + WS_WLORA); bf16* Wupf_t = (bf16*)(ws + WS_WUPF); bf16* Wupr_t = (bf16*)(ws + WS_WUPR); bf16* Wout_t = (bf16*)(ws + WS_WOUT);
    LAS float* scr = (LAS float*)(F.lds + RING_OFF + F.wave * 16384);
    const int gw = F.vcu * NWAVES + F.wave, NGW = F.G * NWAVES, lane = F.lane;
    constexpr int E0 = 960, E1 = E0 + 1280, E2 = E1 + 256, E3 = E2 + 256, E4 = E3 + 512, E5 = E4 + 128, E6 = E5 + 2560;
    for (int it = gw; it < E6; it += NGW) {
        if (it < E0) { const int kb = it / 60, nb = it % 60; tr_item(a.in[I_WIN], INCOLS, 64 * kb, 32 * nb, Win_t + (size_t)(32 * nb) * D, D, scr, lane); }
        else if (it < E1) { const int r = it - E0, kb = r / 80, nb = r % 80;
            int drow = 2048 + 32 * nb; if (nb >= 16) { const int gj = 32 * ((nb - 16) & 31); drow = 2560 + (gj >> 7) * 256 + (gj & 127) + (nb >= 48 ? 128 : 0); }
            tr_item(a.in[I_WIN] + 1920, INCOLS, 64 * kb, 32 * nb, Win_t + (size_t)drow * D, D, scr, lane); }
        else if (it < E2) { const int r = it - E1, kb = r >> 5, nb = r & 31; tr_item(a.in[I_WUPF], D, 64 * kb, 32 * nb, Wupf_t + (size_t)(32 * nb) * 1024, 1024, scr, lane); }
        else if (it < E3) { const int r = it - E2, kb = r >> 5, nb = r & 31; tr_item(a.in[I_WUPR], D, 64 * kb, 32 * nb, Wupf_t + (size_t)(32 * nb) * 1024 + 512, 1024, scr, lane); }
        else if (it < E4) { const int r = it - E3, kb = r >> 5, nb = r & 31; tr_item(a.in[I_WOUT], D, 64 * kb, 32 * nb, Wout_t + (size_t)(32 * nb) * D, D, scr, lane); }
        else if (it < E5) { const int row = RCOLS + (it - E4); GAS v4u* p = (GAS v4u*)(Win_t + (size_t)row * D + 16 * lane); p[0] = (v4u){0u, 0u, 0u, 0u}; p[1] = (v4u){0u, 0u, 0u, 0u}; }
        else { const int n = it - E5, t = n >> 9, nn = n & 511, koff = t < 4 ? 64 * t : 256, klen = t < 4 ? 64 : 128;
            const float* src = t == 0 ? a.in[I_W2F] : t == 1 ? a.in[I_W2B] : t == 2 ? a.in[I_A2F] : t == 3 ? a.in[I_A2B] : a.in[I_G2];
            float v[6];
#pragma unroll
            for (int e = 0; e < 6; ++e) { const int kk = 6 * lane + e - koff; v[e] = (kk >= 0 && kk < klen) ? src[(size_t)kk * 512 + nn] : 0.f; }
            GAS unsigned* p = (GAS unsigned*)(Wlora_t + (size_t)n * LK + 6 * lane); p[0] = pk2(v[0], v[1]); p[1] = pk2(v[2], v[3]); p[2] = pk2(v[4], v[5]); }
    }
    { constexpr int NPIECE = (LN + NWAVES * 64 - 1) / (NWAVES * 64); const bool spread = F.G >= 192 + NPIECE;
      const int p0 = spread ? (int)blockIdx.x - 192 : 0, p1 = spread ? p0 + 1 : (blockIdx.x == 0 ? NPIECE : 0);
      if (p0 >= 0 && p0 < NPIECE) { float* LB = (float*)(a.ws + WS_LB);
          for (int i = p0 * NWAVES * 64 + F.tid; i < LN && i < p1 * NWAVES * 64; i += NWAVES * 64) { const int t = i >> 9, nn = i & 511; LB[i] = t == 0 ? a.in[I_W0F][nn] : t == 1 ? a.in[I_W0B][nn] : t == 2 ? a.in[I_A0F][nn] : t == 3 ? a.in[I_A0B][nn] : 0.f; } } }
    __syncthreads();
    LAS float* L = (LAS float*)(F.lds + RING_OFF);
    for (int it = blockIdx.x; it < 192; it += F.G) {
        {
            const int n0 = it * 32;
            LAS float* sc = L; LAS float* red = L + 17 * 1024;
            { float cvv[34];
#pragma unroll
              for (int i = 0; i < 34; ++i) { const int idx = F.tid + 512 * i, b = idx >> 10, k = idx & 1023; cvv[i] = b < 16 ? a.in[I_C][b * 1024 + k] : a.in[I_CCTX][k]; }
#pragma unroll
              for (int i = 0; i < 34; ++i) sc[F.tid + 512 * i] = cvv[i] * sigf(cvv[i]); }
            __syncthreads();
            const int col = F.tid & 31, ks = F.tid >> 5;
            float acc[17];
#pragma unroll
            for (int b = 0; b < 17; ++b) acc[b] = 0.f;
            for (int k8 = 0; k8 < 64; k8 += 32) { float wv[32];
#pragma unroll
                for (int j = 0; j < 32; ++j) wv[j] = __builtin_nontemporal_load(a.in[I_WADA] + (size_t)(ks * 64 + k8 + j) * MODW + n0 + col);
#pragma unroll
                for (int j = 0; j < 32; ++j) { const int k = ks * 64 + k8 + j;
#pragma unroll
                    for (int b = 0; b < 17; ++b) acc[b] += sc[b * 1024 + k] * wv[j]; } }
#pragma unroll
            for (int b = 0; b < 17; ++b) red[(ks * 17 + b) * 32 + col] = acc[b];
            __syncthreads();
            for (int o = F.tid; o < 17 * 32; o += NWAVES * 64) { const int b = o >> 5, c2 = o & 31; float s = a.in[I_BADA][n0 + c2];
                for (int k2 = 0; k2 < 16; ++k2) s += red[(k2 * 17 + b) * 32 + c2];
                ((float*)(a.ws + WS_MOD))[b * MODW + n0 + c2] = s; }
            __syncthreads();
        }
    }
}
__device__ __forceinline__ void p_weights2(const Frame& F, const Args& a) {
    bf16* Wgu_t = (bf16*)(a.ws + WS_WGU); bf16* Wdown_t = (bf16*)(a.ws + WS_WDOWN);
    LAS float* scr = (LAS float*)(F.lds + RING_OFF + F.wave * 16384);
    const int gw = F.vcu * NWAVES + F.wave, NGW = F.G * NWAVES;
    for (int it = gw; it < 2816 + 1408; it += NGW) {
        if (it < 2816) { const int kb = it / 176, nb = it % 176, n0 = 32 * nb; const int np = n0 < DFF ? n0 : n0 - DFF; const int drow = (np >> 7) * 256 + (np & 127) + (n0 < DFF ? 0 : 128);
            tr_item(a.in[I_WGU], 2 * DFF, 64 * kb, n0, Wgu_t + (size_t)drow * D, D, scr, F.lane); }
        else { const int r = it - 2816, kb = r >> 5, nb = r & 31; tr_item(a.in[I_WDOWN], D, 64 * kb, 32 * nb, Wdown_t + (size_t)(32 * nb) * DFF, DFF, scr, F.lane); }
    }
}
template <int KIND> __device__ __forceinline__ void norm_mod_rows(const Args& a, int m0, int m1, const float* g, bf16* O, int lane) {
    if (m0 >= m1) return;
    const float* MODp = (const float*)(a.ws + WS_MOD);
    f32x4 gg[4];
#pragma unroll
    for (int j = 0; j < 4; ++j) gg[j] = ((const f32x4*)g)[lane + 64 * j];
    auto rowp = [&](int m) -> const GAS f32x4* { const float* p = (KIND == 1 || m < MX) ? a.in[I_X] + (size_t)m * D : a.in[I_CTX] + (size_t)(m - MX) * D; return (const GAS f32x4*)p + lane; };
    const bf16* D1 = (const bf16*)(a.ws + WS_D1);
    f32x4 cur[4], nxt[4], ss[4], cc[4]; v2u cd[4], nd[4]; int bcur = -1;
    { const GAS f32x4* p = rowp(m0);
#pragma unroll
      for (int j = 0; j < 4; ++j) { cur[j] = __builtin_nontemporal_load(p + 64 * j); if (KIND == 1) cd[j] = __builtin_nontemporal_load((const GAS v2u*)(D1 + (size_t)m0 * D) + lane + 64 * j); } }
    for (int m = m0; m < m1; ++m) {
        if (m + 1 < m1) { const GAS f32x4* p = rowp(m + 1);
#pragma unroll
            for (int j = 0; j < 4; ++j) { nxt[j] = __builtin_nontemporal_load(p + 64 * j); if (KIND == 1) nd[j] = __builtin_nontemporal_load((const GAS v2u*)(D1 + (size_t)(m + 1) * D) + lane + 64 * j); } }
        if (KIND == 1) {
#pragma unroll
            for (int j = 0; j < 4; ++j) cur[j] = cur[j] + (f32x4){bflo(cd[j].x), bfhi(cd[j].x), bflo(cd[j].y), bfhi(cd[j].y)}; }
        const int b = KIND == 0 ? (m < MX ? (m >> 11) : 16) : (m >> 11);
        if (b != bcur) { bcur = b; const float* md = MODp + (size_t)b * MODW + (KIND == 0 ? 0 : 3072);
#pragma unroll
            for (int j = 0; j < 4; ++j) { ss[j] = ((const f32x4*)md)[lane + 64 * j]; cc[j] = ((const f32x4*)(md + 1024))[lane + 64 * j] + 1.0f; } }
        float s2 = 0.f;
#pragma unroll
        for (int j = 0; j < 4; ++j) s2 += (cur[j].x * cur[j].x + cur[j].y * cur[j].y) + (cur[j].z * cur[j].z + cur[j].w * cur[j].w);
        const float rstd = 1.0f / sqrtf(wave_sum(s2) * (1.f / D) + NORM_EPS);
        GAS v2u* o8 = (GAS v2u*)(O + (size_t)m * D) + lane;
#pragma unroll
        for (int j = 0; j < 4; ++j) { const f32x4 o = (cur[j] * rstd) * gg[j] * cc[j] + ss[j]; v2u w; w.x = pk2(o.x, o.y); w.y = pk2(o.z, o.w); o8[64 * j] = w; }
#pragma unroll
        for (int j = 0; j < 4; ++j) { cur[j] = nxt[j]; cd[j] = nd[j]; }
    }
}
typedef short bf16x8v __attribute__((ext_vector_type(8)));
__device__ __forceinline__ unsigned offb(unsigned row, unsigned ch) { return 256u * row + 16u * (ch ^ (((row & 3u) << 2) | ((row >> 2) & 3u))); }
__device__ __forceinline__ void tr_read8(unsigned a0, unsigned a1, v2u (&r0)[4], v2u (&r1)[4]) {
    asm volatile("ds_read_b64_tr_b16 %0, %8\n\tds_read_b64_tr_b16 %1, %8 offset:8192\n\tds_read_b64_tr_b16 %2, %8 offset:16384\n\tds_read_b64_tr_b16 %3, %8 offset:24576\n\t"
                 "ds_read_b64_tr_b16 %4, %9\n\tds_read_b64_tr_b16 %5, %9 offset:8192\n\tds_read_b64_tr_b16 %6, %9 offset:16384\n\tds_read_b64_tr_b16 %7, %9 offset:24576\n\ts_waitcnt lgkmcnt(0)"
                 : "=&v"(r0[0]), "=&v"(r0[1]), "=&v"(r0[2]), "=&v"(r0[3]), "=&v"(r1[0]), "=&v"(r1[1]), "=&v"(r1[2]), "=&v"(r1[3]) : "v"(a0), "v"(a1) : "memory");
}
__device__ __forceinline__ void tr_read4(unsigned a0, unsigned a1, v2u (&r0)[2], v2u (&r1)[2]) {
    asm volatile("ds_read_b64_tr_b16 %0, %4\n\tds_read_b64_tr_b16 %1, %4 offset:8192\n\tds_read_b64_tr_b16 %2, %5\n\tds_read_b64_tr_b16 %3, %5 offset:8192\n\ts_waitcnt lgkmcnt(0)"
                 : "=&v"(r0[0]), "=&v"(r0[1]), "=&v"(r1[0]), "=&v"(r1[1]) : "v"(a0), "v"(a1) : "memory");
}
__device__ __forceinline__ bf16x8v mk_b(v2u lo, v2u hi) { v4u w = {lo.x, lo.y, hi.x, hi.y}; return __builtin_bit_cast(bf16x8v, w); }
__device__ __forceinline__ void dft_pass_a(const Frame& F, const bf16* PXF, bf16* Y2) {
    constexpr int RSW = 272;
    const int w = F.wave, l = F.lane, lr = l & 15, g4 = l >> 4, q = (l & 15) >> 2, p = l & 3;
    const unsigned ldsb = (unsigned)(size_t)(F.lds + RING_OFF);
    LAS unsigned char* IN = F.lds + RING_OFF; LAS bf16* OUT = (LAS bf16*)(F.lds + RING_OFF + 32768); LAS unsigned char* RAW = F.lds + RING_OFF + 65536;
    bf16x8v afr[4], af0[2][4];
    { const int m = 16 * w + lr, ri = m >> 6, k2 = m & 63;
#pragma unroll
      for (int ks = 0; ks < 4; ++ks) { unsigned pk[4];
#pragma unroll
          for (int e2 = 0; e2 < 4; ++e2) { float vv[2];
#pragma unroll
              for (int h = 0; h < 2; ++h) { const int k = 32 * ks + 8 * g4 + 2 * e2 + h, rj = k >> 6, n2 = k & 63, idx = (k2 * n2) & 63; const float rev = (float)idx * (1.0f / 64.0f), sn = __builtin_amdgcn_sinf(rev), cs = __builtin_amdgcn_cosf(rev); vv[h] = (ri == rj) ? cs : (ri == 0 ? sn : -sn); }
              pk[e2] = pk2(vv[0], vv[1]); }
          afr[ks] = __builtin_bit_cast(bf16x8v, (v4u){pk[0], pk[1], pk[2], pk[3]}); } }
#pragma unroll
    for (int mt = 0; mt < 2; ++mt) { const int m = 32 * w + 16 * mt + lr, ri = m >> 7, k3 = m & 127;
#pragma unroll
      for (int ks = 0; ks < 4; ++ks) { unsigned pk[4];
#pragma unroll
          for (int e2 = 0; e2 < 4; ++e2) { float vv[2];
#pragma unroll
              for (int h = 0; h < 2; ++h) { const int n3 = 32 * ks + 8 * g4 + 2 * e2 + h, idx = (k3 * n3) & 127; const float rev = (float)idx * (1.0f / 128.0f), sn = __builtin_amdgcn_sinf(rev), cs = __builtin_amdgcn_cosf(rev); vv[h] = ri == 0 ? cs : -sn; }
              pk[e2] = pk2(vv[0], vv[1]); }
          af0[mt][ks] = __builtin_bit_cast(bf16x8v, (v4u){pk[0], pk[1], pk[2], pk[3]}); } }
    unsigned rb[2], mk[2];
#pragma unroll
    for (int t = 0; t < 2; ++t) { const unsigned row = 8 * g4 + 4 * t + q; rb[t] = ldsb + 256u * row + 8u * (p & 1); mk[t] = ((row & 3u) << 2) | ((row >> 2) & 3u); }
    const unsigned hb = p >> 1;
    v4u pre[2];
    { const int it = blockIdx.x; if (it < 2048) { const int jc = it & 3, n1 = (it >> 2) & 31, b = it >> 7;
#pragma unroll
        for (int i = 0; i < 2; ++i) { const int cid = F.tid + 512 * i, row = cid >> 4, ch = cid & 15; pre[i] = __builtin_nontemporal_load((const GAS v4u*)(PXF + (size_t)(b * 2048 + n1 * 64 + row) * 512 + jc * 128 + ch * 8)); } } }
    for (int it = blockIdx.x; it < 2048; it += F.G) {
        const int jc = it & 3, n1 = (it >> 2) & 31, b = it >> 7;
        __syncthreads();
#pragma unroll
        for (int i = 0; i < 2; ++i) { const int cid = F.tid + 512 * i, row = cid >> 4, ch = cid & 15; *(LAS v4u*)(RAW + row * RSW + ch * 16) = pre[i]; }
        { const int itn = it + F.G; if (itn < 2048) { const int jcn = itn & 3, n1n = (itn >> 2) & 31, bn = itn >> 7;
#pragma unroll
            for (int i = 0; i < 2; ++i) { const int cid = F.tid + 512 * i, row = cid >> 4, ch = cid & 15; pre[i] = __builtin_nontemporal_load((const GAS v4u*)(PXF + (size_t)(bn * 2048 + n1n * 64 + row) * 512 + jcn * 128 + ch * 8)); } } }
        __syncthreads();
#pragma unroll
        for (int nt = 0; nt < 4; ++nt) {
            bf16x8v bx[4];
#pragma unroll
            for (int ks = 0; ks < 4; ++ks) bx[ks] = *(const LAS bf16x8v*)(RAW + (16 * nt + lr) * RSW + (32 * ks + 8 * g4) * 2);
#pragma unroll
            for (int mt = 0; mt < 2; ++mt) { f32x4 acc = {0.f, 0.f, 0.f, 0.f};
#pragma unroll
                for (int ks = 0; ks < 4; ++ks) acc = __builtin_amdgcn_mfma_f32_16x16x32_bf16(af0[mt][ks], bx[ks], acc, 0, 0, 0);
                const int m0 = 32 * w + 16 * mt + 4 * g4, ri = m0 >> 7, c0 = m0 & 127, row = ri * 64 + 16 * nt + lr;
                *(LAS v2u*)(IN + offb(row, c0 >> 3) + 8 * ((c0 >> 2) & 1)) = (v2u){pk2(acc[0], acc[1]), pk2(acc[2], acc[3])}; }
        }
        __syncthreads();
#pragma unroll 2
        for (int c = 0; c < 8; ++c) {
            v2u r0[4], r1[4];
            tr_read8(rb[0] + 16u * ((2u * c + hb) ^ mk[0]), rb[1] + 16u * ((2u * c + hb) ^ mk[1]), r0, r1);
            f32x4 acc = {0.f, 0.f, 0.f, 0.f};
#pragma unroll
            for (int ks = 0; ks < 4; ++ks) acc = __builtin_amdgcn_mfma_f32_16x16x32_bf16(afr[ks], mk_b(r0[ks], r1[ks]), acc, 0, 0, 0);
#pragma unroll
            for (int r = 0; r < 4; ++r) OUT[(16 * w + 4 * g4 + r) * 128 + 16 * c + lr] = (bf16)f2bf(acc[r]);
        }
        __syncthreads();
#pragma unroll
        for (int i = 0; i < 4; ++i) { const int cid = F.tid + 512 * i, row = cid >> 4, ch = cid & 15, ri = row >> 6, k2 = row & 63;
            *(GAS v4u*)(Y2 + (size_t)(b * 2048 + n1 * 64 + k2) * 1024 + ri * 512 + jc * 128 + ch * 8) = *(const LAS v4u*)(OUT + row * 128 + ch * 8); }
    }
}
__device__ __forceinline__ void dft_pass_b(const Frame& F, const bf16* Y2, bf16* FX) {
    const int w = F.wave, l = F.lane, lr = l & 15, g4 = l >> 4, q = (l & 15) >> 2, p = l & 3;
    const int g = w >> 1, c0 = (w & 1) * 4;
    const unsigned ldsb = (unsigned)(size_t)(F.lds + RING_OFF) + 16384u * g;
    LAS unsigned char* IN = F.lds + RING_OFF; LAS bf16* OUT = (LAS bf16*)(F.lds + RING_OFF + 65536);
    bf16x8v afr[2][2];
#pragma unroll
    for (int mt = 0; mt < 2; ++mt) { const int k1 = 16 * mt + lr;
#pragma unroll
      for (int ks = 0; ks < 2; ++ks) { unsigned pk[4];
#pragma unroll
          for (int e2 = 0; e2 < 4; ++e2) { float vv[2];
#pragma unroll
              for (int h = 0; h < 2; ++h) { const int k = 32 * ks + 8 * g4 + 2 * e2 + h, ri = k >> 5, n1 = k & 31, idx = (k1 * n1) & 31; const float rev = (float)idx * (1.0f / 32.0f), sn = __builtin_amdgcn_sinf(rev), cs = __builtin_amdgcn_cosf(rev); vv[h] = (ri == 0 ? cs : sn); }
              pk[e2] = pk2(vv[0], vv[1]); }
          afr[mt][ks] = __builtin_bit_cast(bf16x8v, (v4u){pk[0], pk[1], pk[2], pk[3]}); } }
    unsigned rb[2], mk[2];
#pragma unroll
    for (int t = 0; t < 2; ++t) { const unsigned row = 8 * g4 + 4 * t + q; rb[t] = ldsb + 256u * row + 8u * (p & 1); mk[t] = ((row & 3u) << 2) | ((row >> 2) & 3u); }
    const unsigned hb = p >> 1;
    v4u pre[8];
    { const int it = blockIdx.x; if (it < 1024) { const int k2 = it & 63, b = it >> 6;
#pragma unroll
        for (int i = 0; i < 8; ++i) { const int cid = F.tid + 512 * i, row = cid >> 6, c64 = cid & 63; pre[i] = __builtin_nontemporal_load((const GAS v4u*)(Y2 + (size_t)(b * 2048 + (row & 31) * 64 + k2) * 1024 + (row >> 5) * 512 + c64 * 8)); } } }
    for (int it = blockIdx.x; it < 1024; it += F.G) {
        const int k2 = it & 63, b = it >> 6;
        __syncthreads();
#pragma unroll
        for (int i = 0; i < 8; ++i) { const int cid = F.tid + 512 * i, row = cid >> 6, c64 = cid & 63, gg = c64 >> 4, ch = c64 & 15; *(LAS v4u*)(IN + 16384 * gg + offb(row, ch)) = pre[i]; }
        { const int itn = it + F.G; if (itn < 1024) { const int k2n = itn & 63, bn = itn >> 6;
#pragma unroll
            for (int i = 0; i < 8; ++i) { const int cid = F.tid + 512 * i, row = cid >> 6, c64 = cid & 63; pre[i] = __builtin_nontemporal_load((const GAS v4u*)(Y2 + (size_t)(bn * 2048 + (row & 31) * 64 + k2n) * 1024 + (row >> 5) * 512 + c64 * 8)); } } }
        __syncthreads();
#pragma unroll
        for (int cc = 0; cc < 4; ++cc) { const int c = c0 + cc;
            v2u r0[2], r1[2];
            tr_read4(rb[0] + 16u * ((2u * c + hb) ^ mk[0]), rb[1] + 16u * ((2u * c + hb) ^ mk[1]), r0, r1);
#pragma unroll
            for (int mt = 0; mt < 2; ++mt) { f32x4 acc = {0.f, 0.f, 0.f, 0.f};
#pragma unroll
                for (int ks = 0; ks < 2; ++ks) acc = __builtin_amdgcn_mfma_f32_16x16x32_bf16(afr[mt][ks], mk_b(r0[ks], r1[ks]), acc, 0, 0, 0);
#pragma unroll
                for (int r = 0; r < 4; ++r) OUT[(16 * mt + 4 * g4 + r) * 512 + g * 128 + 16 * c + lr] = (bf16)f2bf(acc[r] * (1.0f / 512.0f)); }
        }
        __syncthreads();
#pragma unroll
        for (int i = 0; i < 4; ++i) { const int cid = F.tid + 512 * i, row = cid >> 6, ch = cid & 63;
            *(GAS v4u*)(FX + (size_t)(b * 2048 + row * 64 + k2) * 1024 + ch * 8) = *(const LAS v4u*)(OUT + row * 512 + ch * 8); }
    }
}
template <int CTRL> __device__ __forceinline__ float dpp_add(float x) { const int v = __builtin_amdgcn_update_dpp(__float_as_int(x), __float_as_int(x), CTRL, 0xF, 0xF, false); return x + __int_as_float(v); }
__device__ __forceinline__ void edge_rows(const Frame& F, const Args& a) {
    const float* EB = (const float*)(a.ws + WS_EB); bf16* RB = (bf16*)(a.ws + WS_R); bf16* KB = (bf16*)(a.ws + WS_K); bf16* VB = (bf16*)(a.ws + WS_V); bf16* AL = (bf16*)a.out;
    const int gw = F.vcu * NWAVES + F.wave, lane = F.lane;
    if (gw >= 8 * (MT / 256)) return;
    const int tile = gw >> 3, last = (gw >> 2) & 1, j = gw & 3, col = 512 * j + 8 * lane;
    if (col >= RCOLS) return;
    const bool lat = tile < MX / 256, s0 = lat ? (tile & 7) == 0 : true, s1 = lat ? (tile & 7) == 7 : true;
    const int m = tile * 256 + (last ? 255 : 0);
    const float* cp = EB + ((size_t)tile * 4 + (last ? 3 : 0)) * 2048 + col;
    const float* pp = (last ? EB + ((size_t)tile * 4 + 2) * 2048 : EB + ((size_t)(tile > 0 ? tile - 1 : 0) * 4 + 3) * 2048) + col;
    const float* np = (last ? EB + ((size_t)(tile + 1 < MT / 256 ? tile + 1 : tile) * 4 + 0) * 2048 : EB + ((size_t)tile * 4 + 1) * 2048) + col;
    const bool hp = last ? true : !s0, hn = last ? !s1 : true;
    const f32x4 z = {0.f, 0.f, 0.f, 0.f};
    f32x4 c4[2], p4[2], n4[2], mp4[2], mn4[2];
#pragma unroll
    for (int h = 0; h < 2; ++h) { c4[h] = ((const f32x4*)cp)[h]; p4[h] = hp ? ((const f32x4*)pp)[h] : z; n4[h] = hn ? ((const f32x4*)np)[h] : z; mp4[h] = ((const f32x4*)(a.in[I_MUP] + col))[h]; mn4[h] = ((const f32x4*)(a.in[I_MUN] + col))[h]; }
    float u[8];
#pragma unroll
    for (int e = 0; e < 8; ++e) { const float c = c4[e >> 2][e & 3]; u[e] = c + mp4[e >> 2][e & 3] * (p4[e >> 2][e & 3] - c) + mn4[e >> 2][e & 3] * (n4[e >> 2][e & 3] - c); }
    if (j == 0) *(GAS v4u*)(RB + (size_t)m * RW + 8 * lane) = pk8(u);
    else if (j == 1) *(GAS v4u*)(KB + (size_t)m * RW + 8 * lane) = pk8(u);
    else if (j == 2) *(GAS v4u*)(VB + (size_t)m * RW + 8 * lane) = pk8(u);
    else {
        if (lane < 16) {
#pragma unroll
            for (int e = 0; e < 8; ++e) u[e] = 2.0f * sigf(2.0f * u[e]) - 1.0f;
        } else if (lane >= 32) {
#pragma unroll
            for (int e = 0; e < 8; ++e) u[e] = sigf(u[e]);
        }
        *(GAS v4u*)(AL + (size_t)m * LK + 8 * lane) = pk8(u);
    }
}
__device__ __forceinline__ int scan_row(int s, int b, int dir) { if (s < CTXL) { const int t = dir ? (CTXL - 1 - s) : s; return MX + b * CTXL + t; } const int s2 = s - CTXL; const int t = dir ? (SEQ - 1 - s2) : s2; return b * SEQ + t; }
__device__ __forceinline__ float red16(float x) { x = dpp_add<0xB1>(x); x = dpp_add<0x4E>(x); x = dpp_add<0x141>(x); x = dpp_add<0x140>(x); return x; }
typedef float f32x2 __attribute__((ext_vector_type(2)));
__device__ __forceinline__ float fm_(float a, float b, float c) { float d; asm("v_fma_f32 %0, %1, %2, %3" : "=v"(d) : "v"(a), "v"(b), "v"(c)); return d; }
__device__ __forceinline__ float ml_(float a, float b) { float d; asm("v_mul_f32 %0, %1, %2" : "=v"(d) : "v"(a), "v"(b)); return d; }
__device__ __forceinline__ void red16x2(float& a, float& b) {
    asm volatile("s_nop 1\n\t"
        "v_add_f32_dpp %0, %0, %0 quad_perm:[1,0,3,2] row_mask:0xf bank_mask:0xf\n\tv_add_f32_dpp %1, %1, %1 quad_perm:[1,0,3,2] row_mask:0xf bank_mask:0xf\n\ts_nop 0\n\t"
        "v_add_f32_dpp %0, %0, %0 quad_perm:[2,3,0,1] row_mask:0xf bank_mask:0xf\n\tv_add_f32_dpp %1, %1, %1 quad_perm:[2,3,0,1] row_mask:0xf bank_mask:0xf\n\ts_nop 0\n\t"
        "v_add_f32_dpp %0, %0, %0 row_half_mirror row_mask:0xf bank_mask:0xf\n\tv_add_f32_dpp %1, %1, %1 row_half_mirror row_mask:0xf bank_mask:0xf\n\ts_nop 0\n\t"
        "v_add_f32_dpp %0, %0, %0 row_mirror row_mask:0xf bank_mask:0xf\n\tv_add_f32_dpp %1, %1, %1 row_mirror row_mask:0xf bank_mask:0xf\n\ts_nop 0"
        : "+v"(a), "+v"(b));
}
typedef short bf16x8v_ __attribute__((ext_vector_type(8)));
namespace sc {
constexpr int C = 16, NCHUNK = (CTXL + SEQ) / C, CTXCHUNK = CTXL / C, NSLOT = 5;
constexpr int RS = 144, ARR = 16 * RS, ES = 272;
constexpr int O_P = 0, O_RT = ARR, O_NPT = 2 * ARR, O_DPT = 3 * ARR, O_VT = 4 * ARR, O_DM = 5 * ARR, O_NR = O_DM + 512, O_DR = O_NR + 512, O_LINV = O_DR + 512, O_LC = O_LINV + 512, SLOT_B = O_LC + 256;
constexpr int PRIVP = NSLOT * SLOT_B, O_NN = 0, O_DD = ARR, O_EW = 2 * ARR, O_NF = O_EW + 16 * ES, PRIVP_B = O_NF + 1024;
constexpr int ZERO_OFF = PRIVP + 4 * PRIVP_B;
constexpr int FLAG_OFF = ZERO_OFF + 1024;
constexpr int KC_OFF = FLAG_OFF + 64;
static_assert(SLOT_B % 16 == 0 && PRIVP_B % 16 == 0 && KC_OFF + 1024 <= RING_BYTES, "scan LDS map");
}
__device__ __forceinline__ unsigned cvtpk(float lo, float hi) { unsigned r; asm volatile("v_cvt_pk_bf16_f32 %0, %1, %2" : "=v"(r) : "v"(lo), "v"(hi)); return r; }
__device__ __forceinline__ float bf1(unsigned short x) { return __uint_as_float((unsigned)x << 16); }
__device__ __forceinline__ unsigned short tobf(float f) { return (unsigned short)f2bf(f); }
__device__ __forceinline__ unsigned short tobf1(float f) { return (unsigned short)cvtpk(f, f); }
__device__ __forceinline__ bf16x8v_ tr_frag1(unsigned a) { v2u r0, r1;
    asm volatile("ds_read_b64_tr_b16 %0, %2\n\tds_read_b64_tr_b16 %1, %2 offset:512\n\ts_waitcnt lgkmcnt(0)" : "=&v"(r0), "=&v"(r1) : "v"(a) : "memory"); return mk_b(r0, r1); }
__device__ __forceinline__ void tr_frag4(unsigned a, bf16x8v_ (&f)[4]) { v2u r[8];
    asm volatile("ds_read_b64_tr_b16 %0, %8\n\tds_read_b64_tr_b16 %1, %8 offset:512\n\tds_read_b64_tr_b16 %2, %8 offset:32\n\tds_read_b64_tr_b16 %3, %8 offset:544\n\t"
                 "ds_read_b64_tr_b16 %4, %8 offset:64\n\tds_read_b64_tr_b16 %5, %8 offset:576\n\tds_read_b64_tr_b16 %6, %8 offset:96\n\tds_read_b64_tr_b16 %7, %8 offset:608\n\ts_waitcnt lgkmcnt(0)"
                 : "=&v"(r[0]), "=&v"(r[1]), "=&v"(r[2]), "=&v"(r[3]), "=&v"(r[4]), "=&v"(r[5]), "=&v"(r[6]), "=&v"(r[7]) : "v"(a) : "memory");
    f[0] = mk_b(r[0], r[1]); f[1] = mk_b(r[2], r[3]); f[2] = mk_b(r[4], r[5]); f[3] = mk_b(r[6], r[7]); }
__device__ __forceinline__ void scan_phase(const Frame& F, const Args& a) {
    using namespace sc;
    const bf16* RB = (const bf16*)(a.ws + WS_R); const bf16* KB = (const bf16*)(a.ws + WS_K); const bf16* VB = (const bf16*)(a.ws + WS_V); const bf16* LP = (const bf16*)(a.ws + WS_LP);
    LAS unsigned char* L = F.lds + RING_OFF;
    const int l = F.lane, lr = l & 15, g = l >> 4;
    for (int chain = blockIdx.x; chain < 256; chain += F.G) {
        const int b = chain >> 4, h = (chain >> 1) & 7, dir = chain & 1;
        bf16* Yg = (bf16*)a.out + (dir ? (size_t)MX * RW : 0);
        float* SBTg = (float*)(a.ws + WS_SBT);
        if (F.tid < 256 + 16) ((LAS unsigned*)(L + ZERO_OFF))[F.tid] = 0u;
        if (F.tid >= 64 && F.tid < 320) { const int i_ = F.tid - 64, k_ = h * 64 + (i_ & 63);
            ((LAS float*)(L + KC_OFF))[i_] = i_ < 64 ? a.in[I_KK][k_] : i_ < 128 ? a.in[I_KA][k_] : i_ < 192 ? a.in[I_RK][k_] * a.in[I_KA][k_] : (dir == 0 ? a.in[I_RK][k_] * (2.0f - 2.0f * a.in[I_KA][k_]) : 0.f); }
        __syncthreads();
        if (F.wave >= 4) {
            const int p = F.wave - 4;
            LAS unsigned char* PV = L + PRIVP + p * PRIVP_B;
            const int t1 = l >> 2, kq = l & 3, hc1 = h * 64 + 16 * kq;
            v4u raw[10];
#define SC_PREFETCH(cc) do { const int m_ = scan_row((cc) * C + t1, b, dir); const GAS v4u* q0 = (const GAS v4u*)(RB + (size_t)m_ * RW + hc1); const GAS v4u* q1 = (const GAS v4u*)(KB + (size_t)m_ * RW + hc1); const GAS v4u* q2 = (const GAS v4u*)(VB + (size_t)m_ * RW + hc1); \
                const GAS v4u* q3 = (const GAS v4u*)(LP + (size_t)m_ * LN + dir * 512 + hc1); const GAS v4u* q4 = (const GAS v4u*)(LP + (size_t)m_ * LN + 1024 + dir * 512 + hc1); \
                raw[0] = __builtin_nontemporal_load(q0); raw[1] = __builtin_nontemporal_load(q0 + 1); raw[2] = __builtin_nontemporal_load(q1); raw[3] = __builtin_nontemporal_load(q1 + 1); raw[4] = __builtin_nontemporal_load(q2); raw[5] = __builtin_nontemporal_load(q2 + 1); \
                raw[6] = __builtin_nontemporal_load(q3); raw[7] = __builtin_nontemporal_load(q3 + 1); raw[8] = __builtin_nontemporal_load(q4); raw[9] = __builtin_nontemporal_load(q4 + 1); } while (0)
            if (p < NCHUNK) SC_PREFETCH(p);
            volatile LAS unsigned* RDY = (volatile LAS unsigned*)(L + FLAG_OFF); volatile LAS unsigned* DONE = RDY + NSLOT;
            for (int c = p; c < NCHUNK; c += 4) {
                if (c >= NSLOT) { unsigned spins = 0; while (*DONE < 4u * (unsigned)(c - NSLOT + 1)) { __builtin_amdgcn_s_sleep(2); if (++spins > (1u << 22)) break; } asm volatile("" ::: "memory"); }
#pragma unroll 1
                for (int f = 1; f <= 3; ++f) {
                {
                    LAS unsigned char* SL = L + (c % NSLOT) * SLOT_B;
                    if (f == 1) {
                        float r16[16], k16[16], e16[16], a16[16];
                        { float t8[8]; unpk8(raw[0], t8); for (int e = 0; e < 8; ++e) r16[e] = t8[e]; unpk8(raw[1], t8); for (int e = 0; e < 8; ++e) r16[8 + e] = t8[e];
                          unpk8(raw[2], t8); for (int e = 0; e < 8; ++e) k16[e] = t8[e]; unpk8(raw[3], t8); for (int e = 0; e < 8; ++e) k16[8 + e] = t8[e];
                          unpk8(raw[6], t8); for (int e = 0; e < 8; ++e) e16[e] = t8[e]; unpk8(raw[7], t8); for (int e = 0; e < 8; ++e) e16[8 + e] = t8[e];
                          unpk8(raw[8], t8); for (int e = 0; e < 8; ++e) a16[e] = t8[e]; unpk8(raw[9], t8); for (int e = 0; e < 8; ++e) a16[8 + e] = t8[e]; }
                        const int ro = t1 * RS + kq * 32;
                        *(LAS v4u*)(SL + O_VT + ro) = raw[4]; *(LAS v4u*)(SL + O_VT + ro + 16) = raw[5];
#pragma unroll
                        for (int e4 = 0; e4 < 4; ++e4) *(LAS f32x4*)(PV + O_EW + t1 * ES + kq * 64 + e4 * 16) = (f32x4){e16[4 * e4], e16[4 * e4 + 1], e16[4 * e4 + 2], e16[4 * e4 + 3]};
                        if (c + 4 < NCHUNK) SC_PREFETCH(c + 4);
                        float kkc[16], kac[16];
#pragma unroll
                        for (int e4 = 0; e4 < 4; ++e4) { const f32x4 q0 = *(const LAS f32x4*)(L + KC_OFF + (16 * kq + 4 * e4) * 4), q1 = *(const LAS f32x4*)(L + KC_OFF + 256 + (16 * kq + 4 * e4) * 4);
#pragma unroll
                            for (int e = 0; e < 4; ++e) { kkc[4 * e4 + e] = q0[e]; kac[4 * e4 + e] = q1[e]; } }
                        float kk16[16], nb16[16], kd16[16]; float ss = 0.f;
#pragma unroll
                        for (int e = 0; e < 16; ++e) { kk16[e] = k16[e] * kkc[e]; ss += kk16[e] * kk16[e]; }
                        ss = dpp_add<0xB1>(ss); ss = dpp_add<0x4E>(ss);
                        const float rn = 1.0f / sqrtf(fmaxf(ss, 1e-24f));
#pragma unroll
                        for (int e = 0; e < 16; ++e) { kk16[e] *= rn; nb16[e] = -kk16[e] * a16[e]; }
                        { float sb = 0.f;
#pragma unroll
                          for (int e4 = 0; e4 < 4; ++e4) { const f32x4 q2 = *(const LAS f32x4*)(L + KC_OFF + 512 + (16 * kq + 4 * e4) * 4), q3 = *(const LAS f32x4*)(L + KC_OFF + 768 + (16 * kq + 4 * e4) * 4);
#pragma unroll
                              for (int e = 0; e < 4; ++e) { const int x = 4 * e4 + e; const float ka_ = k16[x] * a16[x]; kd16[x] = k16[x] + (ka_ - k16[x]) * kac[x]; sb += (r16[x] * k16[x]) * (q2[e] * a16[x] + q3[e]); } }
                          sb = dpp_add<0xB1>(sb); sb = dpp_add<0x4E>(sb);
                          if (c >= CTXCHUNK && kq == 0) SBTg[((size_t)scan_row(c * C + t1, b, dir) * 8 + h) * 4 + 1 + dir] = sb; }
                        asm volatile("s_waitcnt lgkmcnt(0)" ::: "memory");
                        {
                          LAS float* Ep = (LAS float*)(PV + O_EW) + l; float cs = 0.f;
#pragma unroll
                          for (int t = 0; t < 16; ++t) { cs += Ep[t * (ES / 4)]; Ep[t * (ES / 4)] = cs; }
                          ((LAS float*)(SL + O_LC))[l] = __expf(cs); }
                        asm volatile("s_waitcnt lgkmcnt(0)" ::: "memory");
                        unsigned pP[8], pR[8], pN[8], pD[8], pNP[8], pDP[8];
#pragma unroll
                        for (int e4 = 0; e4 < 4; ++e4) { const f32x4 cs4 = *(const LAS f32x4*)(PV + O_EW + t1 * ES + kq * 64 + e4 * 16);
                            const f32x4 cm4 = *(const LAS f32x4*)(L + (t1 > 0 ? PRIVP + p * PRIVP_B + O_EW + (t1 - 1) * ES + kq * 64 + e4 * 16 : ZERO_OFF)); const f32x4 lc4 = *(const LAS f32x4*)(SL + O_LC + kq * 64 + e4 * 16);
                            float vP[4], vR[4], vN[4], vD[4], vNP[4], vDP[4];
#pragma unroll
                            for (int e = 0; e < 4; ++e) { const int x = 4 * e4 + e; const float pc = __expf(cs4[e]), pm = __expf(cm4[e]), ic = __builtin_amdgcn_rcpf(pc);
                                vP[e] = kk16[x] * pm; vR[e] = r16[x] * pc; vN[e] = nb16[x] * ic; vD[e] = kd16[x] * ic; vNP[e] = vN[e] * lc4[e]; vDP[e] = vD[e] * lc4[e]; }
                            pP[2 * e4] = cvtpk(vP[0], vP[1]); pP[2 * e4 + 1] = cvtpk(vP[2], vP[3]); pR[2 * e4] = cvtpk(vR[0], vR[1]); pR[2 * e4 + 1] = cvtpk(vR[2], vR[3]);
                            pN[2 * e4] = cvtpk(vN[0], vN[1]); pN[2 * e4 + 1] = cvtpk(vN[2], vN[3]); pD[2 * e4] = cvtpk(vD[0], vD[1]); pD[2 * e4 + 1] = cvtpk(vD[2], vD[3]);
                            pNP[2 * e4] = cvtpk(vNP[0], vNP[1]); pNP[2 * e4 + 1] = cvtpk(vNP[2], vNP[3]); pDP[2 * e4] = cvtpk(vDP[0], vDP[1]); pDP[2 * e4 + 1] = cvtpk(vDP[2], vDP[3]); }
                        *(LAS v4u*)(SL + O_P + ro) = (v4u){pP[0], pP[1], pP[2], pP[3]}; *(LAS v4u*)(SL + O_P + ro + 16) = (v4u){pP[4], pP[5], pP[6], pP[7]};
                        *(LAS v4u*)(SL + O_RT + ro) = (v4u){pR[0], pR[1], pR[2], pR[3]}; *(LAS v4u*)(SL + O_RT + ro + 16) = (v4u){pR[4], pR[5], pR[6], pR[7]};
                        *(LAS v4u*)(PV + O_NN + ro) = (v4u){pN[0], pN[1], pN[2], pN[3]}; *(LAS v4u*)(PV + O_NN + ro + 16) = (v4u){pN[4], pN[5], pN[6], pN[7]};
                        *(LAS v4u*)(PV + O_DD + ro) = (v4u){pD[0], pD[1], pD[2], pD[3]}; *(LAS v4u*)(PV + O_DD + ro + 16) = (v4u){pD[4], pD[5], pD[6], pD[7]};
                        *(LAS v4u*)(SL + O_NPT + ro) = (v4u){pNP[0], pNP[1], pNP[2], pNP[3]}; *(LAS v4u*)(SL + O_NPT + ro + 16) = (v4u){pNP[4], pNP[5], pNP[6], pNP[7]};
                        *(LAS v4u*)(SL + O_DPT + ro) = (v4u){pDP[0], pDP[1], pDP[2], pDP[3]}; *(LAS v4u*)(SL + O_DPT + ro + 16) = (v4u){pDP[4], pDP[5], pDP[6], pDP[7]};
                    } else if (f == 2) {
                        bf16x8v_ ap[2], ar[2], bn[2], bd[2];
#pragma unroll
                        for (int ks = 0; ks < 2; ++ks) { const int o = lr * RS + ks * 64 + g * 16; ap[ks] = *(const LAS bf16x8v_*)(SL + O_P + o); ar[ks] = *(const LAS bf16x8v_*)(SL + O_RT + o); bn[ks] = *(const LAS bf16x8v_*)(PV + O_NN + o); bd[ks] = *(const LAS bf16x8v_*)(PV + O_DD + o); }
                        f32x4 cN = {0.f, 0.f, 0.f, 0.f}, cDm = cN, cNr = cN, cDr = cN;
#pragma unroll
                        for (int ks = 0; ks < 2; ++ks) { cN = __builtin_amdgcn_mfma_f32_16x16x32_bf16(ap[ks], bn[ks], cN, 0, 0, 0); cDm = __builtin_amdgcn_mfma_f32_16x16x32_bf16(ap[ks], bd[ks], cDm, 0, 0, 0);
                            cNr = __builtin_amdgcn_mfma_f32_16x16x32_bf16(ar[ks], bn[ks], cNr, 0, 0, 0); cDr = __builtin_amdgcn_mfma_f32_16x16x32_bf16(ar[ks], bd[ks], cDr, 0, 0, 0); }
                        *(LAS f32x4*)(PV + O_NF + (lr * 16 + 4 * g) * 4) = (f32x4){lr < 4 * g ? cN[0] : 0.f, lr < 4 * g + 1 ? cN[1] : 0.f, lr < 4 * g + 2 ? cN[2] : 0.f, lr < 4 * g + 3 ? cN[3] : 0.f};
#pragma unroll
                        for (int r = 0; r < 4; ++r) { const int t = 4 * g + r, j = lr; const bool lo = j < t, le = j <= t;
                            ((LAS unsigned short*)(SL + O_DM))[t * 16 + j] = tobf1(lo ? cDm[r] : 0.f); ((LAS unsigned short*)(SL + O_NR))[t * 16 + j] = tobf1(le ? cNr[r] : 0.f); ((LAS unsigned short*)(SL + O_DR))[t * 16 + j] = tobf1(le ? cDr[r] : 0.f); }
                    } else {
                        const LAS f32x4* NFTp = (const LAS f32x4*)(PV + O_NF); float acc[16];
#pragma unroll
                        for (int t = 0; t < 16; ++t) acc[t] = (t == lr) ? 1.0f : 0.0f;
                        f32x4 col[4];
#pragma unroll
                        for (int q4 = 0; q4 < 4; ++q4) col[q4] = NFTp[q4];
#pragma unroll
                        for (int j = 0; j < 16; ++j) { const float Lj = acc[j]; ((LAS unsigned short*)(SL + O_LINV))[j * 16 + lr] = tobf1(Lj);
                            f32x4 nxt[4];
                            if (j + 1 < 16) {
#pragma unroll
                                for (int q4 = 0; q4 < 4; ++q4) nxt[q4] = NFTp[(j + 1) * 4 + q4]; }
#pragma unroll
                            for (int t = j + 1; t < 16; ++t) acc[t] += col[t >> 2][t & 3] * Lj;
                            if (j + 1 < 16) {
#pragma unroll
                                for (int q4 = 0; q4 < 4; ++q4) col[q4] = nxt[q4]; } }
                    }
                }
                asm volatile("s_waitcnt lgkmcnt(0)" ::: "memory");
                }
                if (l == 0) RDY[c % NSLOT] = (unsigned)(c + 1);
            }
#undef SC_PREFETCH
        } else {
            const int w = F.wave, irow = 16 * w + lr, q = lr >> 2, pp = l & 3;
            f32x4 S[4];
#pragma unroll
            for (int kt = 0; kt < 4; ++kt) S[kt] = (f32x4){0.f, 0.f, 0.f, 0.f};
            volatile LAS unsigned* RDY = (volatile LAS unsigned*)(L + FLAG_OFF); LAS unsigned* DONE = (LAS unsigned*)(L + FLAG_OFF) + NSLOT;
            const unsigned ldsb_ = (unsigned)(size_t)L, lanetr_ = (unsigned)((4 * g + q) * RS + 8 * pp);
            for (int c = 0; c < NCHUNK; ++c) {
                { unsigned spins = 0; while (RDY[c % NSLOT] != (unsigned)(c + 1)) { __builtin_amdgcn_s_sleep(1); if (++spins > (1u << 22)) break; } asm volatile("" ::: "memory"); }
                {
                    LAS unsigned char* SL = L + (c % NSLOT) * SLOT_B; const unsigned slb_ = ldsb_ + (unsigned)((c % NSLOT) * SLOT_B);
                    asm volatile("s_nop 7" : "+v"(S[0]), "+v"(S[1]), "+v"(S[2]), "+v"(S[3]));
                    bf16x8v_ bS[2], aP[2], aR[2];
#pragma unroll
                    for (int ks = 0; ks < 2; ++ks) { bS[ks] = __builtin_bit_cast(bf16x8v_, (v4u){cvtpk(S[2 * ks][0], S[2 * ks][1]), cvtpk(S[2 * ks][2], S[2 * ks][3]), cvtpk(S[2 * ks + 1][0], S[2 * ks + 1][1]), cvtpk(S[2 * ks + 1][2], S[2 * ks + 1][3])});
                        const int o = lr * RS + (32 * ks + 4 * g) * 2;
                        aP[ks] = mk_b(*(const LAS v2u*)(SL + O_P + o), *(const LAS v2u*)(SL + O_P + o + 32)); aR[ks] = mk_b(*(const LAS v2u*)(SL + O_RT + o), *(const LAS v2u*)(SL + O_RT + o + 32)); }
                    const v2u z2 = {0u, 0u}; const int o16 = lr * 32 + g * 8;
                    const bf16x8v_ aDm = mk_b(*(const LAS v2u*)(SL + O_DM + o16), z2), aNr = mk_b(*(const LAS v2u*)(SL + O_NR + o16), z2), aDr = mk_b(*(const LAS v2u*)(SL + O_DR + o16), z2), aLi = mk_b(*(const LAS v2u*)(SL + O_LINV + o16), z2);
                    v2u trv, trn[4], trd[4];
                    asm volatile("ds_read_b64_tr_b16 %0, %9\n\t"
                                 "ds_read_b64_tr_b16 %1, %10\n\tds_read_b64_tr_b16 %2, %10 offset:32\n\tds_read_b64_tr_b16 %3, %10 offset:64\n\tds_read_b64_tr_b16 %4, %10 offset:96\n\t"
                                 "ds_read_b64_tr_b16 %5, %11\n\tds_read_b64_tr_b16 %6, %11 offset:32\n\tds_read_b64_tr_b16 %7, %11 offset:64\n\tds_read_b64_tr_b16 %8, %11 offset:96\n\ts_waitcnt lgkmcnt(0)"
                                 : "=&v"(trv), "=&v"(trn[0]), "=&v"(trn[1]), "=&v"(trn[2]), "=&v"(trn[3]), "=&v"(trd[0]), "=&v"(trd[1]), "=&v"(trd[2]), "=&v"(trd[3])
                                 : "v"(slb_ + (unsigned)(O_VT + 32 * w) + lanetr_), "v"(slb_ + (unsigned)O_NPT + lanetr_), "v"(slb_ + (unsigned)O_DPT + lanetr_) : "memory");
                    const bf16x8v_ bV = mk_b(trv, z2);
                    f32x4 W = {0.f, 0.f, 0.f, 0.f};
                    W = __builtin_amdgcn_mfma_f32_16x16x32_bf16(aP[0], bS[0], W, 0, 0, 0); W = __builtin_amdgcn_mfma_f32_16x16x32_bf16(aP[1], bS[1], W, 0, 0, 0); W = __builtin_amdgcn_mfma_f32_16x16x32_bf16(aDm, bV, W, 0, 0, 0);
                    asm volatile("s_nop 7\n\ts_nop 7" : "+v"(W));
                    const bf16x8v_ bW = __builtin_bit_cast(bf16x8v_, (v4u){cvtpk(W[0], W[1]), cvtpk(W[2], W[3]), 0u, 0u});
                    f32x4 Z = {0.f, 0.f, 0.f, 0.f};
                    Z = __builtin_amdgcn_mfma_f32_16x16x32_bf16(aLi, bW, Z, 0, 0, 0);
                    asm volatile("s_nop 7\n\ts_nop 7" : "+v"(Z));
                    const bf16x8v_ bZ = __builtin_bit_cast(bf16x8v_, (v4u){cvtpk(Z[0], Z[1]), cvtpk(Z[2], Z[3]), 0u, 0u});
                    if (c >= CTXCHUNK) {
                        f32x4 Y = {0.f, 0.f, 0.f, 0.f};
                        Y = __builtin_amdgcn_mfma_f32_16x16x32_bf16(aR[0], bS[0], Y, 0, 0, 0); Y = __builtin_amdgcn_mfma_f32_16x16x32_bf16(aR[1], bS[1], Y, 0, 0, 0);
                        Y = __builtin_amdgcn_mfma_f32_16x16x32_bf16(aNr, bZ, Y, 0, 0, 0); Y = __builtin_amdgcn_mfma_f32_16x16x32_bf16(aDr, bV, Y, 0, 0, 0);
#pragma unroll
                        for (int r = 0; r < 4; ++r) { const int m = scan_row(c * C + 4 * g + r, b, dir); Yg[(size_t)m * RW + h * 64 + irow] = tobf(Y[r]); }
                    }
#pragma unroll
                    for (int kt = 0; kt < 4; ++kt) { const f32x4 lc = *(const LAS f32x4*)(SL + O_LC + (16 * kt + 4 * g) * 4);
                        f32x4 sv = S[kt] * lc; sv = __builtin_amdgcn_mfma_f32_16x16x32_bf16(mk_b(trn[kt], z2), bZ, sv, 0, 0, 0); sv = __builtin_amdgcn_mfma_f32_16x16x32_bf16(mk_b(trd[kt], z2), bV, sv, 0, 0, 0); S[kt] = sv; }
                }
                asm volatile("s_waitcnt lgkmcnt(0)" ::: "memory");
                if (l == 0) __hip_atomic_fetch_add(DONE, 1u, __ATOMIC_RELAXED, __HIP_MEMORY_SCOPE_WORKGROUP);
            }
        }
        __syncthreads();
    }
}
__device__ __forceinline__ void rwkv_out_phase(const Frame& F, const Args& a) {
    const bf16* RB = (const bf16*)(a.ws + WS_R); const bf16* KB = (const bf16*)(a.ws + WS_K); const bf16* VB = (const bf16*)(a.ws + WS_V); const bf16* LP = (const bf16*)(a.ws + WS_LP); bf16* O = (bf16*)(a.ws + WS_FXO) + 512;
    const bf16* YF = (const bf16*)a.out; const bf16* YBk = (const bf16*)a.out + (size_t)MX * RW;
    const int gw = F.vcu * NWAVES + F.wave, NGW = F.G * NWAVES, col = 8 * F.lane;
    float lg[8], lb[8];
#pragma unroll
    for (int e = 0; e < 8; ++e) { lg[e] = a.in[I_LNG][col + e]; lb[e] = a.in[I_LNB][col + e]; }
    const float* SBT = (const float*)(a.ws + WS_SBT);
    for (int m = gw; m < MX; m += NGW) {
        float y[8], v[8], gg[8], o[8];
        { float yb8[8]; unpk8(__builtin_nontemporal_load((const GAS v4u*)(YF + (size_t)m * RW + col)), y); unpk8(__builtin_nontemporal_load((const GAS v4u*)(YBk + (size_t)m * RW + col)), yb8);
#pragma unroll
          for (int e = 0; e < 8; ++e) y[e] += yb8[e]; }
        unpk8(__builtin_nontemporal_load((const GAS v4u*)(VB + (size_t)m * RW + col)), v); unpk8(__builtin_nontemporal_load((const GAS v4u*)(LP + (size_t)m * LN + 2048 + col)), gg);
        const f32x4 sb4 = __builtin_nontemporal_load((const GAS f32x4*)(SBT + ((size_t)m * 8 + (F.lane >> 3)) * 4));
        float s = 0.f;
#pragma unroll
        for (int e = 0; e < 8; ++e) s += y[e];
        const float mean = red8(s) * (1.0f / 64.0f);
        float qv = 0.f; const float bs = sb4[1] + sb4[2];
#pragma unroll
        for (int e = 0; e < 8; ++e) { y[e] -= mean; qv += y[e] * y[e]; }
        const float rstd = 1.0f / sqrtf(red8(qv) * (1.0f / 64.0f) + GN_EPS);
#pragma unroll
        for (int e = 0; e < 8; ++e) o[e] = ((y[e] * rstd * lg[e] + lb[e]) + bs * v[e]) * gg[e];
        *(GAS v4u*)(O + (size_t)m * 1024 + col) = pk8(o);
    }
}
__global__ void __launch_bounds__(NWAVES * 64, 2) mk_fwd(Args args) {
    extern __shared__ __attribute__((aligned(16))) unsigned char lds[];
    Frame F;
    F.lds = (LAS unsigned char*)lds;
    F.MISC = (volatile LAS unsigned*)(F.lds + MISC_OFF);
    F.tid = threadIdx.x; F.lane = F.tid & 63; F.wave = __builtin_amdgcn_readfirstlane(F.tid >> 6);
    F.G = gridDim.x; { const int bx = blockIdx.x; F.vcu = (F.G % 8 == 0) ? (bx % 8) * (F.G / 8) + bx / 8 : bx; }
    F.ctl = (gu32*)(args.ws + WS_CTL);
    for (int u = F.tid; u < (LDS_BYTES - LDSCTL_OFF) / 4; u += NWAVES * 64) ((LAS unsigned*)(F.lds + LDSCTL_OFF))[u] = 0u;
    __syncthreads();
    XcdBarrier bar; bar.bar = (unsigned*)(F.ctl + CW_BAR); bar.x = 0; bar.st = nullptr;
    if (N_LAUNCHES == 1) bar = xcd_barrier_post((unsigned*)(F.ctl + CW_BAR), F.MISC + 8);
    if (N_LAUNCHES == 1 && threadIdx.x == 0 && (bar.x != (blockIdx.x & 7u) || (gridDim.x & 7u) != 0u)) (void)xb_add((unsigned*)(F.ctl + CW_BADMAP), 1u);
#define GRID_BAR() do { if (N_LAUNCHES == 1) xcd_barrier(bar); } while (0)
    const int lo = args.ph_lo, hi = args.ph_hi;
#define IN(k) (refresh_tid(F), lo <= (k) && (k) < hi)
#define INP(k) (lo <= (k) && (k) < hi)
#define SEAM(k) do { if (INP(k) && INP((k) + 1)) GRID_BAR(); } while (0)
#define SEAM_L(k) do { if (INP(k) && INP((k) + 1)) { if (N_LAUNCHES == 1) { if (F.MISC[10]) xcd_barrier_local(bar); else xcd_barrier(bar); } } } while (0)
#define WSP(T, off) ((T*)(args.ws + (off)))
#define MOD WSP(float, WS_MOD)
#define Win_t WSP(bf16, WS_WIN)
#define Wlora_t WSP(bf16, WS_WLORA)
#define Wupf_t WSP(bf16, WS_WUPF)
#define Wupr_t WSP(bf16, WS_WUPR)
#define Wout_t WSP(bf16, WS_WOUT)
#define Wgu_t WSP(bf16, WS_WGU)
#define Wdown_t WSP(bf16, WS_WDOWN)
#define HX WSP(bf16, WS_HX)
#define PXR WSP(bf16, WS_PXR)
#define Z3 WSP(bf16, WS_Z3)
#define GF WSP(bf16, WS_GF)
#define GR WSP(bf16, WS_GR)
#define Y2 ((bf16*)((unsigned char*)args.out + 32 * MiB))
#define FX WSP(bf16, WS_FXO)
#define AL ((bf16*)args.out)
#define LP WSP(bf16, WS_LP)
#define MB WSP(bf16, WS_MB)
#define HX2 WSP(bf16, WS_HX2)
#define ACT WSP(bf16, WS_ACT)
    const int gw = F.vcu * NWAVES + F.wave, NGW = F.G * NWAVES;
    using EpiIn1 = pg8::EpiIn<WS_Z3, WS_GF, WS_GR, WS_R, WS_EB>;

    for (int rep_ = 0; rep_ < 1 + ((MK_REPEAT >> 0) & 1); ++rep_)
    if (IN(0)) { p0_weights(F, args); } SEAM(0);
    if (N_LAUNCHES == 1) {
        if (threadIdx.x == 0) F.MISC[10] = (xb_ld((unsigned*)(F.ctl + CW_BADMAP)) == 0u) ? 1u : 0u;
        __syncthreads(); }
    for (int rep_ = 0; rep_ < 1 + ((MK_REPEAT >> 1) & 1); ++rep_)
    if (IN(1)) {
        { constexpr int RPW = (MT + 2047) / 2048; const int rpw = (MT + NGW - 1) / NGW; (void)RPW; const int m0 = gw * rpw, m1 = (m0 + rpw < MT) ? m0 + rpw : MT; norm_mod_rows<0>(args, m0, m1, args.in[I_N1G], HX, F.lane); }
    } SEAM(1);
    for (int rep_ = 0; rep_ < 1 + ((MK_REPEAT >> 2) & 1); ++rep_)
    if (IN(2)) {
        { pg8::Gemm g{HX, Win_t, MX, NIN, D}; pg8::StaticOrder S; S.init(MX, NIN, F.G, (int)blockIdx.x); EpiIn1 E{args.ws, (bf16*)args.out, args.in[I_MUP], args.in[I_MUN], (LAS float*)(F.lds + XB_OFF), 0};
          pg8::gemm_phase<EpiIn1, pg8::StaticOrder, true, true>(F.lds + RING_OFF, g, S, E); }
        { pg8::Gemm g{HX + (size_t)MX * D, Win_t, MC, RPAD, D}; pg8::StaticOrder S; S.init(MC, RPAD, F.G, (int)blockIdx.x); EpiIn1 E{args.ws, (bf16*)args.out, args.in[I_MUP], args.in[I_MUN], (LAS float*)(F.lds + XB_OFF), MX};
          pg8::gemm_phase<EpiIn1, pg8::StaticOrder, true, true>(F.lds + RING_OFF, g, S, E); }
    } SEAM(2);
    for (int rep_ = 0; rep_ < 1 + ((MK_REPEAT >> 3) & 1); ++rep_)
    if (IN(3)) { edge_rows(F, args); dft_pass_a(F, Z3, Y2); } SEAM(3);
    for (int rep_ = 0; rep_ < 1 + ((MK_REPEAT >> 7) & 1); ++rep_)
    if (IN(7)) { dft_pass_b(F, Y2, FX); __syncthreads();
        pg8::Gemm g{AL, Wlora_t, MT, LN, LK}; pg8::StaticOrder S; S.init(MT, LN, F.G, (int)blockIdx.x); pg8::EpiLora E{LP, WSP(const float, WS_LB)};
        pg8::gemm_phase<pg8::EpiLora, pg8::StaticOrder, true, true>(F.lds + RING_OFF, g, S, E); } SEAM(7);
    for (int rep_ = 0; rep_ < 1 + ((MK_REPEAT >> 8) & 1); ++rep_)
    if (IN(8)) { scan_phase(F, args); } SEAM(8);
    for (int rep_ = 0; rep_ < 1 + ((MK_REPEAT >> 9) & 1); ++rep_)
    if (IN(9)) { rwkv_out_phase(F, args); } SEAM(9);
    for (int rep_ = 0; rep_ < 1 + ((MK_REPEAT >> 10) & 1); ++rep_)
    if (IN(10)) { pg8::Gemm g{FX, Wupf_t, MX, D, D}; pg8::StaticOrder S; S.init(MX, D, F.G, (int)blockIdx.x); pg8::EpiMerge2 E{MB, GF, GR};
        pg8::gemm_phase<pg8::EpiMerge2, pg8::StaticOrder, true, true>(F.lds + RING_OFF, g, S, E); } SEAM_L(10);
    for (int rep_ = 0; rep_ < 1 + ((MK_REPEAT >> 11) & 1); ++rep_)
    if (IN(11)) { pg8::Gemm g{MB, Wout_t, MX, D, D}; pg8::StaticOrder S; S.init(MX, D, F.G, (int)blockIdx.x); pg8::EpiDelta E{WSP(bf16, WS_D1), MOD + 2048};
        pg8::gemm_phase<pg8::EpiDelta, pg8::StaticOrder, true, true>(F.lds + RING_OFF, g, S, E); } SEAM_L(11);
    for (int rep_ = 0; rep_ < 1 + ((MK_REPEAT >> 12) & 1); ++rep_)
    if (IN(12)) {
        p_weights2(F, args);
        { const int rpw = (MX + NGW - 1) / NGW; const int m0 = gw * rpw, m1 = (m0 + rpw < MX) ? m0 + rpw : MX; norm_mod_rows<1>(args, m0, m1, args.in[I_N2G], HX2, F.lane); }
    } SEAM(12);
    for (int rep_ = 0; rep_ < 1 + ((MK_REPEAT >> 13) & 1); ++rep_)
    if (IN(13)) { pg8::Gemm g{HX2, Wgu_t, MX, 2 * DFF, D}; pg8::StaticOrder S; S.init(MX, 2 * DFF, F.G, (int)blockIdx.x); pg8::EpiSwiglu E{ACT};
        pg8::gemm_phase<pg8::EpiSwiglu, pg8::StaticOrder, true, true>(F.lds + RING_OFF, g, S, E); } SEAM_L(13);
    for (int rep_ = 0; rep_ < 1 + ((MK_REPEAT >> 14) & 1); ++rep_)
    if (IN(14)) { pg8::Gemm g{ACT, Wdown_t, MX, D, DFF}; pg8::StaticOrder S; S.init(MX, D, F.G, (int)blockIdx.x); pg8::EpiDelta E{WSP(bf16, WS_D2), MOD + 5120};
        pg8::gemm_phase<pg8::EpiDelta, pg8::StaticOrder, true, true>(F.lds + RING_OFF, g, S, E); } SEAM_L(14);
    for (int rep_ = 0; rep_ < 1 + ((MK_REPEAT >> 15) & 1); ++rep_)
    if (IN(15)) {
        const int wpx = (F.G % 8 == 0) ? NGW / 8 : NGW, rpx = (F.G % 8 == 0) ? MX / 8 : MX, xg = gw / wpx, lw = gw % wpx;
        for (int m = xg * rpx + lw; m < (xg + 1) * rpx; m += wpx) {
            GAS f32x4* xr = (GAS f32x4*)(args.out + (size_t)m * D) + F.lane; const GAS f32x4* xin = (const GAS f32x4*)(args.in[I_X] + (size_t)m * D) + F.lane;
            const GAS v2u* dr = (const GAS v2u*)(WSP(bf16, WS_D2) + (size_t)m * D) + F.lane; const GAS v2u* d1r = (const GAS v2u*)(WSP(bf16, WS_D1) + (size_t)m * D) + F.lane; f32x4 v[4]; float s2 = 0.f;
#pragma unroll
            for (int j = 0; j < 4; ++j) { const v2u dd = __builtin_nontemporal_load(dr + 64 * j), d1 = __builtin_nontemporal_load(d1r + 64 * j); v[j] = (__builtin_nontemporal_load(xin + 64 * j) + (f32x4){bflo(d1.x), bfhi(d1.x), bflo(d1.y), bfhi(d1.y)}) + (f32x4){bflo(dd.x), bfhi(dd.x), bflo(dd.y), bfhi(dd.y)}; s2 += (v[j].x * v[j].x + v[j].y * v[j].y) + (v[j].z * v[j].z + v[j].w * v[j].w); }
            const float rstd = 1.0f / sqrtf(wave_sum(s2) * (1.f / D) + NORM_EPS);
#pragma unroll
            for (int j = 0; j < 4; ++j) xr[64 * j] = (v[j] * rstd) * ((const f32x4*)args.in[I_FNG])[F.lane + 64 * j];
        }
    }
#undef IN
#undef SEAM
#undef GRID_BAR
}

extern "C" void kernel_launch(void* const* d_in, const int* in_sizes, int n_in, void* d_out, int out_size, void* d_ws, size_t ws_size, hipStream_t stream) {
    static int grid = 0;
    if (grid == 0) {
        if (n_in != 31 || in_sizes[0] != MX * D || out_size != MX * D || ws_size < WS_END) { fprintf(stderr, "kernel_launch: shape/workspace mismatch (n_in %d, in0 %d, out %d, ws %zu); nothing launched\n", n_in, n_in > 0 ? in_sizes[0] : -1, out_size, ws_size); grid = -1; return; }
        int dev = 0, cus = 0;
        if (hipGetDevice(&dev) != hipSuccess || hipDeviceGetAttribute(&cus, hipDeviceAttributeMultiprocessorCount, dev) != hipSuccess) { grid = -1; return; }
        if (hipFuncSetAttribute((const void*)mk_fwd, hipFuncAttributeMaxDynamicSharedMemorySize, LDS_BYTES) != hipSuccess) { fprintf(stderr, "kernel_launch: hipFuncSetAttribute failed\n"); grid = -1; return; }
        (void)hipGetLastError();
        grid = cus;
    }
    if (grid < 0) return;
    if (hipMemsetAsync((char*)d_ws + WS_CTL, 0, CTL_ZERO_BYTES, stream) != hipSuccess) return;
    Args a{};
    for (int i = 0; i < 31; ++i) a.in[i] = (const float*)d_in[i];
    a.out = (float*)d_out; a.ws = (unsigned char*)d_ws;
    if (N_LAUNCHES == 1) { a.ph_lo = 0; a.ph_hi = NPH; a.li = 0; hipLaunchKernelGGL(mk_fwd, dim3(grid), dim3(NWAVES * 64), LDS_BYTES, stream, a); }
    else for (int p = 0; p < NPH; ++p) { a.ph_lo = p; a.ph_hi = p + 1; a.li = p; hipLaunchKernelGGL(mk_fwd, dim3(grid), dim3(NWAVES * 64), LDS_BYTES, stream, a); }
}
```

```cpp
#include <hip/hip_runtime.h>
#include <cstdio>
#include <cstdint>
#ifndef MK_REPEAT
#define MK_REPEAT 0x0
#endif
#ifndef MK_N_LAUNCHES
#define MK_N_LAUNCHES 1
#endif
namespace pg8 {
#define PG8_LAS __attribute__((address_space(3)))
typedef unsigned short bf16_t;
typedef short bf16x8 __attribute__((ext_vector_type(8)));
typedef float f32x4 __attribute__((ext_vector_type(4)));
typedef unsigned u32x4 __attribute__((ext_vector_type(4)));
constexpr int BM = 256, BK = 64, HALF = 128, HTB = HALF * BK * 2  , STAGE_BYTES = 8 * HTB, NXCD = 8, WGM = 8;

__host__ __device__ __forceinline__ int lds_byte(int r, int c) { const int st = (r >> 4) * 2 + (c >> 5), rr = r & 15, cc = c & 31, ob = rr * 64 + cc * 2; return st * 1024 + (ob ^ (((ob >> 9) & 1) << 5)); }
__host__ __device__ __forceinline__ void stage_rc(int b, int& R, int& C) { const int st = b / 1024, sb = b % 1024, swz = sb ^ (((sb >> 9) & 1) << 5); R = (st >> 1) * 16 + swz / 64; C = (st & 1) * 32 + (swz % 64) / 2; }
__host__ __device__ __forceinline__ int perm32(int rho) { const int n = rho >> 4, i = rho & 15; return 8 * (i >> 2) + 4 * n + (i & 3); }

struct Unit { int pm, pn; };
struct Gemm { const bf16_t* A; const bf16_t* Bt; int M, N, K; };

struct StaticOrder {
    int nM, nN, nwg, G, c;
    __host__ __device__ void init(int M, int N, int G_, int c_) { nM = M / BM; nN = N / BM; nwg = nM * nN; G = G_; c = c_; }
    __host__ __device__ bool next(int i, Unit& u) const {
        const long L = (long)i * G + c; if (L >= nwg) return false;
        int wgid = (int)L; { const int q = nwg / NXCD, r = nwg % NXCD, xcd = wgid % NXCD, off = wgid / NXCD; wgid = (xcd < r ? xcd * (q + 1) : r * (q + 1) + (xcd - r) * q) + off; }
        const int nig = WGM * nN, gid = wgid / nig, fm = gid * WGM, gsz = (nM - fm) < WGM ? (nM - fm) : WGM;
        u.pm = fm + ((wgid % nig) % gsz); u.pn = (wgid % nig) / gsz; return true;
    }
    __device__ __forceinline__ void a_ready(const Unit&) const {}
    __device__ __forceinline__ void done(const Unit&) const {}
};

__device__ __forceinline__ unsigned cvt_pk_bf16(float lo, float hi) { unsigned r; asm volatile("v_cvt_pk_bf16_f32 %0, %1, %2" : "=v"(r) : "v"(lo), "v"(hi)); return r; }
__device__ __forceinline__ float bf_lo(unsigned w) { return __uint_as_float(w << 16); }
__device__ __forceinline__ float bf_hi(unsigned w) { return __uint_as_float(w & 0xffff0000u); }
__device__ __forceinline__ float sigm(float x) { return __builtin_amdgcn_rcpf(1.0f + __expf(-x)); }
__device__ __forceinline__ f32x4 sigm4(f32x4 v) { return (f32x4){sigm(v[0]), sigm(v[1]), sigm(v[2]), sigm(v[3])}; }
__device__ __forceinline__ u32x4 pack8(f32x4 v0, f32x4 v1) { u32x4 w; w.x = cvt_pk_bf16(v0[0], v0[1]); w.y = cvt_pk_bf16(v0[2], v0[3]); w.z = cvt_pk_bf16(v1[0], v1[1]); w.w = cvt_pk_bf16(v1[2], v1[3]); return w; }
__device__ __forceinline__ void unpack8(u32x4 w, f32x4& v0, f32x4& v1) { v0 = (f32x4){bf_lo(w.x), bf_hi(w.x), bf_lo(w.y), bf_hi(w.y)}; v1 = (f32x4){bf_lo(w.z), bf_hi(w.z), bf_lo(w.w), bf_hi(w.w)}; }
template <int CTRL> __device__ __forceinline__ float dpp_rot(float src) { return __int_as_float(__builtin_amdgcn_mov_dpp(__float_as_int(src), CTRL, 0xF, 0xF, true)); }
template <size_t O_Z3, size_t O_GF, size_t O_GR, size_t O_R, size_t O_EB> struct EpiIn {
    static constexpr bool PERM = true, AFTER_DRAIN = false, HAS_MID = false; static constexpr int KSLICE = 0; static constexpr bool SKIP_B1 = true, HAS_PRE = true;
    static __device__ __forceinline__ bool skip_b1(int pn) { return pn == 7; }
    static constexpr size_t RKV_STRIDE = (size_t)36 * 1024 * 1024 / 2;
    unsigned char* ws; bf16_t* al; const float* mup; const float* mun; PG8_LAS float* xb; int row_off;
    __device__ __forceinline__ void pre(const Unit& u, int ui, int wid, int lane) const {
        if (u.pn >= 8) return;
        const int t = wid * 64 + lane, col = 256 * u.pn + (t & 255);
        const float* src = (t < 256 ? mup : mun) + (col < 1920 ? col : 0);
        __builtin_amdgcn_global_load_lds((const unsigned*)src, (PG8_LAS unsigned*)(xb + 2048 + (ui & 1) * 512 + wid * 64), 4, 0, 0);
    }
    __device__ __forceinline__ void operator()(const f32x4 (&acc)[2][2][4][2], const Unit& u, int wr, int wc, int fr, int fq, int ui) const {
        const int pn = u.pn;
        if (pn >= 8) {
            const int row0 = row_off + u.pm * BM + wr * 64 + fr;
            if (pn < 10) {
                bf16_t* base = (bf16_t*)(ws + O_Z3); const int col0 = (pn - 8) * 256 + wc * 32 + 8 * fq;
#pragma unroll
                for (int ai = 0; ai < 2; ++ai)
#pragma unroll
                    for (int m = 0; m < 4; ++m) { bf16_t* rowp = base + (size_t)(row0 + ai * HALF + m * 16) * 512 + col0;
#pragma unroll
                        for (int bj = 0; bj < 2; ++bj) *(u32x4*)(rowp + bj * HALF) = pack8(acc[ai][bj][m][0], acc[ai][bj][m][1]); }
            } else {
                bf16_t* gq = (bf16_t*)(ws + O_GF); bf16_t* gr = (bf16_t*)(ws + O_GR); const int col0 = (pn - 10) * 128 + wc * 32 + 8 * fq;
#pragma unroll
                for (int ai = 0; ai < 2; ++ai)
#pragma unroll
                    for (int m = 0; m < 4; ++m) { const size_t off = (size_t)(row0 + ai * HALF + m * 16) * 1024 + col0;
                        f32x4 qv[2], sv[2];
#pragma unroll
                        for (int n = 0; n < 2; ++n)
#pragma unroll
                            for (int e = 0; e < 4; ++e) { const float ef = __expf(-acc[ai][0][m][n][e]), er1 = 1.0f + __expf(-acc[ai][1][m][n][e]);
                                sv[n][e] = __builtin_amdgcn_rcpf(er1); qv[n][e] = __builtin_amdgcn_rcpf(1.0f + ef) * fminf(er1, 1e20f); }
                        *(u32x4*)(gq + off) = pack8(qv[0], qv[1]); *(u32x4*)(gr + off) = pack8(sv[0], sv[1]); }
            }
            return;
        }
        asm volatile("" : "+v"(fr), "+v"(fq));
        const int cw = wc * 32 + 8 * fq, tile = (row_off >> 8) + u.pm;
        float* eb = (float*)(ws + O_EB); bf16_t* rkv = (bf16_t*)(ws + O_R);
#pragma unroll
        for (int ai = 0; ai < 2; ++ai)
#pragma unroll
            for (int bj = 0; bj < 2; ++bj)
#pragma unroll
                for (int n = 0; n < 2; ++n) { PG8_LAS float* p0 = xb + ((2 * ai + wr) * 2) * 256 + 128 * bj + cw + 4 * n;
                    if (fr == 0) *(PG8_LAS f32x4*)p0 = acc[ai][bj][0][n];
                    if (fr == 15) *(PG8_LAS f32x4*)(p0 + 256) = acc[ai][bj][3][n]; }
        if (wr == 0 && fr < 2) {
#pragma unroll
            for (int bj = 0; bj < 2; ++bj)
#pragma unroll
                for (int n = 0; n < 2; ++n) *(f32x4*)(eb + ((size_t)tile * 4 + fr) * 2048 + 256 * pn + 128 * bj + cw + 4 * n) = acc[0][bj][0][n]; }
        if (wr == 1 && fr >= 14) {
#pragma unroll
            for (int bj = 0; bj < 2; ++bj)
#pragma unroll
                for (int n = 0; n < 2; ++n) *(f32x4*)(eb + ((size_t)tile * 4 + 2 + (fr - 14)) * 2048 + 256 * pn + 128 * bj + cw + 4 * n) = acc[1][bj][3][n]; }
        asm volatile("s_waitcnt lgkmcnt(0)" ::: "memory"); __builtin_amdgcn_s_barrier(); asm volatile("" ::: "memory");
        bf16_t* dst; int ldd, dcol;
        if (pn < 6) { dst = rkv + (size_t)(pn >> 1) * RKV_STRIDE; ldd = 512; dcol = (pn & 1) * 256; } else { dst = al; ldd = 384; dcol = (pn - 6) * 256; }
#pragma unroll
        for (int bj = 0; bj < 2; ++bj) {
            if (pn == 7 && bj == 1) continue;
            const int act = (pn == 6 && bj == 0) ? 1 : (pn == 7) ? 2 : 0;
            const PG8_LAS float* tab = xb + 2048 + (ui & 1) * 512 + 128 * bj + cw;
            const bool f0 = fr == 0, f15 = fr == 15; const f32x4 z4 = {0.f, 0.f, 0.f, 0.f};
#pragma unroll
            for (int ai = 0; ai < 2; ++ai) { const int q = 2 * ai + wr;
                unsigned pk[4][2][2];
#pragma unroll
                for (int n = 0; n < 2; ++n) {
                    const f32x4 mp = *(const PG8_LAS f32x4*)(tab + 4 * n), mn = *(const PG8_LAS f32x4*)(tab + 256 + 4 * n);
                    const f32x4 w0 = 1.0f - mp - mn, mpA = f0 ? z4 : mp, mpB = f0 ? mp : z4, mnA = f15 ? z4 : mn, mnB = f15 ? mn : z4;
                    f32x4 xp = z4, xn = z4;
                    if (q > 0) xp = *(const PG8_LAS f32x4*)(xb + ((q - 1) * 2 + 1) * 256 + 128 * bj + cw + 4 * n);
                    if (q < 3) xn = *(const PG8_LAS f32x4*)(xb + ((q + 1) * 2) * 256 + 128 * bj + cw + 4 * n);
                    f32x4 R1[4], L1[4];
#pragma unroll
                    for (int m = 0; m < 4; ++m)
#pragma unroll
                        for (int e = 0; e < 4; ++e) { R1[m][e] = dpp_rot<0x121>(acc[ai][bj][m][n][e]); L1[m][e] = dpp_rot<0x12F>(acc[ai][bj][m][n][e]); }
#pragma unroll
                    for (int m = 0; m < 4; ++m) {
                        f32x4 uu = w0 * acc[ai][bj][m][n] + mpA * R1[m] + mpB * (m > 0 ? R1[m > 0 ? m - 1 : 0] : xp) + mnA * L1[m] + mnB * (m < 3 ? L1[m < 3 ? m + 1 : 3] : xn);
                        if (act == 1) uu = 2.0f * sigm4(2.0f * uu) - 1.0f; else if (act == 2) uu = sigm4(uu);
                        pk[m][n][0] = cvt_pk_bf16(uu[0], uu[1]); pk[m][n][1] = cvt_pk_bf16(uu[2], uu[3]); }
                }
#pragma unroll
                for (int m = 0; m < 4; ++m) *(u32x4*)(dst + (size_t)(row_off + u.pm * BM + 128 * ai + 64 * wr + 16 * m + fr) * ldd + dcol + 128 * bj + cw) = (u32x4){pk[m][0][0], pk[m][0][1], pk[m][1][0], pk[m][1][1]};
            }
        }
    }
};
struct EpiLora {
    static constexpr bool PERM = true, AFTER_DRAIN = false, HAS_MID = false; static constexpr int KSLICE = 128; static constexpr bool SKIP_B1 = false, HAS_PRE = false;
    bf16_t* lp; const float* bias;
    static __device__ __forceinline__ int koff(int pn) { const int t = pn >> 1; return t >= 4 ? 256 : (t >= 2 ? 128 : 0); }
    __device__ __forceinline__ void operator()(const f32x4 (&acc)[2][2][4][2], const Unit& u, int wr, int wc, int fr, int fq) const {
        const int pn = u.pn, t = pn >> 1;
        const int row0 = u.pm * BM + wr * 64 + fr, col0 = pn * 256 + wc * 32 + 8 * fq;
        const float sc = t < 2 ? -0.6065306597f : 1.0f;
#pragma unroll
        for (int bj = 0; bj < 2; ++bj) { const f32x4 b0 = *(const f32x4*)(bias + col0 + bj * HALF), b1 = *(const f32x4*)(bias + col0 + bj * HALF + 4);
#pragma unroll
            for (int ai = 0; ai < 2; ++ai)
#pragma unroll
                for (int m = 0; m < 4; ++m) { f32x4 v0 = acc[ai][bj][m][0] + b0, v1 = acc[ai][bj][m][1] + b1;
                    if (t < 4) { v0 = sigm4(v0) * sc; v1 = sigm4(v1) * sc; }
                    *(u32x4*)(lp + (size_t)(row0 + ai * HALF + m * 16) * 2560 + col0 + bj * HALF) = pack8(v0, v1); } }
    }
};
struct EpiMerge2 {
    static constexpr bool PERM = true, AFTER_DRAIN = false, HAS_MID = true; static constexpr int KSLICE = 0; static constexpr bool SKIP_B1 = false, HAS_PRE = false;
    bf16_t* mb; const bf16_t* gf; const bf16_t* gr;
    __device__ __forceinline__ void mid(f32x4 (&acc)[2][2][4][2], const Unit& u, int wr, int wc, int fr, int fq) const {
        asm volatile("" : "+v"(fr), "+v"(fq));
        const int row0 = u.pm * BM + wr * 64 + fr, col0 = u.pn * BM + wc * 32 + 8 * fq;
        constexpr int DEPTH = 8;
        u32x4 fw[DEPTH];
#define PG8_GOFF(it_) ((size_t)(row0 + ((it_) >> 3) * HALF + (((it_) >> 1) & 3) * 16) * 1024 + col0 + ((it_) & 1) * HALF)
#pragma unroll
        for (int d = 0; d < DEPTH; ++d) fw[d] = *(const u32x4*)(gf + PG8_GOFF(d));
#pragma unroll
        for (int it = 0; it < 16; ++it) { const int ai = it >> 3, m = (it >> 1) & 3, bj = it & 1, sl = it % DEPTH;
            const u32x4 fwc = fw[sl];
            asm volatile("" ::: "memory");
            if (it + DEPTH < 16) fw[sl] = *(const u32x4*)(gf + PG8_GOFF(it + DEPTH));
            asm volatile("" ::: "memory");
            acc[ai][bj][m][0][0] *= bf_lo(fwc.x); acc[ai][bj][m][0][1] *= bf_hi(fwc.x); acc[ai][bj][m][0][2] *= bf_lo(fwc.y); acc[ai][bj][m][0][3] *= bf_hi(fwc.y);
            acc[ai][bj][m][1][0] *= bf_lo(fwc.z); acc[ai][bj][m][1][1] *= bf_hi(fwc.z); acc[ai][bj][m][1][2] *= bf_lo(fwc.w); acc[ai][bj][m][1][3] *= bf_hi(fwc.w); }
    }
    __device__ __forceinline__ void operator()(const f32x4 (&acc)[2][2][4][2], const Unit& u, int wr, int wc, int fr, int fq) const {
        const int row0 = u.pm * BM + wr * 64 + fr, col0 = u.pn * BM + wc * 32 + 8 * fq;
        constexpr int DEPTH = 8;
        u32x4 rw[DEPTH];
#pragma unroll
        for (int d = 0; d < DEPTH; ++d) rw[d] = *(const u32x4*)(gr + PG8_GOFF(d));
#pragma unroll
        for (int it = 0; it < 16; ++it) { const int ai = it >> 3, m = (it >> 1) & 3, bj = it & 1, sl = it % DEPTH;
            const u32x4 rwc = rw[sl];
            asm volatile("" ::: "memory");
            if (it + DEPTH < 16) rw[sl] = *(const u32x4*)(gr + PG8_GOFF(it + DEPTH));
            asm volatile("" ::: "memory");
            f32x4 g0, g1; unpack8(rwc, g0, g1);
#pragma unroll
            for (int e = 0; e < 4; ++e) { g0[e] = fmaxf(g0[e], 1e-20f); g1[e] = fmaxf(g1[e], 1e-20f); }
            *(u32x4*)(mb + PG8_GOFF(it)) = pack8(g0 * acc[ai][bj][m][0], g1 * acc[ai][bj][m][1]); }
#undef PG8_GOFF
    }
};
struct EpiResid {
    static constexpr bool PERM = false, AFTER_DRAIN = false, HAS_MID = false; static constexpr int KSLICE = 0; static constexpr bool SKIP_B1 = false, HAS_PRE = false;
    const float* base; float* out; const float* gate;
    __device__ __forceinline__ void operator()(const f32x4 (&acc)[2][2][4][2], const Unit& u, int wr, int wc, int fr, int fq) const {
        const int row0 = u.pm * BM + wr * 64 + fr, col0 = u.pn * BM + wc * 32 + 4 * fq; const float* gp = gate + (size_t)(u.pm >> 3) * 6144 + col0;
        f32x4 gv[2][2];
#pragma unroll
        for (int bj = 0; bj < 2; ++bj)
#pragma unroll
            for (int n = 0; n < 2; ++n) gv[bj][n] = *(const f32x4*)(gp + bj * HALF + n * 16);
        f32x4 cur[2][2], nxt[2][2];
#pragma unroll
        for (int bj = 0; bj < 2; ++bj)
#pragma unroll
            for (int n = 0; n < 2; ++n) cur[bj][n] = *(const f32x4*)(base + (size_t)row0 * 1024 + col0 + bj * HALF + n * 16);
#pragma unroll
        for (int g8 = 0; g8 < 8; ++g8) { const int ai = g8 >> 2, m = g8 & 3; const size_t off = (size_t)(row0 + ai * HALF + m * 16) * 1024 + col0;
            if (g8 + 1 < 8) { const int ai2 = (g8 + 1) >> 2, m2 = (g8 + 1) & 3; const size_t off2 = (size_t)(row0 + ai2 * HALF + m2 * 16) * 1024 + col0;
#pragma unroll
                for (int bj = 0; bj < 2; ++bj)
#pragma unroll
                    for (int n = 0; n < 2; ++n) nxt[bj][n] = *(const f32x4*)(base + off2 + bj * HALF + n * 16); }
            asm volatile("" ::: "memory");
#pragma unroll
            for (int bj = 0; bj < 2; ++bj)
#pragma unroll
                for (int n = 0; n < 2; ++n) *(f32x4*)(out + off + bj * HALF + n * 16) = cur[bj][n] + gv[bj][n] * acc[ai][bj][m][n];
            asm volatile("" ::: "memory");
#pragma unroll
            for (int bj = 0; bj < 2; ++bj)
#pragma unroll
                for (int n = 0; n < 2; ++n) cur[bj][n] = nxt[bj][n];
        }
    }
};
struct EpiDelta {
    static constexpr bool PERM = true, AFTER_DRAIN = false, HAS_MID = false; static constexpr int KSLICE = 0; static constexpr bool SKIP_B1 = false, HAS_PRE = false;
    bf16_t* dlt; const float* gate;
    __device__ __forceinline__ void operator()(const f32x4 (&acc)[2][2][4][2], const Unit& u, int wr, int wc, int fr, int fq) const {
        const int row0 = u.pm * BM + wr * 64 + fr, col0 = u.pn * BM + wc * 32 + 8 * fq; const float* gp = gate + (size_t)(u.pm >> 3) * 6144 + col0;
        f32x4 gv[2][2];
#pragma unroll
        for (int bj = 0; bj < 2; ++bj)
#pragma unroll
            for (int n = 0; n < 2; ++n) gv[bj][n] = *(const f32x4*)(gp + bj * HALF + 4 * n);
#pragma unroll
        for (int ai = 0; ai < 2; ++ai)
#pragma unroll
            for (int m = 0; m < 4; ++m) { bf16_t* rowp = dlt + (size_t)(row0 + ai * HALF + m * 16) * 1024 + col0;
#pragma unroll
                for (int bj = 0; bj < 2; ++bj) *(u32x4*)(rowp + bj * HALF) = pack8(acc[ai][bj][m][0] * gv[bj][0], acc[ai][bj][m][1] * gv[bj][1]); }
    }
};
struct EpiSwiglu {
    static constexpr bool PERM = true, AFTER_DRAIN = false, HAS_MID = false; static constexpr int KSLICE = 0; static constexpr bool SKIP_B1 = false, HAS_PRE = false;
    bf16_t* act;
    __device__ __forceinline__ void operator()(const f32x4 (&acc)[2][2][4][2], const Unit& u, int wr, int wc, int fr, int fq) const {
        const int row0 = u.pm * BM + wr * 64 + fr, col0 = u.pn * 128 + wc * 32 + 8 * fq;
#pragma unroll
        for (int ai = 0; ai < 2; ++ai)
#pragma unroll
            for (int m = 0; m < 4; ++m) { const f32x4 g0 = acc[ai][0][m][0], g1 = acc[ai][0][m][1];
                *(u32x4*)(act + (size_t)(row0 + ai * HALF + m * 16) * 2816 + col0) = pack8(g0 * sigm4(g0) * acc[ai][1][m][0], g1 * sigm4(g1) * acc[ai][1][m][1]); }
    }
};

template <class Epi, class Sched, bool ALIGN_EPI = false, bool SP2 = false>
__device__ __forceinline__ void gemm_phase(PG8_LAS unsigned char* lds, const Gemm g, const Sched& S, const Epi& E) {
    int tid_ = threadIdx.x; asm volatile("" : "+v"(tid_));
    const int tid = tid_, wid = __builtin_amdgcn_readfirstlane(tid >> 6), lane = tid & 63, wr = wid >> 2, wc = wid & 3, fr = lane & 15, fq = lane >> 4;
    int nt_ = Epi::KSLICE ? Epi::KSLICE / BK : g.K / BK; asm volatile("" : "+s"(nt_));
    const int K = g.K, nt = nt_;
    unsigned voffA[2], voffB[2];
#pragma unroll
    for (int i = 0; i < 2; ++i) { int R, C; stage_rc(tid * 16 + i * 8192, R, C); const int Rb = Epi::PERM ? ((R & ~31) + perm32(R & 31)) : R;
        voffA[i] = (unsigned)(R * K + C) * 2u; voffB[i] = (unsigned)(Rb * K + C) * 2u; }
    const size_t kstep = (size_t)(BK * 2);
    const size_t hstep = (size_t)HALF * K * 2;
    const size_t tstep = 2 * hstep;
    const unsigned ldsw = (unsigned)wid * 1024u;
    const int aoff = lds_byte(wr * 64 + fr, fq * 8), boff = lds_byte(wc * 32 + fr, fq * 8);
#define PG8_SA(b, h) (((b) * 2 + (h)) * HTB)
#define PG8_SB(b, h) ((4 + (b) * 2 + (h)) * HTB)
#define PG8_STAGE(bufoff, gbase, voff) do { _Pragma("unroll") for (int _i = 0; _i < 2; ++_i) \
        __builtin_amdgcn_global_load_lds((const unsigned*)((const char*)(gbase) + (voff)[_i]), (PG8_LAS unsigned*)(lds + (bufoff) + ldsw + _i * 8192), 16, 0, 0); } while (0)
#define PG8_LDA(dst, b, h) do { _Pragma("unroll") for (int m = 0; m < 4; ++m) _Pragma("unroll") for (int k = 0; k < 2; ++k) dst[m][k] = *(const PG8_LAS bf16x8*)(lds + PG8_SA(b, h) + aoff + m * 2048 + k * 1024); } while (0)
#define PG8_LDB(dst, b, h) do { _Pragma("unroll") for (int n = 0; n < 2; ++n) _Pragma("unroll") for (int k = 0; k < 2; ++k) dst[n][k] = *(const PG8_LAS bf16x8*)(lds + PG8_SB(b, h) + boff + n * 2048 + k * 1024); } while (0)
#define PG8_MMA(ai, bj, At, Bt) do { __builtin_amdgcn_s_setprio(1); _Pragma("unroll") for (int m = 0; m < 4; ++m) _Pragma("unroll") for (int n = 0; n < 2; ++n) _Pragma("unroll") for (int k = 0; k < 2; ++k) \
        acc[ai][bj][m][n] = __builtin_amdgcn_mfma_f32_16x16x32_bf16(Bt[n][k], At[m][k], acc[ai][bj][m][n], 0, 0, 0); __builtin_amdgcn_s_setprio(0); } while (0)
#define PG8_MMA1(ai, At) do { if constexpr (Epi::SKIP_B1) { if (!skb) PG8_MMA(ai, 1, At, B1); } else PG8_MMA(ai, 1, At, B1); } while (0)
#define PG8_WAIT_V(n) asm volatile("s_waitcnt vmcnt(" #n ")" ::: "memory")
#define PG8_WAIT_L(n) asm volatile("s_waitcnt lgkmcnt(" #n ")" ::: "memory")
#define PG8_BAR __builtin_amdgcn_s_barrier()
#define PG8_SCHED __builtin_amdgcn_sched_barrier(0)
    Unit cur, nxt; int ui = 0;
    if (!S.next(0, cur)) return;
    bool skb = false; if constexpr (Epi::SKIP_B1) skb = Epi::skip_b1(cur.pn);
    if constexpr (Epi::HAS_PRE) E.pre(cur, 0, wid, lane);
    f32x4 acc[2][2][4][2];
#pragma unroll
    for (int a = 0; a < 2; ++a)
#pragma unroll
        for (int b = 0; b < 2; ++b)
#pragma unroll
            for (int m = 0; m < 4; ++m)
#pragma unroll
                for (int n = 0; n < 2; ++n) acc[a][b][m][n] = (f32x4){0.f, 0.f, 0.f, 0.f};
    bf16x8 At[4][2], B0[2][2], B1[2][2];
    const char* cA = (const char*)g.A + (size_t)cur.pm * tstep; const char* cB = (const char*)g.Bt + (size_t)cur.pn * tstep;
    if constexpr (Epi::KSLICE != 0) { const int ko = Epi::koff(cur.pn) * 2; cA += ko; cB += ko; }
    S.a_ready(cur);
    if constexpr (SP2) {
        PG8_STAGE(PG8_SB(0, 0), cB, voffB); PG8_STAGE(PG8_SB(0, 1), cB + hstep, voffB); PG8_STAGE(PG8_SA(0, 0), cA, voffA); PG8_STAGE(PG8_SA(0, 1), cA + hstep, voffA);
        if (wr == 1) PG8_BAR;
        PG8_WAIT_V(2); PG8_BAR;
        PG8_STAGE(PG8_SB(1, 0), cB + kstep, voffB); PG8_STAGE(PG8_SA(1, 0), cA + kstep, voffA); PG8_STAGE(PG8_SB(1, 1), cB + hstep + kstep, voffB);
        PG8_WAIT_V(6); PG8_BAR;
    } else {
        PG8_STAGE(PG8_SB(0, 0), cB, voffB); PG8_STAGE(PG8_SA(0, 0), cA, voffA); PG8_STAGE(PG8_SB(0, 1), cB + hstep, voffB); PG8_STAGE(PG8_SA(0, 1), cA + hstep, voffA);
        if (wr == 1) PG8_BAR;
        PG8_WAIT_V(4); PG8_BAR;
        PG8_STAGE(PG8_SB(1, 0), cB + kstep, voffB); PG8_STAGE(PG8_SA(1, 0), cA + kstep, voffA); PG8_STAGE(PG8_SB(1, 1), cB + hstep + kstep, voffB);
        PG8_WAIT_V(6); PG8_BAR;
    }
    for (;;) {
        const bool has_next = S.next(ui + 1, nxt);
        const char* nA = has_next ? (const char*)g.A + (size_t)nxt.pm * tstep : cA; const char* nB = has_next ? (const char*)g.Bt + (size_t)nxt.pn * tstep : cB;
        if constexpr (Epi::KSLICE != 0) { if (has_next) { const int ko = Epi::koff(nxt.pn) * 2; nA += ko; nB += ko; } }
#pragma unroll 1
        for (int t = 0; t < nt; t += 2) {
            const bool last = (t == nt - 2);
            const char* a1 = cA + (size_t)(t + 1) * kstep;
            const char* a2 = last ? nA : cA + (size_t)(t + 2) * kstep; const char* b2 = last ? nB : cB + (size_t)(t + 2) * kstep;
            const char* a3 = a2 + kstep; const char* b3 = b2 + kstep;
            if (last && has_next) S.a_ready(nxt);
            if constexpr (SP2) {
            PG8_LDB(B0, 0, 0); PG8_LDB(B1, 0, 1); PG8_SCHED; PG8_LDA(At, 0, 0); PG8_STAGE(PG8_SA(1, 1), a1 + hstep, voffA);
            PG8_WAIT_V(8); PG8_WAIT_L(0); PG8_BAR; PG8_MMA(0, 0, At, B0); PG8_MMA1(0, At); PG8_BAR; PG8_SCHED;
            PG8_LDA(At, 0, 1); PG8_STAGE(PG8_SB(0, 0), b2, voffB); PG8_STAGE(PG8_SB(0, 1), b2 + hstep, voffB); PG8_STAGE(PG8_SA(0, 0), a2, voffA);
            PG8_WAIT_V(8); PG8_WAIT_L(0); PG8_BAR; PG8_MMA(1, 0, At, B0); PG8_MMA1(1, At); PG8_BAR; PG8_SCHED;
            PG8_LDB(B0, 1, 0); PG8_LDB(B1, 1, 1); PG8_SCHED; PG8_LDA(At, 1, 0); PG8_STAGE(PG8_SA(0, 1), a2 + hstep, voffA);
            PG8_WAIT_V(8); PG8_WAIT_L(0); PG8_BAR; PG8_MMA(0, 0, At, B0); PG8_MMA1(0, At); PG8_BAR; PG8_SCHED;
            PG8_LDA(At, 1, 1); PG8_STAGE(PG8_SB(1, 0), b3, voffB); PG8_STAGE(PG8_SB(1, 1), b3 + hstep, voffB); PG8_STAGE(PG8_SA(1, 0), a3, voffA);
            PG8_WAIT_V(8); PG8_WAIT_L(0); PG8_BAR; PG8_MMA(1, 0, At, B0); PG8_MMA1(1, At); PG8_BAR; PG8_SCHED;
            } else {
            PG8_LDB(B0, 0, 0); PG8_SCHED; PG8_LDA(At, 0, 0); PG8_STAGE(PG8_SA(1, 1), a1 + hstep, voffA);
            PG8_WAIT_L(8); PG8_BAR; PG8_WAIT_L(0); PG8_MMA(0, 0, At, B0); PG8_BAR; PG8_SCHED;
            PG8_LDB(B1, 0, 1); PG8_STAGE(PG8_SB(0, 0), b2, voffB);
            PG8_BAR; PG8_WAIT_L(0); PG8_MMA(0, 1, At, B1); PG8_BAR;
            PG8_LDA(At, 0, 1); PG8_STAGE(PG8_SA(0, 0), a2, voffA);
            PG8_BAR; PG8_WAIT_L(0); PG8_MMA(1, 0, At, B0); PG8_BAR; PG8_SCHED;
            PG8_STAGE(PG8_SB(0, 1), b2 + hstep, voffB);
            PG8_WAIT_V(6); PG8_BAR; PG8_MMA(1, 1, At, B1); PG8_BAR;
            PG8_LDB(B0, 1, 0); PG8_SCHED; PG8_LDA(At, 1, 0); PG8_STAGE(PG8_SA(0, 1), a2 + hstep, voffA);
            PG8_WAIT_L(8); PG8_BAR; PG8_WAIT_L(0); PG8_MMA(0, 0, At, B0); PG8_BAR; PG8_SCHED;
            PG8_LDB(B1, 1, 1); PG8_STAGE(PG8_SB(1, 0), b3, voffB);
            PG8_BAR; PG8_WAIT_L(0); PG8_MMA(0, 1, At, B1); PG8_BAR;
            PG8_LDA(At, 1, 1); PG8_STAGE(PG8_SA(1, 0), a3, voffA);
            PG8_BAR; PG8_WAIT_L(0); PG8_MMA(1, 0, At, B0); PG8_BAR; PG8_SCHED;
            PG8_STAGE(PG8_SB(1, 1), b3 + hstep, voffB);
            PG8_WAIT_V(6); PG8_BAR; PG8_MMA(1, 1, At, B1); PG8_BAR;
            }
            if constexpr (Epi::HAS_MID) { if (t == (nt >> 1) - 2) {
                if constexpr (ALIGN_EPI) { if (wr == 0) PG8_BAR; }
                E.mid(acc, cur, wr, wc, fr, fq);
                if constexpr (ALIGN_EPI) { if (wr == 1) PG8_BAR; } } }
        }
        if constexpr (ALIGN_EPI) { if (wr == 0) PG8_BAR; }
        if constexpr (!Epi::AFTER_DRAIN) { if constexpr (Epi::HAS_PRE) E(acc, cur, wr, wc, fr, fq, ui); else E(acc, cur, wr, wc, fr, fq); S.done(cur); }
        if (!has_next) break;
#pragma unroll
        for (int a = 0; a < 2; ++a)
#pragma unroll
            for (int b = 0; b < 2; ++b)
#pragma unroll
                for (int m = 0; m < 4; ++m)
#pragma unroll
                    for (int n = 0; n < 2; ++n) acc[a][b][m][n] = (f32x4){0.f, 0.f, 0.f, 0.f};
        cur = nxt; cA = nA; cB = nB; ++ui; if constexpr (Epi::SKIP_B1) skb = Epi::skip_b1(cur.pn);
        if constexpr (Epi::HAS_PRE) E.pre(cur, ui, wid, lane);
        if constexpr (ALIGN_EPI) { if (wr == 1) PG8_BAR; }
    }
    PG8_WAIT_V(0);
    if constexpr (!ALIGN_EPI) { if (wr == 0) PG8_BAR; }
    PG8_BAR;
    if constexpr (Epi::AFTER_DRAIN) { E.fused(acc, cur, wr, wc, fr, fq, lds, wid, lane); S.done(cur); }
#undef PG8_SA
#undef PG8_SB
#undef PG8_STAGE
#undef PG8_LDA
#undef PG8_LDB
#undef PG8_MMA
#undef PG8_MMA1
#undef PG8_WAIT_V
#undef PG8_WAIT_L
#undef PG8_BAR
#undef PG8_SCHED
}
}
constexpr int NWAVES = 8;
constexpr int N_LAUNCHES = MK_N_LAUNCHES;
constexpr int NPH = 16;
constexpr int D = 1024, NB = 16, SEQ = 2048, CTXL = 256, MX = NB * SEQ, MC = NB * CTXL, MT = MX + MC;
constexpr int RW = 512, NH = 8, HD = 64, RCOLS = 1920, RPAD = 2048, INCOLS = 4480, NIN = 4608, DFF = 2816, LK = 384, LN = 2560, MODW = 6144;
constexpr float NORM_EPS = 1e-6f, GN_EPS = 64e-5f;
constexpr size_t MiB = 1u << 20;
constexpr size_t WS_CTL = 0, CTL_ZERO_BYTES = 64 * 1024;
constexpr size_t WS_MOD = 1 * MiB, WS_LB = WS_MOD + 512 * 1024;
constexpr size_t WS_WIN = 2 * MiB, WS_WLORA = 12 * MiB, WS_WUPF = 14 * MiB, WS_WUPR = 15 * MiB, WS_WOUT = 16 * MiB;
constexpr size_t WS_A = 18 * MiB, WS_B = 82 * MiB, WS_C = 146 * MiB, WS_D = 210 * MiB, WS_E = 390 * MiB, WS_END = 512 * MiB;
constexpr size_t WS_GF = WS_A, WS_HX2 = WS_A, WS_GR = WS_B, WS_WGU = WS_E, WS_WDOWN = WS_E + 11 * MiB, WS_D1 = WS_B, WS_D2 = WS_A;
constexpr size_t WS_Z3 = WS_C, WS_FXO = WS_C;
constexpr size_t WS_PXR = WS_D, WS_LP = WS_D, WS_MB = WS_D, WS_ACT = WS_D;
constexpr size_t WS_EB = WS_E + 114 * MiB;
constexpr size_t WS_HX = WS_D, WS_Y2 = WS_E, WS_R = WS_E, WS_K = WS_E + 36 * MiB, WS_V = WS_E + 72 * MiB, WS_SBT = WS_E + 110 * MiB;
static_assert(WS_K - WS_R == 36 * MiB && WS_V - WS_K == 36 * MiB, "EpiIn::RKV_STRIDE");
static_assert(WS_LP + (size_t)MT * LN * 2 <= WS_E && WS_ACT + (size_t)MX * DFF * 2 <= WS_E && WS_V + (size_t)MT * RW * 2 <= WS_END && WS_HX + (size_t)MT * D * 2 <= WS_END, "d_ws map");
constexpr int CW_TMO = 0, CW_BAR = 4096, CW_BADMAP = 8192;
constexpr int RING_OFF = 0, RING_BYTES = 131072, LDSCTL_OFF = RING_BYTES, MISC_OFF = LDSCTL_OFF + 320, LDS_BYTES = 147456;
constexpr int XB_OFF = RING_BYTES + 4096;

#define GAS __attribute__((address_space(1)))
#define LAS __attribute__((address_space(3)))
typedef unsigned short bf16;
typedef unsigned v4u __attribute__((ext_vector_type(4)));
typedef unsigned v2u __attribute__((ext_vector_type(2)));
typedef float f32x4 __attribute__((ext_vector_type(4)));
typedef GAS unsigned gu32;
#define RLX_AGENT __ATOMIC_RELAXED, __HIP_MEMORY_SCOPE_AGENT
#define LDS_WAIT() asm volatile("s_waitcnt lgkmcnt(0)" ::: "memory")
#define VM_WAIT() asm volatile("s_waitcnt vmcnt(0)" ::: "memory")
__device__ __forceinline__ unsigned f2bf(float f) { unsigned u = __builtin_bit_cast(unsigned, f); return (u + 0x7fffu + ((u >> 16) & 1u)) >> 16; }
__device__ __forceinline__ unsigned pk2(float lo, float hi) { return f2bf(lo) | (f2bf(hi) << 16); }
__device__ __forceinline__ float bflo(unsigned w) { return __uint_as_float(w << 16); }
__device__ __forceinline__ float bfhi(unsigned w) { return __uint_as_float(w & 0xffff0000u); }
__device__ __forceinline__ float sigf(float x) { return 1.0f / (1.0f + __expf(-x)); }
__device__ __forceinline__ void unpk8(v4u w, float (&f)[8]) { f[0] = bflo(w.x); f[1] = bfhi(w.x); f[2] = bflo(w.y); f[3] = bfhi(w.y); f[4] = bflo(w.z); f[5] = bfhi(w.z); f[6] = bflo(w.w); f[7] = bfhi(w.w); }
__device__ __forceinline__ v4u pk8(const float (&f)[8]) { v4u o; o.x = pk2(f[0], f[1]); o.y = pk2(f[2], f[3]); o.z = pk2(f[4], f[5]); o.w = pk2(f[6], f[7]); return o; }

#define XB_TMO      128
#define XB_XCNT(j)  (256  + 64 * (j))
#define XB_XSUB(j)  (1280 + 64 * (j))
#define XB_XGEN(j)  (2304 + 64 * (j))
#define XB_TOP      3328
#define XB_TOPGEN   3392
#define XCD_BAR_WORDS 3456
#define XB_SPIN_CAP (1u << 18)

__device__ __forceinline__ unsigned xb_ld(unsigned* p)              { return __hip_atomic_load(p, __ATOMIC_RELAXED, __HIP_MEMORY_SCOPE_AGENT); }
__device__ __forceinline__ unsigned xb_add(unsigned* p, unsigned v) { return __hip_atomic_fetch_add(p, v, __ATOMIC_RELAXED, __HIP_MEMORY_SCOPE_AGENT); }
__device__ __forceinline__ unsigned xb_xcc_id() { return (unsigned)__builtin_amdgcn_s_getreg((3 << 11) | 20) & 0xFu; }
#define XB_SPIN(cond, bar) do { unsigned _sp = 0; while (cond) { __builtin_amdgcn_s_sleep(1); \
    if ((++_sp & 255u) == 0u) { if (xb_ld(&(bar)[XB_TMO])) break; if (_sp > XB_SPIN_CAP) { atomicAdd(&(bar)[XB_TMO], 1u); break; } } } } while (0)

struct XcdBarrier {
    unsigned* bar; unsigned x;
    volatile LAS unsigned* st;
};

__device__ __forceinline__ XcdBarrier xcd_barrier_post(unsigned* bar, volatile LAS unsigned* st) {
    XcdBarrier b; b.bar = bar; b.x = xb_xcc_id(); b.st = st;
    if (threadIdx.x == 0) (void)xb_add(&bar[XB_XCNT(b.x)], 1u);
    return b;
}
__device__ __forceinline__ void xcd_barrier_complete(unsigned* bar, unsigned x, unsigned& nloc, unsigned& nx) {
    const unsigned G = gridDim.x * gridDim.y * gridDim.z;
    unsigned sum, cnt, mine, sp = 0u;
    for (;;) {
        sum = 0u; cnt = 0u; mine = 0u;
#pragma unroll
        for (unsigned j = 0; j < 16; ++j) { const unsigned c = xb_ld(&bar[XB_XCNT(j)]); sum += c; cnt += (c > 0u) ? 1u : 0u; mine = (j == x) ? c : mine; }
        if (sum == G) break;
        __builtin_amdgcn_s_sleep(1);
        if ((++sp & 255u) == 0u) { if (xb_ld(&bar[XB_TMO])) break; if (sp > XB_SPIN_CAP) { atomicAdd(&bar[XB_TMO], 1u); break; } }
    }
    nloc = mine > 0u ? mine : 1u; nx = cnt > 0u ? cnt : 1u;
}

__device__ __forceinline__ void xcd_barrier(const XcdBarrier& b) {
    asm volatile("s_waitcnt vmcnt(0)" ::: "memory");
    __syncthreads();
    if (threadIdx.x == 0) {
        unsigned* bar = b.bar;
        __builtin_amdgcn_s_waitcnt(0);
        unsigned nloc = b.st[0], nx = b.st[1];
        if (nloc == 0u) { xcd_barrier_complete(bar, b.x, nloc, nx); b.st[0] = nloc; b.st[1] = nx; }
        const unsigned old = xb_add(&bar[XB_XSUB(b.x)], 1u);
        const unsigned gen = old / nloc;
        if (old + 1u == (gen + 1u) * nloc) {
            __builtin_amdgcn_fence(__ATOMIC_RELEASE, "agent");
            asm volatile("s_waitcnt vmcnt(0)" ::: "memory");
            const unsigned og = xb_add(&bar[XB_TOP], 1u);
            const unsigned tg = og / nx;
            if (og + 1u == (tg + 1u) * nx) xb_add(&bar[XB_TOPGEN], 1u);
            else XB_SPIN(xb_ld(&bar[XB_TOPGEN]) == tg, bar);
            __builtin_amdgcn_fence(__ATOMIC_ACQUIRE, "agent");
            xb_add(&bar[XB_XGEN(b.x)], 1u);
            asm volatile("s_waitcnt vmcnt(0)" ::: "memory");
        } else {
            XB_SPIN(xb_ld(&bar[XB_XGEN(b.x)]) == gen, bar);
            __builtin_amdgcn_fence(__ATOMIC_ACQUIRE, "agent");
            asm volatile("s_waitcnt vmcnt(0)" ::: "memory");
        }
    }
    __syncthreads();
}
__device__ __forceinline__ void xcd_barrier_local(const XcdBarrier& b) {
    asm volatile("s_waitcnt vmcnt(0)" ::: "memory");
    __syncthreads();
    if (threadIdx.x == 0) {
        unsigned* bar = b.bar;
        __builtin_amdgcn_s_waitcnt(0);
        const unsigned nloc = b.st[0] ? b.st[0] : 1u;
        const unsigned old = xb_add(&bar[XB_XSUB(b.x)], 1u);
        const unsigned gen = old / nloc;
        if (old + 1u == (gen + 1u) * nloc) (void)xb_add(&bar[XB_XGEN(b.x)], 1u);
        else XB_SPIN(xb_ld(&bar[XB_XGEN(b.x)]) == gen, bar);
        __builtin_amdgcn_fence(__ATOMIC_ACQUIRE, "agent");
        asm volatile("s_waitcnt vmcnt(0)" ::: "memory");
    }
    __syncthreads();
}
struct Args { const float* in[31]; float* out; unsigned char* ws; int ph_lo, ph_hi, li, pad; };
enum In { I_X = 0, I_C, I_CTX, I_CCTX, I_N1G, I_N2G, I_WADA, I_BADA, I_WIN, I_MUP, I_MUN, I_W0F, I_W2F, I_A0F, I_A2F, I_W0B, I_W2B, I_A0B, I_A2B, I_G2, I_KK, I_KA, I_RK, I_LNG, I_LNB, I_WUPR, I_WUPF, I_WOUT, I_WGU, I_WDOWN, I_FNG };
struct Frame { LAS unsigned char* lds; volatile LAS unsigned* MISC; gu32* ctl; int tid, lane, wave, vcu, G; };

__device__ __forceinline__ void refresh_tid(Frame& F) { int t = threadIdx.x; asm volatile("" : "+v"(t)); F.tid = t; F.lane = t & 63; }
__device__ __forceinline__ float wave_sum(float v) {
#pragma unroll
    for (int o = 1; o < 64; o <<= 1) v += __shfl_xor(v, o);
    return v;
}
__device__ __forceinline__ float red8(float v) { v += __shfl_xor(v, 1); v += __shfl_xor(v, 2); v += __shfl_xor(v, 4); return v; }

__device__ __forceinline__ void tr_item(const float* W, int ldw, int k0, int n0, bf16* WTrow0, int ldk, LAS float* scr, int lane) {
    float tv[32];
#pragma unroll
    for (int i = 0; i < 32; ++i) tv[i] = __builtin_nontemporal_load(W + (size_t)(k0 + 2 * i + (lane >> 5)) * ldw + n0 + (lane & 31));
#pragma unroll
    for (int i = 0; i < 32; ++i) scr[(2 * i + (lane >> 5)) * 33 + (lane & 31)] = tv[i];
    LDS_WAIT(); asm volatile("" ::: "memory");
    const int c = lane & 7;
#pragma unroll
    for (int j = 0; j < 4; ++j) { const int n = (lane >> 3) + 8 * j; const LAS float* s = scr + (8 * c) * 33 + n;
        v4u o; o.x = pk2(s[0 * 33], s[1 * 33]); o.y = pk2(s[2 * 33], s[3 * 33]); o.z = pk2(s[4 * 33], s[5 * 33]); o.w = pk2(s[6 * 33], s[7 * 33]);
        *(GAS v4u*)(WTrow0 + (size_t)n * ldk + k0 + 8 * c) = o; }
    LDS_WAIT(); asm volatile("" ::: "memory");
}

__device__ __forceinline__ void p0_weights(const Frame& F, const Args& a) {
    unsigned char* ws = a.ws;
    bf16* Win_t = (bf16*)(ws + WS_WIN); bf16* Wlora_t = (bf16*)(ws + WS_WLORA); bf16* Wupf_t = (bf16*)(ws + WS_WUPF); bf16* Wupr_t = (bf16*)(ws + WS_WUPR); bf16* Wout_t = (bf16*)(ws + WS_WOUT);
    LAS float* scr = (LAS float*)(F.lds + RING_OFF + F.wave * 16384);
    const int gw = F.vcu * NWAVES + F.wave, NGW = F.G * NWAVES, lane = F.lane;
    constexpr int E0 = 960, E1 = E0 + 1280, E2 = E1 + 256, E3 = E2 + 256, E4 = E3 + 512, E5 = E4 + 128, E6 = E5 + 2560;
    for (int it = gw; it < E6; it += NGW) {
        if (it < E0) { const int kb = it / 60, nb = it % 60; tr_item(a.in[I_WIN], INCOLS, 64 * kb, 32 * nb, Win_t + (size_t)(32 * nb) * D, D, scr, lane); }
        else if (it < E1) { const int r = it - E0, kb = r / 80, nb = r % 80;
            int drow = 2048 + 32 * nb; if (nb >= 16) { const int gj = 32 * ((nb - 16) & 31); drow = 2560 + (gj >> 7) * 256 + (gj & 127) + (nb >= 48 ? 128 : 0); }
            tr_item(a.in[I_WIN] + 1920, INCOLS, 64 * kb, 32 * nb, Win_t + (size_t)drow * D, D, scr, lane); }
        else if (it < E2) { const int r = it - E1, kb = r >> 5, nb = r & 31; tr_item(a.in[I_WUPF], D, 64 * kb, 32 * nb, Wupf_t + (size_t)(32 * nb) * 1024, 1024, scr, lane); }
        else if (it < E3) { const int r = it - E2, kb = r >> 5, nb = r & 31; tr_item(a.in[I_WUPR], D, 64 * kb, 32 * nb, Wupf_t + (size_t)(32 * nb) * 1024 + 512, 1024, scr, lane); }
        else if (it < E4) { const int r = it - E3, kb = r >> 5, nb = r & 31; tr_item(a.in[I_WOUT], D, 64 * kb, 32 * nb, Wout_t + (size_t)(32 * nb) * D, D, scr, lane); }
        else if (it < E5) { const int row = RCOLS + (it - E4); GAS v4u* p = (GAS v4u*)(Win_t + (size_t)row * D + 16 * lane); p[0] = (v4u){0u, 0u, 0u, 0u}; p[1] = (v4u){0u, 0u, 0u, 0u}; }
        else { const int n = it - E5, t = n >> 9, nn = n & 511, koff = t < 4 ? 64 * t : 256, klen = t < 4 ? 64 : 128;
            const float* src = t == 0 ? a.in[I_W2F] : t == 1 ? a.in[I_W2B] : t == 2 ? a.in[I_A2F] : t == 3 ? a.in[I_A2B] : a.in[I_G2];
            float v[6];
#pragma unroll
            for (int e = 0; e < 6; ++e) { const int kk = 6 * lane + e - koff; v[e] = (kk >= 0 && kk < klen) ? src[(size_t)kk * 512 + nn] : 0.f; }
            GAS unsigned* p = (GAS unsigned*)(Wlora_t + (size_t)n * LK + 6 * lane); p[0] = pk2(v[0], v[1]); p[1] = pk2(v[2], v[3]); p[2] = pk2(v[4], v[5]); }
    }
    { constexpr int NPIECE = (LN + NWAVES * 64 - 1) / (NWAVES * 64); const bool spread = F.G >= 192 + NPIECE;
      const int p0 = spread ? (int)blockIdx.x - 192 : 0, p1 = spread ? p0 + 1 : (blockIdx.x == 0 ? NPIECE : 0);
      if (p0 >= 0 && p0 < NPIECE) { float* LB = (float*)(a.ws + WS_LB);
          for (int i = p0 * NWAVES * 64 + F.tid; i < LN && i < p1 * NWAVES * 64; i += NWAVES * 64) { const int t = i >> 9, nn = i & 511; LB[i] = t == 0 ? a.in[I_W0F][nn] : t == 1 ? a.in[I_W0B][nn] : t == 2 ? a.in[I_A0F][nn] : t == 3 ? a.in[I_A0B][nn] : 0.f; } } }
    __syncthreads();
    LAS float* L = (LAS float*)(F.lds + RING_OFF);
    for (int it = blockIdx.x; it < 192; it += F.G) {
        {
            const int n0 = it * 32;
            LAS float* sc = L; LAS float* red = L + 17 * 1024;
            { float cvv[34];
#pragma unroll
              for (int i = 0; i < 34; ++i) { const int idx = F.tid + 512 * i, b = idx >> 10, k = idx & 1023; cvv[i] = b < 16 ? a.in[I_C][b * 1024 + k] : a.in[I_CCTX][k]; }
#pragma unroll
              for (int i = 0; i < 34; ++i) sc[F.tid + 512 * i] = cvv[i] * sigf(cvv[i]); }
            __syncthreads();
            const int col = F.tid & 31, ks = F.tid >> 5;
            float acc[17];
#pragma unroll
            for (int b = 0; b < 17; ++b) acc[b] = 0.f;
            for (int k8 = 0; k8 < 64; k8 += 32) { float wv[32];
#pragma unroll
                for (int j = 0; j < 32; ++j) wv[j] = __builtin_nontemporal_load(a.in[I_WADA] + (size_t)(ks * 64 + k8 + j) * MODW + n0 + col);
#pragma unroll
                for (int j = 0; j < 32; ++j) { const int k = ks * 64 + k8 + j;
#pragma unroll
                    for (int b = 0; b < 17; ++b) acc[b] += sc[b * 1024 + k] * wv[j]; } }
#pragma unroll
            for (int b = 0; b < 17; ++b) red[(ks * 17 + b) * 32 + col] = acc[b];
            __syncthreads();
            for (int o = F.tid; o < 17 * 32; o += NWAVES * 64) { const int b = o >> 5, c2 = o & 31; float s = a.in[I_BADA][n0 + c2];
                for (int k2 = 0; k2 < 16; ++k2) s += red[(k2 * 17 + b) * 32 + c2];
                ((float*)(a.ws + WS_MOD))[b * MODW + n0 + c2] = s; }
            __syncthreads();
        }
    }
}
__device__ __forceinline__ void p_weights2(const Frame& F, const Args& a) {
    bf16* Wgu_t = (bf16*)(a.ws + WS_WGU); bf16* Wdown_t = (bf16*)(a.ws + WS_WDOWN);
    LAS float* scr = (LAS float*)(F.lds + RING_OFF + F.wave * 16384);
    const int gw = F.vcu * NWAVES + F.wave, NGW = F.G * NWAVES;
    for (int it = gw; it < 2816 + 1408; it += NGW) {
        if (it < 2816) { const int kb = it / 176, nb = it % 176, n0 = 32 * nb; const int np = n0 < DFF ? n0 : n0 - DFF; const int drow = (np >> 7) * 256 + (np & 127) + (n0 < DFF ? 0 : 128);
            tr_item(a.in[I_WGU], 2 * DFF, 64 * kb, n0, Wgu_t + (size_t)drow * D, D, scr, F.lane); }
        else { const int r = it - 2816, kb = r >> 5, nb = r & 31; tr_item(a.in[I_WDOWN], D, 64 * kb, 32 * nb, Wdown_t + (size_t)(32 * nb) * DFF, DFF, scr, F.lane); }
    }
}
template <int KIND> __device__ __forceinline__ void norm_mod_rows(const Args& a, int m0, int m1, const float* g, bf16* O, int lane) {
    if (m0 >= m1) return;
    const float* MODp = (const float*)(a.ws + WS_MOD);
    f32x4 gg[4];
#pragma unroll
    for (int j = 0; j < 4; ++j) gg[j] = ((const f32x4*)g)[lane + 64 * j];
    auto rowp = [&](int m) -> const GAS f32x4* { const float* p = (KIND == 1 || m < MX) ? a.in[I_X] + (size_t)m * D : a.in[I_CTX] + (size_t)(m - MX) * D; return (const GAS f32x4*)p + lane; };
    const bf16* D1 = (const bf16*)(a.ws + WS_D1);
    f32x4 cur[4], nxt[4], ss[4], cc[4]; v2u cd[4], nd[4]; int bcur = -1;
    { const GAS f32x4* p = rowp(m0);
#pragma unroll
      for (int j = 0; j < 4; ++j) { cur[j] = __builtin_nontemporal_load(p + 64 * j); if (KIND == 1) cd[j] = __builtin_nontemporal_load((const GAS v2u*)(D1 + (size_t)m0 * D) + lane + 64 * j); } }
    for (int m = m0; m < m1; ++m) {
        if (m + 1 < m1) { const GAS f32x4* p = rowp(m + 1);
#pragma unroll
            for (int j = 0; j < 4; ++j) { nxt[j] = __builtin_nontemporal_load(p + 64 * j); if (KIND == 1) nd[j] = __builtin_nontemporal_load((const GAS v2u*)(D1 + (size_t)(m + 1) * D) + lane + 64 * j); } }
        if (KIND == 1) {
#pragma unroll
            for (int j = 0; j < 4; ++j) cur[j] = cur[j] + (f32x4){bflo(cd[j].x), bfhi(cd[j].x), bflo(cd[j].y), bfhi(cd[j].y)}; }
        const int b = KIND == 0 ? (m < MX ? (m >> 11) : 16) : (m >> 11);
        if (b != bcur) { bcur = b; const float* md = MODp + (size_t)b * MODW + (KIND == 0 ? 0 : 3072);
#pragma unroll
            for (int j = 0; j < 4; ++j) { ss[j] = ((const f32x4*)md)[lane + 64 * j]; cc[j] = ((const f32x4*)(md + 1024))[lane + 64 * j] + 1.0f; } }
        float s2 = 0.f;
#pragma unroll
        for (int j = 0; j < 4; ++j) s2 += (cur[j].x * cur[j].x + cur[j].y * cur[j].y) + (cur[j].z * cur[j].z + cur[j].w * cur[j].w);
        const float rstd = 1.0f / sqrtf(wave_sum(s2) * (1.f / D) + NORM_EPS);
        GAS v2u* o8 = (GAS v2u*)(O + (size_t)m * D) + lane;
#pragma unroll
        for (int j = 0; j < 4; ++j) { const f32x4 o = (cur[j] * rstd) * gg[j] * cc[j] + ss[j]; v2u w; w.x = pk2(o.x, o.y); w.y = pk2(o.z, o.w); o8[64 * j] = w; }
#pragma unroll
        for (int j = 0; j < 4; ++j) { cur[j] = nxt[j]; cd[j] = nd[j]; }
    }
}
typedef short bf16x8v __attribute__((ext_vector_type(8)));
__device__ __forceinline__ unsigned offb(unsigned row, unsigned ch) { return 256u * row + 16u * (ch ^ (((row & 3u) << 2) | ((row >> 2) & 3u))); }
__device__ __forceinline__ void tr_read8(unsigned a0, unsigned a1, v2u (&r0)[4], v2u (&r1)[4]) {
    asm volatile("ds_read_b64_tr_b16 %0, %8\n\tds_read_b64_tr_b16 %1, %8 offset:8192\n\tds_read_b64_tr_b16 %2, %8 offset:16384\n\tds_read_b64_tr_b16 %3, %8 offset:24576\n\t"
                 "ds_read_b64_tr_b16 %4, %9\n\tds_read_b64_tr_b16 %5, %9 offset:8192\n\tds_read_b64_tr_b16 %6, %9 offset:16384\n\tds_read_b64_tr_b16 %7, %9 offset:24576\n\ts_waitcnt lgkmcnt(0)"
                 : "=&v"(r0[0]), "=&v"(r0[1]), "=&v"(r0[2]), "=&v"(r0[3]), "=&v"(r1[0]), "=&v"(r1[1]), "=&v"(r1[2]), "=&v"(r1[3]) : "v"(a0), "v"(a1) : "memory");
}
__device__ __forceinline__ void tr_read4(unsigned a0, unsigned a1, v2u (&r0)[2], v2u (&r1)[2]) {
    asm volatile("ds_read_b64_tr_b16 %0, %4\n\tds_read_b64_tr_b16 %1, %4 offset:8192\n\tds_read_b64_tr_b16 %2, %5\n\tds_read_b64_tr_b16 %3, %5 offset:8192\n\ts_waitcnt lgkmcnt(0)"
                 : "=&v"(r0[0]), "=&v"(r0[1]), "=&v"(r1[0]), "=&v"(r1[1]) : "v"(a0), "v"(a1) : "memory");
}
__device__ __forceinline__ bf16x8v mk_b(v2u lo, v2u hi) { v4u w = {lo.x, lo.y, hi.x, hi.y}; return __builtin_bit_cast(bf16x8v, w); }
__device__ __forceinline__ void dft_pass_a(const Frame& F, const bf16* PXF, bf16* Y2) {
    constexpr int RSW = 272;
    const int w = F.wave, l = F.lane, lr = l & 15, g4 = l >> 4, q = (l & 15) >> 2, p = l & 3;
    const unsigned ldsb = (unsigned)(size_t)(F.lds + RING_OFF);
    LAS unsigned char* IN = F.lds + RING_OFF; LAS bf16* OUT = (LAS bf16*)(F.lds + RING_OFF + 32768); LAS unsigned char* RAW = F.lds + RING_OFF + 65536;
    bf16x8v afr[4], af0[2][4];
    { const int m = 16 * w + lr, ri = m >> 6, k2 = m & 63;
#pragma unroll
      for (int ks = 0; ks < 4; ++ks) { unsigned pk[4];
#pragma unroll
          for (int e2 = 0; e2 < 4; ++e2) { float vv[2];
#pragma unroll
              for (int h = 0; h < 2; ++h) { const int k = 32 * ks + 8 * g4 + 2 * e2 + h, rj = k >> 6, n2 = k & 63, idx = (k2 * n2) & 63; const float rev = (float)idx * (1.0f / 64.0f), sn = __builtin_amdgcn_sinf(rev), cs = __builtin_amdgcn_cosf(rev); vv[h] = (ri == rj) ? cs : (ri == 0 ? sn : -sn); }
              pk[e2] = pk2(vv[0], vv[1]); }
          afr[ks] = __builtin_bit_cast(bf16x8v, (v4u){pk[0], pk[1], pk[2], pk[3]}); } }
#pragma unroll
    for (int mt = 0; mt < 2; ++mt) { const int m = 32 * w + 16 * mt + lr, ri = m >> 7, k3 = m & 127;
#pragma unroll
      for (int ks = 0; ks < 4; ++ks) { unsigned pk[4];
#pragma unroll
          for (int e2 = 0; e2 < 4; ++e2) { float vv[2];
#pragma unroll
              for (int h = 0; h < 2; ++h) { const int n3 = 32 * ks + 8 * g4 + 2 * e2 + h, idx = (k3 * n3) & 127; const float rev = (float)idx * (1.0f / 128.0f), sn = __builtin_amdgcn_sinf(rev), cs = __builtin_amdgcn_cosf(rev); vv[h] = ri == 0 ? cs : -sn; }
              pk[e2] = pk2(vv[0], vv[1]); }
          af0[mt][ks] = __builtin_bit_cast(bf16x8v, (v4u){pk[0], pk[1], pk[2], pk[3]}); } }
    unsigned rb[2], mk[2];
#pragma unroll
    for (int t = 0; t < 2; ++t) { const unsigned row = 8 * g4 + 4 * t + q; rb[t] = ldsb + 256u * row + 8u * (p & 1); mk[t] = ((row & 3u) << 2) | ((row >> 2) & 3u); }
    const unsigned hb = p >> 1;
    v4u pre[2];
    { const int it = blockIdx.x; if (it < 2048) { const int jc = it & 3, n1 = (it >> 2) & 31, b = it >> 7;
#pragma unroll
        for (int i = 0; i < 2; ++i) { const int cid = F.tid + 512 * i, row = cid >> 4, ch = cid & 15; pre[i] = __builtin_nontemporal_load((const GAS v4u*)(PXF + (size_t)(b * 2048 + n1 * 64 + row) * 512 + jc * 128 + ch * 8)); } } }
    for (int it = blockIdx.x; it < 2048; it += F.G) {
        const int jc = it & 3, n1 = (it >> 2) & 31, b = it >> 7;
        __syncthreads();
#pragma unroll
        for (int i = 0; i < 2; ++i) { const int cid = F.tid + 512 * i, row = cid >> 4, ch = cid & 15; *(LAS v4u*)(RAW + row * RSW + ch * 16) = pre[i]; }
        { const int itn = it + F.G; if (itn < 2048) { const int jcn = itn & 3, n1n = (itn >> 2) & 31, bn = itn >> 7;
#pragma unroll
            for (int i = 0; i < 2; ++i) { const int cid = F.tid + 512 * i, row = cid >> 4, ch = cid & 15; pre[i] = __builtin_nontemporal_load((const GAS v4u*)(PXF + (size_t)(bn * 2048 + n1n * 64 + row) * 512 + jcn * 128 + ch * 8)); } } }
        __syncthreads();
#pragma unroll
        for (int nt = 0; nt < 4; ++nt) {
            bf16x8v bx[4];
#pragma unroll
            for (int ks = 0; ks < 4; ++ks) bx[ks] = *(const LAS bf16x8v*)(RAW + (16 * nt + lr) * RSW + (32 * ks + 8 * g4) * 2);
#pragma unroll
            for (int mt = 0; mt < 2; ++mt) { f32x4 acc = {0.f, 0.f, 0.f, 0.f};
#pragma unroll
                for (int ks = 0; ks < 4; ++ks) acc = __builtin_amdgcn_mfma_f32_16x16x32_bf16(af0[mt][ks], bx[ks], acc, 0, 0, 0);
                const int m0 = 32 * w + 16 * mt + 4 * g4, ri = m0 >> 7, c0 = m0 & 127, row = ri * 64 + 16 * nt + lr;
                *(LAS v2u*)(IN + offb(row, c0 >> 3) + 8 * ((c0 >> 2) & 1)) = (v2u){pk2(acc[0], acc[1]), pk2(acc[2], acc[3])}; }
        }
        __syncthreads();
#pragma unroll 2
        for (int c = 0; c < 8; ++c) {
            v2u r0[4], r1[4];
            tr_read8(rb[0] + 16u * ((2u * c + hb) ^ mk[0]), rb[1] + 16u * ((2u * c + hb) ^ mk[1]), r0, r1);
            f32x4 acc = {0.f, 0.f, 0.f, 0.f};
#pragma unroll
            for (int ks = 0; ks < 4; ++ks) acc = __builtin_amdgcn_mfma_f32_16x16x32_bf16(afr[ks], mk_b(r0[ks], r1[ks]), acc, 0, 0, 0);
#pragma unroll
            for (int r = 0; r < 4; ++r) OUT[(16 * w + 4 * g4 + r) * 128 + 16 * c + lr] = (bf16)f2bf(acc[r]);
        }
        __syncthreads();
#pragma unroll
        for (int i = 0; i < 4; ++i) { const int cid = F.tid + 512 * i, row = cid >> 4, ch = cid & 15, ri = row >> 6, k2 = row & 63;
            *(GAS v4u*)(Y2 + (size_t)(b * 2048 + n1 * 64 + k2) * 1024 + ri * 512 + jc * 128 + ch * 8) = *(const LAS v4u*)(OUT + row * 128 + ch * 8); }
    }
}
__device__ __forceinline__ void dft_pass_b(const Frame& F, const bf16* Y2, bf16* FX) {
    const int w = F.wave, l = F.lane, lr = l & 15, g4 = l >> 4, q = (l & 15) >> 2, p = l & 3;
    const int g = w >> 1, c0 = (w & 1) * 4;
    const unsigned ldsb = (unsigned)(size_t)(F.lds + RING_OFF) + 16384u * g;
    LAS unsigned char* IN = F.lds + RING_OFF; LAS bf16* OUT = (LAS bf16*)(F.lds + RING_OFF + 65536);
    bf16x8v afr[2][2];
#pragma unroll
    for (int mt = 0; mt < 2; ++mt) { const int k1 = 16 * mt + lr;
#pragma unroll
      for (int ks = 0; ks < 2; ++ks) { unsigned pk[4];
#pragma unroll
          for (int e2 = 0; e2 < 4; ++e2) { float vv[2];
#pragma unroll
              for (int h = 0; h < 2; ++h) { const int k = 32 * ks + 8 * g4 + 2 * e2 + h, ri = k >> 5, n1 = k & 31, idx = (k1 * n1) & 31; const float rev = (float)idx * (1.0f / 32.0f), sn = __builtin_amdgcn_sinf(rev), cs = __builtin_amdgcn_cosf(rev); vv[h] = (ri == 0 ? cs : sn); }
              pk[e2] = pk2(vv[0], vv[1]); }
          afr[mt][ks] = __builtin_bit_cast(bf16x8v, (v4u){pk[0], pk[1], pk[2], pk[3]}); } }
    unsigned rb[2], mk[2];
#pragma unroll
    for (int t = 0; t < 2; ++t) { const unsigned row = 8 * g4 + 4 * t + q; rb[t] = ldsb + 256u * row + 8u * (p & 1); mk[t] = ((row & 3u) << 2) | ((row >> 2) & 3u); }
    const unsigned hb = p >> 1;
    v4u pre[8];
    { const int it = blockIdx.x; if (it < 1024) { const int k2 = it & 63, b = it >> 6;
#pragma unroll
        for (int i = 0; i < 8; ++i) { const int cid = F.tid + 512 * i, row = cid >> 6, c64 = cid & 63; pre[i] = __builtin_nontemporal_load((const GAS v4u*)(Y2 + (size_t)(b * 2048 + (row & 31) * 64 + k2) * 1024 + (row >> 5) * 512 + c64 * 8)); } } }
    for (int it = blockIdx.x; it < 1024; it += F.G) {
        const int k2 = it & 63, b = it >> 6;
        __syncthreads();
#pragma unroll
        for (int i = 0; i < 8; ++i) { const int cid = F.tid + 512 * i, row = cid >> 6, c64 = cid & 63, gg = c64 >> 4, ch = c64 & 15; *(LAS v4u*)(IN + 16384 * gg + offb(row, ch)) = pre[i]; }
        { const int itn = it + F.G; if (itn < 1024) { const int k2n = itn & 63, bn = itn >> 6;
#pragma unroll
            for (int i = 0; i < 8; ++i) { const int cid = F.tid + 512 * i, row = cid >> 6, c64 = cid & 63; pre[i] = __builtin_nontemporal_load((const GAS v4u*)(Y2 + (size_t)(bn * 2048 + (row & 31) * 64 + k2n) * 1024 + (row >> 5) * 512 + c64 * 8)); } } }
        __syncthreads();
#pragma unroll
        for (int cc = 0; cc < 4; ++cc) { const int c = c0 + cc;
            v2u r0[2], r1[2];
            tr_read4(rb[0] + 16u * ((2u * c + hb) ^ mk[0]), rb[1] + 16u * ((2u * c + hb) ^ mk[1]), r0, r1);
#pragma unroll
            for (int mt = 0; mt < 2; ++mt) { f32x4 acc = {0.f, 0.f, 0.f, 0.f};
#pragma unroll
                for (int ks = 0; ks < 2; ++ks) acc = __builtin_amdgcn_mfma_f32_16x16x32_bf16(afr[mt][ks], mk_b(r0[ks], r1[ks]), acc, 0, 0, 0);
#pragma unroll
                for (int r = 0; r < 4; ++r) OUT[(16 * mt + 4 * g4 + r) * 512 + g * 128 + 16 * c + lr] = (bf16)f2bf(acc[r] * (1.0f / 512.0f)); }
        }
        __syncthreads();
#pragma unroll
        for (int i = 0; i < 4; ++i) { const int cid = F.tid + 512 * i, row = cid >> 6, ch = cid & 63;
            *(GAS v4u*)(FX + (size_t)(b * 2048 + row * 64 + k2) * 1024 + ch * 8) = *(const LAS v4u*)(OUT + row * 512 + ch * 8); }
    }
}
template <int CTRL> __device__ __forceinline__ float dpp_add(float x) { const int v = __builtin_amdgcn_update_dpp(__float_as_int(x), __float_as_int(x), CTRL, 0xF, 0xF, false); return x + __int_as_float(v); }
__device__ __forceinline__ void edge_rows(const Frame& F, const Args& a) {
    const float* EB = (const float*)(a.ws + WS_EB); bf16* RB = (bf16*)(a.ws + WS_R); bf16* KB = (bf16*)(a.ws + WS_K); bf16* VB = (bf16*)(a.ws + WS_V); bf16* AL = (bf16*)a.out;
    const int gw = F.vcu * NWAVES + F.wave, lane = F.lane;
    if (gw >= 8 * (MT / 256)) return;
    const int tile = gw >> 3, last = (gw >> 2) & 1, j = gw & 3, col = 512 * j + 8 * lane;
    if (col >= RCOLS) return;
    const bool lat = tile < MX / 256, s0 = lat ? (tile & 7) == 0 : true, s1 = lat ? (tile & 7) == 7 : true;
    const int m = tile * 256 + (last ? 255 : 0);
    const float* cp = EB + ((size_t)tile * 4 + (last ? 3 : 0)) * 2048 + col;
    const float* pp = (last ? EB + ((size_t)tile * 4 + 2) * 2048 : EB + ((size_t)(tile > 0 ? tile - 1 : 0) * 4 + 3) * 2048) + col;
    const float* np = (last ? EB + ((size_t)(tile + 1 < MT / 256 ? tile + 1 : tile) * 4 + 0) * 2048 : EB + ((size_t)tile * 4 + 1) * 2048) + col;
    const bool hp = last ? true : !s0, hn = last ? !s1 : true;
    const f32x4 z = {0.f, 0.f, 0.f, 0.f};
    f32x4 c4[2], p4[2], n4[2], mp4[2], mn4[2];
#pragma unroll
    for (int h = 0; h < 2; ++h) { c4[h] = ((const f32x4*)cp)[h]; p4[h] = hp ? ((const f32x4*)pp)[h] : z; n4[h] = hn ? ((const f32x4*)np)[h] : z; mp4[h] = ((const f32x4*)(a.in[I_MUP] + col))[h]; mn4[h] = ((const f32x4*)(a.in[I_MUN] + col))[h]; }
    float u[8];
#pragma unroll
    for (int e = 0; e < 8; ++e) { const float c = c4[e >> 2][e & 3]; u[e] = c + mp4[e >> 2][e & 3] * (p4[e >> 2][e & 3] - c) + mn4[e >> 2][e & 3] * (n4[e >> 2][e & 3] - c); }
    if (j == 0) *(GAS v4u*)(RB + (size_t)m * RW + 8 * lane) = pk8(u);
    else if (j == 1) *(GAS v4u*)(KB + (size_t)m * RW + 8 * lane) = pk8(u);
    else if (j == 2) *(GAS v4u*)(VB + (size_t)m * RW + 8 * lane) = pk8(u);
    else {
        if (lane < 16) {
#pragma unroll
            for (int e = 0; e < 8; ++e) u[e] = 2.0f * sigf(2.0f * u[e]) - 1.0f;
        } else if (lane >= 32) {
#pragma unroll
            for (int e = 0; e < 8; ++e) u[e] = sigf(u[e]);
        }
        *(GAS v4u*)(AL + (size_t)m * LK + 8 * lane) = pk8(u);
    }
}
__device__ __forceinline__ int scan_row(int s, int b, int dir) { if (s < CTXL) { const int t = dir ? (CTXL - 1 - s) : s; return MX + b * CTXL + t; } const int s2 = s - CTXL; const int t = dir ? (SEQ - 1 - s2) : s2; return b * SEQ + t; }
__device__ __forceinline__ float red16(float x) { x = dpp_add<0xB1>(x); x = dpp_add<0x4E>(x); x = dpp_add<0x141>(x); x = dpp_add<0x140>(x); return x; }
typedef float f32x2 __attribute__((ext_vector_type(2)));
__device__ __forceinline__ float fm_(float a, float b, float c) { float d; asm("v_fma_f32 %0, %1, %2, %3" : "=v"(d) : "v"(a), "v"(b), "v"(c)); return d; }
__device__ __forceinline__ float ml_(float a, float b) { float d; asm("v_mul_f32 %0, %1, %2" : "=v"(d) : "v"(a), "v"(b)); return d; }
__device__ __forceinline__ void red16x2(float& a, float& b) {
    asm volatile("s_nop 1\n\t"
        "v_add_f32_dpp %0, %0, %0 quad_perm:[1,0,3,2] row_mask:0xf bank_mask:0xf\n\tv_add_f32_dpp %1, %1, %1 quad_perm:[1,0,3,2] row_mask:0xf bank_mask:0xf\n\ts_nop 0\n\t"
        "v_add_f32_dpp %0, %0, %0 quad_perm:[2,3,0,1] row_mask:0xf bank_mask:0xf\n\tv_add_f32_dpp %1, %1, %1 quad_perm:[2,3,0,1] row_mask:0xf bank_mask:0xf\n\ts_nop 0\n\t"
        "v_add_f32_dpp %0, %0, %0 row_half_mirror row_mask:0xf bank_mask:0xf\n\tv_add_f32_dpp %1, %1, %1 row_half_mirror row_mask:0xf bank_mask:0xf\n\ts_nop 0\n\t"
        "v_add_f32_dpp %0, %0, %0 row_mirror row_mask:0xf bank_mask:0xf\n\tv_add_f32_dpp %1, %1, %1 row_mirror row_mask:0xf bank_mask:0xf\n\ts_nop 0"
        : "+v"(a), "+v"(b));
}
typedef short bf16x8v_ __attribute__((ext_vector_type(8)));
namespace sc {
constexpr int C = 16, NCHUNK = (CTXL + SEQ) / C, CTXCHUNK = CTXL / C, NSLOT = 5;
constexpr int RS = 144, ARR = 16 * RS, ES = 272;
constexpr int O_P = 0, O_RT = ARR, O_NPT = 2 * ARR, O_DPT = 3 * ARR, O_VT = 4 * ARR, O_DM = 5 * ARR, O_NR = O_DM + 512, O_DR = O_NR + 512, O_LINV = O_DR + 512, O_LC = O_LINV + 512, SLOT_B = O_LC + 256;
constexpr int PRIVP = NSLOT * SLOT_B, O_NN = 0, O_DD = ARR, O_EW = 2 * ARR, O_NF = O_EW + 16 * ES, PRIVP_B = O_NF + 1024;
constexpr int ZERO_OFF = PRIVP + 4 * PRIVP_B;
constexpr int FLAG_OFF = ZERO_OFF + 1024;
constexpr int KC_OFF = FLAG_OFF + 64;
static_assert(SLOT_B % 16 == 0 && PRIVP_B % 16 == 0 && KC_OFF + 1024 <= RING_BYTES, "scan LDS map");
}
__device__ __forceinline__ unsigned cvtpk(float lo, float hi) { unsigned r; asm volatile("v_cvt_pk_bf16_f32 %0, %1, %2" : "=v"(r) : "v"(lo), "v"(hi)); return r; }
__device__ __forceinline__ float bf1(unsigned short x) { return __uint_as_float((unsigned)x << 16); }
__device__ __forceinline__ unsigned short tobf(float f) { return (unsigned short)f2bf(f); }
__device__ __forceinline__ unsigned short tobf1(float f) { return (unsigned short)cvtpk(f, f); }
__device__ __forceinline__ bf16x8v_ tr_frag1(unsigned a) { v2u r0, r1;
    asm volatile("ds_read_b64_tr_b16 %0, %2\n\tds_read_b64_tr_b16 %1, %2 offset:512\n\ts_waitcnt lgkmcnt(0)" : "=&v"(r0), "=&v"(r1) : "v"(a) : "memory"); return mk_b(r0, r1); }
__device__ __forceinline__ void tr_frag4(unsigned a, bf16x8v_ (&f)[4]) { v2u r[8];
    asm volatile("ds_read_b64_tr_b16 %0, %8\n\tds_read_b64_tr_b16 %1, %8 offset:512\n\tds_read_b64_tr_b16 %2, %8 offset:32\n\tds_read_b64_tr_b16 %3, %8 offset:544\n\t"
                 "ds_read_b64_tr_b16 %4, %8 offset:64\n\tds_read_b64_tr_b16 %5, %8 offset:576\n\tds_read_b64_tr_b16 %6, %8 offset:96\n\tds_read_b64_tr_b16 %7, %8 offset:608\n\ts_waitcnt lgkmcnt(0)"
                 : "=&v"(r[0]), "=&v"(r[1]), "=&v"(r[2]), "=&v"(r[3]), "=&v"(r[4]), "=&v"(r[5]), "=&v"(r[6]), "=&v"(r[7]) : "v"(a) : "memory");
    f[0] = mk_b(r[0], r[1]); f[1] = mk_b(r[2], r[3]); f[2] = mk_b(r[4], r[5]); f[3] = mk_b(r[6], r[7]); }
__device__ __forceinline__ void scan_phase(const Frame& F, const Args& a) {
    using namespace sc;
    const bf16* RB = (const bf16*)(a.ws + WS_R); const bf16* KB = (const bf16*)(a.ws + WS_K); const bf16* VB = (const bf16*)(a.ws + WS_V); const bf16* LP = (const bf16*)(a.ws + WS_LP);
    LAS unsigned char* L = F.lds + RING_OFF;
    const int l = F.lane, lr = l & 15, g = l >> 4;
    for (int chain = blockIdx.x; chain < 256; chain += F.G) {
        const int b = chain >> 4, h = (chain >> 1) & 7, dir = chain & 1;
        bf16* Yg = (bf16*)a.out + (dir ? (size_t)MX * RW : 0);
        float* SBTg = (float*)(a.ws + WS_SBT);
        if (F.tid < 256 + 16) ((LAS unsigned*)(L + ZERO_OFF))[F.tid] = 0u;
        if (F.tid >= 64 && F.tid < 320) { const int i_ = F.tid - 64, k_ = h * 64 + (i_ & 63);
            ((LAS float*)(L + KC_OFF))[i_] = i_ < 64 ? a.in[I_KK][k_] : i_ < 128 ? a.in[I_KA][k_] : i_ < 192 ? a.in[I_RK][k_] * a.in[I_KA][k_] : (dir == 0 ? a.in[I_RK][k_] * (2.0f - 2.0f * a.in[I_KA][k_]) : 0.f); }
        __syncthreads();
        if (F.wave >= 4) {
            const int p = F.wave - 4;
            LAS unsigned char* PV = L + PRIVP + p * PRIVP_B;
            const int t1 = l >> 2, kq = l & 3, hc1 = h * 64 + 16 * kq;
            v4u raw[10];
#define SC_PREFETCH(cc) do { const int m_ = scan_row((cc) * C + t1, b, dir); const GAS v4u* q0 = (const GAS v4u*)(RB + (size_t)m_ * RW + hc1); const GAS v4u* q1 = (const GAS v4u*)(KB + (size_t)m_ * RW + hc1); const GAS v4u* q2 = (const GAS v4u*)(VB + (size_t)m_ * RW + hc1); \
                const GAS v4u* q3 = (const GAS v4u*)(LP + (size_t)m_ * LN + dir * 512 + hc1); const GAS v4u* q4 = (const GAS v4u*)(LP + (size_t)m_ * LN + 1024 + dir * 512 + hc1); \
                raw[0] = __builtin_nontemporal_load(q0); raw[1] = __builtin_nontemporal_load(q0 + 1); raw[2] = __builtin_nontemporal_load(q1); raw[3] = __builtin_nontemporal_load(q1 + 1); raw[4] = __builtin_nontemporal_load(q2); raw[5] = __builtin_nontemporal_load(q2 + 1); \
                raw[6] = __builtin_nontemporal_load(q3); raw[7] = __builtin_nontemporal_load(q3 + 1); raw[8] = __builtin_nontemporal_load(q4); raw[9] = __builtin_nontemporal_load(q4 + 1); } while (0)
            if (p < NCHUNK) SC_PREFETCH(p);
            volatile LAS unsigned* RDY = (volatile LAS unsigned*)(L + FLAG_OFF); volatile LAS unsigned* DONE = RDY + NSLOT;
            for (int c = p; c < NCHUNK; c += 4) {
                if (c >= NSLOT) { unsigned spins = 0; while (*DONE < 4u * (unsigned)(c - NSLOT + 1)) { __builtin_amdgcn_s_sleep(2); if (++spins > (1u << 22)) break; } asm volatile("" ::: "memory"); }
#pragma unroll 1
                for (int f = 1; f <= 3; ++f) {
                {
                    LAS unsigned char* SL = L + (c % NSLOT) * SLOT_B;
                    if (f == 1) {
                        float r16[16], k16[16], e16[16], a16[16];
                        { float t8[8]; unpk8(raw[0], t8); for (int e = 0; e < 8; ++e) r16[e] = t8[e]; unpk8(raw[1], t8); for (int e = 0; e < 8; ++e) r16[8 + e] = t8[e];
                          unpk8(raw[2], t8); for (int e = 0; e < 8; ++e) k16[e] = t8[e]; unpk8(raw[3], t8); for (int e = 0; e < 8; ++e) k16[8 + e] = t8[e];
                          unpk8(raw[6], t8); for (int e = 0; e < 8; ++e) e16[e] = t8[e]; unpk8(raw[7], t8); for (int e = 0; e < 8; ++e) e16[8 + e] = t8[e];
                          unpk8(raw[8], t8); for (int e = 0; e < 8; ++e) a16[e] = t8[e]; unpk8(raw[9], t8); for (int e = 0; e < 8; ++e) a16[8 + e] = t8[e]; }
                        const int ro = t1 * RS + kq * 32;
                        *(LAS v4u*)(SL + O_VT + ro) = raw[4]; *(LAS v4u*)(SL + O_VT + ro + 16) = raw[5];
#pragma unroll
                        for (int e4 = 0; e4 < 4; ++e4) *(LAS f32x4*)(PV + O_EW + t1 * ES + kq * 64 + e4 * 16) = (f32x4){e16[4 * e4], e16[4 * e4 + 1], e16[4 * e4 + 2], e16[4 * e4 + 3]};
                        if (c + 4 < NCHUNK) SC_PREFETCH(c + 4);
                        float kkc[16], kac[16];
#pragma unroll
                        for (int e4 = 0; e4 < 4; ++e4) { const f32x4 q0 = *(const LAS f32x4*)(L + KC_OFF + (16 * kq + 4 * e4) * 4), q1 = *(const LAS f32x4*)(L + KC_OFF + 256 + (16 * kq + 4 * e4) * 4);
#pragma unroll
                            for (int e = 0; e < 4; ++e) { kkc[4 * e4 + e] = q0[e]; kac[4 * e4 + e] = q1[e]; } }
                        float kk16[16], nb16[16], kd16[16]; float ss = 0.f;
#pragma unroll
                        for (int e = 0; e < 16; ++e) { kk16[e] = k16[e] * kkc[e]; ss += kk16[e] * kk16[e]; }
                        ss = dpp_add<0xB1>(ss); ss = dpp_add<0x4E>(ss);
                        const float rn = 1.0f / sqrtf(fmaxf(ss, 1e-24f));
#pragma unroll
                        for (int e = 0; e < 16; ++e) { kk16[e] *= rn; nb16[e] = -kk16[e] * a16[e]; }
                        { float sb = 0.f;
#pragma unroll
                          for (int e4 = 0; e4 < 4; ++e4) { const f32x4 q2 = *(const LAS f32x4*)(L + KC_OFF + 512 + (16 * kq + 4 * e4) * 4), q3 = *(const LAS f32x4*)(L + KC_OFF + 768 + (16 * kq + 4 * e4) * 4);
#pragma unroll
                              for (int e = 0; e < 4; ++e) { const int x = 4 * e4 + e; const float ka_ = k16[x] * a16[x]; kd16[x] = k16[x] + (ka_ - k16[x]) * kac[x]; sb += (r16[x] * k16[x]) * (q2[e] * a16[x] + q3[e]); } }
                          sb = dpp_add<0xB1>(sb); sb = dpp_add<0x4E>(sb);
                          if (c >= CTXCHUNK && kq == 0) SBTg[((size_t)scan_row(c * C + t1, b, dir) * 8 + h) * 4 + 1 + dir] = sb; }
                        asm volatile("s_waitcnt lgkmcnt(0)" ::: "memory");
                        {
                          LAS float* Ep = (LAS float*)(PV + O_EW) + l; float cs = 0.f;
#pragma unroll
                          for (int t = 0; t < 16; ++t) { cs += Ep[t * (ES / 4)]; Ep[t * (ES / 4)] = cs; }
                          ((LAS float*)(SL + O_LC))[l] = __expf(cs); }
                        asm volatile("s_waitcnt lgkmcnt(0)" ::: "memory");
                        unsigned pP[8], pR[8], pN[8], pD[8], pNP[8], pDP[8];
#pragma unroll
                        for (int e4 = 0; e4 < 4; ++e4) { const f32x4 cs4 = *(const LAS f32x4*)(PV + O_EW + t1 * ES + kq * 64 + e4 * 16);
                            const f32x4 cm4 = *(const LAS f32x4*)(L + (t1 > 0 ? PRIVP + p * PRIVP_B + O_EW + (t1 - 1) * ES + kq * 64 + e4 * 16 : ZERO_OFF)); const f32x4 lc4 = *(const LAS f32x4*)(SL + O_LC + kq * 64 + e4 * 16);
                            float vP[4], vR[4], vN[4], vD[4], vNP[4], vDP[4];
#pragma unroll
                            for (int e = 0; e < 4; ++e) { const int x = 4 * e4 + e; const float pc = __expf(cs4[e]), pm = __expf(cm4[e]), ic = __builtin_amdgcn_rcpf(pc);
                                vP[e] = kk16[x] * pm; vR[e] = r16[x] * pc; vN[e] = nb16[x] * ic; vD[e] = kd16[x] * ic; vNP[e] = vN[e] * lc4[e]; vDP[e] = vD[e] * lc4[e]; }
                            pP[2 * e4] = cvtpk(vP[0], vP[1]); pP[2 * e4 + 1] = cvtpk(vP[2], vP[3]); pR[2 * e4] = cvtpk(vR[0], vR[1]); pR[2 * e4 + 1] = cvtpk(vR[2], vR[3]);
                            pN[2 * e4] = cvtpk(vN[0], vN[1]); pN[2 * e4 + 1] = cvtpk(vN[2], vN[3]); pD[2 * e4] = cvtpk(vD[0], vD[1]); pD[2 * e4 + 1] = cvtpk(vD[2], vD[3]);
                            pNP[2 * e4] = cvtpk(vNP[0], vNP[1]); pNP[2 * e4 + 1] = cvtpk(vNP[2], vNP[3]); pDP[2 * e4] = cvtpk(vDP[0], vDP[1]); pDP[2 * e4 + 1] = cvtpk(vDP[2], vDP[3]); }
                        *(LAS v4u*)(SL + O_P + ro) = (v4u){pP[0], pP[1], pP[2], pP[3]}; *(LAS v4u*)(SL + O_P + ro + 16) = (v4u){pP[4], pP[5], pP[6], pP[7]};
                        *(LAS v4u*)(SL + O_RT + ro) = (v4u){pR[0], pR[1], pR[2], pR[3]}; *(LAS v4u*)(SL + O_RT + ro + 16) = (v4u){pR[4], pR[5], pR[6], pR[7]};
                        *(LAS v4u*)(PV + O_NN + ro) = (v4u){pN[0], pN[1], pN[2], pN[3]}; *(LAS v4u*)(PV + O_NN + ro + 16) = (v4u){pN[4], pN[5], pN[6], pN[7]};
                        *(LAS v4u*)(PV + O_DD + ro) = (v4u){pD[0], pD[1], pD[2], pD[3]}; *(LAS v4u*)(PV + O_DD + ro + 16) = (v4u){pD[4], pD[5], pD[6], pD[7]};
                        *(LAS v4u*)(SL + O_NPT + ro) = (v4u){pNP[0], pNP[1], pNP[2], pNP[3]}; *(LAS v4u*)(SL + O_NPT + ro + 16) = (v4u){pNP[4], pNP[5], pNP[6], pNP[7]};
                        *(LAS v4u*)(SL + O_DPT + ro) = (v4u){pDP[0], pDP[1], pDP[2], pDP[3]}; *(LAS v4u*)(SL + O_DPT + ro + 16) = (v4u){pDP[4], pDP[5], pDP[6], pDP[7]};
                    } else if (f == 2) {
                        bf16x8v_ ap[2], ar[2], bn[2], bd[2];
#pragma unroll
                        for (int ks = 0; ks < 2; ++ks) { const int o = lr * RS + ks * 64 + g * 16; ap[ks] = *(const LAS bf16x8v_*)(SL + O_P + o); ar[ks] = *(const LAS bf16x8v_*)(SL + O_RT + o); bn[ks] = *(const LAS bf16x8v_*)(PV + O_NN + o); bd[ks] = *(const LAS bf16x8v_*)(PV + O_DD + o); }
                        f32x4 cN = {0.f, 0.f, 0.f, 0.f}, cDm = cN, cNr = cN, cDr = cN;
#pragma unroll
                        for (int ks = 0; ks < 2; ++ks) { cN = __builtin_amdgcn_mfma_f32_16x16x32_bf16(ap[ks], bn[ks], cN, 0, 0, 0); cDm = __builtin_amdgcn_mfma_f32_16x16x32_bf16(ap[ks], bd[ks], cDm, 0, 0, 0);
                            cNr = __builtin_amdgcn_mfma_f32_16x16x32_bf16(ar[ks], bn[ks], cNr, 0, 0, 0); cDr = __builtin_amdgcn_mfma_f32_16x16x32_bf16(ar[ks], bd[ks], cDr, 0, 0, 0); }
                        *(LAS f32x4*)(PV + O_NF + (lr * 16 + 4 * g) * 4) = (f32x4){lr < 4 * g ? cN[0] : 0.f, lr < 4 * g + 1 ? cN[1] : 0.f, lr < 4 * g + 2 ? cN[2] : 0.f, lr < 4 * g + 3 ? cN[3] : 0.f};
#pragma unroll
                        for (int r = 0; r < 4; ++r) { const int t = 4 * g + r, j = lr; const bool lo = j < t, le = j <= t;
                            ((LAS unsigned short*)(SL + O_DM))[t * 16 + j] = tobf1(lo ? cDm[r] : 0.f); ((LAS unsigned short*)(SL + O_NR))[t * 16 + j] = tobf1(le ? cNr[r] : 0.f); ((LAS unsigned short*)(SL + O_DR))[t * 16 + j] = tobf1(le ? cDr[r] : 0.f); }
                    } else {
                        const LAS f32x4* NFTp = (const LAS f32x4*)(PV + O_NF); float acc[16];
#pragma unroll
                        for (int t = 0; t < 16; ++t) acc[t] = (t == lr) ? 1.0f : 0.0f;
                        f32x4 col[4];
#pragma unroll
                        for (int q4 = 0; q4 < 4; ++q4) col[q4] = NFTp[q4];
#pragma unroll
                        for (int j = 0; j < 16; ++j) { const float Lj = acc[j]; ((LAS unsigned short*)(SL + O_LINV))[j * 16 + lr] = tobf1(Lj);
                            f32x4 nxt[4];
                            if (j + 1 < 16) {
#pragma unroll
                                for (int q4 = 0; q4 < 4; ++q4) nxt[q4] = NFTp[(j + 1) * 4 + q4]; }
#pragma unroll
                            for (int t = j + 1; t < 16; ++t) acc[t] += col[t >> 2][t & 3] * Lj;
                            if (j + 1 < 16) {
#pragma unroll
                                for (int q4 = 0; q4 < 4; ++q4) col[q4] = nxt[q4]; } }
                    }
                }
                asm volatile("s_waitcnt lgkmcnt(0)" ::: "memory");
                }
                if (l == 0) RDY[c % NSLOT] = (unsigned)(c + 1);
            }
#undef SC_PREFETCH
        } else {
            const int w = F.wave, irow = 16 * w + lr, q = lr >> 2, pp = l & 3;
            f32x4 S[4];
#pragma unroll
            for (int kt = 0; kt < 4; ++kt) S[kt] = (f32x4){0.f, 0.f, 0.f, 0.f};
            volatile LAS unsigned* RDY = (volatile LAS unsigned*)(L + FLAG_OFF); LAS unsigned* DONE = (LAS unsigned*)(L + FLAG_OFF) + NSLOT;
            const unsigned ldsb_ = (unsigned)(size_t)L, lanetr_ = (unsigned)((4 * g + q) * RS + 8 * pp);
            for (int c = 0; c < NCHUNK; ++c) {
                { unsigned spins = 0; while (RDY[c % NSLOT] != (unsigned)(c + 1)) { __builtin_amdgcn_s_sleep(1); if (++spins > (1u << 22)) break; } asm volatile("" ::: "memory"); }
                {
                    LAS unsigned char* SL = L + (c % NSLOT) * SLOT_B; const unsigned slb_ = ldsb_ + (unsigned)((c % NSLOT) * SLOT_B);
                    asm volatile("s_nop 7" : "+v"(S[0]), "+v"(S[1]), "+v"(S[2]), "+v"(S[3]));
                    bf16x8v_ bS[2], aP[2], aR[2];
#pragma unroll
                    for (int ks = 0; ks < 2; ++ks) { bS[ks] = __builtin_bit_cast(bf16x8v_, (v4u){cvtpk(S[2 * ks][0], S[2 * ks][1]), cvtpk(S[2 * ks][2], S[2 * ks][3]), cvtpk(S[2 * ks + 1][0], S[2 * ks + 1][1]), cvtpk(S[2 * ks + 1][2], S[2 * ks + 1][3])});
                        const int o = lr * RS + (32 * ks + 4 * g) * 2;
                        aP[ks] = mk_b(*(const LAS v2u*)(SL + O_P + o), *(const LAS v2u*)(SL + O_P + o + 32)); aR[ks] = mk_b(*(const LAS v2u*)(SL + O_RT + o), *(const LAS v2u*)(SL + O_RT + o + 32)); }
                    const v2u z2 = {0u, 0u}; const int o16 = lr * 32 + g * 8;
                    const bf16x8v_ aDm = mk_b(*(const LAS v2u*)(SL + O_DM + o16), z2), aNr = mk_b(*(const LAS v2u*)(SL + O_NR + o16), z2), aDr = mk_b(*(const LAS v2u*)(SL + O_DR + o16), z2), aLi = mk_b(*(const LAS v2u*)(SL + O_LINV + o16), z2);
                    v2u trv, trn[4], trd[4];
                    asm volatile("ds_read_b64_tr_b16 %0, %9\n\t"
                                 "ds_read_b64_tr_b16 %1, %10\n\tds_read_b64_tr_b16 %2, %10 offset:32\n\tds_read_b64_tr_b16 %3, %10 offset:64\n\tds_read_b64_tr_b16 %4, %10 offset:96\n\t"
                                 "ds_read_b64_tr_b16 %5, %11\n\tds_read_b64_tr_b16 %6, %11 offset:32\n\tds_read_b64_tr_b16 %7, %11 offset:64\n\tds_read_b64_tr_b16 %8, %11 offset:96\n\ts_waitcnt lgkmcnt(0)"
                                 : "=&v"(trv), "=&v"(trn[0]), "=&v"(trn[1]), "=&v"(trn[2]), "=&v"(trn[3]), "=&v"(trd[0]), "=&v"(trd[1]), "=&v"(trd[2]), "=&v"(trd[3])
                                 : "v"(slb_ + (unsigned)(O_VT + 32 * w) + lanetr_), "v"(slb_ + (unsigned)O_NPT + lanetr_), "v"(slb_ + (unsigned)O_DPT + lanetr_) : "memory");
                    const bf16x8v_ bV = mk_b(trv, z2);
                    f32x4 W = {0.f, 0.f, 0.f, 0.f};
                    W = __builtin_amdgcn_mfma_f32_16x16x32_bf16(aP[0], bS[0], W, 0, 0, 0); W = __builtin_amdgcn_mfma_f32_16x16x32_bf16(aP[1], bS[1], W, 0, 0, 0); W = __builtin_amdgcn_mfma_f32_16x16x32_bf16(aDm, bV, W, 0, 0, 0);
                    asm volatile("s_nop 7\n\ts_nop 7" : "+v"(W));
                    const bf16x8v_ bW = __builtin_bit_cast(bf16x8v_, (v4u){cvtpk(W[0], W[1]), cvtpk(W[2], W[3]), 0u, 0u});
                    f32x4 Z = {0.f, 0.f, 0.f, 0.f};
                    Z = __builtin_amdgcn_mfma_f32_16x16x32_bf16(aLi, bW, Z, 0, 0, 0);
                    asm volatile("s_nop 7\n\ts_nop 7" : "+v"(Z));
                    const bf16x8v_ bZ = __builtin_bit_cast(bf16x8v_, (v4u){cvtpk(Z[0], Z[1]), cvtpk(Z[2], Z[3]), 0u, 0u});
                    if (c >= CTXCHUNK) {
                        f32x4 Y = {0.f, 0.f, 0.f, 0.f};
                        Y = __builtin_amdgcn_mfma_f32_16x16x32_bf16(aR[0], bS[0], Y, 0, 0, 0); Y = __builtin_amdgcn_mfma_f32_16x16x32_bf16(aR[1], bS[1], Y, 0, 0, 0);
                        Y = __builtin_amdgcn_mfma_f32_16x16x32_bf16(aNr, bZ, Y, 0, 0, 0); Y = __builtin_amdgcn_mfma_f32_16x16x32_bf16(aDr, bV, Y, 0, 0, 0);
#pragma unroll
                        for (int r = 0; r < 4; ++r) { const int m = scan_row(c * C + 4 * g + r, b, dir); Yg[(size_t)m * RW + h * 64 + irow] = tobf(Y[r]); }
                    }
#pragma unroll
                    for (int kt = 0; kt < 4; ++kt) { const f32x4 lc = *(const LAS f32x4*)(SL + O_LC + (16 * kt + 4 * g) * 4);
                        f32x4 sv = S[kt] * lc; sv = __builtin_amdgcn_mfma_f32_16x16x32_bf16(mk_b(trn[kt], z2), bZ, sv, 0, 0, 0); sv = __builtin_amdgcn_mfma_f32_16x16x32_bf16(mk_b(trd[kt], z2), bV, sv, 0, 0, 0); S[kt] = sv; }
                }
                asm volatile("s_waitcnt lgkmcnt(0)" ::: "memory");
                if (l == 0) __hip_atomic_fetch_add(DONE, 1u, __ATOMIC_RELAXED, __HIP_MEMORY_SCOPE_WORKGROUP);
            }
        }
        __syncthreads();
    }
}
__device__ __forceinline__ void rwkv_out_phase(const Frame& F, const Args& a) {
    const bf16* RB = (const bf16*)(a.ws + WS_R); const bf16* KB = (const bf16*)(a.ws + WS_K); const bf16* VB = (const bf16*)(a.ws + WS_V); const bf16* LP = (const bf16*)(a.ws + WS_LP); bf16* O = (bf16*)(a.ws + WS_FXO) + 512;
    const bf16* YF = (const bf16*)a.out; const bf16* YBk = (const bf16*)a.out + (size_t)MX * RW;
    const int gw = F.vcu * NWAVES + F.wave, NGW = F.G * NWAVES, col = 8 * F.lane;
    float lg[8], lb[8];
#pragma unroll
    for (int e = 0; e < 8; ++e) { lg[e] = a.in[I_LNG][col + e]; lb[e] = a.in[I_LNB][col + e]; }
    const float* SBT = (const float*)(a.ws + WS_SBT);
    v4u ryf, ryb, rv, rg; f32x4 rsb;
#define RO_LOAD(m_) do { ryf = __builtin_nontemporal_load((const GAS v4u*)(YF + (size_t)(m_) * RW + col)); ryb = __builtin_nontemporal_load((const GAS v4u*)(YBk + (size_t)(m_) * RW + col)); \
        rv = __builtin_nontemporal_load((const GAS v4u*)(VB + (size_t)(m_) * RW + col)); rg = __builtin_nontemporal_load((const GAS v4u*)(LP + (size_t)(m_) * LN + 2048 + col)); \
        rsb = __builtin_nontemporal_load((const GAS f32x4*)(SBT + ((size_t)(m_) * 8 + (F.lane >> 3)) * 4)); } while (0)
    if (gw < MX) RO_LOAD(gw);
    for (int m = gw; m < MX; m += NGW) {
        float y[8], v[8], gg[8], o[8];
        { float yb8[8]; unpk8(ryf, y); unpk8(ryb, yb8);
#pragma unroll
          for (int e = 0; e < 8; ++e) y[e] += yb8[e]; }
        unpk8(rv, v); unpk8(rg, gg);
        const f32x4 sb4 = rsb;
        if (m + NGW < MX) RO_LOAD(m + NGW);
        float s = 0.f;
#pragma unroll
        for (int e = 0; e < 8; ++e) s += y[e];
        const float mean = red8(s) * (1.0f / 64.0f);
        float qv = 0.f; const float bs = sb4[1] + sb4[2];
#pragma unroll
        for (int e = 0; e < 8; ++e) { y[e] -= mean; qv += y[e] * y[e]; }
        const float rstd = 1.0f / sqrtf(red8(qv) * (1.0f / 64.0f) + GN_EPS);
#pragma unroll
        for (int e = 0; e < 8; ++e) o[e] = ((y[e] * rstd * lg[e] + lb[e]) + bs * v[e]) * gg[e];
        *(GAS v4u*)(O + (size_t)m * 1024 + col) = pk8(o);
    }
#undef RO_LOAD
}
__global__ void __launch_bounds__(NWAVES * 64, 2) mk_fwd(Args args) {
    extern __shared__ __attribute__((aligned(16))) unsigned char lds[];
    Frame F;
    F.lds = (LAS unsigned char*)lds;
    F.MISC = (volatile LAS unsigned*)(F.lds + MISC_OFF);
    F.tid = threadIdx.x; F.lane = F.tid & 63; F.wave = __builtin_amdgcn_readfirstlane(F.tid >> 6);
    F.G = gridDim.x; { const int bx = blockIdx.x; F.vcu = (F.G % 8 == 0) ? (bx % 8) * (F.G / 8) + bx / 8 : bx; }
    F.ctl = (gu32*)(args.ws + WS_CTL);
    for (int u = F.tid; u < (LDS_BYTES - LDSCTL_OFF) / 4; u += NWAVES * 64) ((LAS unsigned*)(F.lds + LDSCTL_OFF))[u] = 0u;
    __syncthreads();
    XcdBarrier bar; bar.bar = (unsigned*)(F.ctl + CW_BAR); bar.x = 0; bar.st = nullptr;
    if (N_LAUNCHES == 1) bar = xcd_barrier_post((unsigned*)(F.ctl + CW_BAR), F.MISC + 8);
    if (N_LAUNCHES == 1 && threadIdx.x == 0 && (bar.x != (blockIdx.x & 7u) || (gridDim.x & 7u) != 0u)) (void)xb_add((unsigned*)(F.ctl + CW_BADMAP), 1u);
#define GRID_BAR() do { if (N_LAUNCHES == 1) xcd_barrier(bar); } while (0)
    const int lo = args.ph_lo, hi = args.ph_hi;
#define IN(k) (refresh_tid(F), lo <= (k) && (k) < hi)
#define INP(k) (lo <= (k) && (k) < hi)
#define SEAM(k) do { if (INP(k) && INP((k) + 1)) GRID_BAR(); } while (0)
#define SEAM_L(k) do { if (INP(k) && INP((k) + 1)) { if (N_LAUNCHES == 1) { if (F.MISC[10]) xcd_barrier_local(bar); else xcd_barrier(bar); } } } while (0)
#define WSP(T, off) ((T*)(args.ws + (off)))
#define MOD WSP(float, WS_MOD)
#define Win_t WSP(bf16, WS_WIN)
#define Wlora_t WSP(bf16, WS_WLORA)
#define Wupf_t WSP(bf16, WS_WUPF)
#define Wupr_t WSP(bf16, WS_WUPR)
#define Wout_t WSP(bf16, WS_WOUT)
#define Wgu_t WSP(bf16, WS_WGU)
#define Wdown_t WSP(bf16, WS_WDOWN)
#define HX WSP(bf16, WS_HX)
#define PXR WSP(bf16, WS_PXR)
#define Z3 WSP(bf16, WS_Z3)
#define GF WSP(bf16, WS_GF)
#define GR WSP(bf16, WS_GR)
#define Y2 ((bf16*)((unsigned char*)args.out + 32 * MiB))
#define FX WSP(bf16, WS_FXO)
#define AL ((bf16*)args.out)
#define LP WSP(bf16, WS_LP)
#define MB WSP(bf16, WS_MB)
#define HX2 WSP(bf16, WS_HX2)
#define ACT WSP(bf16, WS_ACT)
    const int gw = F.vcu * NWAVES + F.wave, NGW = F.G * NWAVES;
    using EpiIn1 = pg8::EpiIn<WS_Z3, WS_GF, WS_GR, WS_R, WS_EB>;

    for (int rep_ = 0; rep_ < 1 + ((MK_REPEAT >> 0) & 1); ++rep_)
    if (IN(0)) { p0_weights(F, args); } SEAM(0);
    if (N_LAUNCHES == 1) {
        if (threadIdx.x == 0) F.MISC[10] = (xb_ld((unsigned*)(F.ctl + CW_BADMAP)) == 0u) ? 1u : 0u;
        __syncthreads(); }
    for (int rep_ = 0; rep_ < 1 + ((MK_REPEAT >> 1) & 1); ++rep_)
    if (IN(1)) {
        { constexpr int RPW = (MT + 2047) / 2048; const int rpw = (MT + NGW - 1) / NGW; (void)RPW; const int m0 = gw * rpw, m1 = (m0 + rpw < MT) ? m0 + rpw : MT; norm_mod_rows<0>(args, m0, m1, args.in[I_N1G], HX, F.lane); }
    } SEAM(1);
    for (int rep_ = 0; rep_ < 1 + ((MK_REPEAT >> 2) & 1); ++rep_)
    if (IN(2)) {
        { pg8::Gemm g{HX, Win_t, MX, NIN, D}; pg8::StaticOrder S; S.init(MX, NIN, F.G, (int)blockIdx.x); EpiIn1 E{args.ws, (bf16*)args.out, args.in[I_MUP], args.in[I_MUN], (LAS float*)(F.lds + XB_OFF), 0};
          pg8::gemm_phase<EpiIn1, pg8::StaticOrder, true, true>(F.lds + RING_OFF, g, S, E); }
        { pg8::Gemm g{HX + (size_t)MX * D, Win_t, MC, RPAD, D}; pg8::StaticOrder S; S.init(MC, RPAD, F.G, (int)blockIdx.x); EpiIn1 E{args.ws, (bf16*)args.out, args.in[I_MUP], args.in[I_MUN], (LAS float*)(F.lds + XB_OFF), MX};
          pg8::gemm_phase<EpiIn1, pg8::StaticOrder, true, true>(F.lds + RING_OFF, g, S, E); }
    } SEAM(2);
    for (int rep_ = 0; rep_ < 1 + ((MK_REPEAT >> 3) & 1); ++rep_)
    if (IN(3)) { edge_rows(F, args); dft_pass_a(F, Z3, Y2); } SEAM(3);
    for (int rep_ = 0; rep_ < 1 + ((MK_REPEAT >> 7) & 1); ++rep_)
    if (IN(7)) { dft_pass_b(F, Y2, FX); __syncthreads();
        pg8::Gemm g{AL, Wlora_t, MT, LN, LK}; pg8::StaticOrder S; S.init(MT, LN, F.G, (int)blockIdx.x); pg8::EpiLora E{LP, WSP(const float, WS_LB)};
        pg8::gemm_phase<pg8::EpiLora, pg8::StaticOrder, true, true>(F.lds + RING_OFF, g, S, E); } SEAM(7);
    for (int rep_ = 0; rep_ < 1 + ((MK_REPEAT >> 8) & 1); ++rep_)
    if (IN(8)) { scan_phase(F, args); } SEAM(8);
    for (int rep_ = 0; rep_ < 1 + ((MK_REPEAT >> 9) & 1); ++rep_)
    if (IN(9)) { rwkv_out_phase(F, args); } SEAM(9);
    for (int rep_ = 0; rep_ < 1 + ((MK_REPEAT >> 10) & 1); ++rep_)
    if (IN(10)) { pg8::Gemm g{FX, Wupf_t, MX, D, D}; pg8::StaticOrder S; S.init(MX, D, F.G, (int)blockIdx.x); pg8::EpiMerge2 E{MB, GF, GR};
        pg8::gemm_phase<pg8::EpiMerge2, pg8::StaticOrder, true, true>(F.lds + RING_OFF, g, S, E); } SEAM_L(10);
    for (int rep_ = 0; rep_ < 1 + ((MK_REPEAT >> 11) & 1); ++rep_)
    if (IN(11)) { pg8::Gemm g{MB, Wout_t, MX, D, D}; pg8::StaticOrder S; S.init(MX, D, F.G, (int)blockIdx.x); pg8::EpiDelta E{WSP(bf16, WS_D1), MOD + 2048};
        pg8::gemm_phase<pg8::EpiDelta, pg8::StaticOrder, true, true>(F.lds + RING_OFF, g, S, E); } SEAM_L(11);
    for (int rep_ = 0; rep_ < 1 + ((MK_REPEAT >> 12) & 1); ++rep_)
    if (IN(12)) {
        p_weights2(F, args);
        { const int rpw = (MX + NGW - 1) / NGW; const int m0 = gw * rpw, m1 = (m0 + rpw < MX) ? m0 + rpw : MX; norm_mod_rows<1>(args, m0, m1, args.in[I_N2G], HX2, F.lane); }
    } SEAM(12);
    for (int rep_ = 0; rep_ < 1 + ((MK_REPEAT >> 13) & 1); ++rep_)
    if (IN(13)) { pg8::Gemm g{HX2, Wgu_t, MX, 2 * DFF, D}; pg8::StaticOrder S; S.init(MX, 2 * DFF, F.G, (int)blockIdx.x); pg8::EpiSwiglu E{ACT};
        pg8::gemm_phase<pg8::EpiSwiglu, pg8::StaticOrder, true, true>(F.lds + RING_OFF, g, S, E); } SEAM_L(13);
    for (int rep_ = 0; rep_ < 1 + ((MK_REPEAT >> 14) & 1); ++rep_)
    if (IN(14)) { pg8::Gemm g{ACT, Wdown_t, MX, D, DFF}; pg8::StaticOrder S; S.init(MX, D, F.G, (int)blockIdx.x); pg8::EpiDelta E{WSP(bf16, WS_D2), MOD + 5120};
        pg8::gemm_phase<pg8::EpiDelta, pg8::StaticOrder, true, true>(F.lds + RING_OFF, g, S, E); } SEAM_L(14);
    for (int rep_ = 0; rep_ < 1 + ((MK_REPEAT >> 15) & 1); ++rep_)
    if (IN(15)) {
        const int wpx = (F.G % 8 == 0) ? NGW / 8 : NGW, rpx = (F.G % 8 == 0) ? MX / 8 : MX, xg = gw / wpx, lw = gw % wpx;
        f32x4 px[4]; v2u pd1[4], pd2[4];
#define FN_LOAD(m_) do { const GAS f32x4* xin = (const GAS f32x4*)(args.in[I_X] + (size_t)(m_) * D) + F.lane; const GAS v2u* dr = (const GAS v2u*)(WSP(bf16, WS_D2) + (size_t)(m_) * D) + F.lane; \
            const GAS v2u* d1r = (const GAS v2u*)(WSP(bf16, WS_D1) + (size_t)(m_) * D) + F.lane; \
            _Pragma("unroll") for (int j = 0; j < 4; ++j) { px[j] = __builtin_nontemporal_load(xin + 64 * j); pd1[j] = __builtin_nontemporal_load(d1r + 64 * j); pd2[j] = __builtin_nontemporal_load(dr + 64 * j); } } while (0)
        const int mbeg = xg * rpx + lw, mend = (xg + 1) * rpx;
        if (mbeg < mend) FN_LOAD(mbeg);
        for (int m = mbeg; m < mend; m += wpx) {
            GAS f32x4* xr = (GAS f32x4*)(args.out + (size_t)m * D) + F.lane; f32x4 v[4]; float s2 = 0.f;
#pragma unroll
            for (int j = 0; j < 4; ++j) { const v2u dd = pd2[j], d1 = pd1[j]; v[j] = (px[j] + (f32x4){bflo(d1.x), bfhi(d1.x), bflo(d1.y), bfhi(d1.y)}) + (f32x4){bflo(dd.x), bfhi(dd.x), bflo(dd.y), bfhi(dd.y)}; s2 += (v[j].x * v[j].x + v[j].y * v[j].y) + (v[j].z * v[j].z + v[j].w * v[j].w); }
            if (m + wpx < mend) FN_LOAD(m + wpx);
            const float rstd = 1.0f / sqrtf(wave_sum(s2) * (1.f / D) + NORM_EPS);
#pragma unroll
            for (int j = 0; j < 4; ++j) xr[64 * j] = (v[j] * rstd) * ((const f32x4*)args.in[I_FNG])[F.lane + 64 * j];
        }
#undef FN_LOAD
    }
#undef IN
#undef SEAM
#undef GRID_BAR
}

extern "C" void kernel_launch(void* const* d_in, const int* in_sizes, int n_in, void* d_out, int out_size, void* d_ws, size_t ws_size, hipStream_t stream) {
    static int grid = 0;
    if (grid == 0) {
        if (n_in != 31 || in_sizes[0] != MX * D || out_size != MX * D || ws_size < WS_END) { fprintf(stderr, "kernel_launch: shape/workspace mismatch (n_in %d, in0 %d, out %d, ws %zu); nothing launched\n", n_in, n_in > 0 ? in_sizes[0] : -1, out_size, ws_size); grid = -1; return; }
        int dev = 0, cus = 0;
        if (hipGetDevice(&dev) != hipSuccess || hipDeviceGetAttribute(&cus, hipDeviceAttributeMultiprocessorCount, dev) != hipSuccess) { grid = -1; return; }
        if (hipFuncSetAttribute((const void*)mk_fwd, hipFuncAttributeMaxDynamicSharedMemorySize, LDS_BYTES) != hipSuccess) { fprintf(stderr, "kernel_launch: hipFuncSetAttribute failed\n"); grid = -1; return; }
        (void)hipGetLastError();
        grid = cus;
    }
    if (grid < 0) return;
    if (hipMemsetAsync((char*)d_ws + WS_CTL, 0, CTL_ZERO_BYTES, stream) != hipSuccess) return;
    Args a{};
    for (int i = 0; i < 31; ++i) a.in[i] = (const float*)d_in[i];
    a.out = (float*)d_out; a.ws = (unsigned char*)d_ws;
    if (N_LAUNCHES == 1) { a.ph_lo = 0; a.ph_hi = NPH; a.li = 0; hipLaunchKernelGGL(mk_fwd, dim3(grid), dim3(NWAVES * 64), LDS_BYTES, stream, a); }
    else for (int p = 0; p < NPH; ++p) { a.ph_lo = p; a.ph_hi = p + 1; a.li = p; hipLaunchKernelGGL(mk_fwd, dim3(grid), dim3(NWAVES * 64), LDS_BYTES, stream, a); }
}
```

```cpp
#include <hip/hip_runtime.h>
#include <cstdio>
#include <cstdint>
#ifndef MK_REPEAT
#define MK_REPEAT 0x0
#endif
#ifndef MK_N_LAUNCHES
#define MK_N_LAUNCHES 1
#endif
namespace pg8 {
#define PG8_LAS __attribute__((address_space(3)))
typedef unsigned short bf16_t;
typedef short bf16x8 __attribute__((ext_vector_type(8)));
typedef float f32x4 __attribute__((ext_vector_type(4)));
typedef unsigned u32x4 __attribute__((ext_vector_type(4)));
constexpr int BM = 256, BK = 64, HALF = 128, HTB = HALF * BK * 2  , STAGE_BYTES = 8 * HTB, NXCD = 8, WGM = 8;

__host__ __device__ __forceinline__ int lds_byte(int r, int c) { const int st = (r >> 4) * 2 + (c >> 5), rr = r & 15, cc = c & 31, ob = rr * 64 + cc * 2; return st * 1024 + (ob ^ (((ob >> 9) & 1) << 5)); }
__host__ __device__ __forceinline__ void stage_rc(int b, int& R, int& C) { const int st = b / 1024, sb = b % 1024, swz = sb ^ (((sb >> 9) & 1) << 5); R = (st >> 1) * 16 + swz / 64; C = (st & 1) * 32 + (swz % 64) / 2; }
__host__ __device__ __forceinline__ int perm32(int rho) { const int n = rho >> 4, i = rho & 15; return 8 * (i >> 2) + 4 * n + (i & 3); }

struct Unit { int pm, pn; };
struct Gemm { const bf16_t* A; const bf16_t* Bt; int M, N, K; };

struct StaticOrder {
    int nM, nN, nwg, G, c;
    __host__ __device__ void init(int M, int N, int G_, int c_) { nM = M / BM; nN = N / BM; nwg = nM * nN; G = G_; c = c_; }
    __host__ __device__ bool next(int i, Unit& u) const {
        const long L = (long)i * G + c; if (L >= nwg) return false;
        int wgid = (int)L; { const int q = nwg / NXCD, r = nwg % NXCD, xcd = wgid % NXCD, off = wgid / NXCD; wgid = (xcd < r ? xcd * (q + 1) : r * (q + 1) + (xcd - r) * q) + off; }
        const int nig = WGM * nN, gid = wgid / nig, fm = gid * WGM, gsz = (nM - fm) < WGM ? (nM - fm) : WGM;
        u.pm = fm + ((wgid % nig) % gsz); u.pn = (wgid % nig) / gsz; return true;
    }
    __device__ __forceinline__ void a_ready(const Unit&) const {}
    __device__ __forceinline__ void done(const Unit&) const {}
};

__device__ __forceinline__ unsigned cvt_pk_bf16(float lo, float hi) { unsigned r; asm volatile("v_cvt_pk_bf16_f32 %0, %1, %2" : "=v"(r) : "v"(lo), "v"(hi)); return r; }
__device__ __forceinline__ float bf_lo(unsigned w) { return __uint_as_float(w << 16); }
__device__ __forceinline__ float bf_hi(unsigned w) { return __uint_as_float(w & 0xffff0000u); }
__device__ __forceinline__ float sigm(float x) { return __builtin_amdgcn_rcpf(1.0f + __expf(-x)); }
__device__ __forceinline__ f32x4 sigm4(f32x4 v) { return (f32x4){sigm(v[0]), sigm(v[1]), sigm(v[2]), sigm(v[3])}; }
__device__ __forceinline__ u32x4 pack8(f32x4 v0, f32x4 v1) { u32x4 w; w.x = cvt_pk_bf16(v0[0], v0[1]); w.y = cvt_pk_bf16(v0[2], v0[3]); w.z = cvt_pk_bf16(v1[0], v1[1]); w.w = cvt_pk_bf16(v1[2], v1[3]); return w; }
__device__ __forceinline__ void unpack8(u32x4 w, f32x4& v0, f32x4& v1) { v0 = (f32x4){bf_lo(w.x), bf_hi(w.x), bf_lo(w.y), bf_hi(w.y)}; v1 = (f32x4){bf_lo(w.z), bf_hi(w.z), bf_lo(w.w), bf_hi(w.w)}; }
template <int CTRL> __device__ __forceinline__ float dpp_rot(float src) { return __int_as_float(__builtin_amdgcn_mov_dpp(__float_as_int(src), CTRL, 0xF, 0xF, true)); }
template <size_t O_Z3, size_t O_GF, size_t O_GR, size_t O_R, size_t O_EB> struct EpiIn {
    static constexpr bool PERM = true, AFTER_DRAIN = false, HAS_MID = false; static constexpr int KSLICE = 0; static constexpr bool SKIP_B1 = true, HAS_PRE = true;
    static __device__ __forceinline__ bool skip_b1(int pn) { return pn == 7; }
    static constexpr size_t RKV_STRIDE = (size_t)36 * 1024 * 1024 / 2;
    unsigned char* ws; bf16_t* al; const float* mup; const float* mun; PG8_LAS float* xb; int row_off;
    __device__ __forceinline__ void pre(const Unit& u, int ui, int wid, int lane) const {
        if (u.pn >= 8) return;
        const int t = wid * 64 + lane, col = 256 * u.pn + (t & 255);
        const float* src = (t < 256 ? mup : mun) + (col < 1920 ? col : 0);
        __builtin_amdgcn_global_load_lds((const unsigned*)src, (PG8_LAS unsigned*)(xb + 2048 + (ui & 1) * 512 + wid * 64), 4, 0, 0);
    }
    __device__ __forceinline__ void operator()(const f32x4 (&acc)[2][2][4][2], const Unit& u, int wr, int wc, int fr, int fq, int ui) const {
        const int pn = u.pn;
        if (pn >= 8) {
            const int row0 = row_off + u.pm * BM + wr * 64 + fr;
            if (pn < 10) {
                bf16_t* base = (bf16_t*)(ws + O_Z3); const int col0 = (pn - 8) * 256 + wc * 32 + 8 * fq;
#pragma unroll
                for (int ai = 0; ai < 2; ++ai)
#pragma unroll
                    for (int m = 0; m < 4; ++m) { bf16_t* rowp = base + (size_t)(row0 + ai * HALF + m * 16) * 512 + col0;
#pragma unroll
                        for (int bj = 0; bj < 2; ++bj) *(u32x4*)(rowp + bj * HALF) = pack8(acc[ai][bj][m][0], acc[ai][bj][m][1]); }
            } else {
                bf16_t* gq = (bf16_t*)(ws + O_GF); bf16_t* gr = (bf16_t*)(ws + O_GR); const int col0 = (pn - 10) * 128 + wc * 32 + 8 * fq;
#pragma unroll
                for (int ai = 0; ai < 2; ++ai)
#pragma unroll
                    for (int m = 0; m < 4; ++m) { const size_t off = (size_t)(row0 + ai * HALF + m * 16) * 1024 + col0;
                        f32x4 qv[2], sv[2];
#pragma unroll
                        for (int n = 0; n < 2; ++n)
#pragma unroll
                            for (int e = 0; e < 4; ++e) { const float ef = __expf(-acc[ai][0][m][n][e]), er1 = 1.0f + __expf(-acc[ai][1][m][n][e]);
                                sv[n][e] = __builtin_amdgcn_rcpf(er1); qv[n][e] = __builtin_amdgcn_rcpf(1.0f + ef) * fminf(er1, 1e20f); }
                        *(u32x4*)(gq + off) = pack8(qv[0], qv[1]); *(u32x4*)(gr + off) = pack8(sv[0], sv[1]); }
            }
            return;
        }
        asm volatile("" : "+v"(fr), "+v"(fq));
        const int cw = wc * 32 + 8 * fq, tile = (row_off >> 8) + u.pm;
        float* eb = (float*)(ws + O_EB); bf16_t* rkv = (bf16_t*)(ws + O_R);
#pragma unroll
        for (int ai = 0; ai < 2; ++ai)
#pragma unroll
            for (int bj = 0; bj < 2; ++bj)
#pragma unroll
                for (int n = 0; n < 2; ++n) { PG8_LAS float* p0 = xb + ((2 * ai + wr) * 2) * 256 + 128 * bj + cw + 4 * n;
                    if (fr == 0) *(PG8_LAS f32x4*)p0 = acc[ai][bj][0][n];
                    if (fr == 15) *(PG8_LAS f32x4*)(p0 + 256) = acc[ai][bj][3][n]; }
        if (wr == 0 && fr < 2) {
#pragma unroll
            for (int bj = 0; bj < 2; ++bj)
#pragma unroll
                for (int n = 0; n < 2; ++n) *(f32x4*)(eb + ((size_t)tile * 4 + fr) * 2048 + 256 * pn + 128 * bj + cw + 4 * n) = acc[0][bj][0][n]; }
        if (wr == 1 && fr >= 14) {
#pragma unroll
            for (int bj = 0; bj < 2; ++bj)
#pragma unroll
                for (int n = 0; n < 2; ++n) *(f32x4*)(eb + ((size_t)tile * 4 + 2 + (fr - 14)) * 2048 + 256 * pn + 128 * bj + cw + 4 * n) = acc[1][bj][3][n]; }
        asm volatile("s_waitcnt lgkmcnt(0)" ::: "memory"); __builtin_amdgcn_s_barrier(); asm volatile("" ::: "memory");
        bf16_t* dst; int ldd, dcol;
        if (pn < 6) { dst = rkv + (size_t)(pn >> 1) * RKV_STRIDE; ldd = 512; dcol = (pn & 1) * 256; } else { dst = al; ldd = 384; dcol = (pn - 6) * 256; }
#pragma unroll
        for (int bj = 0; bj < 2; ++bj) {
            if (pn == 7 && bj == 1) continue;
            const int act = (pn == 6 && bj == 0) ? 1 : (pn == 7) ? 2 : 0;
            const PG8_LAS float* tab = xb + 2048 + (ui & 1) * 512 + 128 * bj + cw;
            const bool f0 = fr == 0, f15 = fr == 15; const f32x4 z4 = {0.f, 0.f, 0.f, 0.f};
#pragma unroll
            for (int ai = 0; ai < 2; ++ai) { const int q = 2 * ai + wr;
                unsigned pk[4][2][2];
#pragma unroll
                for (int n = 0; n < 2; ++n) {
                    const f32x4 mp = *(const PG8_LAS f32x4*)(tab + 4 * n), mn = *(const PG8_LAS f32x4*)(tab + 256 + 4 * n);
                    const f32x4 w0 = 1.0f - mp - mn, mpA = f0 ? z4 : mp, mpB = f0 ? mp : z4, mnA = f15 ? z4 : mn, mnB = f15 ? mn : z4;
                    f32x4 xp = z4, xn = z4;
                    if (q > 0) xp = *(const PG8_LAS f32x4*)(xb + ((q - 1) * 2 + 1) * 256 + 128 * bj + cw + 4 * n);
                    if (q < 3) xn = *(const PG8_LAS f32x4*)(xb + ((q + 1) * 2) * 256 + 128 * bj + cw + 4 * n);
                    f32x4 R1[4], L1[4];
#pragma unroll
                    for (int m = 0; m < 4; ++m)
#pragma unroll
                        for (int e = 0; e < 4; ++e) { R1[m][e] = dpp_rot<0x121>(acc[ai][bj][m][n][e]); L1[m][e] = dpp_rot<0x12F>(acc[ai][bj][m][n][e]); }
#pragma unroll
                    for (int m = 0; m < 4; ++m) {
                        f32x4 uu = w0 * acc[ai][bj][m][n] + mpA * R1[m] + mpB * (m > 0 ? R1[m > 0 ? m - 1 : 0] : xp) + mnA * L1[m] + mnB * (m < 3 ? L1[m < 3 ? m + 1 : 3] : xn);
                        if (act == 1) uu = 2.0f * sigm4(2.0f * uu) - 1.0f; else if (act == 2) uu = sigm4(uu);
                        pk[m][n][0] = cvt_pk_bf16(uu[0], uu[1]); pk[m][n][1] = cvt_pk_bf16(uu[2], uu[3]); }
                }
#pragma unroll
                for (int m = 0; m < 4; ++m) *(u32x4*)(dst + (size_t)(row_off + u.pm * BM + 128 * ai + 64 * wr + 16 * m + fr) * ldd + dcol + 128 * bj + cw) = (u32x4){pk[m][0][0], pk[m][0][1], pk[m][1][0], pk[m][1][1]};
            }
        }
    }
};
struct EpiLora {
    static constexpr bool PERM = true, AFTER_DRAIN = false, HAS_MID = false; static constexpr int KSLICE = 128; static constexpr bool SKIP_B1 = false, HAS_PRE = false;
    bf16_t* lp; const float* bias;
    static __device__ __forceinline__ int koff(int pn) { const int t = pn >> 1; return t >= 4 ? 256 : (t >= 2 ? 128 : 0); }
    __device__ __forceinline__ void operator()(const f32x4 (&acc)[2][2][4][2], const Unit& u, int wr, int wc, int fr, int fq) const {
        const int pn = u.pn, t = pn >> 1;
        const int row0 = u.pm * BM + wr * 64 + fr, col0 = pn * 256 + wc * 32 + 8 * fq;
        const float sc = t < 2 ? -0.6065306597f : 1.0f;
#pragma unroll
        for (int bj = 0; bj < 2; ++bj) { const f32x4 b0 = *(const f32x4*)(bias + col0 + bj * HALF), b1 = *(const f32x4*)(bias + col0 + bj * HALF + 4);
#pragma unroll
            for (int ai = 0; ai < 2; ++ai)
#pragma unroll
                for (int m = 0; m < 4; ++m) { f32x4 v0 = acc[ai][bj][m][0] + b0, v1 = acc[ai][bj][m][1] + b1;
                    if (t < 4) { v0 = sigm4(v0) * sc; v1 = sigm4(v1) * sc; }
                    *(u32x4*)(lp + (size_t)(row0 + ai * HALF + m * 16) * 2560 + col0 + bj * HALF) = pack8(v0, v1); } }
    }
};
struct EpiMerge2 {
    static constexpr bool PERM = true, AFTER_DRAIN = false, HAS_MID = true; static constexpr int KSLICE = 0; static constexpr bool SKIP_B1 = false, HAS_PRE = false;
    bf16_t* mb; const bf16_t* gf; const bf16_t* gr;
    __device__ __forceinline__ void mid(f32x4 (&acc)[2][2][4][2], const Unit& u, int wr, int wc, int fr, int fq) const {
        asm volatile("" : "+v"(fr), "+v"(fq));
        const int row0 = u.pm * BM + wr * 64 + fr, col0 = u.pn * BM + wc * 32 + 8 * fq;
        constexpr int DEPTH = 8;
        u32x4 fw[DEPTH];
#define PG8_GOFF(it_) ((size_t)(row0 + ((it_) >> 3) * HALF + (((it_) >> 1) & 3) * 16) * 1024 + col0 + ((it_) & 1) * HALF)
#pragma unroll
        for (int d = 0; d < DEPTH; ++d) fw[d] = *(const u32x4*)(gf + PG8_GOFF(d));
#pragma unroll
        for (int it = 0; it < 16; ++it) { const int ai = it >> 3, m = (it >> 1) & 3, bj = it & 1, sl = it % DEPTH;
            const u32x4 fwc = fw[sl];
            asm volatile("" ::: "memory");
            if (it + DEPTH < 16) fw[sl] = *(const u32x4*)(gf + PG8_GOFF(it + DEPTH));
            asm volatile("" ::: "memory");
            acc[ai][bj][m][0][0] *= bf_lo(fwc.x); acc[ai][bj][m][0][1] *= bf_hi(fwc.x); acc[ai][bj][m][0][2] *= bf_lo(fwc.y); acc[ai][bj][m][0][3] *= bf_hi(fwc.y);
            acc[ai][bj][m][1][0] *= bf_lo(fwc.z); acc[ai][bj][m][1][1] *= bf_hi(fwc.z); acc[ai][bj][m][1][2] *= bf_lo(fwc.w); acc[ai][bj][m][1][3] *= bf_hi(fwc.w); }
    }
    __device__ __forceinline__ void operator()(const f32x4 (&acc)[2][2][4][2], const Unit& u, int wr, int wc, int fr, int fq) const {
        const int row0 = u.pm * BM + wr * 64 + fr, col0 = u.pn * BM + wc * 32 + 8 * fq;
        constexpr int DEPTH = 8;
        u32x4 rw[DEPTH];
#pragma unroll
        for (int d = 0; d < DEPTH; ++d) rw[d] = *(const u32x4*)(gr + PG8_GOFF(d));
#pragma unroll
        for (int it = 0; it < 16; ++it) { const int ai = it >> 3, m = (it >> 1) & 3, bj = it & 1, sl = it % DEPTH;
            const u32x4 rwc = rw[sl];
            asm volatile("" ::: "memory");
            if (it + DEPTH < 16) rw[sl] = *(const u32x4*)(gr + PG8_GOFF(it + DEPTH));
            asm volatile("" ::: "memory");
            f32x4 g0, g1; unpack8(rwc, g0, g1);
#pragma unroll
            for (int e = 0; e < 4; ++e) { g0[e] = fmaxf(g0[e], 1e-20f); g1[e] = fmaxf(g1[e], 1e-20f); }
            *(u32x4*)(mb + PG8_GOFF(it)) = pack8(g0 * acc[ai][bj][m][0], g1 * acc[ai][bj][m][1]); }
#undef PG8_GOFF
    }
};
struct EpiResid {
    static constexpr bool PERM = false, AFTER_DRAIN = false, HAS_MID = false; static constexpr int KSLICE = 0; static constexpr bool SKIP_B1 = false, HAS_PRE = false;
    const float* base; float* out; const float* gate;
    __device__ __forceinline__ void operator()(const f32x4 (&acc)[2][2][4][2], const Unit& u, int wr, int wc, int fr, int fq) const {
        const int row0 = u.pm * BM + wr * 64 + fr, col0 = u.pn * BM + wc * 32 + 4 * fq; const float* gp = gate + (size_t)(u.pm >> 3) * 6144 + col0;
        f32x4 gv[2][2];
#pragma unroll
        for (int bj = 0; bj < 2; ++bj)
#pragma unroll
            for (int n = 0; n < 2; ++n) gv[bj][n] = *(const f32x4*)(gp + bj * HALF + n * 16);
        f32x4 cur[2][2], nxt[2][2];
#pragma unroll
        for (int bj = 0; bj < 2; ++bj)
#pragma unroll
            for (int n = 0; n < 2; ++n) cur[bj][n] = *(const f32x4*)(base + (size_t)row0 * 1024 + col0 + bj * HALF + n * 16);
#pragma unroll
        for (int g8 = 0; g8 < 8; ++g8) { const int ai = g8 >> 2, m = g8 & 3; const size_t off = (size_t)(row0 + ai * HALF + m * 16) * 1024 + col0;
            if (g8 + 1 < 8) { const int ai2 = (g8 + 1) >> 2, m2 = (g8 + 1) & 3; const size_t off2 = (size_t)(row0 + ai2 * HALF + m2 * 16) * 1024 + col0;
#pragma unroll
                for (int bj = 0; bj < 2; ++bj)
#pragma unroll
                    for (int n = 0; n < 2; ++n) nxt[bj][n] = *(const f32x4*)(base + off2 + bj * HALF + n * 16); }
            asm volatile("" ::: "memory");
#pragma unroll
            for (int bj = 0; bj < 2; ++bj)
#pragma unroll
                for (int n = 0; n < 2; ++n) *(f32x4*)(out + off + bj * HALF + n * 16) = cur[bj][n] + gv[bj][n] * acc[ai][bj][m][n];
            asm volatile("" ::: "memory");
#pragma unroll
            for (int bj = 0; bj < 2; ++bj)
#pragma unroll
                for (int n = 0; n < 2; ++n) cur[bj][n] = nxt[bj][n];
        }
    }
};
struct EpiDelta {
    static constexpr bool PERM = true, AFTER_DRAIN = false, HAS_MID = false; static constexpr int KSLICE = 0; static constexpr bool SKIP_B1 = false, HAS_PRE = false;
    bf16_t* dlt; const float* gate;
    __device__ __forceinline__ void operator()(const f32x4 (&acc)[2][2][4][2], const Unit& u, int wr, int wc, int fr, int fq) const {
        const int row0 = u.pm * BM + wr * 64 + fr, col0 = u.pn * BM + wc * 32 + 8 * fq; const float* gp = gate + (size_t)(u.pm >> 3) * 6144 + col0;
        f32x4 gv[2][2];
#pragma unroll
        for (int bj = 0; bj < 2; ++bj)
#pragma unroll
            for (int n = 0; n < 2; ++n) gv[bj][n] = *(const f32x4*)(gp + bj * HALF + 4 * n);
#pragma unroll
        for (int ai = 0; ai < 2; ++ai)
#pragma unroll
            for (int m = 0; m < 4; ++m) { bf16_t* rowp = dlt + (size_t)(row0 + ai * HALF + m * 16) * 1024 + col0;
#pragma unroll
                for (int bj = 0; bj < 2; ++bj) *(u32x4*)(rowp + bj * HALF) = pack8(acc[ai][bj][m][0] * gv[bj][0], acc[ai][bj][m][1] * gv[bj][1]); }
    }
};
struct EpiSwiglu {
    static constexpr bool PERM = true, AFTER_DRAIN = false, HAS_MID = false; static constexpr int KSLICE = 0; static constexpr bool SKIP_B1 = false, HAS_PRE = false;
    bf16_t* act;
    __device__ __forceinline__ void operator()(const f32x4 (&acc)[2][2][4][2], const Unit& u, int wr, int wc, int fr, int fq) const {
        const int row0 = u.pm * BM + wr * 64 + fr, col0 = u.pn * 128 + wc * 32 + 8 * fq;
#pragma unroll
        for (int ai = 0; ai < 2; ++ai)
#pragma unroll
            for (int m = 0; m < 4; ++m) { const f32x4 g0 = acc[ai][0][m][0], g1 = acc[ai][0][m][1];
                *(u32x4*)(act + (size_t)(row0 + ai * HALF + m * 16) * 2816 + col0) = pack8(g0 * sigm4(g0) * acc[ai][1][m][0], g1 * sigm4(g1) * acc[ai][1][m][1]); }
    }
};

template <class Epi, class Sched, bool ALIGN_EPI = false, bool SP2 = false>
__device__ __forceinline__ void gemm_phase(PG8_LAS unsigned char* lds, const Gemm g, const Sched& S, const Epi& E) {
    int tid_ = threadIdx.x; asm volatile("" : "+v"(tid_));
    const int tid = tid_, wid = __builtin_amdgcn_readfirstlane(tid >> 6), lane = tid & 63, wr = wid >> 2, wc = wid & 3, fr = lane & 15, fq = lane >> 4;
    int nt_ = Epi::KSLICE ? Epi::KSLICE / BK : g.K / BK; asm volatile("" : "+s"(nt_));
    const int K = g.K, nt = nt_;
    unsigned voffA[2], voffB[2];
#pragma unroll
    for (int i = 0; i < 2; ++i) { int R, C; stage_rc(tid * 16 + i * 8192, R, C); const int Rb = Epi::PERM ? ((R & ~31) + perm32(R & 31)) : R;
        voffA[i] = (unsigned)(R * K + C) * 2u; voffB[i] = (unsigned)(Rb * K + C) * 2u; }
    const size_t kstep = (size_t)(BK * 2);
    const size_t hstep = (size_t)HALF * K * 2;
    const size_t tstep = 2 * hstep;
    const unsigned ldsw = (unsigned)wid * 1024u;
    const int aoff = lds_byte(wr * 64 + fr, fq * 8), boff = lds_byte(wc * 32 + fr, fq * 8);
#define PG8_SA(b, h) (((b) * 2 + (h)) * HTB)
#define PG8_SB(b, h) ((4 + (b) * 2 + (h)) * HTB)
#define PG8_STAGE(bufoff, gbase, voff) do { _Pragma("unroll") for (int _i = 0; _i < 2; ++_i) \
        __builtin_amdgcn_global_load_lds((const unsigned*)((const char*)(gbase) + (voff)[_i]), (PG8_LAS unsigned*)(lds + (bufoff) + ldsw + _i * 8192), 16, 0, 0); } while (0)
#define PG8_LDA(dst, b, h) do { _Pragma("unroll") for (int m = 0; m < 4; ++m) _Pragma("unroll") for (int k = 0; k < 2; ++k) dst[m][k] = *(const PG8_LAS bf16x8*)(lds + PG8_SA(b, h) + aoff + m * 2048 + k * 1024); } while (0)
#define PG8_LDB(dst, b, h) do { _Pragma("unroll") for (int n = 0; n < 2; ++n) _Pragma("unroll") for (int k = 0; k < 2; ++k) dst[n][k] = *(const PG8_LAS bf16x8*)(lds + PG8_SB(b, h) + boff + n * 2048 + k * 1024); } while (0)
#define PG8_MMA(ai, bj, At, Bt) do { __builtin_amdgcn_s_setprio(1); _Pragma("unroll") for (int m = 0; m < 4; ++m) _Pragma("unroll") for (int n = 0; n < 2; ++n) _Pragma("unroll") for (int k = 0; k < 2; ++k) \
        acc[ai][bj][m][n] = __builtin_amdgcn_mfma_f32_16x16x32_bf16(Bt[n][k], At[m][k], acc[ai][bj][m][n], 0, 0, 0); __builtin_amdgcn_s_setprio(0); } while (0)
#define PG8_MMA1(ai, At) do { if constexpr (Epi::SKIP_B1) { if (!skb) PG8_MMA(ai, 1, At, B1); } else PG8_MMA(ai, 1, At, B1); } while (0)
#define PG8_WAIT_V(n) asm volatile("s_waitcnt vmcnt(" #n ")" ::: "memory")
#define PG8_WAIT_L(n) asm volatile("s_waitcnt lgkmcnt(" #n ")" ::: "memory")
#define PG8_BAR __builtin_amdgcn_s_barrier()
#define PG8_SCHED __builtin_amdgcn_sched_barrier(0)
    Unit cur, nxt; int ui = 0;
    if (!S.next(0, cur)) return;
    bool skb = false; if constexpr (Epi::SKIP_B1) skb = Epi::skip_b1(cur.pn);
    if constexpr (Epi::HAS_PRE) E.pre(cur, 0, wid, lane);
    f32x4 acc[2][2][4][2];
#pragma unroll
    for (int a = 0; a < 2; ++a)
#pragma unroll
        for (int b = 0; b < 2; ++b)
#pragma unroll
            for (int m = 0; m < 4; ++m)
#pragma unroll
                for (int n = 0; n < 2; ++n) acc[a][b][m][n] = (f32x4){0.f, 0.f, 0.f, 0.f};
    bf16x8 At[4][2], B0[2][2], B1[2][2];
    const char* cA = (const char*)g.A + (size_t)cur.pm * tstep; const char* cB = (const char*)g.Bt + (size_t)cur.pn * tstep;
    if constexpr (Epi::KSLICE != 0) { const int ko = Epi::koff(cur.pn) * 2; cA += ko; cB += ko; }
    S.a_ready(cur);
    if constexpr (SP2) {
        PG8_STAGE(PG8_SB(0, 0), cB, voffB); PG8_STAGE(PG8_SB(0, 1), cB + hstep, voffB); PG8_STAGE(PG8_SA(0, 0), cA, voffA); PG8_STAGE(PG8_SA(0, 1), cA + hstep, voffA);
        if (wr == 1) PG8_BAR;
        PG8_WAIT_V(2); PG8_BAR;
        PG8_STAGE(PG8_SB(1, 0), cB + kstep, voffB); PG8_STAGE(PG8_SA(1, 0), cA + kstep, voffA); PG8_STAGE(PG8_SB(1, 1), cB + hstep + kstep, voffB);
        PG8_WAIT_V(6); PG8_BAR;
    } else {
        PG8_STAGE(PG8_SB(0, 0), cB, voffB); PG8_STAGE(PG8_SA(0, 0), cA, voffA); PG8_STAGE(PG8_SB(0, 1), cB + hstep, voffB); PG8_STAGE(PG8_SA(0, 1), cA + hstep, voffA);
        if (wr == 1) PG8_BAR;
        PG8_WAIT_V(4); PG8_BAR;
        PG8_STAGE(PG8_SB(1, 0), cB + kstep, voffB); PG8_STAGE(PG8_SA(1, 0), cA + kstep, voffA); PG8_STAGE(PG8_SB(1, 1), cB + hstep + kstep, voffB);
        PG8_WAIT_V(6); PG8_BAR;
    }
    for (;;) {
        const bool has_next = S.next(ui + 1, nxt);
        const char* nA = has_next ? (const char*)g.A + (size_t)nxt.pm * tstep : cA; const char* nB = has_next ? (const char*)g.Bt + (size_t)nxt.pn * tstep : cB;
        if constexpr (Epi::KSLICE != 0) { if (has_next) { const int ko = Epi::koff(nxt.pn) * 2; nA += ko; nB += ko; } }
#pragma unroll 1
        for (int t = 0; t < nt; t += 2) {
            const bool last = (t == nt - 2);
            const char* a1 = cA + (size_t)(t + 1) * kstep;
            const char* a2 = last ? nA : cA + (size_t)(t + 2) * kstep; const char* b2 = last ? nB : cB + (size_t)(t + 2) * kstep;
            const char* a3 = a2 + kstep; const char* b3 = b2 + kstep;
            if (last && has_next) S.a_ready(nxt);
            if constexpr (SP2) {
            PG8_LDB(B0, 0, 0); PG8_LDB(B1, 0, 1); PG8_SCHED; PG8_LDA(At, 0, 0); PG8_STAGE(PG8_SA(1, 1), a1 + hstep, voffA);
            PG8_WAIT_V(8); PG8_WAIT_L(0); PG8_BAR; PG8_MMA(0, 0, At, B0); PG8_MMA1(0, At); PG8_BAR; PG8_SCHED;
            PG8_LDA(At, 0, 1); PG8_STAGE(PG8_SB(0, 0), b2, voffB); PG8_STAGE(PG8_SB(0, 1), b2 + hstep, voffB); PG8_STAGE(PG8_SA(0, 0), a2, voffA);
            PG8_WAIT_V(8); PG8_WAIT_L(0); PG8_BAR; PG8_MMA(1, 0, At, B0); PG8_MMA1(1, At); PG8_BAR; PG8_SCHED;
            PG8_LDB(B0, 1, 0); PG8_LDB(B1, 1, 1); PG8_SCHED; PG8_LDA(At, 1, 0); PG8_STAGE(PG8_SA(0, 1), a2 + hstep, voffA);
            PG8_WAIT_V(8); PG8_WAIT_L(0); PG8_BAR; PG8_MMA(0, 0, At, B0); PG8_MMA1(0, At); PG8_BAR; PG8_SCHED;
            PG8_LDA(At, 1, 1); PG8_STAGE(PG8_SB(1, 0), b3, voffB); PG8_STAGE(PG8_SB(1, 1), b3 + hstep, voffB); PG8_STAGE(PG8_SA(1, 0), a3, voffA);
            PG8_WAIT_V(8); PG8_WAIT_L(0); PG8_BAR; PG8_MMA(1, 0, At, B0); PG8_MMA1(1, At); PG8_BAR; PG8_SCHED;
            } else {
            PG8_LDB(B0, 0, 0); PG8_SCHED; PG8_LDA(At, 0, 0); PG8_STAGE(PG8_SA(1, 1), a1 + hstep, voffA);
            PG8_WAIT_L(8); PG8_BAR; PG8_WAIT_L(0); PG8_MMA(0, 0, At, B0); PG8_BAR; PG8_SCHED;
            PG8_LDB(B1, 0, 1); PG8_STAGE(PG8_SB(0, 0), b2, voffB);
            PG8_BAR; PG8_WAIT_L(0); PG8_MMA(0, 1, At, B1); PG8_BAR;
            PG8_LDA(At, 0, 1); PG8_STAGE(PG8_SA(0, 0), a2, voffA);
            PG8_BAR; PG8_WAIT_L(0); PG8_MMA(1, 0, At, B0); PG8_BAR; PG8_SCHED;
            PG8_STAGE(PG8_SB(0, 1), b2 + hstep, voffB);
            PG8_WAIT_V(6); PG8_BAR; PG8_MMA(1, 1, At, B1); PG8_BAR;
            PG8_LDB(B0, 1, 0); PG8_SCHED; PG8_LDA(At, 1, 0); PG8_STAGE(PG8_SA(0, 1), a2 + hstep, voffA);
            PG8_WAIT_L(8); PG8_BAR; PG8_WAIT_L(0); PG8_MMA(0, 0, At, B0); PG8_BAR; PG8_SCHED;
            PG8_LDB(B1, 1, 1); PG8_STAGE(PG8_SB(1, 0), b3, voffB);
            PG8_BAR; PG8_WAIT_L(0); PG8_MMA(0, 1, At, B1); PG8_BAR;
            PG8_LDA(At, 1, 1); PG8_STAGE(PG8_SA(1, 0), a3, voffA);
            PG8_BAR; PG8_WAIT_L(0); PG8_MMA(1, 0, At, B0); PG8_BAR; PG8_SCHED;
            PG8_STAGE(PG8_SB(1, 1), b3 + hstep, voffB);
            PG8_WAIT_V(6); PG8_BAR; PG8_MMA(1, 1, At, B1); PG8_BAR;
            }
            if constexpr (Epi::HAS_MID) { if (t == (nt >> 1) - 2) {
                if constexpr (ALIGN_EPI) { if (wr == 0) PG8_BAR; }
                E.mid(acc, cur, wr, wc, fr, fq);
                if constexpr (ALIGN_EPI) { if (wr == 1) PG8_BAR; } } }
        }
        if constexpr (ALIGN_EPI) { if (wr == 0) PG8_BAR; }
        if constexpr (!Epi::AFTER_DRAIN) { if constexpr (Epi::HAS_PRE) E(acc, cur, wr, wc, fr, fq, ui); else E(acc, cur, wr, wc, fr, fq); S.done(cur); }
        if (!has_next) break;
#pragma unroll
        for (int a = 0; a < 2; ++a)
#pragma unroll
            for (int b = 0; b < 2; ++b)
#pragma unroll
                for (int m = 0; m < 4; ++m)
#pragma unroll
                    for (int n = 0; n < 2; ++n) acc[a][b][m][n] = (f32x4){0.f, 0.f, 0.f, 0.f};
        cur = nxt; cA = nA; cB = nB; ++ui; if constexpr (Epi::SKIP_B1) skb = Epi::skip_b1(cur.pn);
        if constexpr (Epi::HAS_PRE) E.pre(cur, ui, wid, lane);
        if constexpr (ALIGN_EPI) { if (wr == 1) PG8_BAR; }
    }
    PG8_WAIT_V(0);
    if constexpr (!ALIGN_EPI) { if (wr == 0) PG8_BAR; }
    PG8_BAR;
    if constexpr (Epi::AFTER_DRAIN) { E.fused(acc, cur, wr, wc, fr, fq, lds, wid, lane); S.done(cur); }
#undef PG8_SA
#undef PG8_SB
#undef PG8_STAGE
#undef PG8_LDA
#undef PG8_LDB
#undef PG8_MMA
#undef PG8_MMA1
#undef PG8_WAIT_V
#undef PG8_WAIT_L
#undef PG8_BAR
#undef PG8_SCHED
}
}
constexpr int NWAVES = 8;
constexpr int N_LAUNCHES = MK_N_LAUNCHES;
constexpr int NPH = 16;
constexpr int D = 1024, NB = 16, SEQ = 2048, CTXL = 256, MX = NB * SEQ, MC = NB * CTXL, MT = MX + MC;
constexpr int RW = 512, NH = 8, HD = 64, RCOLS = 1920, RPAD = 2048, INCOLS = 4480, NIN = 4608, DFF = 2816, LK = 384, LN = 2560, MODW = 6144;
constexpr float NORM_EPS = 1e-6f, GN_EPS = 64e-5f;
constexpr size_t MiB = 1u << 20;
constexpr size_t WS_CTL = 0, CTL_ZERO_BYTES = 64 * 1024;
constexpr size_t WS_MOD = 1 * MiB, WS_LB = WS_MOD + 512 * 1024;
constexpr size_t WS_WIN = 2 * MiB, WS_WLORA = 12 * MiB, WS_WUPF = 14 * MiB, WS_WUPR = 15 * MiB, WS_WOUT = 16 * MiB;
constexpr size_t WS_A = 18 * MiB, WS_B = 82 * MiB, WS_C = 146 * MiB, WS_D = 210 * MiB, WS_E = 390 * MiB, WS_END = 512 * MiB;
constexpr size_t WS_GF = WS_A, WS_HX2 = WS_A, WS_GR = WS_B, WS_WGU = WS_E, WS_WDOWN = WS_E + 11 * MiB, WS_D1 = WS_B, WS_D2 = WS_A;
constexpr size_t WS_Z3 = WS_C, WS_FXO = WS_C;
constexpr size_t WS_PXR = WS_D, WS_LP = WS_D, WS_MB = WS_D, WS_ACT = WS_D;
constexpr size_t WS_EB = WS_E + 114 * MiB;
constexpr size_t WS_HX = WS_D, WS_Y2 = WS_E, WS_R = WS_E, WS_K = WS_E + 36 * MiB, WS_V = WS_E + 72 * MiB, WS_SBT = WS_E + 110 * MiB;
static_assert(WS_K - WS_R == 36 * MiB && WS_V - WS_K == 36 * MiB, "EpiIn::RKV_STRIDE");
static_assert(WS_LP + (size_t)MT * LN * 2 <= WS_E && WS_ACT + (size_t)MX * DFF * 2 <= WS_E && WS_V + (size_t)MT * RW * 2 <= WS_END && WS_HX + (size_t)MT * D * 2 <= WS_END, "d_ws map");
constexpr int CW_TMO = 0, CW_BAR = 4096, CW_BADMAP = 8192;
constexpr int RING_OFF = 0, RING_BYTES = 131072, LDSCTL_OFF = RING_BYTES, MISC_OFF = LDSCTL_OFF + 320, LDS_BYTES = 147456;
constexpr int XB_OFF = RING_BYTES + 4096;

#define GAS __attribute__((address_space(1)))
#define LAS __attribute__((address_space(3)))
typedef unsigned short bf16;
typedef unsigned v4u __attribute__((ext_vector_type(4)));
typedef unsigned v2u __attribute__((ext_vector_type(2)));
typedef float f32x4 __attribute__((ext_vector_type(4)));
typedef GAS unsigned gu32;
#define RLX_AGENT __ATOMIC_RELAXED, __HIP_MEMORY_SCOPE_AGENT
#define LDS_WAIT() asm volatile("s_waitcnt lgkmcnt(0)" ::: "memory")
#define VM_WAIT() asm volatile("s_waitcnt vmcnt(0)" ::: "memory")
__device__ __forceinline__ unsigned f2bf(float f) { unsigned u = __builtin_bit_cast(unsigned, f); return (u + 0x7fffu + ((u >> 16) & 1u)) >> 16; }
__device__ __forceinline__ unsigned pk2(float lo, float hi) { return f2bf(lo) | (f2bf(hi) << 16); }
__device__ __forceinline__ float bflo(unsigned w) { return __uint_as_float(w << 16); }
__device__ __forceinline__ float bfhi(unsigned w) { return __uint_as_float(w & 0xffff0000u); }
__device__ __forceinline__ float sigf(float x) { return 1.0f / (1.0f + __expf(-x)); }
__device__ __forceinline__ void unpk8(v4u w, float (&f)[8]) { f[0] = bflo(w.x); f[1] = bfhi(w.x); f[2] = bflo(w.y); f[3] = bfhi(w.y); f[4] = bflo(w.z); f[5] = bfhi(w.z); f[6] = bflo(w.w); f[7] = bfhi(w.w); }
__device__ __forceinline__ v4u pk8(const float (&f)[8]) { v4u o; o.x = pk2(f[0], f[1]); o.y = pk2(f[2], f[3]); o.z = pk2(f[4], f[5]); o.w = pk2(f[6], f[7]); return o; }

#define XB_TMO      128
#define XB_XCNT(j)  (256  + 64 * (j))
#define XB_XSUB(j)  (1280 + 64 * (j))
#define XB_XGEN(j)  (2304 + 64 * (j))
#define XB_TOP      3328
#define XB_TOPGEN   3392
#define XCD_BAR_WORDS 3456
#define XB_SPIN_CAP (1u << 18)

__device__ __forceinline__ unsigned xb_ld(unsigned* p)              { return __hip_atomic_load(p, __ATOMIC_RELAXED, __HIP_MEMORY_SCOPE_AGENT); }
__device__ __forceinline__ unsigned xb_add(unsigned* p, unsigned v) { return __hip_atomic_fetch_add(p, v, __ATOMIC_RELAXED, __HIP_MEMORY_SCOPE_AGENT); }
__device__ __forceinline__ unsigned xb_xcc_id() { return (unsigned)__builtin_amdgcn_s_getreg((3 << 11) | 20) & 0xFu; }
#define XB_SPIN(cond, bar) do { unsigned _sp = 0; while (cond) { __builtin_amdgcn_s_sleep(1); \
    if ((++_sp & 255u) == 0u) { if (xb_ld(&(bar)[XB_TMO])) break; if (_sp > XB_SPIN_CAP) { atomicAdd(&(bar)[XB_TMO], 1u); break; } } } } while (0)

struct XcdBarrier {
    unsigned* bar; unsigned x;
    volatile LAS unsigned* st;
};

__device__ __forceinline__ XcdBarrier xcd_barrier_post(unsigned* bar, volatile LAS unsigned* st) {
    XcdBarrier b; b.bar = bar; b.x = xb_xcc_id(); b.st = st;
    if (threadIdx.x == 0) (void)xb_add(&bar[XB_XCNT(b.x)], 1u);
    return b;
}
__device__ __forceinline__ void xcd_barrier_complete(unsigned* bar, unsigned x, unsigned& nloc, unsigned& nx) {
    const unsigned G = gridDim.x * gridDim.y * gridDim.z;
    unsigned sum, cnt, mine, sp = 0u;
    for (;;) {
        sum = 0u; cnt = 0u; mine = 0u;
#pragma unroll
        for (unsigned j = 0; j < 16; ++j) { const unsigned c = xb_ld(&bar[XB_XCNT(j)]); sum += c; cnt += (c > 0u) ? 1u : 0u; mine = (j == x) ? c : mine; }
        if (sum == G) break;
        __builtin_amdgcn_s_sleep(1);
        if ((++sp & 255u) == 0u) { if (xb_ld(&bar[XB_TMO])) break; if (sp > XB_SPIN_CAP) { atomicAdd(&bar[XB_TMO], 1u); break; } }
    }
    nloc = mine > 0u ? mine : 1u; nx = cnt > 0u ? cnt : 1u;
}

__device__ __forceinline__ void xcd_barrier(const XcdBarrier& b) {
    asm volatile("s_waitcnt vmcnt(0)" ::: "memory");
    __syncthreads();
    if (threadIdx.x == 0) {
        unsigned* bar = b.bar;
        __builtin_amdgcn_s_waitcnt(0);
        unsigned nloc = b.st[0], nx = b.st[1];
        if (nloc == 0u) { xcd_barrier_complete(bar, b.x, nloc, nx); b.st[0] = nloc; b.st[1] = nx; }
        const unsigned old = xb_add(&bar[XB_XSUB(b.x)], 1u);
        const unsigned gen = old / nloc;
        if (old + 1u == (gen + 1u) * nloc) {
            __builtin_amdgcn_fence(__ATOMIC_RELEASE, "agent");
            asm volatile("s_waitcnt vmcnt(0)" ::: "memory");
            const unsigned og = xb_add(&bar[XB_TOP], 1u);
            const unsigned tg = og / nx;
            if (og + 1u == (tg + 1u) * nx) xb_add(&bar[XB_TOPGEN], 1u);
            else XB_SPIN(xb_ld(&bar[XB_TOPGEN]) == tg, bar);
            __builtin_amdgcn_fence(__ATOMIC_ACQUIRE, "agent");
            xb_add(&bar[XB_XGEN(b.x)], 1u);
            asm volatile("s_waitcnt vmcnt(0)" ::: "memory");
        } else {
            XB_SPIN(xb_ld(&bar[XB_XGEN(b.x)]) == gen, bar);
            __builtin_amdgcn_fence(__ATOMIC_ACQUIRE, "agent");
            asm volatile("s_waitcnt vmcnt(0)" ::: "memory");
        }
    }
    __syncthreads();
}
__device__ __forceinline__ void xcd_barrier_local(const XcdBarrier& b) {
    asm volatile("s_waitcnt vmcnt(0)" ::: "memory");
    __syncthreads();
    if (threadIdx.x == 0) {
        unsigned* bar = b.bar;
        __builtin_amdgcn_s_waitcnt(0);
        const unsigned nloc = b.st[0] ? b.st[0] : 1u;
        const unsigned old = xb_add(&bar[XB_XSUB(b.x)], 1u);
        const unsigned gen = old / nloc;
        if (old + 1u == (gen + 1u) * nloc) (void)xb_add(&bar[XB_XGEN(b.x)], 1u);
        else XB_SPIN(xb_ld(&bar[XB_XGEN(b.x)]) == gen, bar);
        __builtin_amdgcn_fence(__ATOMIC_ACQUIRE, "agent");
        asm volatile("s_waitcnt vmcnt(0)" ::: "memory");
    }
    __syncthreads();
}
struct Args { const float* in[31]; float* out; unsigned char* ws; int ph_lo, ph_hi, li, pad; };
enum In { I_X = 0, I_C, I_CTX, I_CCTX, I_N1G, I_N2G, I_WADA, I_BADA, I_WIN, I_MUP, I_MUN, I_W0F, I_W2F, I_A0F, I_A2F, I_W0B, I_W2B, I_A0B, I_A2B, I_G2, I_KK, I_KA, I_RK, I_LNG, I_LNB, I_WUPR, I_WUPF, I_WOUT, I_WGU, I_WDOWN, I_FNG };
struct Frame { LAS unsigned char* lds; volatile LAS unsigned* MISC; gu32* ctl; int tid, lane, wave, vcu, G; };

__device__ __forceinline__ void refresh_tid(Frame& F) { int t = threadIdx.x; asm volatile("" : "+v"(t)); F.tid = t; F.lane = t & 63; }
__device__ __forceinline__ float wave_sum(float v) {
#pragma unroll
    for (int o = 1; o < 64; o <<= 1) v += __shfl_xor(v, o);
    return v;
}
__device__ __forceinline__ float red8(float v) { v += __shfl_xor(v, 1); v += __shfl_xor(v, 2); v += __shfl_xor(v, 4); return v; }

__device__ __forceinline__ void tr_item(const float* W, int ldw, int k0, int n0, bf16* WTrow0, int ldk, LAS float* scr, int lane) {
    float tv[32];
#pragma unroll
    for (int i = 0; i < 32; ++i) tv[i] = __builtin_nontemporal_load(W + (size_t)(k0 + 2 * i + (lane >> 5)) * ldw + n0 + (lane & 31));
#pragma unroll
    for (int i = 0; i < 32; ++i) scr[(2 * i + (lane >> 5)) * 33 + (lane & 31)] = tv[i];
    LDS_WAIT(); asm volatile("" ::: "memory");
    const int c = lane & 7;
#pragma unroll
    for (int j = 0; j < 4; ++j) { const int n = (lane >> 3) + 8 * j; const LAS float* s = scr + (8 * c) * 33 + n;
        v4u o; o.x = pk2(s[0 * 33], s[1 * 33]); o.y = pk2(s[2 * 33], s[3 * 33]); o.z = pk2(s[4 * 33], s[5 * 33]); o.w = pk2(s[6 * 33], s[7 * 33]);
        *(GAS v4u*)(WTrow0 + (size_t)n * ldk + k0 + 8 * c) = o; }
    LDS_WAIT(); asm volatile("" ::: "memory");
}

__device__ __forceinline__ void p0_weights(const Frame& F, const Args& a) {
    unsigned char* ws = a.ws;
    bf16* Win_t = (bf16*)(ws + WS_WIN); bf16* Wlora_t = (bf16*)(ws + WS_WLORA); bf16* Wupf_t = (bf16*)(ws + WS_WUPF); bf16* Wupr_t = (bf16*)(ws + WS_WUPR); bf16* Wout_t = (bf16*)(ws + WS_WOUT);
    LAS float* scr = (LAS float*)(F.lds + RING_OFF + F.wave * 16384);
    const int gw = F.vcu * NWAVES + F.wave, NGW = F.G * NWAVES, lane = F.lane;
    constexpr int E0 = 960, E1 = E0 + 1280, E2 = E1 + 256, E3 = E2 + 256, E4 = E3 + 512, E5 = E4 + 128, E6 = E5 + 2560;
    for (int it = gw; it < E6; it += NGW) {
        if (it < E0) { const int kb = it / 60, nb = it % 60; tr_item(a.in[I_WIN], INCOLS, 64 * kb, 32 * nb, Win_t + (size_t)(32 * nb) * D, D, scr, lane); }
        else if (it < E1) { const int r = it - E0, kb = r / 80, nb = r % 80;
            int drow = 2048 + 32 * nb; if (nb >= 16) { const int gj = 32 * ((nb - 16) & 31); drow = 2560 + (gj >> 7) * 256 + (gj & 127) + (nb >= 48 ? 128 : 0); }
            tr_item(a.in[I_WIN] + 1920, INCOLS, 64 * kb, 32 * nb, Win_t + (size_t)drow * D, D, scr, lane); }
        else if (it < E2) { const int r = it - E1, kb = r >> 5, nb = r & 31; tr_item(a.in[I_WUPF], D, 64 * kb, 32 * nb, Wupf_t + (size_t)(32 * nb) * 1024, 1024, scr, lane); }
        else if (it < E3) { const int r = it - E2, kb = r >> 5, nb = r & 31; tr_item(a.in[I_WUPR], D, 64 * kb, 32 * nb, Wupf_t + (size_t)(32 * nb) * 1024 + 512, 1024, scr, lane); }
        else if (it < E4) { const int r = it - E3, kb = r >> 5, nb = r & 31; tr_item(a.in[I_WOUT], D, 64 * kb, 32 * nb, Wout_t + (size_t)(32 * nb) * D, D, scr, lane); }
        else if (it < E5) { const int row = RCOLS + (it - E4); GAS v4u* p = (GAS v4u*)(Win_t + (size_t)row * D + 16 * lane); p[0] = (v4u){0u, 0u, 0u, 0u}; p[1] = (v4u){0u, 0u, 0u, 0u}; }
        else { const int n = it - E5, t = n >> 9, nn = n & 511, koff = t < 4 ? 64 * t : 256, klen = t < 4 ? 64 : 128;
            const float* src = t == 0 ? a.in[I_W2F] : t == 1 ? a.in[I_W2B] : t == 2 ? a.in[I_A2F] : t == 3 ? a.in[I_A2B] : a.in[I_G2];
            float v[6];
#pragma unroll
            for (int e = 0; e < 6; ++e) { const int kk = 6 * lane + e - koff; v[e] = (kk >= 0 && kk < klen) ? src[(size_t)kk * 512 + nn] : 0.f; }
            GAS unsigned* p = (GAS unsigned*)(Wlora_t + (size_t)n * LK + 6 * lane); p[0] = pk2(v[0], v[1]); p[1] = pk2(v[2], v[3]); p[2] = pk2(v[4], v[5]); }
    }
    { constexpr int NPIECE = (LN + NWAVES * 64 - 1) / (NWAVES * 64); const bool spread = F.G >= 192 + NPIECE;
      const int p0 = spread ? (int)blockIdx.x - 192 : 0, p1 = spread ? p0 + 1 : (blockIdx.x == 0 ? NPIECE : 0);
      if (p0 >= 0 && p0 < NPIECE) { float* LB = (float*)(a.ws + WS_LB);
          for (int i = p0 * NWAVES * 64 + F.tid; i < LN && i < p1 * NWAVES * 64; i += NWAVES * 64) { const int t = i >> 9, nn = i & 511; LB[i] = t == 0 ? a.in[I_W0F][nn] : t == 1 ? a.in[I_W0B][nn] : t == 2 ? a.in[I_A0F][nn] : t == 3 ? a.in[I_A0B][nn] : 0.f; } } }
    __syncthreads();
    LAS float* L = (LAS float*)(F.lds + RING_OFF);
    for (int it = blockIdx.x; it < 192; it += F.G) {
        {
            const int n0 = it * 32;
            LAS float* sc = L; LAS float* red = L + 17 * 1024;
            { float cvv[34];
#pragma unroll
              for (int i = 0; i < 34; ++i) { const int idx = F.tid + 512 * i, b = idx >> 10, k = idx & 1023; cvv[i] = b < 16 ? a.in[I_C][b * 1024 + k] : a.in[I_CCTX][k]; }
#pragma unroll
              for (int i = 0; i < 34; ++i) sc[F.tid + 512 * i] = cvv[i] * sigf(cvv[i]); }
            __syncthreads();
            const int col = F.tid & 31, ks = F.tid >> 5;
            float acc[17];
#pragma unroll
            for (int b = 0; b < 17; ++b) acc[b] = 0.f;
            for (int k8 = 0; k8 < 64; k8 += 32) { float wv[32];
#pragma unroll
                for (int j = 0; j < 32; ++j) wv[j] = __builtin_nontemporal_load(a.in[I_WADA] + (size_t)(ks * 64 + k8 + j) * MODW + n0 + col);
#pragma unroll
                for (int j = 0; j < 32; ++j) { const int k = ks * 64 + k8 + j;
#pragma unroll
                    for (int b = 0; b < 17; ++b) acc[b] += sc[b * 1024 + k] * wv[j]; } }
#pragma unroll
            for (int b = 0; b < 17; ++b) red[(ks * 17 + b) * 32 + col] = acc[b];
            __syncthreads();
            for (int o = F.tid; o < 17 * 32; o += NWAVES * 64) { const int b = o >> 5, c2 = o & 31; float s = a.in[I_BADA][n0 + c2];
                for (int k2 = 0; k2 < 16; ++k2) s += red[(k2 * 17 + b) * 32 + c2];
                ((float*)(a.ws + WS_MOD))[b * MODW + n0 + c2] = s; }
            __syncthreads();
        }
    }
}
__device__ __forceinline__ void p_weights2(const Frame& F, const Args& a) {
    bf16* Wgu_t = (bf16*)(a.ws + WS_WGU); bf16* Wdown_t = (bf16*)(a.ws + WS_WDOWN);
    LAS float* scr = (LAS float*)(F.lds + RING_OFF + F.wave * 16384);
    const int gw = F.vcu * NWAVES + F.wave, NGW = F.G * NWAVES;
    for (int it = gw; it < 2816 + 1408; it += NGW) {
        if (it < 2816) { const int kb = it / 176, nb = it % 176, n0 = 32 * nb; const int np = n0 < DFF ? n0 : n0 - DFF; const int drow = (np >> 7) * 256 + (np & 127) + (n0 < DFF ? 0 : 128);
            tr_item(a.in[I_WGU], 2 * DFF, 64 * kb, n0, Wgu_t + (size_t)drow * D, D, scr, F.lane); }
        else { const int r = it - 2816, kb = r >> 5, nb = r & 31; tr_item(a.in[I_WDOWN], D, 64 * kb, 32 * nb, Wdown_t + (size_t)(32 * nb) * DFF, DFF, scr, F.lane); }
    }
}
template <int KIND> __device__ __forceinline__ void norm_mod_rows(const Args& a, int m0, int m1, const float* g, bf16* O, int lane) {
    if (m0 >= m1) return;
    const float* MODp = (const float*)(a.ws + WS_MOD);
    f32x4 gg[4];
#pragma unroll
    for (int j = 0; j < 4; ++j) gg[j] = ((const f32x4*)g)[lane + 64 * j];
    auto rowp = [&](int m) -> const GAS f32x4* { const float* p = (KIND == 1 || m < MX) ? a.in[I_X] + (size_t)m * D : a.in[I_CTX] + (size_t)(m - MX) * D; return (const GAS f32x4*)p + lane; };
    const bf16* D1 = (const bf16*)(a.ws + WS_D1);
    f32x4 cur[4], nxt[4], ss[4], cc[4]; v2u cd[4], nd[4]; int bcur = -1;
    { const GAS f32x4* p = rowp(m0);
#pragma unroll
      for (int j = 0; j < 4; ++j) { cur[j] = __builtin_nontemporal_load(p + 64 * j); if (KIND == 1) cd[j] = __builtin_nontemporal_load((const GAS v2u*)(D1 + (size_t)m0 * D) + lane + 64 * j); } }
    for (int m = m0; m < m1; ++m) {
        if (m + 1 < m1) { const GAS f32x4* p = rowp(m + 1);
#pragma unroll
            for (int j = 0; j < 4; ++j) { nxt[j] = __builtin_nontemporal_load(p + 64 * j); if (KIND == 1) nd[j] = __builtin_nontemporal_load((const GAS v2u*)(D1 + (size_t)(m + 1) * D) + lane + 64 * j); } }
        if (KIND == 1) {
#pragma unroll
            for (int j = 0; j < 4; ++j) cur[j] = cur[j] + (f32x4){bflo(cd[j].x), bfhi(cd[j].x), bflo(cd[j].y), bfhi(cd[j].y)}; }
        const int b = KIND == 0 ? (m < MX ? (m >> 11) : 16) : (m >> 11);
        if (b != bcur) { bcur = b; const float* md = MODp + (size_t)b * MODW + (KIND == 0 ? 0 : 3072);
#pragma unroll
            for (int j = 0; j < 4; ++j) { ss[j] = ((const f32x4*)md)[lane + 64 * j]; cc[j] = ((const f32x4*)(md + 1024))[lane + 64 * j] + 1.0f; } }
        float s2 = 0.f;
#pragma unroll
        for (int j = 0; j < 4; ++j) s2 += (cur[j].x * cur[j].x + cur[j].y * cur[j].y) + (cur[j].z * cur[j].z + cur[j].w * cur[j].w);
        const float rstd = 1.0f / sqrtf(wave_sum(s2) * (1.f / D) + NORM_EPS);
        GAS v2u* o8 = (GAS v2u*)(O + (size_t)m * D) + lane;
#pragma unroll
        for (int j = 0; j < 4; ++j) { const f32x4 o = (cur[j] * rstd) * gg[j] * cc[j] + ss[j]; v2u w; w.x = pk2(o.x, o.y); w.y = pk2(o.z, o.w); o8[64 * j] = w; }
#pragma unroll
        for (int j = 0; j < 4; ++j) { cur[j] = nxt[j]; cd[j] = nd[j]; }
    }
}
typedef short bf16x8v __attribute__((ext_vector_type(8)));
__device__ __forceinline__ unsigned offb(unsigned row, unsigned ch) { return 256u * row + 16u * (ch ^ (((row & 3u) << 2) | ((row >> 2) & 3u))); }
__device__ __forceinline__ void tr_read8(unsigned a0, unsigned a1, v2u (&r0)[4], v2u (&r1)[4]) {
    asm volatile("ds_read_b64_tr_b16 %0, %8\n\tds_read_b64_tr_b16 %1, %8 offset:8192\n\tds_read_b64_tr_b16 %2, %8 offset:16384\n\tds_read_b64_tr_b16 %3, %8 offset:24576\n\t"
                 "ds_read_b64_tr_b16 %4, %9\n\tds_read_b64_tr_b16 %5, %9 offset:8192\n\tds_read_b64_tr_b16 %6, %9 offset:16384\n\tds_read_b64_tr_b16 %7, %9 offset:24576\n\ts_waitcnt lgkmcnt(0)"
                 : "=&v"(r0[0]), "=&v"(r0[1]), "=&v"(r0[2]), "=&v"(r0[3]), "=&v"(r1[0]), "=&v"(r1[1]), "=&v"(r1[2]), "=&v"(r1[3]) : "v"(a0), "v"(a1) : "memory");
}
__device__ __forceinline__ void tr_read4(unsigned a0, unsigned a1, v2u (&r0)[2], v2u (&r1)[2]) {
    asm volatile("ds_read_b64_tr_b16 %0, %4\n\tds_read_b64_tr_b16 %1, %4 offset:8192\n\tds_read_b64_tr_b16 %2, %5\n\tds_read_b64_tr_b16 %3, %5 offset:8192\n\ts_waitcnt lgkmcnt(0)"
                 : "=&v"(r0[0]), "=&v"(r0[1]), "=&v"(r1[0]), "=&v"(r1[1]) : "v"(a0), "v"(a1) : "memory");
}
__device__ __forceinline__ bf16x8v mk_b(v2u lo, v2u hi) { v4u w = {lo.x, lo.y, hi.x, hi.y}; return __builtin_bit_cast(bf16x8v, w); }
__device__ __forceinline__ void dft_pass_a(const Frame& F, const bf16* PXF, bf16* Y2) {
    constexpr int RSW = 272;
    const int w = F.wave, l = F.lane, lr = l & 15, g4 = l >> 4, q = (l & 15) >> 2, p = l & 3;
    const unsigned ldsb = (unsigned)(size_t)(F.lds + RING_OFF);
    LAS unsigned char* IN = F.lds + RING_OFF; LAS bf16* OUT = (LAS bf16*)(F.lds + RING_OFF + 32768); LAS unsigned char* RAW = F.lds + RING_OFF + 65536;
    bf16x8v afr[4], af0[2][4];
    { const int m = 16 * w + lr, ri = m >> 6, k2 = m & 63;
#pragma unroll
      for (int ks = 0; ks < 4; ++ks) { unsigned pk[4];
#pragma unroll
          for (int e2 = 0; e2 < 4; ++e2) { float vv[2];
#pragma unroll
              for (int h = 0; h < 2; ++h) { const int k = 32 * ks + 8 * g4 + 2 * e2 + h, rj = k >> 6, n2 = k & 63, idx = (k2 * n2) & 63; const float rev = (float)idx * (1.0f / 64.0f), sn = __builtin_amdgcn_sinf(rev), cs = __builtin_amdgcn_cosf(rev); vv[h] = (ri == rj) ? cs : (ri == 0 ? sn : -sn); }
              pk[e2] = pk2(vv[0], vv[1]); }
          afr[ks] = __builtin_bit_cast(bf16x8v, (v4u){pk[0], pk[1], pk[2], pk[3]}); } }
#pragma unroll
    for (int mt = 0; mt < 2; ++mt) { const int m = 32 * w + 16 * mt + lr, ri = m >> 7, k3 = m & 127;
#pragma unroll
      for (int ks = 0; ks < 4; ++ks) { unsigned pk[4];
#pragma unroll
          for (int e2 = 0; e2 < 4; ++e2) { float vv[2];
#pragma unroll
              for (int h = 0; h < 2; ++h) { const int n3 = 32 * ks + 8 * g4 + 2 * e2 + h, idx = (k3 * n3) & 127; const float rev = (float)idx * (1.0f / 128.0f), sn = __builtin_amdgcn_sinf(rev), cs = __builtin_amdgcn_cosf(rev); vv[h] = ri == 0 ? cs : -sn; }
              pk[e2] = pk2(vv[0], vv[1]); }
          af0[mt][ks] = __builtin_bit_cast(bf16x8v, (v4u){pk[0], pk[1], pk[2], pk[3]}); } }
    unsigned rb[2], mk[2];
#pragma unroll
    for (int t = 0; t < 2; ++t) { const unsigned row = 8 * g4 + 4 * t + q; rb[t] = ldsb + 256u * row + 8u * (p & 1); mk[t] = ((row & 3u) << 2) | ((row >> 2) & 3u); }
    const unsigned hb = p >> 1;
    v4u pre[2];
    { const int it = blockIdx.x; if (it < 2048) { const int jc = it & 3, n1 = (it >> 2) & 31, b = it >> 7;
#pragma unroll
        for (int i = 0; i < 2; ++i) { const int cid = F.tid + 512 * i, row = cid >> 4, ch = cid & 15; pre[i] = __builtin_nontemporal_load((const GAS v4u*)(PXF + (size_t)(b * 2048 + n1 * 64 + row) * 512 + jc * 128 + ch * 8)); } } }
    for (int it = blockIdx.x; it < 2048; it += F.G) {
        const int jc = it & 3, n1 = (it >> 2) & 31, b = it >> 7;
        __syncthreads();
#pragma unroll
        for (int i = 0; i < 2; ++i) { const int cid = F.tid + 512 * i, row = cid >> 4, ch = cid & 15; *(LAS v4u*)(RAW + row * RSW + ch * 16) = pre[i]; }
        { const int itn = it + F.G; if (itn < 2048) { const int jcn = itn & 3, n1n = (itn >> 2) & 31, bn = itn >> 7;
#pragma unroll
            for (int i = 0; i < 2; ++i) { const int cid = F.tid + 512 * i, row = cid >> 4, ch = cid & 15; pre[i] = __builtin_nontemporal_load((const GAS v4u*)(PXF + (size_t)(bn * 2048 + n1n * 64 + row) * 512 + jcn * 128 + ch * 8)); } } }
        __syncthreads();
#pragma unroll
        for (int nt = 0; nt < 4; ++nt) {
            bf16x8v bx[4];
#pragma unroll
            for (int ks = 0; ks < 4; ++ks) bx[ks] = *(const LAS bf16x8v*)(RAW + (16 * nt + lr) * RSW + (32 * ks + 8 * g4) * 2);
#pragma unroll
            for (int mt = 0; mt < 2; ++mt) { f32x4 acc = {0.f, 0.f, 0.f, 0.f};
#pragma unroll
                for (int ks = 0; ks < 4; ++ks) acc = __builtin_amdgcn_mfma_f32_16x16x32_bf16(af0[mt][ks], bx[ks], acc, 0, 0, 0);
                const int m0 = 32 * w + 16 * mt + 4 * g4, ri = m0 >> 7, c0 = m0 & 127, row = ri * 64 + 16 * nt + lr;
                *(LAS v2u*)(IN + offb(row, c0 >> 3) + 8 * ((c0 >> 2) & 1)) = (v2u){pk2(acc[0], acc[1]), pk2(acc[2], acc[3])}; }
        }
        __syncthreads();
#pragma unroll 2
        for (int c = 0; c < 8; ++c) {
            v2u r0[4], r1[4];
            tr_read8(rb[0] + 16u * ((2u * c + hb) ^ mk[0]), rb[1] + 16u * ((2u * c + hb) ^ mk[1]), r0, r1);
            f32x4 acc = {0.f, 0.f, 0.f, 0.f};
#pragma unroll
            for (int ks = 0; ks < 4; ++ks) acc = __builtin_amdgcn_mfma_f32_16x16x32_bf16(afr[ks], mk_b(r0[ks], r1[ks]), acc, 0, 0, 0);
#pragma unroll
            for (int r = 0; r < 4; ++r) OUT[(16 * w + 4 * g4 + r) * 128 + 16 * c + lr] = (bf16)f2bf(acc[r]);
        }
        __syncthreads();
#pragma unroll
        for (int i = 0; i < 4; ++i) { const int cid = F.tid + 512 * i, row = cid >> 4, ch = cid & 15, ri = row >> 6, k2 = row & 63;
            *(GAS v4u*)(Y2 + (size_t)(b * 2048 + n1 * 64 + k2) * 1024 + ri * 512 + jc * 128 + ch * 8) = *(const LAS v4u*)(OUT + row * 128 + ch * 8); }
    }
}
__device__ __forceinline__ void dft_pass_b(const Frame& F, const bf16* Y2, bf16* FX) {
    const int w = F.wave, l = F.lane, lr = l & 15, g4 = l >> 4, q = (l & 15) >> 2, p = l & 3;
    const int g = w >> 1, c0 = (w & 1) * 4;
    const unsigned ldsb = (unsigned)(size_t)(F.lds + RING_OFF) + 16384u * g;
    LAS unsigned char* IN = F.lds + RING_OFF; LAS bf16* OUT = (LAS bf16*)(F.lds + RING_OFF + 65536);
    bf16x8v afr[2][2];
#pragma unroll
    for (int mt = 0; mt < 2; ++mt) { const int k1 = 16 * mt + lr;
#pragma unroll
      for (int ks = 0; ks < 2; ++ks) { unsigned pk[4];
#pragma unroll
          for (int e2 = 0; e2 < 4; ++e2) { float vv[2];
#pragma unroll
              for (int h = 0; h < 2; ++h) { const int k = 32 * ks + 8 * g4 + 2 * e2 + h, ri = k >> 5, n1 = k & 31, idx = (k1 * n1) & 31; const float rev = (float)idx * (1.0f / 32.0f), sn = __builtin_amdgcn_sinf(rev), cs = __builtin_amdgcn_cosf(rev); vv[h] = (ri == 0 ? cs : sn); }
              pk[e2] = pk2(vv[0], vv[1]); }
          afr[mt][ks] = __builtin_bit_cast(bf16x8v, (v4u){pk[0], pk[1], pk[2], pk[3]}); } }
    unsigned rb[2], mk[2];
#pragma unroll
    for (int t = 0; t < 2; ++t) { const unsigned row = 8 * g4 + 4 * t + q; rb[t] = ldsb + 256u * row + 8u * (p & 1); mk[t] = ((row & 3u) << 2) | ((row >> 2) & 3u); }
    const unsigned hb = p >> 1;
    v4u pre[8];
    { const int it = blockIdx.x; if (it < 1024) { const int k2 = it & 63, b = it >> 6;
#pragma unroll
        for (int i = 0; i < 8; ++i) { const int cid = F.tid + 512 * i, row = cid >> 6, c64 = cid & 63; pre[i] = __builtin_nontemporal_load((const GAS v4u*)(Y2 + (size_t)(b * 2048 + (row & 31) * 64 + k2) * 1024 + (row >> 5) * 512 + c64 * 8)); } } }
    for (int it = blockIdx.x; it < 1024; it += F.G) {
        const int k2 = it & 63, b = it >> 6;
        __syncthreads();
#pragma unroll
        for (int i = 0; i < 8; ++i) { const int cid = F.tid + 512 * i, row = cid >> 6, c64 = cid & 63, gg = c64 >> 4, ch = c64 & 15; *(LAS v4u*)(IN + 16384 * gg + offb(row, ch)) = pre[i]; }
        { const int itn = it + F.G; if (itn < 1024) { const int k2n = itn & 63, bn = itn >> 6;
#pragma unroll
            for (int i = 0; i < 8; ++i) { const int cid = F.tid + 512 * i, row = cid >> 6, c64 = cid & 63; pre[i] = __builtin_nontemporal_load((const GAS v4u*)(Y2 + (size_t)(bn * 2048 + (row & 31) * 64 + k2n) * 1024 + (row >> 5) * 512 + c64 * 8)); } } }
        __syncthreads();
#pragma unroll
        for (int cc = 0; cc < 4; ++cc) { const int c = c0 + cc;
            v2u r0[2], r1[2];
            tr_read4(rb[0] + 16u * ((2u * c + hb) ^ mk[0]), rb[1] + 16u * ((2u * c + hb) ^ mk[1]), r0, r1);
#pragma unroll
            for (int mt = 0; mt < 2; ++mt) { f32x4 acc = {0.f, 0.f, 0.f, 0.f};
#pragma unroll
                for (int ks = 0; ks < 2; ++ks) acc = __builtin_amdgcn_mfma_f32_16x16x32_bf16(afr[mt][ks], mk_b(r0[ks], r1[ks]), acc, 0, 0, 0);
#pragma unroll
                for (int r = 0; r < 4; ++r) OUT[(16 * mt + 4 * g4 + r) * 512 + g * 128 + 16 * c + lr] = (bf16)f2bf(acc[r] * (1.0f / 512.0f)); }
        }
        __syncthreads();
#pragma unroll
        for (int i = 0; i < 4; ++i) { const int cid = F.tid + 512 * i, row = cid >> 6, ch = cid & 63;
            *(GAS v4u*)(FX + (size_t)(b * 2048 + row * 64 + k2) * 1024 + ch * 8) = *(const LAS v4u*)(OUT + row * 512 + ch * 8); }
    }
}
template <int CTRL> __device__ __forceinline__ float dpp_add(float x) { const int v = __builtin_amdgcn_update_dpp(__float_as_int(x), __float_as_int(x), CTRL, 0xF, 0xF, false); return x + __int_as_float(v); }
__device__ __forceinline__ void edge_rows(const Frame& F, const Args& a) {
    const float* EB = (const float*)(a.ws + WS_EB); bf16* RB = (bf16*)(a.ws + WS_R); bf16* KB = (bf16*)(a.ws + WS_K); bf16* VB = (bf16*)(a.ws + WS_V); bf16* AL = (bf16*)a.out;
    const int gw = F.vcu * NWAVES + F.wave, lane = F.lane;
    if (gw >= 8 * (MT / 256)) return;
    const int tile = gw >> 3, last = (gw >> 2) & 1, j = gw & 3, col = 512 * j + 8 * lane;
    if (col >= RCOLS) return;
    const bool lat = tile < MX / 256, s0 = lat ? (tile & 7) == 0 : true, s1 = lat ? (tile & 7) == 7 : true;
    const int m = tile * 256 + (last ? 255 : 0);
    const float* cp = EB + ((size_t)tile * 4 + (last ? 3 : 0)) * 2048 + col;
    const float* pp = (last ? EB + ((size_t)tile * 4 + 2) * 2048 : EB + ((size_t)(tile > 0 ? tile - 1 : 0) * 4 + 3) * 2048) + col;
    const float* np = (last ? EB + ((size_t)(tile + 1 < MT / 256 ? tile + 1 : tile) * 4 + 0) * 2048 : EB + ((size_t)tile * 4 + 1) * 2048) + col;
    const bool hp = last ? true : !s0, hn = last ? !s1 : true;
    const f32x4 z = {0.f, 0.f, 0.f, 0.f};
    f32x4 c4[2], p4[2], n4[2], mp4[2], mn4[2];
#pragma unroll
    for (int h = 0; h < 2; ++h) { c4[h] = ((const f32x4*)cp)[h]; p4[h] = hp ? ((const f32x4*)pp)[h] : z; n4[h] = hn ? ((const f32x4*)np)[h] : z; mp4[h] = ((const f32x4*)(a.in[I_MUP] + col))[h]; mn4[h] = ((const f32x4*)(a.in[I_MUN] + col))[h]; }
    float u[8];
#pragma unroll
    for (int e = 0; e < 8; ++e) { const float c = c4[e >> 2][e & 3]; u[e] = c + mp4[e >> 2][e & 3] * (p4[e >> 2][e & 3] - c) + mn4[e >> 2][e & 3] * (n4[e >> 2][e & 3] - c); }
    if (j == 0) *(GAS v4u*)(RB + (size_t)m * RW + 8 * lane) = pk8(u);
    else if (j == 1) *(GAS v4u*)(KB + (size_t)m * RW + 8 * lane) = pk8(u);
    else if (j == 2) *(GAS v4u*)(VB + (size_t)m * RW + 8 * lane) = pk8(u);
    else {
        if (lane < 16) {
#pragma unroll
            for (int e = 0; e < 8; ++e) u[e] = 2.0f * sigf(2.0f * u[e]) - 1.0f;
        } else if (lane >= 32) {
#pragma unroll
            for (int e = 0; e < 8; ++e) u[e] = sigf(u[e]);
        }
        *(GAS v4u*)(AL + (size_t)m * LK + 8 * lane) = pk8(u);
    }
}
__device__ __forceinline__ int scan_row(int s, int b, int dir) { if (s < CTXL) { const int t = dir ? (CTXL - 1 - s) : s; return MX + b * CTXL + t; } const int s2 = s - CTXL; const int t = dir ? (SEQ - 1 - s2) : s2; return b * SEQ + t; }
__device__ __forceinline__ float red16(float x) { x = dpp_add<0xB1>(x); x = dpp_add<0x4E>(x); x = dpp_add<0x141>(x); x = dpp_add<0x140>(x); return x; }
typedef float f32x2 __attribute__((ext_vector_type(2)));
__device__ __forceinline__ float fm_(float a, float b, float c) { float d; asm("v_fma_f32 %0, %1, %2, %3" : "=v"(d) : "v"(a), "v"(b), "v"(c)); return d; }
__device__ __forceinline__ float ml_(float a, float b) { float d; asm("v_mul_f32 %0, %1, %2" : "=v"(d) : "v"(a), "v"(b)); return d; }
__device__ __forceinline__ void red16x2(float& a, float& b) {
    asm volatile("s_nop 1\n\t"
        "v_add_f32_dpp %0, %0, %0 quad_perm:[1,0,3,2] row_mask:0xf bank_mask:0xf\n\tv_add_f32_dpp %1, %1, %1 quad_perm:[1,0,3,2] row_mask:0xf bank_mask:0xf\n\ts_nop 0\n\t"
        "v_add_f32_dpp %0, %0, %0 quad_perm:[2,3,0,1] row_mask:0xf bank_mask:0xf\n\tv_add_f32_dpp %1, %1, %1 quad_perm:[2,3,0,1] row_mask:0xf bank_mask:0xf\n\ts_nop 0\n\t"
        "v_add_f32_dpp %0, %0, %0 row_half_mirror row_mask:0xf bank_mask:0xf\n\tv_add_f32_dpp %1, %1, %1 row_half_mirror row_mask:0xf bank_mask:0xf\n\ts_nop 0\n\t"
        "v_add_f32_dpp %0, %0, %0 row_mirror row_mask:0xf bank_mask:0xf\n\tv_add_f32_dpp %1, %1, %1 row_mirror row_mask:0xf bank_mask:0xf\n\ts_nop 0"
        : "+v"(a), "+v"(b));
}
typedef short bf16x8v_ __attribute__((ext_vector_type(8)));
namespace sc {
constexpr int C = 16, NCHUNK = (CTXL + SEQ) / C, CTXCHUNK = CTXL / C, NSLOT = 5;
constexpr int RS = 144, ARR = 16 * RS, ES = 272;
constexpr int O_P = 0, O_RT = ARR, O_NPT = 2 * ARR, O_DPT = 3 * ARR, O_VT = 4 * ARR, O_DM = 5 * ARR, O_NR = O_DM + 512, O_DR = O_NR + 512, O_LINV = O_DR + 512, O_LC = O_LINV + 512, SLOT_B = O_LC + 256;
constexpr int PRIVP = NSLOT * SLOT_B, O_NN = 0, O_DD = ARR, O_EW = 2 * ARR, O_NF = O_EW + 16 * ES, PRIVP_B = O_NF + 1024;
constexpr int ZERO_OFF = PRIVP + 4 * PRIVP_B;
constexpr int FLAG_OFF = ZERO_OFF + 1024;
constexpr int KC_OFF = FLAG_OFF + 64;
static_assert(SLOT_B % 16 == 0 && PRIVP_B % 16 == 0 && KC_OFF + 1024 <= RING_BYTES, "scan LDS map");
}
__device__ __forceinline__ unsigned cvtpk(float lo, float hi) { unsigned r; asm volatile("v_cvt_pk_bf16_f32 %0, %1, %2" : "=v"(r) : "v"(lo), "v"(hi)); return r; }
__device__ __forceinline__ float bf1(unsigned short x) { return __uint_as_float((unsigned)x << 16); }
__device__ __forceinline__ unsigned short tobf(float f) { return (unsigned short)f2bf(f); }
__device__ __forceinline__ unsigned short tobf1(float f) { return (unsigned short)cvtpk(f, f); }
__device__ __forceinline__ bf16x8v_ tr_frag1(unsigned a) { v2u r0, r1;
    asm volatile("ds_read_b64_tr_b16 %0, %2\n\tds_read_b64_tr_b16 %1, %2 offset:512\n\ts_waitcnt lgkmcnt(0)" : "=&v"(r0), "=&v"(r1) : "v"(a) : "memory"); return mk_b(r0, r1); }
__device__ __forceinline__ void tr_frag4(unsigned a, bf16x8v_ (&f)[4]) { v2u r[8];
    asm volatile("ds_read_b64_tr_b16 %0, %8\n\tds_read_b64_tr_b16 %1, %8 offset:512\n\tds_read_b64_tr_b16 %2, %8 offset:32\n\tds_read_b64_tr_b16 %3, %8 offset:544\n\t"
                 "ds_read_b64_tr_b16 %4, %8 offset:64\n\tds_read_b64_tr_b16 %5, %8 offset:576\n\tds_read_b64_tr_b16 %6, %8 offset:96\n\tds_read_b64_tr_b16 %7, %8 offset:608\n\ts_waitcnt lgkmcnt(0)"
                 : "=&v"(r[0]), "=&v"(r[1]), "=&v"(r[2]), "=&v"(r[3]), "=&v"(r[4]), "=&v"(r[5]), "=&v"(r[6]), "=&v"(r[7]) : "v"(a) : "memory");
    f[0] = mk_b(r[0], r[1]); f[1] = mk_b(r[2], r[3]); f[2] = mk_b(r[4], r[5]); f[3] = mk_b(r[6], r[7]); }
__device__ __forceinline__ void scan_phase(const Frame& F, const Args& a) {
    using namespace sc;
    const bf16* RB = (const bf16*)(a.ws + WS_R); const bf16* KB = (const bf16*)(a.ws + WS_K); const bf16* VB = (const bf16*)(a.ws + WS_V); const bf16* LP = (const bf16*)(a.ws + WS_LP);
    LAS unsigned char* L = F.lds + RING_OFF;
    const int l = F.lane, lr = l & 15, g = l >> 4;
    for (int chain = blockIdx.x; chain < 256; chain += F.G) {
        const int b = chain >> 4, h = (chain >> 1) & 7, dir = chain & 1;
        bf16* Yg = (bf16*)a.out + (dir ? (size_t)MX * RW : 0);
        float* SBTg = (float*)(a.ws + WS_SBT);
        if (F.tid < 256 + 16) ((LAS unsigned*)(L + ZERO_OFF))[F.tid] = 0u;
        if (F.tid >= 64 && F.tid < 320) { const int i_ = F.tid - 64, k_ = h * 64 + (i_ & 63);
            ((LAS float*)(L + KC_OFF))[i_] = i_ < 64 ? a.in[I_KK][k_] : i_ < 128 ? a.in[I_KA][k_] : i_ < 192 ? a.in[I_RK][k_] * a.in[I_KA][k_] : (dir == 0 ? a.in[I_RK][k_] * (2.0f - 2.0f * a.in[I_KA][k_]) : 0.f); }
        __syncthreads();
        if (F.wave >= 4) {
            const int p = F.wave - 4;
            LAS unsigned char* PV = L + PRIVP + p * PRIVP_B;
            const int t1 = l >> 2, kq = l & 3, hc1 = h * 64 + 16 * kq;
            v4u raw[10];
#define SC_PREFETCH(cc) do { const int m_ = scan_row((cc) * C + t1, b, dir); const GAS v4u* q0 = (const GAS v4u*)(RB + (size_t)m_ * RW + hc1); const GAS v4u* q1 = (const GAS v4u*)(KB + (size_t)m_ * RW + hc1); const GAS v4u* q2 = (const GAS v4u*)(VB + (size_t)m_ * RW + hc1); \
                const GAS v4u* q3 = (const GAS v4u*)(LP + (size_t)m_ * LN + dir * 512 + hc1); const GAS v4u* q4 = (const GAS v4u*)(LP + (size_t)m_ * LN + 1024 + dir * 512 + hc1); \
                raw[0] = __builtin_nontemporal_load(q0); raw[1] = __builtin_nontemporal_load(q0 + 1); raw[2] = __builtin_nontemporal_load(q1); raw[3] = __builtin_nontemporal_load(q1 + 1); raw[4] = __builtin_nontemporal_load(q2); raw[5] = __builtin_nontemporal_load(q2 + 1); \
                raw[6] = __builtin_nontemporal_load(q3); raw[7] = __builtin_nontemporal_load(q3 + 1); raw[8] = __builtin_nontemporal_load(q4); raw[9] = __builtin_nontemporal_load(q4 + 1); } while (0)
            if (p < NCHUNK) SC_PREFETCH(p);
            volatile LAS unsigned* RDY = (volatile LAS unsigned*)(L + FLAG_OFF); volatile LAS unsigned* DONE = RDY + NSLOT;
            for (int c = p; c < NCHUNK; c += 4) {
                if (c >= NSLOT) { unsigned spins = 0; while (*DONE < 4u * (unsigned)(c - NSLOT + 1)) { __builtin_amdgcn_s_sleep(2); if (++spins > (1u << 22)) break; } asm volatile("" ::: "memory"); }
#pragma unroll 1
                for (int f = 1; f <= 3; ++f) {
                {
                    LAS unsigned char* SL = L + (c % NSLOT) * SLOT_B;
                    if (f == 1) {
                        float r16[16], k16[16], e16[16], a16[16];
                        { float t8[8]; unpk8(raw[0], t8); for (int e = 0; e < 8; ++e) r16[e] = t8[e]; unpk8(raw[1], t8); for (int e = 0; e < 8; ++e) r16[8 + e] = t8[e];
                          unpk8(raw[2], t8); for (int e = 0; e < 8; ++e) k16[e] = t8[e]; unpk8(raw[3], t8); for (int e = 0; e < 8; ++e) k16[8 + e] = t8[e];
                          unpk8(raw[6], t8); for (int e = 0; e < 8; ++e) e16[e] = t8[e]; unpk8(raw[7], t8); for (int e = 0; e < 8; ++e) e16[8 + e] = t8[e];
                          unpk8(raw[8], t8); for (int e = 0; e < 8; ++e) a16[e] = t8[e]; unpk8(raw[9], t8); for (int e = 0; e < 8; ++e) a16[8 + e] = t8[e]; }
                        const int ro = t1 * RS + kq * 32;
                        *(LAS v4u*)(SL + O_VT + ro) = raw[4]; *(LAS v4u*)(SL + O_VT + ro + 16) = raw[5];
#pragma unroll
                        for (int e4 = 0; e4 < 4; ++e4) *(LAS f32x4*)(PV + O_EW + t1 * ES + kq * 64 + e4 * 16) = (f32x4){e16[4 * e4], e16[4 * e4 + 1], e16[4 * e4 + 2], e16[4 * e4 + 3]};
                        if (c + 4 < NCHUNK) SC_PREFETCH(c + 4);
                        float kkc[16], kac[16];
#pragma unroll
                        for (int e4 = 0; e4 < 4; ++e4) { const f32x4 q0 = *(const LAS f32x4*)(L + KC_OFF + (16 * kq + 4 * e4) * 4), q1 = *(const LAS f32x4*)(L + KC_OFF + 256 + (16 * kq + 4 * e4) * 4);
#pragma unroll
                            for (int e = 0; e < 4; ++e) { kkc[4 * e4 + e] = q0[e]; kac[4 * e4 + e] = q1[e]; } }
                        float kk16[16], nb16[16], kd16[16]; float ss = 0.f;
#pragma unroll
                        for (int e = 0; e < 16; ++e) { kk16[e] = k16[e] * kkc[e]; ss += kk16[e] * kk16[e]; }
                        ss = dpp_add<0xB1>(ss); ss = dpp_add<0x4E>(ss);
                        const float rn = 1.0f / sqrtf(fmaxf(ss, 1e-24f));
#pragma unroll
                        for (int e = 0; e < 16; ++e) { kk16[e] *= rn; nb16[e] = -kk16[e] * a16[e]; }
                        { float sb = 0.f;
#pragma unroll
                          for (int e4 = 0; e4 < 4; ++e4) { const f32x4 q2 = *(const LAS f32x4*)(L + KC_OFF + 512 + (16 * kq + 4 * e4) * 4), q3 = *(const LAS f32x4*)(L + KC_OFF + 768 + (16 * kq + 4 * e4) * 4);
#pragma unroll
                              for (int e = 0; e < 4; ++e) { const int x = 4 * e4 + e; const float ka_ = k16[x] * a16[x]; kd16[x] = k16[x] + (ka_ - k16[x]) * kac[x]; sb += (r16[x] * k16[x]) * (q2[e] * a16[x] + q3[e]); } }
                          sb = dpp_add<0xB1>(sb); sb = dpp_add<0x4E>(sb);
                          if (c >= CTXCHUNK && kq == 0) SBTg[((size_t)scan_row(c * C + t1, b, dir) * 8 + h) * 4 + 1 + dir] = sb; }
                        asm volatile("s_waitcnt lgkmcnt(0)" ::: "memory");
                        {
                          LAS float* Ep = (LAS float*)(PV + O_EW) + l; float cs = 0.f;
#pragma unroll
                          for (int t = 0; t < 16; ++t) { cs += Ep[t * (ES / 4)]; Ep[t * (ES / 4)] = cs; }
                          ((LAS float*)(SL + O_LC))[l] = __expf(cs); }
                        asm volatile("s_waitcnt lgkmcnt(0)" ::: "memory");
                        unsigned pP[8], pR[8], pN[8], pD[8], pNP[8], pDP[8];
#pragma unroll
                        for (int e4 = 0; e4 < 4; ++e4) { const f32x4 cs4 = *(const LAS f32x4*)(PV + O_EW + t1 * ES + kq * 64 + e4 * 16);
                            const f32x4 cm4 = *(const LAS f32x4*)(L + (t1 > 0 ? PRIVP + p * PRIVP_B + O_EW + (t1 - 1) * ES + kq * 64 + e4 * 16 : ZERO_OFF)); const f32x4 lc4 = *(const LAS f32x4*)(SL + O_LC + kq * 64 + e4 * 16);
                            float vP[4], vR[4], vN[4], vD[4], vNP[4], vDP[4];
#pragma unroll
                            for (int e = 0; e < 4; ++e) { const int x = 4 * e4 + e; const float pc = __expf(cs4[e]), pm = __expf(cm4[e]), ic = __builtin_amdgcn_rcpf(pc);
                                vP[e] = kk16[x] * pm; vR[e] = r16[x] * pc; vN[e] = nb16[x] * ic; vD[e] = kd16[x] * ic; vNP[e] = vN[e] * lc4[e]; vDP[e] = vD[e] * lc4[e]; }
                            pP[2 * e4] = cvtpk(vP[0], vP[1]); pP[2 * e4 + 1] = cvtpk(vP[2], vP[3]); pR[2 * e4] = cvtpk(vR[0], vR[1]); pR[2 * e4 + 1] = cvtpk(vR[2], vR[3]);
                            pN[2 * e4] = cvtpk(vN[0], vN[1]); pN[2 * e4 + 1] = cvtpk(vN[2], vN[3]); pD[2 * e4] = cvtpk(vD[0], vD[1]); pD[2 * e4 + 1] = cvtpk(vD[2], vD[3]);
                            pNP[2 * e4] = cvtpk(vNP[0], vNP[1]); pNP[2 * e4 + 1] = cvtpk(vNP[2], vNP[3]); pDP[2 * e4] = cvtpk(vDP[0], vDP[1]); pDP[2 * e4 + 1] = cvtpk(vDP[2], vDP[3]); }
                        *(LAS v4u*)(SL + O_P + ro) = (v4u){pP[0], pP[1], pP[2], pP[3]}; *(LAS v4u*)(SL + O_P + ro + 16) = (v4u){pP[4], pP[5], pP[6], pP[7]};
                        *(LAS v4u*)(SL + O_RT + ro) = (v4u){pR[0], pR[1], pR[2], pR[3]}; *(LAS v4u*)(SL + O_RT + ro + 16) = (v4u){pR[4], pR[5], pR[6], pR[7]};
                        *(LAS v4u*)(PV + O_NN + ro) = (v4u){pN[0], pN[1], pN[2], pN[3]}; *(LAS v4u*)(PV + O_NN + ro + 16) = (v4u){pN[4], pN[5], pN[6], pN[7]};
                        *(LAS v4u*)(PV + O_DD + ro) = (v4u){pD[0], pD[1], pD[2], pD[3]}; *(LAS v4u*)(PV + O_DD + ro + 16) = (v4u){pD[4], pD[5], pD[6], pD[7]};
                        *(LAS v4u*)(SL + O_NPT + ro) = (v4u){pNP[0], pNP[1], pNP[2], pNP[3]}; *(LAS v4u*)(SL + O_NPT + ro + 16) = (v4u){pNP[4], pNP[5], pNP[6], pNP[7]};
                        *(LAS v4u*)(SL + O_DPT + ro) = (v4u){pDP[0], pDP[1], pDP[2], pDP[3]}; *(LAS v4u*)(SL + O_DPT + ro + 16) = (v4u){pDP[4], pDP[5], pDP[6], pDP[7]};
                    } else if (f == 2) {
                        bf16x8v_ ap[2], ar[2], bn[2], bd[2];
#pragma unroll
                        for (int ks = 0; ks < 2; ++ks) { const int o = lr * RS + ks * 64 + g * 16; ap[ks] = *(const LAS bf16x8v_*)(SL + O_P + o); ar[ks] = *(const LAS bf16x8v_*)(SL + O_RT + o); bn[ks] = *(const LAS bf16x8v_*)(PV + O_NN + o); bd[ks] = *(const LAS bf16x8v_*)(PV + O_DD + o); }
                        f32x4 cN = {0.f, 0.f, 0.f, 0.f}, cDm = cN, cNr = cN, cDr = cN;
#pragma unroll
                        for (int ks = 0; ks < 2; ++ks) { cN = __builtin_amdgcn_mfma_f32_16x16x32_bf16(ap[ks], bn[ks], cN, 0, 0, 0); cDm = __builtin_amdgcn_mfma_f32_16x16x32_bf16(ap[ks], bd[ks], cDm, 0, 0, 0);
                            cNr = __builtin_amdgcn_mfma_f32_16x16x32_bf16(ar[ks], bn[ks], cNr, 0, 0, 0); cDr = __builtin_amdgcn_mfma_f32_16x16x32_bf16(ar[ks], bd[ks], cDr, 0, 0, 0); }
                        *(LAS f32x4*)(PV + O_NF + (lr * 16 + 4 * g) * 4) = (f32x4){lr < 4 * g ? cN[0] : 0.f, lr < 4 * g + 1 ? cN[1] : 0.f, lr < 4 * g + 2 ? cN[2] : 0.f, lr < 4 * g + 3 ? cN[3] : 0.f};
#pragma unroll
                        for (int r = 0; r < 4; ++r) { const int t = 4 * g + r, j = lr; const bool lo = j < t, le = j <= t;
                            ((LAS unsigned short*)(SL + O_DM))[t * 16 + j] = tobf1(lo ? cDm[r] : 0.f); ((LAS unsigned short*)(SL + O_NR))[t * 16 + j] = tobf1(le ? cNr[r] : 0.f); ((LAS unsigned short*)(SL + O_DR))[t * 16 + j] = tobf1(le ? cDr[r] : 0.f); }
                    } else {
                        const LAS f32x4* NFTp = (const LAS f32x4*)(PV + O_NF); float acc[16];
#pragma unroll
                        for (int t = 0; t < 16; ++t) acc[t] = (t == lr) ? 1.0f : 0.0f;
                        f32x4 col[4];
#pragma unroll
                        for (int q4 = 0; q4 < 4; ++q4) col[q4] = NFTp[q4];
#pragma unroll
                        for (int j = 0; j < 16; ++j) { const float Lj = acc[j]; ((LAS unsigned short*)(SL + O_LINV))[j * 16 + lr] = tobf1(Lj);
                            f32x4 nxt[4];
                            if (j + 1 < 16) {
#pragma unroll
                                for (int q4 = 0; q4 < 4; ++q4) nxt[q4] = NFTp[(j + 1) * 4 + q4]; }
#pragma unroll
                            for (int t = j + 1; t < 16; ++t) acc[t] += col[t >> 2][t & 3] * Lj;
                            if (j + 1 < 16) {
#pragma unroll
                                for (int q4 = 0; q4 < 4; ++q4) col[q4] = nxt[q4]; } }
                    }
                }
                asm volatile("s_waitcnt lgkmcnt(0)" ::: "memory");
                }
                if (l == 0) RDY[c % NSLOT] = (unsigned)(c + 1);
            }
#undef SC_PREFETCH
        } else {
            const int w = F.wave, irow = 16 * w + lr, q = lr >> 2, pp = l & 3;
            f32x4 S[4];
#pragma unroll
            for (int kt = 0; kt < 4; ++kt) S[kt] = (f32x4){0.f, 0.f, 0.f, 0.f};
            volatile LAS unsigned* RDY = (volatile LAS unsigned*)(L + FLAG_OFF); LAS unsigned* DONE = (LAS unsigned*)(L + FLAG_OFF) + NSLOT;
            const unsigned ldsb_ = (unsigned)(size_t)L, lanetr_ = (unsigned)((4 * g + q) * RS + 8 * pp);
            for (int c = 0; c < NCHUNK; ++c) {
                { unsigned spins = 0; while (RDY[c % NSLOT] != (unsigned)(c + 1)) { __builtin_amdgcn_s_sleep(1); if (++spins > (1u << 22)) break; } asm volatile("" ::: "memory"); }
                {
                    LAS unsigned char* SL = L + (c % NSLOT) * SLOT_B; const unsigned slb_ = ldsb_ + (unsigned)((c % NSLOT) * SLOT_B);
                    asm volatile("s_nop 7" : "+v"(S[0]), "+v"(S[1]), "+v"(S[2]), "+v"(S[3]));
                    bf16x8v_ bS[2], aP[2], aR[2];
#pragma unroll
                    for (int ks = 0; ks < 2; ++ks) { bS[ks] = __builtin_bit_cast(bf16x8v_, (v4u){cvtpk(S[2 * ks][0], S[2 * ks][1]), cvtpk(S[2 * ks][2], S[2 * ks][3]), cvtpk(S[2 * ks + 1][0], S[2 * ks + 1][1]), cvtpk(S[2 * ks + 1][2], S[2 * ks + 1][3])});
                        const int o = lr * RS + (32 * ks + 4 * g) * 2;
                        aP[ks] = mk_b(*(const LAS v2u*)(SL + O_P + o), *(const LAS v2u*)(SL + O_P + o + 32)); aR[ks] = mk_b(*(const LAS v2u*)(SL + O_RT + o), *(const LAS v2u*)(SL + O_RT + o + 32)); }
                    const v2u z2 = {0u, 0u}; const int o16 = lr * 32 + g * 8;
                    const bf16x8v_ aDm = mk_b(*(const LAS v2u*)(SL + O_DM + o16), z2), aNr = mk_b(*(const LAS v2u*)(SL + O_NR + o16), z2), aDr = mk_b(*(const LAS v2u*)(SL + O_DR + o16), z2), aLi = mk_b(*(const LAS v2u*)(SL + O_LINV + o16), z2);
                    v2u trv, trn[4], trd[4];
                    asm volatile("ds_read_b64_tr_b16 %0, %9\n\t"
                                 "ds_read_b64_tr_b16 %1, %10\n\tds_read_b64_tr_b16 %2, %10 offset:32\n\tds_read_b64_tr_b16 %3, %10 offset:64\n\tds_read_b64_tr_b16 %4, %10 offset:96\n\t"
                                 "ds_read_b64_tr_b16 %5, %11\n\tds_read_b64_tr_b16 %6, %11 offset:32\n\tds_read_b64_tr_b16 %7, %11 offset:64\n\tds_read_b64_tr_b16 %8, %11 offset:96\n\ts_waitcnt lgkmcnt(0)"
                                 : "=&v"(trv), "=&v"(trn[0]), "=&v"(trn[1]), "=&v"(trn[2]), "=&v"(trn[3]), "=&v"(trd[0]), "=&v"(trd[1]), "=&v"(trd[2]), "=&v"(trd[3])
                                 : "v"(slb_ + (unsigned)(O_VT + 32 * w) + lanetr_), "v"(slb_ + (unsigned)O_NPT + lanetr_), "v"(slb_ + (unsigned)O_DPT + lanetr_) : "memory");
                    const bf16x8v_ bV = mk_b(trv, z2);
                    f32x4 W = {0.f, 0.f, 0.f, 0.f};
                    W = __builtin_amdgcn_mfma_f32_16x16x32_bf16(aP[0], bS[0], W, 0, 0, 0); W = __builtin_amdgcn_mfma_f32_16x16x32_bf16(aP[1], bS[1], W, 0, 0, 0); W = __builtin_amdgcn_mfma_f32_16x16x32_bf16(aDm, bV, W, 0, 0, 0);
                    asm volatile("s_nop 7\n\ts_nop 7" : "+v"(W));
                    const bf16x8v_ bW = __builtin_bit_cast(bf16x8v_, (v4u){cvtpk(W[0], W[1]), cvtpk(W[2], W[3]), 0u, 0u});
                    f32x4 Z = {0.f, 0.f, 0.f, 0.f};
                    Z = __builtin_amdgcn_mfma_f32_16x16x32_bf16(aLi, bW, Z, 0, 0, 0);
                    asm volatile("s_nop 7\n\ts_nop 7" : "+v"(Z));
                    const bf16x8v_ bZ = __builtin_bit_cast(bf16x8v_, (v4u){cvtpk(Z[0], Z[1]), cvtpk(Z[2], Z[3]), 0u, 0u});
                    if (c >= CTXCHUNK) {
                        f32x4 Y = {0.f, 0.f, 0.f, 0.f};
                        Y = __builtin_amdgcn_mfma_f32_16x16x32_bf16(aR[0], bS[0], Y, 0, 0, 0); Y = __builtin_amdgcn_mfma_f32_16x16x32_bf16(aR[1], bS[1], Y, 0, 0, 0);
                        Y = __builtin_amdgcn_mfma_f32_16x16x32_bf16(aNr, bZ, Y, 0, 0, 0); Y = __builtin_amdgcn_mfma_f32_16x16x32_bf16(aDr, bV, Y, 0, 0, 0);
#pragma unroll
                        for (int r = 0; r < 4; ++r) { const int m = scan_row(c * C + 4 * g + r, b, dir); Yg[(size_t)m * RW + h * 64 + irow] = tobf(Y[r]); }
                    }
#pragma unroll
                    for (int kt = 0; kt < 4; ++kt) { const f32x4 lc = *(const LAS f32x4*)(SL + O_LC + (16 * kt + 4 * g) * 4);
                        f32x4 sv = S[kt] * lc; sv = __builtin_amdgcn_mfma_f32_16x16x32_bf16(mk_b(trn[kt], z2), bZ, sv, 0, 0, 0); sv = __builtin_amdgcn_mfma_f32_16x16x32_bf16(mk_b(trd[kt], z2), bV, sv, 0, 0, 0); S[kt] = sv; }
                }
                asm volatile("s_waitcnt lgkmcnt(0)" ::: "memory");
                if (l == 0) __hip_atomic_fetch_add(DONE, 1u, __ATOMIC_RELAXED, __HIP_MEMORY_SCOPE_WORKGROUP);
            }
        }
        __syncthreads();
    }
}
__device__ __forceinline__ void rwkv_out_phase(const Frame& F, const Args& a) {
    const bf16* RB = (const bf16*)(a.ws + WS_R); const bf16* KB = (const bf16*)(a.ws + WS_K); const bf16* VB = (const bf16*)(a.ws + WS_V); const bf16* LP = (const bf16*)(a.ws + WS_LP); bf16* O = (bf16*)(a.ws + WS_FXO) + 512;
    const bf16* YF = (const bf16*)a.out; const bf16* YBk = (const bf16*)a.out + (size_t)MX * RW;
    const int gw = F.vcu * NWAVES + F.wave, NGW = F.G * NWAVES, col = 8 * F.lane;
    float lg[8], lb[8];
#pragma unroll
    for (int e = 0; e < 8; ++e) { lg[e] = a.in[I_LNG][col + e]; lb[e] = a.in[I_LNB][col + e]; }
    const float* SBT = (const float*)(a.ws + WS_SBT);
    v4u ryf, ryb, rv, rg; f32x4 rsb;
#define RO_LOAD(m_) do { ryf = __builtin_nontemporal_load((const GAS v4u*)(YF + (size_t)(m_) * RW + col)); ryb = __builtin_nontemporal_load((const GAS v4u*)(YBk + (size_t)(m_) * RW + col)); \
        rv = __builtin_nontemporal_load((const GAS v4u*)(VB + (size_t)(m_) * RW + col)); rg = __builtin_nontemporal_load((const GAS v4u*)(LP + (size_t)(m_) * LN + 2048 + col)); \
        rsb = __builtin_nontemporal_load((const GAS f32x4*)(SBT + ((size_t)(m_) * 8 + (F.lane >> 3)) * 4)); } while (0)
    if (gw < MX) RO_LOAD(gw);
    for (int m = gw; m < MX; m += NGW) {
        float y[8], v[8], gg[8], o[8];
        { float yb8[8]; unpk8(ryf, y); unpk8(ryb, yb8);
#pragma unroll
          for (int e = 0; e < 8; ++e) y[e] += yb8[e]; }
        unpk8(rv, v); unpk8(rg, gg);
        const f32x4 sb4 = rsb;
        if (m + NGW < MX) RO_LOAD(m + NGW);
        float s = 0.f;
#pragma unroll
        for (int e = 0; e < 8; ++e) s += y[e];
        const float mean = red8(s) * (1.0f / 64.0f);
        float qv = 0.f; const float bs = sb4[1] + sb4[2];
#pragma unroll
        for (int e = 0; e < 8; ++e) { y[e] -= mean; qv += y[e] * y[e]; }
        const float rstd = 1.0f / sqrtf(red8(qv) * (1.0f / 64.0f) + GN_EPS);
#pragma unroll
        for (int e = 0; e < 8; ++e) o[e] = ((y[e] * rstd * lg[e] + lb[e]) + bs * v[e]) * gg[e];
        *(GAS v4u*)(O + (size_t)m * 1024 + col) = pk8(o);
    }
#undef RO_LOAD
}
__global__ void __launch_bounds__(NWAVES * 64, 2) mk_fwd(Args args) {
    extern __shared__ __attribute__((aligned(16))) unsigned char lds[];
    Frame F;
    F.lds = (LAS unsigned char*)lds;
    F.MISC = (volatile LAS unsigned*)(F.lds + MISC_OFF);
    F.tid = threadIdx.x; F.lane = F.tid & 63; F.wave = __builtin_amdgcn_readfirstlane(F.tid >> 6);
    F.G = gridDim.x; { const int bx = blockIdx.x; F.vcu = (F.G % 8 == 0) ? (bx % 8) * (F.G / 8) + bx / 8 : bx; }
    F.ctl = (gu32*)(args.ws + WS_CTL);
    for (int u = F.tid; u < (LDS_BYTES - LDSCTL_OFF) / 4; u += NWAVES * 64) ((LAS unsigned*)(F.lds + LDSCTL_OFF))[u] = 0u;
    __syncthreads();
    XcdBarrier bar; bar.bar = (unsigned*)(F.ctl + CW_BAR); bar.x = 0; bar.st = nullptr;
    if (N_LAUNCHES == 1) bar = xcd_barrier_post((unsigned*)(F.ctl + CW_BAR), F.MISC + 8);
    if (N_LAUNCHES == 1 && threadIdx.x == 0 && (bar.x != (blockIdx.x & 7u) || (gridDim.x & 7u) != 0u)) (void)xb_add((unsigned*)(F.ctl + CW_BADMAP), 1u);
#define GRID_BAR() do { if (N_LAUNCHES == 1) xcd_barrier(bar); } while (0)
    const int lo = args.ph_lo, hi = args.ph_hi;
#define IN(k) (refresh_tid(F), lo <= (k) && (k) < hi)
#define INP(k) (lo <= (k) && (k) < hi)
#define SEAM(k) do { if (INP(k) && INP((k) + 1)) GRID_BAR(); } while (0)
#define SEAM_L(k) do { if (INP(k) && INP((k) + 1)) { if (N_LAUNCHES == 1) { if (F.MISC[10]) xcd_barrier_local(bar); else xcd_barrier(bar); } } } while (0)
#define WSP(T, off) ((T*)(args.ws + (off)))
#define MOD WSP(float, WS_MOD)
#define Win_t WSP(bf16, WS_WIN)
#define Wlora_t WSP(bf16, WS_WLORA)
#define Wupf_t WSP(bf16, WS_WUPF)
#define Wupr_t WSP(bf16, WS_WUPR)
#define Wout_t WSP(bf16, WS_WOUT)
#define Wgu_t WSP(bf16, WS_WGU)
#define Wdown_t WSP(bf16, WS_WDOWN)
#define HX WSP(bf16, WS_HX)
#define PXR WSP(bf16, WS_PXR)
#define Z3 WSP(bf16, WS_Z3)
#define GF WSP(bf16, WS_GF)
#define GR WSP(bf16, WS_GR)
#define Y2 ((bf16*)((unsigned char*)args.out + 32 * MiB))
#define FX WSP(bf16, WS_FXO)
#define AL ((bf16*)args.out)
#define LP WSP(bf16, WS_LP)
#define MB WSP(bf16, WS_MB)
#define HX2 WSP(bf16, WS_HX2)
#define ACT WSP(bf16, WS_ACT)
    const int gw = F.vcu * NWAVES + F.wave, NGW = F.G * NWAVES;
    using EpiIn1 = pg8::EpiIn<WS_Z3, WS_GF, WS_GR, WS_R, WS_EB>;

    for (int rep_ = 0; rep_ < 1 + ((MK_REPEAT >> 0) & 1); ++rep_)
    if (IN(0)) { p0_weights(F, args); } SEAM(0);
    if (N_LAUNCHES == 1) {
        if (threadIdx.x == 0) F.MISC[10] = (xb_ld((unsigned*)(F.ctl + CW_BADMAP)) == 0u) ? 1u : 0u;
        __syncthreads(); }
    for (int rep_ = 0; rep_ < 1 + ((MK_REPEAT >> 1) & 1); ++rep_)
    if (IN(1)) {
        { constexpr int RPW = (MT + 2047) / 2048; const int rpw = (MT + NGW - 1) / NGW; (void)RPW; const int m0 = gw * rpw, m1 = (m0 + rpw < MT) ? m0 + rpw : MT; norm_mod_rows<0>(args, m0, m1, args.in[I_N1G], HX, F.lane); }
    } SEAM(1);
    for (int rep_ = 0; rep_ < 1 + ((MK_REPEAT >> 2) & 1); ++rep_)
    if (IN(2)) {
        { pg8::Gemm g{HX, Win_t, MX, NIN, D}; pg8::StaticOrder S; S.init(MX, NIN, F.G, (int)blockIdx.x); EpiIn1 E{args.ws, (bf16*)args.out, args.in[I_MUP], args.in[I_MUN], (LAS float*)(F.lds + XB_OFF), 0};
          pg8::gemm_phase<EpiIn1, pg8::StaticOrder, true, true>(F.lds + RING_OFF, g, S, E); }
        { pg8::Gemm g{HX + (size_t)MX * D, Win_t, MC, RPAD, D}; pg8::StaticOrder S; S.init(MC, RPAD, F.G, (int)blockIdx.x); EpiIn1 E{args.ws, (bf16*)args.out, args.in[I_MUP], args.in[I_MUN], (LAS float*)(F.lds + XB_OFF), MX};
          pg8::gemm_phase<EpiIn1, pg8::StaticOrder, true, true>(F.lds + RING_OFF, g, S, E); }
    } SEAM(2);
    for (int rep_ = 0; rep_ < 1 + ((MK_REPEAT >> 3) & 1); ++rep_)
    if (IN(3)) { edge_rows(F, args); dft_pass_a(F, Z3, Y2); } SEAM(3);
    for (int rep_ = 0; rep_ < 1 + ((MK_REPEAT >> 7) & 1); ++rep_)
    if (IN(7)) { dft_pass_b(F, Y2, FX); __syncthreads();
        pg8::Gemm g{AL, Wlora_t, MT, LN, LK}; pg8::StaticOrder S; S.init(MT, LN, F.G, (int)blockIdx.x); pg8::EpiLora E{LP, WSP(const float, WS_LB)};
        pg8::gemm_phase<pg8::EpiLora, pg8::StaticOrder, true, true>(F.lds + RING_OFF, g, S, E); } SEAM(7);
    for (int rep_ = 0; rep_ < 1 + ((MK_REPEAT >> 8) & 1); ++rep_)
    if (IN(8)) { scan_phase(F, args); } SEAM(8);
    for (int rep_ = 0; rep_ < 1 + ((MK_REPEAT >> 9) & 1); ++rep_)
    if (IN(9)) { rwkv_out_phase(F, args); } SEAM(9);
    for (int rep_ = 0; rep_ < 1 + ((MK_REPEAT >> 10) & 1); ++rep_)
    if (IN(10)) { pg8::Gemm g{FX, Wupf_t, MX, D, D}; pg8::StaticOrder S; S.init(MX, D, F.G, (int)blockIdx.x); pg8::EpiMerge2 E{MB, GF, GR};
        pg8::gemm_phase<pg8::EpiMerge2, pg8::StaticOrder, true, true>(F.lds + RING_OFF, g, S, E); } SEAM_L(10);
    for (int rep_ = 0; rep_ < 1 + ((MK_REPEAT >> 11) & 1); ++rep_)
    if (IN(11)) { pg8::Gemm g{MB, Wout_t, MX, D, D}; pg8::StaticOrder S; S.init(MX, D, F.G, (int)blockIdx.x); pg8::EpiDelta E{WSP(bf16, WS_D1), MOD + 2048};
        pg8::gemm_phase<pg8::EpiDelta, pg8::StaticOrder, true, true>(F.lds + RING_OFF, g, S, E); } SEAM_L(11);
    for (int rep_ = 0; rep_ < 1 + ((MK_REPEAT >> 12) & 1); ++rep_)
    if (IN(12)) {
        p_weights2(F, args);
        { const int rpw = (MX + NGW - 1) / NGW; const int m0 = gw * rpw, m1 = (m0 + rpw < MX) ? m0 + rpw : MX; norm_mod_rows<1>(args, m0, m1, args.in[I_N2G], HX2, F.lane); }
    } SEAM(12);
    for (int rep_ = 0; rep_ < 1 + ((MK_REPEAT >> 13) & 1); ++rep_)
    if (IN(13)) { pg8::Gemm g{HX2, Wgu_t, MX, 2 * DFF, D}; pg8::StaticOrder S; S.init(MX, 2 * DFF, F.G, (int)blockIdx.x); pg8::EpiSwiglu E{ACT};
        pg8::gemm_phase<pg8::EpiSwiglu, pg8::StaticOrder, true, true>(F.lds + RING_OFF, g, S, E); } SEAM_L(13);
    for (int rep_ = 0; rep_ < 1 + ((MK_REPEAT >> 14) & 1); ++rep_)
    if (IN(14)) { pg8::Gemm g{ACT, Wdown_t, MX, D, DFF}; pg8::StaticOrder S; S.init(MX, D, F.G, (int)blockIdx.x); pg8::EpiDelta E{WSP(bf16, WS_D2), MOD + 5120};
        pg8::gemm_phase<pg8::EpiDelta, pg8::StaticOrder, true, true>(F.lds + RING_OFF, g, S, E); } SEAM_L(14);
    for (int rep_ = 0; rep_ < 1 + ((MK_REPEAT >> 15) & 1); ++rep_)
    if (IN(15)) {
        const int wpx = (F.G % 8 == 0) ? NGW / 8 : NGW, rpx = (F.G % 8 == 0) ? MX / 8 : MX, xg = gw / wpx, lw = gw % wpx;
        f32x4 px[4]; v2u pd1[4], pd2[4];
#define FN_LOAD(m_) do { const GAS f32x4* xin = (const GAS f32x4*)(args.in[I_X] + (size_t)(m_) * D) + F.lane; const GAS v2u* dr = (const GAS v2u*)(WSP(bf16, WS_D2) + (size_t)(m_) * D) + F.lane; \
            const GAS v2u* d1r = (const GAS v2u*)(WSP(bf16, WS_D1) + (size_t)(m_) * D) + F.lane; \
            _Pragma("unroll") for (int j = 0; j < 4; ++j) { px[j] = __builtin_nontemporal_load(xin + 64 * j); pd1[j] = __builtin_nontemporal_load(d1r + 64 * j); pd2[j] = __builtin_nontemporal_load(dr + 64 * j); } } while (0)
        const int mbeg = xg * rpx + lw, mend = (xg + 1) * rpx;
        if (mbeg < mend) FN_LOAD(mbeg);
        f32x4 fng[4];
#pragma unroll
        for (int j = 0; j < 4; ++j) fng[j] = ((const f32x4*)args.in[I_FNG])[F.lane + 64 * j];
        for (int m = mbeg; m < mend; m += wpx) {
            GAS f32x4* xr = (GAS f32x4*)(args.out + (size_t)m * D) + F.lane; f32x4 v[4]; float s2 = 0.f;
#pragma unroll
            for (int j = 0; j < 4; ++j) { const v2u dd = pd2[j], d1 = pd1[j]; v[j] = (px[j] + (f32x4){bflo(d1.x), bfhi(d1.x), bflo(d1.y), bfhi(d1.y)}) + (f32x4){bflo(dd.x), bfhi(dd.x), bflo(dd.y), bfhi(dd.y)}; s2 += (v[j].x * v[j].x + v[j].y * v[j].y) + (v[j].z * v[j].z + v[j].w * v[j].w); }
            if (m + wpx < mend) FN_LOAD(m + wpx);
            const float rstd = 1.0f / sqrtf(wave_sum(s2) * (1.f / D) + NORM_EPS);
#pragma unroll
            for (int j = 0; j < 4; ++j) xr[64 * j] = (v[j] * rstd) * fng[j];
        }
#undef FN_LOAD
    }
#undef IN
#undef SEAM
#undef GRID_BAR
}

extern "C" void kernel_launch(void* const* d_in, const int* in_sizes, int n_in, void* d_out, int out_size, void* d_ws, size_t ws_size, hipStream_t stream) {
    static int grid = 0;
    if (grid == 0) {
        if (n_in != 31 || in_sizes[0] != MX * D || out_size != MX * D || ws_size < WS_END) { fprintf(stderr, "kernel_launch: shape/workspace mismatch (n_in %d, in0 %d, out %d, ws %zu); nothing launched\n", n_in, n_in > 0 ? in_sizes[0] : -1, out_size, ws_size); grid = -1; return; }
        int dev = 0, cus = 0;
        if (hipGetDevice(&dev) != hipSuccess || hipDeviceGetAttribute(&cus, hipDeviceAttributeMultiprocessorCount, dev) != hipSuccess) { grid = -1; return; }
        if (hipFuncSetAttribute((const void*)mk_fwd, hipFuncAttributeMaxDynamicSharedMemorySize, LDS_BYTES) != hipSuccess) { fprintf(stderr, "kernel_launch: hipFuncSetAttribute failed\n"); grid = -1; return; }
        (void)hipGetLastError();
        grid = cus;
    }
    if (grid < 0) return;
    if (hipMemsetAsync((char*)d_ws + WS_CTL, 0, CTL_ZERO_BYTES, stream) != hipSuccess) return;
    Args a{};
    for (int i = 0; i < 31; ++i) a.in[i] = (const float*)d_in[i];
    a.out = (float*)d_out; a.ws = (unsigned char*)d_ws;
    if (N_LAUNCHES == 1) { a.ph_lo = 0; a.ph_hi = NPH; a.li = 0; hipLaunchKernelGGL(mk_fwd, dim3(grid), dim3(NWAVES * 64), LDS_BYTES, stream, a); }
    else for (int p = 0; p < NPH; ++p) { a.ph_lo = p; a.ph_hi = p + 1; a.li = p; hipLaunchKernelGGL(mk_fwd, dim3(grid), dim3(NWAVES * 64), LDS_BYTES, stream, a); }
}
```

```cpp
#include <hip/hip_runtime.h>
#include <cstdio>
#include <cstdint>
#ifndef MK_REPEAT
#define MK_REPEAT 0x0
#endif
#ifndef MK_N_LAUNCHES
#define MK_N_LAUNCHES 1
#endif
namespace pg8 {
#define PG8_LAS __attribute__((address_space(3)))
typedef unsigned short bf16_t;
typedef short bf16x8 __attribute__((ext_vector_type(8)));
typedef float f32x4 __attribute__((ext_vector_type(4)));
typedef unsigned u32x4 __attribute__((ext_vector_type(4)));
constexpr int BM = 256, BK = 64, HALF = 128, HTB = HALF * BK * 2  , STAGE_BYTES = 8 * HTB, NXCD = 8, WGM = 8;

__host__ __device__ __forceinline__ int lds_byte(int r, int c) { const int st = (r >> 4) * 2 + (c >> 5), rr = r & 15, cc = c & 31, ob = rr * 64 + cc * 2; return st * 1024 + (ob ^ (((ob >> 9) & 1) << 5)); }
__host__ __device__ __forceinline__ void stage_rc(int b, int& R, int& C) { const int st = b / 1024, sb = b % 1024, swz = sb ^ (((sb >> 9) & 1) << 5); R = (st >> 1) * 16 + swz / 64; C = (st & 1) * 32 + (swz % 64) / 2; }
__host__ __device__ __forceinline__ int perm32(int rho) { const int n = rho >> 4, i = rho & 15; return 8 * (i >> 2) + 4 * n + (i & 3); }

struct Unit { int pm, pn; };
struct Gemm { const bf16_t* A; const bf16_t* Bt; int M, N, K; };

struct StaticOrder {
    int nM, nN, nwg, G, c;
    __host__ __device__ void init(int M, int N, int G_, int c_) { nM = M / BM; nN = N / BM; nwg = nM * nN; G = G_; c = c_; }
    __host__ __device__ bool next(int i, Unit& u) const {
        const long L = (long)i * G + c; if (L >= nwg) return false;
        int wgid = (int)L; { const int q = nwg / NXCD, r = nwg % NXCD, xcd = wgid % NXCD, off = wgid / NXCD; wgid = (xcd < r ? xcd * (q + 1) : r * (q + 1) + (xcd - r) * q) + off; }
        const int nig = WGM * nN, gid = wgid / nig, fm = gid * WGM, gsz = (nM - fm) < WGM ? (nM - fm) : WGM;
        u.pm = fm + ((wgid % nig) % gsz); u.pn = (wgid % nig) / gsz; return true;
    }
    __device__ __forceinline__ void a_ready(const Unit&) const {}
    __device__ __forceinline__ void done(const Unit&) const {}
};

__device__ __forceinline__ unsigned cvt_pk_bf16(float lo, float hi) { unsigned r; asm volatile("v_cvt_pk_bf16_f32 %0, %1, %2" : "=v"(r) : "v"(lo), "v"(hi)); return r; }
__device__ __forceinline__ float bf_lo(unsigned w) { return __uint_as_float(w << 16); }
__device__ __forceinline__ float bf_hi(unsigned w) { return __uint_as_float(w & 0xffff0000u); }
__device__ __forceinline__ float sigm(float x) { return __builtin_amdgcn_rcpf(1.0f + __expf(-x)); }
__device__ __forceinline__ f32x4 sigm4(f32x4 v) { return (f32x4){sigm(v[0]), sigm(v[1]), sigm(v[2]), sigm(v[3])}; }
__device__ __forceinline__ u32x4 pack8(f32x4 v0, f32x4 v1) { u32x4 w; w.x = cvt_pk_bf16(v0[0], v0[1]); w.y = cvt_pk_bf16(v0[2], v0[3]); w.z = cvt_pk_bf16(v1[0], v1[1]); w.w = cvt_pk_bf16(v1[2], v1[3]); return w; }
__device__ __forceinline__ void unpack8(u32x4 w, f32x4& v0, f32x4& v1) { v0 = (f32x4){bf_lo(w.x), bf_hi(w.x), bf_lo(w.y), bf_hi(w.y)}; v1 = (f32x4){bf_lo(w.z), bf_hi(w.z), bf_lo(w.w), bf_hi(w.w)}; }
template <int CTRL> __device__ __forceinline__ float dpp_rot(float src) { return __int_as_float(__builtin_amdgcn_mov_dpp(__float_as_int(src), CTRL, 0xF, 0xF, true)); }
template <size_t O_Z3, size_t O_GF, size_t O_GR, size_t O_R, size_t O_EB> struct EpiIn {
    static constexpr bool PERM = true, AFTER_DRAIN = false, HAS_MID = false; static constexpr int KSLICE = 0; static constexpr bool SKIP_B1 = true, HAS_PRE = true;
    static __device__ __forceinline__ bool skip_b1(int pn) { return pn == 7; }
    static constexpr size_t RKV_STRIDE = (size_t)36 * 1024 * 1024 / 2;
    unsigned char* ws; bf16_t* al; const float* mup; const float* mun; PG8_LAS float* xb; int row_off;
    __device__ __forceinline__ void pre(const Unit& u, int ui, int wid, int lane) const {
        if (u.pn >= 8) return;
        const int t = wid * 64 + lane, col = 256 * u.pn + (t & 255);
        const float* src = (t < 256 ? mup : mun) + (col < 1920 ? col : 0);
        __builtin_amdgcn_global_load_lds((const unsigned*)src, (PG8_LAS unsigned*)(xb + 2048 + (ui & 1) * 512 + wid * 64), 4, 0, 0);
    }
    __device__ __forceinline__ void operator()(const f32x4 (&acc)[2][2][4][2], const Unit& u, int wr, int wc, int fr, int fq, int ui) const {
        const int pn = u.pn;
        if (pn >= 8) {
            const int row0 = row_off + u.pm * BM + wr * 64 + fr;
            if (pn < 10) {
                bf16_t* base = (bf16_t*)(ws + O_Z3); const int col0 = (pn - 8) * 256 + wc * 32 + 8 * fq;
#pragma unroll
                for (int ai = 0; ai < 2; ++ai)
#pragma unroll
                    for (int m = 0; m < 4; ++m) { bf16_t* rowp = base + (size_t)(row0 + ai * HALF + m * 16) * 512 + col0;
#pragma unroll
                        for (int bj = 0; bj < 2; ++bj) *(u32x4*)(rowp + bj * HALF) = pack8(acc[ai][bj][m][0], acc[ai][bj][m][1]); }
            } else {
                bf16_t* gq = (bf16_t*)(ws + O_GF); bf16_t* gr = (bf16_t*)(ws + O_GR); const int col0 = (pn - 10) * 128 + wc * 32 + 8 * fq;
#pragma unroll
                for (int ai = 0; ai < 2; ++ai)
#pragma unroll
                    for (int m = 0; m < 4; ++m) { const size_t off = (size_t)(row0 + ai * HALF + m * 16) * 1024 + col0;
                        f32x4 qv[2], sv[2];
#pragma unroll
                        for (int n = 0; n < 2; ++n)
#pragma unroll
                            for (int e = 0; e < 4; ++e) { const float ef = __expf(-acc[ai][0][m][n][e]), er1 = 1.0f + __expf(-acc[ai][1][m][n][e]);
                                sv[n][e] = __builtin_amdgcn_rcpf(er1); qv[n][e] = __builtin_amdgcn_rcpf(1.0f + ef) * fminf(er1, 1e20f); }
                        *(u32x4*)(gq + off) = pack8(qv[0], qv[1]); *(u32x4*)(gr + off) = pack8(sv[0], sv[1]); }
            }
            return;
        }
        asm volatile("" : "+v"(fr), "+v"(fq));
        const int cw = wc * 32 + 8 * fq, tile = (row_off >> 8) + u.pm;
        float* eb = (float*)(ws + O_EB); bf16_t* rkv = (bf16_t*)(ws + O_R);
#pragma unroll
        for (int ai = 0; ai < 2; ++ai)
#pragma unroll
            for (int bj = 0; bj < 2; ++bj)
#pragma unroll
                for (int n = 0; n < 2; ++n) { PG8_LAS float* p0 = xb + ((2 * ai + wr) * 2) * 256 + 128 * bj + cw + 4 * n;
                    if (fr == 0) *(PG8_LAS f32x4*)p0 = acc[ai][bj][0][n];
                    if (fr == 15) *(PG8_LAS f32x4*)(p0 + 256) = acc[ai][bj][3][n]; }
        if (wr == 0 && fr < 2) {
#pragma unroll
            for (int bj = 0; bj < 2; ++bj)
#pragma unroll
                for (int n = 0; n < 2; ++n) *(f32x4*)(eb + ((size_t)tile * 4 + fr) * 2048 + 256 * pn + 128 * bj + cw + 4 * n) = acc[0][bj][0][n]; }
        if (wr == 1 && fr >= 14) {
#pragma unroll
            for (int bj = 0; bj < 2; ++bj)
#pragma unroll
                for (int n = 0; n < 2; ++n) *(f32x4*)(eb + ((size_t)tile * 4 + 2 + (fr - 14)) * 2048 + 256 * pn + 128 * bj + cw + 4 * n) = acc[1][bj][3][n]; }
        asm volatile("s_waitcnt lgkmcnt(0)" ::: "memory"); __builtin_amdgcn_s_barrier(); asm volatile("" ::: "memory");
        bf16_t* dst; int ldd, dcol;
        if (pn < 6) { dst = rkv + (size_t)(pn >> 1) * RKV_STRIDE; ldd = 512; dcol = (pn & 1) * 256; } else { dst = al; ldd = 384; dcol = (pn - 6) * 256; }
#pragma unroll
        for (int bj = 0; bj < 2; ++bj) {
            if (pn == 7 && bj == 1) continue;
            const int act = (pn == 6 && bj == 0) ? 1 : (pn == 7) ? 2 : 0;
            const PG8_LAS float* tab = xb + 2048 + (ui & 1) * 512 + 128 * bj + cw;
            const bool f0 = fr == 0, f15 = fr == 15; const f32x4 z4 = {0.f, 0.f, 0.f, 0.f};
#pragma unroll
            for (int ai = 0; ai < 2; ++ai) { const int q = 2 * ai + wr;
                unsigned pk[4][2][2];
#pragma unroll
                for (int n = 0; n < 2; ++n) {
                    const f32x4 mp = *(const PG8_LAS f32x4*)(tab + 4 * n), mn = *(const PG8_LAS f32x4*)(tab + 256 + 4 * n);
                    const f32x4 w0 = 1.0f - mp - mn, mpA = f0 ? z4 : mp, mpB = f0 ? mp : z4, mnA = f15 ? z4 : mn, mnB = f15 ? mn : z4;
                    f32x4 xp = z4, xn = z4;
                    if (q > 0) xp = *(const PG8_LAS f32x4*)(xb + ((q - 1) * 2 + 1) * 256 + 128 * bj + cw + 4 * n);
                    if (q < 3) xn = *(const PG8_LAS f32x4*)(xb + ((q + 1) * 2) * 256 + 128 * bj + cw + 4 * n);
                    f32x4 R1[4], L1[4];
#pragma unroll
                    for (int m = 0; m < 4; ++m)
#pragma unroll
                        for (int e = 0; e < 4; ++e) { R1[m][e] = dpp_rot<0x121>(acc[ai][bj][m][n][e]); L1[m][e] = dpp_rot<0x12F>(acc[ai][bj][m][n][e]); }
#pragma unroll
                    for (int m = 0; m < 4; ++m) {
                        f32x4 uu = w0 * acc[ai][bj][m][n] + mpA * R1[m] + mpB * (m > 0 ? R1[m > 0 ? m - 1 : 0] : xp) + mnA * L1[m] + mnB * (m < 3 ? L1[m < 3 ? m + 1 : 3] : xn);
                        if (act == 1) uu = 2.0f * sigm4(2.0f * uu) - 1.0f; else if (act == 2) uu = sigm4(uu);
                        pk[m][n][0] = cvt_pk_bf16(uu[0], uu[1]); pk[m][n][1] = cvt_pk_bf16(uu[2], uu[3]); }
                }
#pragma unroll
                for (int m = 0; m < 4; ++m) *(u32x4*)(dst + (size_t)(row_off + u.pm * BM + 128 * ai + 64 * wr + 16 * m + fr) * ldd + dcol + 128 * bj + cw) = (u32x4){pk[m][0][0], pk[m][0][1], pk[m][1][0], pk[m][1][1]};
            }
        }
    }
};
struct EpiLora {
    static constexpr bool PERM = true, AFTER_DRAIN = false, HAS_MID = false; static constexpr int KSLICE = 128; static constexpr bool SKIP_B1 = false, HAS_PRE = true;
    bf16_t* lp; const float* bias; PG8_LAS float* tab;
    __device__ __forceinline__ void pre(const Unit& u, int ui, int wid, int lane) const {
        if (wid < 4) __builtin_amdgcn_global_load_lds((const unsigned*)(bias + 256 * u.pn + wid * 64 + lane), (PG8_LAS unsigned*)(tab + (ui & 1) * 256 + wid * 64), 4, 0, 0);
    }
    static __device__ __forceinline__ int koff(int pn) { const int t = pn >> 1; return t >= 4 ? 256 : (t >= 2 ? 128 : 0); }
    __device__ __forceinline__ void operator()(const f32x4 (&acc)[2][2][4][2], const Unit& u, int wr, int wc, int fr, int fq, int ui) const {
        const int pn = u.pn, t = pn >> 1;
        const PG8_LAS float* tb = tab + (ui & 1) * 256 + wc * 32 + 8 * fq;
        const int row0 = u.pm * BM + wr * 64 + fr, col0 = pn * 256 + wc * 32 + 8 * fq;
        const float sc = t < 2 ? -0.6065306597f : 1.0f;
#pragma unroll
        for (int bj = 0; bj < 2; ++bj) { const f32x4 b0 = *(const PG8_LAS f32x4*)(tb + bj * HALF), b1 = *(const PG8_LAS f32x4*)(tb + bj * HALF + 4);
#pragma unroll
            for (int ai = 0; ai < 2; ++ai)
#pragma unroll
                for (int m = 0; m < 4; ++m) { f32x4 v0 = acc[ai][bj][m][0] + b0, v1 = acc[ai][bj][m][1] + b1;
                    if (t < 4) { v0 = sigm4(v0) * sc; v1 = sigm4(v1) * sc; }
                    *(u32x4*)(lp + (size_t)(row0 + ai * HALF + m * 16) * 2560 + col0 + bj * HALF) = pack8(v0, v1); } }
    }
};
struct EpiMerge2 {
    static constexpr bool PERM = true, AFTER_DRAIN = false, HAS_MID = true; static constexpr int KSLICE = 0; static constexpr bool SKIP_B1 = false, HAS_PRE = false;
    bf16_t* mb; const bf16_t* gf; const bf16_t* gr;
    __device__ __forceinline__ void mid(f32x4 (&acc)[2][2][4][2], const Unit& u, int wr, int wc, int fr, int fq) const {
        asm volatile("" : "+v"(fr), "+v"(fq));
        const int row0 = u.pm * BM + wr * 64 + fr, col0 = u.pn * BM + wc * 32 + 8 * fq;
        constexpr int DEPTH = 8;
        u32x4 fw[DEPTH];
#define PG8_GOFF(it_) ((size_t)(row0 + ((it_) >> 3) * HALF + (((it_) >> 1) & 3) * 16) * 1024 + col0 + ((it_) & 1) * HALF)
#pragma unroll
        for (int d = 0; d < DEPTH; ++d) fw[d] = *(const u32x4*)(gf + PG8_GOFF(d));
#pragma unroll
        for (int it = 0; it < 16; ++it) { const int ai = it >> 3, m = (it >> 1) & 3, bj = it & 1, sl = it % DEPTH;
            const u32x4 fwc = fw[sl];
            asm volatile("" ::: "memory");
            if (it + DEPTH < 16) fw[sl] = *(const u32x4*)(gf + PG8_GOFF(it + DEPTH));
            asm volatile("" ::: "memory");
            acc[ai][bj][m][0][0] *= bf_lo(fwc.x); acc[ai][bj][m][0][1] *= bf_hi(fwc.x); acc[ai][bj][m][0][2] *= bf_lo(fwc.y); acc[ai][bj][m][0][3] *= bf_hi(fwc.y);
            acc[ai][bj][m][1][0] *= bf_lo(fwc.z); acc[ai][bj][m][1][1] *= bf_hi(fwc.z); acc[ai][bj][m][1][2] *= bf_lo(fwc.w); acc[ai][bj][m][1][3] *= bf_hi(fwc.w); }
    }
    __device__ __forceinline__ void operator()(const f32x4 (&acc)[2][2][4][2], const Unit& u, int wr, int wc, int fr, int fq) const {
        const int row0 = u.pm * BM + wr * 64 + fr, col0 = u.pn * BM + wc * 32 + 8 * fq;
        constexpr int DEPTH = 8;
        u32x4 rw[DEPTH];
#pragma unroll
        for (int d = 0; d < DEPTH; ++d) rw[d] = *(const u32x4*)(gr + PG8_GOFF(d));
#pragma unroll
        for (int it = 0; it < 16; ++it) { const int ai = it >> 3, m = (it >> 1) & 3, bj = it & 1, sl = it % DEPTH;
            const u32x4 rwc = rw[sl];
            asm volatile("" ::: "memory");
            if (it + DEPTH < 16) rw[sl] = *(const u32x4*)(gr + PG8_GOFF(it + DEPTH));
            asm volatile("" ::: "memory");
            f32x4 g0, g1; unpack8(rwc, g0, g1);
#pragma unroll
            for (int e = 0; e < 4; ++e) { g0[e] = fmaxf(g0[e], 1e-20f); g1[e] = fmaxf(g1[e], 1e-20f); }
            *(u32x4*)(mb + PG8_GOFF(it)) = pack8(g0 * acc[ai][bj][m][0], g1 * acc[ai][bj][m][1]); }
#undef PG8_GOFF
    }
};
struct EpiResid {
    static constexpr bool PERM = false, AFTER_DRAIN = false, HAS_MID = false; static constexpr int KSLICE = 0; static constexpr bool SKIP_B1 = false, HAS_PRE = false;
    const float* base; float* out; const float* gate;
    __device__ __forceinline__ void operator()(const f32x4 (&acc)[2][2][4][2], const Unit& u, int wr, int wc, int fr, int fq) const {
        const int row0 = u.pm * BM + wr * 64 + fr, col0 = u.pn * BM + wc * 32 + 4 * fq; const float* gp = gate + (size_t)(u.pm >> 3) * 6144 + col0;
        f32x4 gv[2][2];
#pragma unroll
        for (int bj = 0; bj < 2; ++bj)
#pragma unroll
            for (int n = 0; n < 2; ++n) gv[bj][n] = *(const f32x4*)(gp + bj * HALF + n * 16);
        f32x4 cur[2][2], nxt[2][2];
#pragma unroll
        for (int bj = 0; bj < 2; ++bj)
#pragma unroll
            for (int n = 0; n < 2; ++n) cur[bj][n] = *(const f32x4*)(base + (size_t)row0 * 1024 + col0 + bj * HALF + n * 16);
#pragma unroll
        for (int g8 = 0; g8 < 8; ++g8) { const int ai = g8 >> 2, m = g8 & 3; const size_t off = (size_t)(row0 + ai * HALF + m * 16) * 1024 + col0;
            if (g8 + 1 < 8) { const int ai2 = (g8 + 1) >> 2, m2 = (g8 + 1) & 3; const size_t off2 = (size_t)(row0 + ai2 * HALF + m2 * 16) * 1024 + col0;
#pragma unroll
                for (int bj = 0; bj < 2; ++bj)
#pragma unroll
                    for (int n = 0; n < 2; ++n) nxt[bj][n] = *(const f32x4*)(base + off2 + bj * HALF + n * 16); }
            asm volatile("" ::: "memory");
#pragma unroll
            for (int bj = 0; bj < 2; ++bj)
#pragma unroll
                for (int n = 0; n < 2; ++n) *(f32x4*)(out + off + bj * HALF + n * 16) = cur[bj][n] + gv[bj][n] * acc[ai][bj][m][n];
            asm volatile("" ::: "memory");
#pragma unroll
            for (int bj = 0; bj < 2; ++bj)
#pragma unroll
                for (int n = 0; n < 2; ++n) cur[bj][n] = nxt[bj][n];
        }
    }
};
struct EpiDelta {
    static constexpr bool PERM = true, AFTER_DRAIN = false, HAS_MID = false; static constexpr int KSLICE = 0; static constexpr bool SKIP_B1 = false, HAS_PRE = true;
    bf16_t* dlt; const float* gate; PG8_LAS float* tab;
    __device__ __forceinline__ void pre(const Unit& u, int ui, int wid, int lane) const {
        if (wid < 4) __builtin_amdgcn_global_load_lds((const unsigned*)(gate + (size_t)(u.pm >> 3) * 6144 + 256 * u.pn + wid * 64 + lane), (PG8_LAS unsigned*)(tab + (ui & 1) * 256 + wid * 64), 4, 0, 0);
    }
    __device__ __forceinline__ void operator()(const f32x4 (&acc)[2][2][4][2], const Unit& u, int wr, int wc, int fr, int fq, int ui) const {
        const int row0 = u.pm * BM + wr * 64 + fr, col0 = u.pn * BM + wc * 32 + 8 * fq; const PG8_LAS float* gp = tab + (ui & 1) * 256 + wc * 32 + 8 * fq;
        f32x4 gv[2][2];
#pragma unroll
        for (int bj = 0; bj < 2; ++bj)
#pragma unroll
            for (int n = 0; n < 2; ++n) gv[bj][n] = *(const PG8_LAS f32x4*)(gp + bj * HALF + 4 * n);
#pragma unroll
        for (int ai = 0; ai < 2; ++ai)
#pragma unroll
            for (int m = 0; m < 4; ++m) { bf16_t* rowp = dlt + (size_t)(row0 + ai * HALF + m * 16) * 1024 + col0;
#pragma unroll
                for (int bj = 0; bj < 2; ++bj) *(u32x4*)(rowp + bj * HALF) = pack8(acc[ai][bj][m][0] * gv[bj][0], acc[ai][bj][m][1] * gv[bj][1]); }
    }
};
struct EpiSwiglu {
    static constexpr bool PERM = true, AFTER_DRAIN = false, HAS_MID = false; static constexpr int KSLICE = 0; static constexpr bool SKIP_B1 = false, HAS_PRE = false;
    bf16_t* act;
    __device__ __forceinline__ void operator()(const f32x4 (&acc)[2][2][4][2], const Unit& u, int wr, int wc, int fr, int fq) const {
        const int row0 = u.pm * BM + wr * 64 + fr, col0 = u.pn * 128 + wc * 32 + 8 * fq;
#pragma unroll
        for (int ai = 0; ai < 2; ++ai)
#pragma unroll
            for (int m = 0; m < 4; ++m) { const f32x4 g0 = acc[ai][0][m][0], g1 = acc[ai][0][m][1];
                *(u32x4*)(act + (size_t)(row0 + ai * HALF + m * 16) * 2816 + col0) = pack8(g0 * sigm4(g0) * acc[ai][1][m][0], g1 * sigm4(g1) * acc[ai][1][m][1]); }
    }
};

template <class Epi, class Sched, bool ALIGN_EPI = false, bool SP2 = false>
__device__ __forceinline__ void gemm_phase(PG8_LAS unsigned char* lds, const Gemm g, const Sched& S, const Epi& E) {
    int tid_ = threadIdx.x; asm volatile("" : "+v"(tid_));
    const int tid = tid_, wid = __builtin_amdgcn_readfirstlane(tid >> 6), lane = tid & 63, wr = wid >> 2, wc = wid & 3, fr = lane & 15, fq = lane >> 4;
    int nt_ = Epi::KSLICE ? Epi::KSLICE / BK : g.K / BK; asm volatile("" : "+s"(nt_));
    const int K = g.K, nt = nt_;
    unsigned voffA[2], voffB[2];
#pragma unroll
    for (int i = 0; i < 2; ++i) { int R, C; stage_rc(tid * 16 + i * 8192, R, C); const int Rb = Epi::PERM ? ((R & ~31) + perm32(R & 31)) : R;
        voffA[i] = (unsigned)(R * K + C) * 2u; voffB[i] = (unsigned)(Rb * K + C) * 2u; }
    const size_t kstep = (size_t)(BK * 2);
    const size_t hstep = (size_t)HALF * K * 2;
    const size_t tstep = 2 * hstep;
    const unsigned ldsw = (unsigned)wid * 1024u;
    const int aoff = lds_byte(wr * 64 + fr, fq * 8), boff = lds_byte(wc * 32 + fr, fq * 8);
#define PG8_SA(b, h) (((b) * 2 + (h)) * HTB)
#define PG8_SB(b, h) ((4 + (b) * 2 + (h)) * HTB)
#define PG8_STAGE(bufoff, gbase, voff) do { _Pragma("unroll") for (int _i = 0; _i < 2; ++_i) \
        __builtin_amdgcn_global_load_lds((const unsigned*)((const char*)(gbase) + (voff)[_i]), (PG8_LAS unsigned*)(lds + (bufoff) + ldsw + _i * 8192), 16, 0, 0); } while (0)
#define PG8_LDA(dst, b, h) do { _Pragma("unroll") for (int m = 0; m < 4; ++m) _Pragma("unroll") for (int k = 0; k < 2; ++k) dst[m][k] = *(const PG8_LAS bf16x8*)(lds + PG8_SA(b, h) + aoff + m * 2048 + k * 1024); } while (0)
#define PG8_LDB(dst, b, h) do { _Pragma("unroll") for (int n = 0; n < 2; ++n) _Pragma("unroll") for (int k = 0; k < 2; ++k) dst[n][k] = *(const PG8_LAS bf16x8*)(lds + PG8_SB(b, h) + boff + n * 2048 + k * 1024); } while (0)
#define PG8_MMA(ai, bj, At, Bt) do { __builtin_amdgcn_s_setprio(1); _Pragma("unroll") for (int m = 0; m < 4; ++m) _Pragma("unroll") for (int n = 0; n < 2; ++n) _Pragma("unroll") for (int k = 0; k < 2; ++k) \
        acc[ai][bj][m][n] = __builtin_amdgcn_mfma_f32_16x16x32_bf16(Bt[n][k], At[m][k], acc[ai][bj][m][n], 0, 0, 0); __builtin_amdgcn_s_setprio(0); } while (0)
#define PG8_MMA1(ai, At) do { if constexpr (Epi::SKIP_B1) { if (!skb) PG8_MMA(ai, 1, At, B1); } else PG8_MMA(ai, 1, At, B1); } while (0)
#define PG8_WAIT_V(n) asm volatile("s_waitcnt vmcnt(" #n ")" ::: "memory")
#define PG8_WAIT_L(n) asm volatile("s_waitcnt lgkmcnt(" #n ")" ::: "memory")
#define PG8_BAR __builtin_amdgcn_s_barrier()
#define PG8_SCHED __builtin_amdgcn_sched_barrier(0)
    Unit cur, nxt; int ui = 0;
    if (!S.next(0, cur)) return;
    bool skb = false; if constexpr (Epi::SKIP_B1) skb = Epi::skip_b1(cur.pn);
    if constexpr (Epi::HAS_PRE) E.pre(cur, 0, wid, lane);
    f32x4 acc[2][2][4][2];
#pragma unroll
    for (int a = 0; a < 2; ++a)
#pragma unroll
        for (int b = 0; b < 2; ++b)
#pragma unroll
            for (int m = 0; m < 4; ++m)
#pragma unroll
                for (int n = 0; n < 2; ++n) acc[a][b][m][n] = (f32x4){0.f, 0.f, 0.f, 0.f};
    bf16x8 At[4][2], B0[2][2], B1[2][2];
    const char* cA = (const char*)g.A + (size_t)cur.pm * tstep; const char* cB = (const char*)g.Bt + (size_t)cur.pn * tstep;
    if constexpr (Epi::KSLICE != 0) { const int ko = Epi::koff(cur.pn) * 2; cA += ko; cB += ko; }
    S.a_ready(cur);
    if constexpr (SP2) {
        PG8_STAGE(PG8_SB(0, 0), cB, voffB); PG8_STAGE(PG8_SB(0, 1), cB + hstep, voffB); PG8_STAGE(PG8_SA(0, 0), cA, voffA); PG8_STAGE(PG8_SA(0, 1), cA + hstep, voffA);
        if (wr == 1) PG8_BAR;
        PG8_WAIT_V(2); PG8_BAR;
        PG8_STAGE(PG8_SB(1, 0), cB + kstep, voffB); PG8_STAGE(PG8_SA(1, 0), cA + kstep, voffA); PG8_STAGE(PG8_SB(1, 1), cB + hstep + kstep, voffB);
        PG8_WAIT_V(6); PG8_BAR;
    } else {
        PG8_STAGE(PG8_SB(0, 0), cB, voffB); PG8_STAGE(PG8_SA(0, 0), cA, voffA); PG8_STAGE(PG8_SB(0, 1), cB + hstep, voffB); PG8_STAGE(PG8_SA(0, 1), cA + hstep, voffA);
        if (wr == 1) PG8_BAR;
        PG8_WAIT_V(4); PG8_BAR;
        PG8_STAGE(PG8_SB(1, 0), cB + kstep, voffB); PG8_STAGE(PG8_SA(1, 0), cA + kstep, voffA); PG8_STAGE(PG8_SB(1, 1), cB + hstep + kstep, voffB);
        PG8_WAIT_V(6); PG8_BAR;
    }
    for (;;) {
        const bool has_next = S.next(ui + 1, nxt);
        const char* nA = has_next ? (const char*)g.A + (size_t)nxt.pm * tstep : cA; const char* nB = has_next ? (const char*)g.Bt + (size_t)nxt.pn * tstep : cB;
        if constexpr (Epi::KSLICE != 0) { if (has_next) { const int ko = Epi::koff(nxt.pn) * 2; nA += ko; nB += ko; } }
#pragma unroll 1
        for (int t = 0; t < nt; t += 2) {
            const bool last = (t == nt - 2);
            const char* a1 = cA + (size_t)(t + 1) * kstep;
            const char* a2 = last ? nA : cA + (size_t)(t + 2) * kstep; const char* b2 = last ? nB : cB + (size_t)(t + 2) * kstep;
            const char* a3 = a2 + kstep; const char* b3 = b2 + kstep;
            if (last && has_next) S.a_ready(nxt);
            if constexpr (SP2) {
            PG8_LDB(B0, 0, 0); PG8_LDB(B1, 0, 1); PG8_SCHED; PG8_LDA(At, 0, 0); PG8_STAGE(PG8_SA(1, 1), a1 + hstep, voffA);
            PG8_WAIT_V(8); PG8_WAIT_L(0); PG8_BAR; PG8_MMA(0, 0, At, B0); PG8_MMA1(0, At); PG8_BAR; PG8_SCHED;
            PG8_LDA(At, 0, 1); PG8_STAGE(PG8_SB(0, 0), b2, voffB); PG8_STAGE(PG8_SB(0, 1), b2 + hstep, voffB); PG8_STAGE(PG8_SA(0, 0), a2, voffA);
            PG8_WAIT_V(8); PG8_WAIT_L(0); PG8_BAR; PG8_MMA(1, 0, At, B0); PG8_MMA1(1, At); PG8_BAR; PG8_SCHED;
            PG8_LDB(B0, 1, 0); PG8_LDB(B1, 1, 1); PG8_SCHED; PG8_LDA(At, 1, 0); PG8_STAGE(PG8_SA(0, 1), a2 + hstep, voffA);
            PG8_WAIT_V(8); PG8_WAIT_L(0); PG8_BAR; PG8_MMA(0, 0, At, B0); PG8_MMA1(0, At); PG8_BAR; PG8_SCHED;
            PG8_LDA(At, 1, 1); PG8_STAGE(PG8_SB(1, 0), b3, voffB); PG8_STAGE(PG8_SB(1, 1), b3 + hstep, voffB); PG8_STAGE(PG8_SA(1, 0), a3, voffA);
            PG8_WAIT_V(8); PG8_WAIT_L(0); PG8_BAR; PG8_MMA(1, 0, At, B0); PG8_MMA1(1, At); PG8_BAR; PG8_SCHED;
            } else {
            PG8_LDB(B0, 0, 0); PG8_SCHED; PG8_LDA(At, 0, 0); PG8_STAGE(PG8_SA(1, 1), a1 + hstep, voffA);
            PG8_WAIT_L(8); PG8_BAR; PG8_WAIT_L(0); PG8_MMA(0, 0, At, B0); PG8_BAR; PG8_SCHED;
            PG8_LDB(B1, 0, 1); PG8_STAGE(PG8_SB(0, 0), b2, voffB);
            PG8_BAR; PG8_WAIT_L(0); PG8_MMA(0, 1, At, B1); PG8_BAR;
            PG8_LDA(At, 0, 1); PG8_STAGE(PG8_SA(0, 0), a2, voffA);
            PG8_BAR; PG8_WAIT_L(0); PG8_MMA(1, 0, At, B0); PG8_BAR; PG8_SCHED;
            PG8_STAGE(PG8_SB(0, 1), b2 + hstep, voffB);
            PG8_WAIT_V(6); PG8_BAR; PG8_MMA(1, 1, At, B1); PG8_BAR;
            PG8_LDB(B0, 1, 0); PG8_SCHED; PG8_LDA(At, 1, 0); PG8_STAGE(PG8_SA(0, 1), a2 + hstep, voffA);
            PG8_WAIT_L(8); PG8_BAR; PG8_WAIT_L(0); PG8_MMA(0, 0, At, B0); PG8_BAR; PG8_SCHED;
            PG8_LDB(B1, 1, 1); PG8_STAGE(PG8_SB(1, 0), b3, voffB);
            PG8_BAR; PG8_WAIT_L(0); PG8_MMA(0, 1, At, B1); PG8_BAR;
            PG8_LDA(At, 1, 1); PG8_STAGE(PG8_SA(1, 0), a3, voffA);
            PG8_BAR; PG8_WAIT_L(0); PG8_MMA(1, 0, At, B0); PG8_BAR; PG8_SCHED;
            PG8_STAGE(PG8_SB(1, 1), b3 + hstep, voffB);
            PG8_WAIT_V(6); PG8_BAR; PG8_MMA(1, 1, At, B1); PG8_BAR;
            }
            if constexpr (Epi::HAS_MID) { if (t == (nt >> 1) - 2) {
                if constexpr (ALIGN_EPI) { if (wr == 0) PG8_BAR; }
                E.mid(acc, cur, wr, wc, fr, fq);
                if constexpr (ALIGN_EPI) { if (wr == 1) PG8_BAR; } } }
        }
        if constexpr (ALIGN_EPI) { if (wr == 0) PG8_BAR; }
        if constexpr (!Epi::AFTER_DRAIN) { if constexpr (Epi::HAS_PRE) E(acc, cur, wr, wc, fr, fq, ui); else E(acc, cur, wr, wc, fr, fq); S.done(cur); }
        if (!has_next) break;
#pragma unroll
        for (int a = 0; a < 2; ++a)
#pragma unroll
            for (int b = 0; b < 2; ++b)
#pragma unroll
                for (int m = 0; m < 4; ++m)
#pragma unroll
                    for (int n = 0; n < 2; ++n) acc[a][b][m][n] = (f32x4){0.f, 0.f, 0.f, 0.f};
        cur = nxt; cA = nA; cB = nB; ++ui; if constexpr (Epi::SKIP_B1) skb = Epi::skip_b1(cur.pn);
        if constexpr (Epi::HAS_PRE) E.pre(cur, ui, wid, lane);
        if constexpr (ALIGN_EPI) { if (wr == 1) PG8_BAR; }
    }
    PG8_WAIT_V(0);
    if constexpr (!ALIGN_EPI) { if (wr == 0) PG8_BAR; }
    PG8_BAR;
    if constexpr (Epi::AFTER_DRAIN) { E.fused(acc, cur, wr, wc, fr, fq, lds, wid, lane); S.done(cur); }
#undef PG8_SA
#undef PG8_SB
#undef PG8_STAGE
#undef PG8_LDA
#undef PG8_LDB
#undef PG8_MMA
#undef PG8_MMA1
#undef PG8_WAIT_V
#undef PG8_WAIT_L
#undef PG8_BAR
#undef PG8_SCHED
}
}
constexpr int NWAVES = 8;
constexpr int N_LAUNCHES = MK_N_LAUNCHES;
constexpr int NPH = 16;
constexpr int D = 1024, NB = 16, SEQ = 2048, CTXL = 256, MX = NB * SEQ, MC = NB * CTXL, MT = MX + MC;
constexpr int RW = 512, NH = 8, HD = 64, RCOLS = 1920, RPAD = 2048, INCOLS = 4480, NIN = 4608, DFF = 2816, LK = 384, LN = 2560, MODW = 6144;
constexpr float NORM_EPS = 1e-6f, GN_EPS = 64e-5f;
constexpr size_t MiB = 1u << 20;
constexpr size_t WS_CTL = 0, CTL_ZERO_BYTES = 64 * 1024;
constexpr size_t WS_MOD = 1 * MiB, WS_LB = WS_MOD + 512 * 1024;
constexpr size_t WS_WIN = 2 * MiB, WS_WLORA = 12 * MiB, WS_WUPF = 14 * MiB, WS_WUPR = 15 * MiB, WS_WOUT = 16 * MiB;
constexpr size_t WS_A = 18 * MiB, WS_B = 82 * MiB, WS_C = 146 * MiB, WS_D = 210 * MiB, WS_E = 390 * MiB, WS_END = 512 * MiB;
constexpr size_t WS_GF = WS_A, WS_HX2 = WS_A, WS_GR = WS_B, WS_WGU = WS_E, WS_WDOWN = WS_E + 11 * MiB, WS_D1 = WS_B, WS_D2 = WS_A;
constexpr size_t WS_Z3 = WS_C, WS_FXO = WS_C;
constexpr size_t WS_PXR = WS_D, WS_LP = WS_D, WS_MB = WS_D, WS_ACT = WS_D;
constexpr size_t WS_EB = WS_E + 114 * MiB;
constexpr size_t WS_HX = WS_D, WS_Y2 = WS_E, WS_R = WS_E, WS_K = WS_E + 36 * MiB, WS_V = WS_E + 72 * MiB, WS_SBT = WS_E + 110 * MiB;
static_assert(WS_K - WS_R == 36 * MiB && WS_V - WS_K == 36 * MiB, "EpiIn::RKV_STRIDE");
static_assert(WS_LP + (size_t)MT * LN * 2 <= WS_E && WS_ACT + (size_t)MX * DFF * 2 <= WS_E && WS_V + (size_t)MT * RW * 2 <= WS_END && WS_HX + (size_t)MT * D * 2 <= WS_END, "d_ws map");
constexpr int CW_TMO = 0, CW_BAR = 4096, CW_BADMAP = 8192;
constexpr int RING_OFF = 0, RING_BYTES = 131072, LDSCTL_OFF = RING_BYTES, MISC_OFF = LDSCTL_OFF + 320, LDS_BYTES = 147456;
constexpr int XB_OFF = RING_BYTES + 4096;

#define GAS __attribute__((address_space(1)))
#define LAS __attribute__((address_space(3)))
typedef unsigned short bf16;
typedef unsigned v4u __attribute__((ext_vector_type(4)));
typedef unsigned v2u __attribute__((ext_vector_type(2)));
typedef float f32x4 __attribute__((ext_vector_type(4)));
typedef GAS unsigned gu32;
#define RLX_AGENT __ATOMIC_RELAXED, __HIP_MEMORY_SCOPE_AGENT
#define LDS_WAIT() asm volatile("s_waitcnt lgkmcnt(0)" ::: "memory")
#define VM_WAIT() asm volatile("s_waitcnt vmcnt(0)" ::: "memory")
__device__ __forceinline__ unsigned f2bf(float f) { unsigned u = __builtin_bit_cast(unsigned, f); return (u + 0x7fffu + ((u >> 16) & 1u)) >> 16; }
__device__ __forceinline__ unsigned pk2(float lo, float hi) { return f2bf(lo) | (f2bf(hi) << 16); }
__device__ __forceinline__ float bflo(unsigned w) { return __uint_as_float(w << 16); }
__device__ __forceinline__ float bfhi(unsigned w) { return __uint_as_float(w & 0xffff0000u); }
__device__ __forceinline__ float sigf(float x) { return 1.0f / (1.0f + __expf(-x)); }
__device__ __forceinline__ void unpk8(v4u w, float (&f)[8]) { f[0] = bflo(w.x); f[1] = bfhi(w.x); f[2] = bflo(w.y); f[3] = bfhi(w.y); f[4] = bflo(w.z); f[5] = bfhi(w.z); f[6] = bflo(w.w); f[7] = bfhi(w.w); }
__device__ __forceinline__ v4u pk8(const float (&f)[8]) { v4u o; o.x = pk2(f[0], f[1]); o.y = pk2(f[2], f[3]); o.z = pk2(f[4], f[5]); o.w = pk2(f[6], f[7]); return o; }

#define XB_TMO      128
#define XB_XCNT(j)  (256  + 64 * (j))
#define XB_XSUB(j)  (1280 + 64 * (j))
#define XB_XGEN(j)  (2304 + 64 * (j))
#define XB_TOP      3328
#define XB_TOPGEN   3392
#define XCD_BAR_WORDS 3456
#define XB_SPIN_CAP (1u << 18)

__device__ __forceinline__ unsigned xb_ld(unsigned* p)              { return __hip_atomic_load(p, __ATOMIC_RELAXED, __HIP_MEMORY_SCOPE_AGENT); }
__device__ __forceinline__ unsigned xb_add(unsigned* p, unsigned v) { return __hip_atomic_fetch_add(p, v, __ATOMIC_RELAXED, __HIP_MEMORY_SCOPE_AGENT); }
__device__ __forceinline__ unsigned xb_xcc_id() { return (unsigned)__builtin_amdgcn_s_getreg((3 << 11) | 20) & 0xFu; }
#define XB_SPIN(cond, bar) do { unsigned _sp = 0; while (cond) { __builtin_amdgcn_s_sleep(1); \
    if ((++_sp & 255u) == 0u) { if (xb_ld(&(bar)[XB_TMO])) break; if (_sp > XB_SPIN_CAP) { atomicAdd(&(bar)[XB_TMO], 1u); break; } } } } while (0)

struct XcdBarrier {
    unsigned* bar; unsigned x;
    volatile LAS unsigned* st;
};

__device__ __forceinline__ XcdBarrier xcd_barrier_post(unsigned* bar, volatile LAS unsigned* st) {
    XcdBarrier b; b.bar = bar; b.x = xb_xcc_id(); b.st = st;
    if (threadIdx.x == 0) (void)xb_add(&bar[XB_XCNT(b.x)], 1u);
    return b;
}
__device__ __forceinline__ void xcd_barrier_complete(unsigned* bar, unsigned x, unsigned& nloc, unsigned& nx) {
    const unsigned G = gridDim.x * gridDim.y * gridDim.z;
    unsigned sum, cnt, mine, sp = 0u;
    for (;;) {
        sum = 0u; cnt = 0u; mine = 0u;
#pragma unroll
        for (unsigned j = 0; j < 16; ++j) { const unsigned c = xb_ld(&bar[XB_XCNT(j)]); sum += c; cnt += (c > 0u) ? 1u : 0u; mine = (j == x) ? c : mine; }
        if (sum == G) break;
        __builtin_amdgcn_s_sleep(1);
        if ((++sp & 255u) == 0u) { if (xb_ld(&bar[XB_TMO])) break; if (sp > XB_SPIN_CAP) { atomicAdd(&bar[XB_TMO], 1u); break; } }
    }
    nloc = mine > 0u ? mine : 1u; nx = cnt > 0u ? cnt : 1u;
}

__device__ __forceinline__ void xcd_barrier(const XcdBarrier& b) {
    asm volatile("s_waitcnt vmcnt(0)" ::: "memory");
    __syncthreads();
    if (threadIdx.x == 0) {
        unsigned* bar = b.bar;
        __builtin_amdgcn_s_waitcnt(0);
        unsigned nloc = b.st[0], nx = b.st[1];
        if (nloc == 0u) { xcd_barrier_complete(bar, b.x, nloc, nx); b.st[0] = nloc; b.st[1] = nx; }
        const unsigned old = xb_add(&bar[XB_XSUB(b.x)], 1u);
        const unsigned gen = old / nloc;
        if (old + 1u == (gen + 1u) * nloc) {
            __builtin_amdgcn_fence(__ATOMIC_RELEASE, "agent");
            asm volatile("s_waitcnt vmcnt(0)" ::: "memory");
            const unsigned og = xb_add(&bar[XB_TOP], 1u);
            const unsigned tg = og / nx;
            if (og + 1u == (tg + 1u) * nx) xb_add(&bar[XB_TOPGEN], 1u);
            else XB_SPIN(xb_ld(&bar[XB_TOPGEN]) == tg, bar);
            __builtin_amdgcn_fence(__ATOMIC_ACQUIRE, "agent");
            xb_add(&bar[XB_XGEN(b.x)], 1u);
            asm volatile("s_waitcnt vmcnt(0)" ::: "memory");
        } else {
            XB_SPIN(xb_ld(&bar[XB_XGEN(b.x)]) == gen, bar);
            __builtin_amdgcn_fence(__ATOMIC_ACQUIRE, "agent");
            asm volatile("s_waitcnt vmcnt(0)" ::: "memory");
        }
    }
    __syncthreads();
}
__device__ __forceinline__ void xcd_barrier_local(const XcdBarrier& b) {
    asm volatile("s_waitcnt vmcnt(0)" ::: "memory");
    __syncthreads();
    if (threadIdx.x == 0) {
        unsigned* bar = b.bar;
        __builtin_amdgcn_s_waitcnt(0);
        const unsigned nloc = b.st[0] ? b.st[0] : 1u;
        const unsigned old = xb_add(&bar[XB_XSUB(b.x)], 1u);
        const unsigned gen = old / nloc;
        if (old + 1u == (gen + 1u) * nloc) (void)xb_add(&bar[XB_XGEN(b.x)], 1u);
        else XB_SPIN(xb_ld(&bar[XB_XGEN(b.x)]) == gen, bar);
        __builtin_amdgcn_fence(__ATOMIC_ACQUIRE, "agent");
        asm volatile("s_waitcnt vmcnt(0)" ::: "memory");
    }
    __syncthreads();
}
struct Args { const float* in[31]; float* out; unsigned char* ws; int ph_lo, ph_hi, li, pad; };
enum In { I_X = 0, I_C, I_CTX, I_CCTX, I_N1G, I_N2G, I_WADA, I_BADA, I_WIN, I_MUP, I_MUN, I_W0F, I_W2F, I_A0F, I_A2F, I_W0B, I_W2B, I_A0B, I_A2B, I_G2, I_KK, I_KA, I_RK, I_LNG, I_LNB, I_WUPR, I_WUPF, I_WOUT, I_WGU, I_WDOWN, I_FNG };
struct Frame { LAS unsigned char* lds; volatile LAS unsigned* MISC; gu32* ctl; int tid, lane, wave, vcu, G; };

__device__ __forceinline__ void refresh_tid(Frame& F) { int t = threadIdx.x; asm volatile("" : "+v"(t)); F.tid = t; F.lane = t & 63; }
__device__ __forceinline__ float wave_sum(float v) {
#pragma unroll
    for (int o = 1; o < 64; o <<= 1) v += __shfl_xor(v, o);
    return v;
}
__device__ __forceinline__ float red8(float v) { v += __shfl_xor(v, 1); v += __shfl_xor(v, 2); v += __shfl_xor(v, 4); return v; }

__device__ __forceinline__ void tr_item(const float* W, int ldw, int k0, int n0, bf16* WTrow0, int ldk, LAS float* scr, int lane) {
    float tv[32];
#pragma unroll
    for (int i = 0; i < 32; ++i) tv[i] = __builtin_nontemporal_load(W + (size_t)(k0 + 2 * i + (lane >> 5)) * ldw + n0 + (lane & 31));
#pragma unroll
    for (int i = 0; i < 32; ++i) scr[(2 * i + (lane >> 5)) * 33 + (lane & 31)] = tv[i];
    LDS_WAIT(); asm volatile("" ::: "memory");
    const int c = lane & 7;
#pragma unroll
    for (int j = 0; j < 4; ++j) { const int n = (lane >> 3) + 8 * j; const LAS float* s = scr + (8 * c) * 33 + n;
        v4u o; o.x = pk2(s[0 * 33], s[1 * 33]); o.y = pk2(s[2 * 33], s[3 * 33]); o.z = pk2(s[4 * 33], s[5 * 33]); o.w = pk2(s[6 * 33], s[7 * 33]);
        *(GAS v4u*)(WTrow0 + (size_t)n * ldk + k0 + 8 * c) = o; }
    LDS_WAIT(); asm volatile("" ::: "memory");
}

__device__ __forceinline__ void p0_weights(const Frame& F, const Args& a) {
    unsigned char* ws = a.ws;
    bf16* Win_t = (bf16*)(ws + WS_WIN); bf16* Wlora_t = (bf16*)(ws + WS_WLORA); bf16* Wupf_t = (bf16*)(ws + WS_WUPF); bf16* Wupr_t = (bf16*)(ws + WS_WUPR); bf16* Wout_t = (bf16*)(ws + WS_WOUT);
    LAS float* scr = (LAS float*)(F.lds + RING_OFF + F.wave * 16384);
    const int gw = F.vcu * NWAVES + F.wave, NGW = F.G * NWAVES, lane = F.lane;
    constexpr int E0 = 960, E1 = E0 + 1280, E2 = E1 + 256, E3 = E2 + 256, E4 = E3 + 512, E5 = E4 + 128, E6 = E5 + 2560;
    for (int it = gw; it < E6; it += NGW) {
        if (it < E0) { const int kb = it / 60, nb = it % 60; tr_item(a.in[I_WIN], INCOLS, 64 * kb, 32 * nb, Win_t + (size_t)(32 * nb) * D, D, scr, lane); }
        else if (it < E1) { const int r = it - E0, kb = r / 80, nb = r % 80;
            int drow = 2048 + 32 * nb; if (nb >= 16) { const int gj = 32 * ((nb - 16) & 31); drow = 2560 + (gj >> 7) * 256 + (gj & 127) + (nb >= 48 ? 128 : 0); }
            tr_item(a.in[I_WIN] + 1920, INCOLS, 64 * kb, 32 * nb, Win_t + (size_t)drow * D, D, scr, lane); }
        else if (it < E2) { const int r = it - E1, kb = r >> 5, nb = r & 31; tr_item(a.in[I_WUPF], D, 64 * kb, 32 * nb, Wupf_t + (size_t)(32 * nb) * 1024, 1024, scr, lane); }
        else if (it < E3) { const int r = it - E2, kb = r >> 5, nb = r & 31; tr_item(a.in[I_WUPR], D, 64 * kb, 32 * nb, Wupf_t + (size_t)(32 * nb) * 1024 + 512, 1024, scr, lane); }
        else if (it < E4) { const int r = it - E3, kb = r >> 5, nb = r & 31; tr_item(a.in[I_WOUT], D, 64 * kb, 32 * nb, Wout_t + (size_t)(32 * nb) * D, D, scr, lane); }
        else if (it < E5) { const int row = RCOLS + (it - E4); GAS v4u* p = (GAS v4u*)(Win_t + (size_t)row * D + 16 * lane); p[0] = (v4u){0u, 0u, 0u, 0u}; p[1] = (v4u){0u, 0u, 0u, 0u}; }
        else { const int n = it - E5, t = n >> 9, nn = n & 511, koff = t < 4 ? 64 * t : 256, klen = t < 4 ? 64 : 128;
            const float* src = t == 0 ? a.in[I_W2F] : t == 1 ? a.in[I_W2B] : t == 2 ? a.in[I_A2F] : t == 3 ? a.in[I_A2B] : a.in[I_G2];
            float v[6];
#pragma unroll
            for (int e = 0; e < 6; ++e) { const int kk = 6 * lane + e - koff; v[e] = (kk >= 0 && kk < klen) ? src[(size_t)kk * 512 + nn] : 0.f; }
            GAS unsigned* p = (GAS unsigned*)(Wlora_t + (size_t)n * LK + 6 * lane); p[0] = pk2(v[0], v[1]); p[1] = pk2(v[2], v[3]); p[2] = pk2(v[4], v[5]); }
    }
    { constexpr int NPIECE = (LN + NWAVES * 64 - 1) / (NWAVES * 64); const bool spread = F.G >= 192 + NPIECE;
      const int p0 = spread ? (int)blockIdx.x - 192 : 0, p1 = spread ? p0 + 1 : (blockIdx.x == 0 ? NPIECE : 0);
      if (p0 >= 0 && p0 < NPIECE) { float* LB = (float*)(a.ws + WS_LB);
          for (int i = p0 * NWAVES * 64 + F.tid; i < LN && i < p1 * NWAVES * 64; i += NWAVES * 64) { const int t = i >> 9, nn = i & 511; LB[i] = t == 0 ? a.in[I_W0F][nn] : t == 1 ? a.in[I_W0B][nn] : t == 2 ? a.in[I_A0F][nn] : t == 3 ? a.in[I_A0B][nn] : 0.f; } } }
    __syncthreads();
    LAS float* L = (LAS float*)(F.lds + RING_OFF);
    for (int it = blockIdx.x; it < 192; it += F.G) {
        {
            const int n0 = it * 32;
            LAS float* sc = L; LAS float* red = L + 17 * 1024;
            { float cvv[34];
#pragma unroll
              for (int i = 0; i < 34; ++i) { const int idx = F.tid + 512 * i, b = idx >> 10, k = idx & 1023; cvv[i] = b < 16 ? a.in[I_C][b * 1024 + k] : a.in[I_CCTX][k]; }
#pragma unroll
              for (int i = 0; i < 34; ++i) sc[F.tid + 512 * i] = cvv[i] * sigf(cvv[i]); }
            __syncthreads();
            const int col = F.tid & 31, ks = F.tid >> 5;
            float acc[17];
#pragma unroll
            for (int b = 0; b < 17; ++b) acc[b] = 0.f;
            for (int k8 = 0; k8 < 64; k8 += 32) { float wv[32];
#pragma unroll
                for (int j = 0; j < 32; ++j) wv[j] = __builtin_nontemporal_load(a.in[I_WADA] + (size_t)(ks * 64 + k8 + j) * MODW + n0 + col);
#pragma unroll
                for (int j = 0; j < 32; ++j) { const int k = ks * 64 + k8 + j;
#pragma unroll
                    for (int b = 0; b < 17; ++b) acc[b] += sc[b * 1024 + k] * wv[j]; } }
#pragma unroll
            for (int b = 0; b < 17; ++b) red[(ks * 17 + b) * 32 + col] = acc[b];
            __syncthreads();
            for (int o = F.tid; o < 17 * 32; o += NWAVES * 64) { const int b = o >> 5, c2 = o & 31; float s = a.in[I_BADA][n0 + c2];
                for (int k2 = 0; k2 < 16; ++k2) s += red[(k2 * 17 + b) * 32 + c2];
                ((float*)(a.ws + WS_MOD))[b * MODW + n0 + c2] = s; }
            __syncthreads();
        }
    }
}
__device__ __forceinline__ void p_weights2(const Frame& F, const Args& a) {
    bf16* Wgu_t = (bf16*)(a.ws + WS_WGU); bf16* Wdown_t = (bf16*)(a.ws + WS_WDOWN);
    LAS float* scr = (LAS float*)(F.lds + RING_OFF + F.wave * 16384);
    const int gw = F.vcu * NWAVES + F.wave, NGW = F.G * NWAVES;
    for (int it = gw; it < 2816 + 1408; it += NGW) {
        if (it < 2816) { const int kb = it / 176, nb = it % 176, n0 = 32 * nb; const int np = n0 < DFF ? n0 : n0 - DFF; const int drow = (np >> 7) * 256 + (np & 127) + (n0 < DFF ? 0 : 128);
            tr_item(a.in[I_WGU], 2 * DFF, 64 * kb, n0, Wgu_t + (size_t)drow * D, D, scr, F.lane); }
        else { const int r = it - 2816, kb = r >> 5, nb = r & 31; tr_item(a.in[I_WDOWN], D, 64 * kb, 32 * nb, Wdown_t + (size_t)(32 * nb) * DFF, DFF, scr, F.lane); }
    }
}
template <int KIND> __device__ __forceinline__ void norm_mod_rows(const Args& a, int m0, int m1, const float* g, bf16* O, int lane) {
    if (m0 >= m1) return;
    const float* MODp = (const float*)(a.ws + WS_MOD);
    f32x4 gg[4];
#pragma unroll
    for (int j = 0; j < 4; ++j) gg[j] = ((const f32x4*)g)[lane + 64 * j];
    auto rowp = [&](int m) -> const GAS f32x4* { const float* p = (KIND == 1 || m < MX) ? a.in[I_X] + (size_t)m * D : a.in[I_CTX] + (size_t)(m - MX) * D; return (const GAS f32x4*)p + lane; };
    const bf16* D1 = (const bf16*)(a.ws + WS_D1);
    f32x4 cur[4], nxt[4], ss[4], cc[4]; v2u cd[4], nd[4]; int bcur = -1;
    { const GAS f32x4* p = rowp(m0);
#pragma unroll
      for (int j = 0; j < 4; ++j) { cur[j] = __builtin_nontemporal_load(p + 64 * j); if (KIND == 1) cd[j] = __builtin_nontemporal_load((const GAS v2u*)(D1 + (size_t)m0 * D) + lane + 64 * j); } }
    for (int m = m0; m < m1; ++m) {
        if (m + 1 < m1) { const GAS f32x4* p = rowp(m + 1);
#pragma unroll
            for (int j = 0; j < 4; ++j) { nxt[j] = __builtin_nontemporal_load(p + 64 * j); if (KIND == 1) nd[j] = __builtin_nontemporal_load((const GAS v2u*)(D1 + (size_t)(m + 1) * D) + lane + 64 * j); } }
        if (KIND == 1) {
#pragma unroll
            for (int j = 0; j < 4; ++j) cur[j] = cur[j] + (f32x4){bflo(cd[j].x), bfhi(cd[j].x), bflo(cd[j].y), bfhi(cd[j].y)}; }
        const int b = KIND == 0 ? (m < MX ? (m >> 11) : 16) : (m >> 11);
        if (b != bcur) { bcur = b; const float* md = MODp + (size_t)b * MODW + (KIND == 0 ? 0 : 3072);
#pragma unroll
            for (int j = 0; j < 4; ++j) { ss[j] = ((const f32x4*)md)[lane + 64 * j]; cc[j] = ((const f32x4*)(md + 1024))[lane + 64 * j] + 1.0f; } }
        float s2 = 0.f;
#pragma unroll
        for (int j = 0; j < 4; ++j) s2 += (cur[j].x * cur[j].x + cur[j].y * cur[j].y) + (cur[j].z * cur[j].z + cur[j].w * cur[j].w);
        const float rstd = 1.0f / sqrtf(wave_sum(s2) * (1.f / D) + NORM_EPS);
        GAS v2u* o8 = (GAS v2u*)(O + (size_t)m * D) + lane;
#pragma unroll
        for (int j = 0; j < 4; ++j) { const f32x4 o = (cur[j] * rstd) * gg[j] * cc[j] + ss[j]; v2u w; w.x = pk2(o.x, o.y); w.y = pk2(o.z, o.w); o8[64 * j] = w; }
#pragma unroll
        for (int j = 0; j < 4; ++j) { cur[j] = nxt[j]; cd[j] = nd[j]; }
    }
}
typedef short bf16x8v __attribute__((ext_vector_type(8)));
__device__ __forceinline__ unsigned offb(unsigned row, unsigned ch) { return 256u * row + 16u * (ch ^ (((row & 3u) << 2) | ((row >> 2) & 3u))); }
__device__ __forceinline__ void tr_read8(unsigned a0, unsigned a1, v2u (&r0)[4], v2u (&r1)[4]) {
    asm volatile("ds_read_b64_tr_b16 %0, %8\n\tds_read_b64_tr_b16 %1, %8 offset:8192\n\tds_read_b64_tr_b16 %2, %8 offset:16384\n\tds_read_b64_tr_b16 %3, %8 offset:24576\n\t"
                 "ds_read_b64_tr_b16 %4, %9\n\tds_read_b64_tr_b16 %5, %9 offset:8192\n\tds_read_b64_tr_b16 %6, %9 offset:16384\n\tds_read_b64_tr_b16 %7, %9 offset:24576\n\ts_waitcnt lgkmcnt(0)"
                 : "=&v"(r0[0]), "=&v"(r0[1]), "=&v"(r0[2]), "=&v"(r0[3]), "=&v"(r1[0]), "=&v"(r1[1]), "=&v"(r1[2]), "=&v"(r1[3]) : "v"(a0), "v"(a1) : "memory");
}
__device__ __forceinline__ void tr_read4(unsigned a0, unsigned a1, v2u (&r0)[2], v2u (&r1)[2]) {
    asm volatile("ds_read_b64_tr_b16 %0, %4\n\tds_read_b64_tr_b16 %1, %4 offset:8192\n\tds_read_b64_tr_b16 %2, %5\n\tds_read_b64_tr_b16 %3, %5 offset:8192\n\ts_waitcnt lgkmcnt(0)"
                 : "=&v"(r0[0]), "=&v"(r0[1]), "=&v"(r1[0]), "=&v"(r1[1]) : "v"(a0), "v"(a1) : "memory");
}
__device__ __forceinline__ bf16x8v mk_b(v2u lo, v2u hi) { v4u w = {lo.x, lo.y, hi.x, hi.y}; return __builtin_bit_cast(bf16x8v, w); }
__device__ __forceinline__ void dft_pass_a(const Frame& F, const bf16* PXF, bf16* Y2) {
    constexpr int RSW = 272;
    const int w = F.wave, l = F.lane, lr = l & 15, g4 = l >> 4, q = (l & 15) >> 2, p = l & 3;
    const unsigned ldsb = (unsigned)(size_t)(F.lds + RING_OFF);
    LAS unsigned char* IN = F.lds + RING_OFF; LAS bf16* OUT = (LAS bf16*)(F.lds + RING_OFF + 32768); LAS unsigned char* RAW = F.lds + RING_OFF + 65536;
    bf16x8v afr[4], af0[2][4];
    { const int m = 16 * w + lr, ri = m >> 6, k2 = m & 63;
#pragma unroll
      for (int ks = 0; ks < 4; ++ks) { unsigned pk[4];
#pragma unroll
          for (int e2 = 0; e2 < 4; ++e2) { float vv[2];
#pragma unroll
              for (int h = 0; h < 2; ++h) { const int k = 32 * ks + 8 * g4 + 2 * e2 + h, rj = k >> 6, n2 = k & 63, idx = (k2 * n2) & 63; const float rev = (float)idx * (1.0f / 64.0f), sn = __builtin_amdgcn_sinf(rev), cs = __builtin_amdgcn_cosf(rev); vv[h] = (ri == rj) ? cs : (ri == 0 ? sn : -sn); }
              pk[e2] = pk2(vv[0], vv[1]); }
          afr[ks] = __builtin_bit_cast(bf16x8v, (v4u){pk[0], pk[1], pk[2], pk[3]}); } }
#pragma unroll
    for (int mt = 0; mt < 2; ++mt) { const int m = 32 * w + 16 * mt + lr, ri = m >> 7, k3 = m & 127;
#pragma unroll
      for (int ks = 0; ks < 4; ++ks) { unsigned pk[4];
#pragma unroll
          for (int e2 = 0; e2 < 4; ++e2) { float vv[2];
#pragma unroll
              for (int h = 0; h < 2; ++h) { const int n3 = 32 * ks + 8 * g4 + 2 * e2 + h, idx = (k3 * n3) & 127; const float rev = (float)idx * (1.0f / 128.0f), sn = __builtin_amdgcn_sinf(rev), cs = __builtin_amdgcn_cosf(rev); vv[h] = ri == 0 ? cs : -sn; }
              pk[e2] = pk2(vv[0], vv[1]); }
          af0[mt][ks] = __builtin_bit_cast(bf16x8v, (v4u){pk[0], pk[1], pk[2], pk[3]}); } }
    unsigned rb[2], mk[2];
#pragma unroll
    for (int t = 0; t < 2; ++t) { const unsigned row = 8 * g4 + 4 * t + q; rb[t] = ldsb + 256u * row + 8u * (p & 1); mk[t] = ((row & 3u) << 2) | ((row >> 2) & 3u); }
    const unsigned hb = p >> 1;
    v4u pre[2];
    { const int it = blockIdx.x; if (it < 2048) { const int jc = it & 3, n1 = (it >> 2) & 31, b = it >> 7;
#pragma unroll
        for (int i = 0; i < 2; ++i) { const int cid = F.tid + 512 * i, row = cid >> 4, ch = cid & 15; pre[i] = __builtin_nontemporal_load((const GAS v4u*)(PXF + (size_t)(b * 2048 + n1 * 64 + row) * 512 + jc * 128 + ch * 8)); } } }
    for (int it = blockIdx.x; it < 2048; it += F.G) {
        const int jc = it & 3, n1 = (it >> 2) & 31, b = it >> 7;
        __syncthreads();
#pragma unroll
        for (int i = 0; i < 2; ++i) { const int cid = F.tid + 512 * i, row = cid >> 4, ch = cid & 15; *(LAS v4u*)(RAW + row * RSW + ch * 16) = pre[i]; }
        { const int itn = it + F.G; if (itn < 2048) { const int jcn = itn & 3, n1n = (itn >> 2) & 31, bn = itn >> 7;
#pragma unroll
            for (int i = 0; i < 2; ++i) { const int cid = F.tid + 512 * i, row = cid >> 4, ch = cid & 15; pre[i] = __builtin_nontemporal_load((const GAS v4u*)(PXF + (size_t)(bn * 2048 + n1n * 64 + row) * 512 + jcn * 128 + ch * 8)); } } }
        __syncthreads();
#pragma unroll
        for (int nt = 0; nt < 4; ++nt) {
            bf16x8v bx[4];
#pragma unroll
            for (int ks = 0; ks < 4; ++ks) bx[ks] = *(const LAS bf16x8v*)(RAW + (16 * nt + lr) * RSW + (32 * ks + 8 * g4) * 2);
#pragma unroll
            for (int mt = 0; mt < 2; ++mt) { f32x4 acc = {0.f, 0.f, 0.f, 0.f};
#pragma unroll
                for (int ks = 0; ks < 4; ++ks) acc = __builtin_amdgcn_mfma_f32_16x16x32_bf16(af0[mt][ks], bx[ks], acc, 0, 0, 0);
                const int m0 = 32 * w + 16 * mt + 4 * g4, ri = m0 >> 7, c0 = m0 & 127, row = ri * 64 + 16 * nt + lr;
                *(LAS v2u*)(IN + offb(row, c0 >> 3) + 8 * ((c0 >> 2) & 1)) = (v2u){pk2(acc[0], acc[1]), pk2(acc[2], acc[3])}; }
        }
        __syncthreads();
#pragma unroll 2
        for (int c = 0; c < 8; ++c) {
            v2u r0[4], r1[4];
            tr_read8(rb[0] + 16u * ((2u * c + hb) ^ mk[0]), rb[1] + 16u * ((2u * c + hb) ^ mk[1]), r0, r1);
            f32x4 acc = {0.f, 0.f, 0.f, 0.f};
#pragma unroll
            for (int ks = 0; ks < 4; ++ks) acc = __builtin_amdgcn_mfma_f32_16x16x32_bf16(afr[ks], mk_b(r0[ks], r1[ks]), acc, 0, 0, 0);
#pragma unroll
            for (int r = 0; r < 4; ++r) OUT[(16 * w + 4 * g4 + r) * 128 + 16 * c + lr] = (bf16)f2bf(acc[r]);
        }
        __syncthreads();
#pragma unroll
        for (int i = 0; i < 4; ++i) { const int cid = F.tid + 512 * i, row = cid >> 4, ch = cid & 15, ri = row >> 6, k2 = row & 63;
            *(GAS v4u*)(Y2 + (size_t)(b * 2048 + n1 * 64 + k2) * 1024 + ri * 512 + jc * 128 + ch * 8) = *(const LAS v4u*)(OUT + row * 128 + ch * 8); }
    }
}
__device__ __forceinline__ void dft_pass_b(const Frame& F, const bf16* Y2, bf16* FX) {
    const int w = F.wave, l = F.lane, lr = l & 15, g4 = l >> 4, q = (l & 15) >> 2, p = l & 3;
    const int g = w >> 1, c0 = (w & 1) * 4;
    const unsigned ldsb = (unsigned)(size_t)(F.lds + RING_OFF) + 16384u * g;
    LAS unsigned char* IN = F.lds + RING_OFF; LAS bf16* OUT = (LAS bf16*)(F.lds + RING_OFF + 65536);
    bf16x8v afr[2][2];
#pragma unroll
    for (int mt = 0; mt < 2; ++mt) { const int k1 = 16 * mt + lr;
#pragma unroll
      for (int ks = 0; ks < 2; ++ks) { unsigned pk[4];
#pragma unroll
          for (int e2 = 0; e2 < 4; ++e2) { float vv[2];
#pragma unroll
              for (int h = 0; h < 2; ++h) { const int k = 32 * ks + 8 * g4 + 2 * e2 + h, ri = k >> 5, n1 = k & 31, idx = (k1 * n1) & 31; const float rev = (float)idx * (1.0f / 32.0f), sn = __builtin_amdgcn_sinf(rev), cs = __builtin_amdgcn_cosf(rev); vv[h] = (ri == 0 ? cs : sn); }
              pk[e2] = pk2(vv[0], vv[1]); }
          afr[mt][ks] = __builtin_bit_cast(bf16x8v, (v4u){pk[0], pk[1], pk[2], pk[3]}); } }
    unsigned rb[2], mk[2];
#pragma unroll
    for (int t = 0; t < 2; ++t) { const unsigned row = 8 * g4 + 4 * t + q; rb[t] = ldsb + 256u * row + 8u * (p & 1); mk[t] = ((row & 3u) << 2) | ((row >> 2) & 3u); }
    const unsigned hb = p >> 1;
    v4u pre[8];
    { const int it = blockIdx.x; if (it < 1024) { const int k2 = it & 63, b = it >> 6;
#pragma unroll
        for (int i = 0; i < 8; ++i) { const int cid = F.tid + 512 * i, row = cid >> 6, c64 = cid & 63; pre[i] = __builtin_nontemporal_load((const GAS v4u*)(Y2 + (size_t)(b * 2048 + (row & 31) * 64 + k2) * 1024 + (row >> 5) * 512 + c64 * 8)); } } }
    for (int it = blockIdx.x; it < 1024; it += F.G) {
        const int k2 = it & 63, b = it >> 6;
        __syncthreads();
#pragma unroll
        for (int i = 0; i < 8; ++i) { const int cid = F.tid + 512 * i, row = cid >> 6, c64 = cid & 63, gg = c64 >> 4, ch = c64 & 15; *(LAS v4u*)(IN + 16384 * gg + offb(row, ch)) = pre[i]; }
        { const int itn = it + F.G; if (itn < 1024) { const int k2n = itn & 63, bn = itn >> 6;
#pragma unroll
            for (int i = 0; i < 8; ++i) { const int cid = F.tid + 512 * i, row = cid >> 6, c64 = cid & 63; pre[i] = __builtin_nontemporal_load((const GAS v4u*)(Y2 + (size_t)(bn * 2048 + (row & 31) * 64 + k2n) * 1024 + (row >> 5) * 512 + c64 * 8)); } } }
        __syncthreads();
#pragma unroll
        for (int cc = 0; cc < 4; ++cc) { const int c = c0 + cc;
            v2u r0[2], r1[2];
            tr_read4(rb[0] + 16u * ((2u * c + hb) ^ mk[0]), rb[1] + 16u * ((2u * c + hb) ^ mk[1]), r0, r1);
#pragma unroll
            for (int mt = 0; mt < 2; ++mt) { f32x4 acc = {0.f, 0.f, 0.f, 0.f};
#pragma unroll
                for (int ks = 0; ks < 2; ++ks) acc = __builtin_amdgcn_mfma_f32_16x16x32_bf16(afr[mt][ks], mk_b(r0[ks], r1[ks]), acc, 0, 0, 0);
#pragma unroll
                for (int r = 0; r < 4; ++r) OUT[(16 * mt + 4 * g4 + r) * 512 + g * 128 + 16 * c + lr] = (bf16)f2bf(acc[r] * (1.0f / 512.0f)); }
        }
        __syncthreads();
#pragma unroll
        for (int i = 0; i < 4; ++i) { const int cid = F.tid + 512 * i, row = cid >> 6, ch = cid & 63;
            *(GAS v4u*)(FX + (size_t)(b * 2048 + row * 64 + k2) * 1024 + ch * 8) = *(const LAS v4u*)(OUT + row * 512 + ch * 8); }
    }
}
template <int CTRL> __device__ __forceinline__ float dpp_add(float x) { const int v = __builtin_amdgcn_update_dpp(__float_as_int(x), __float_as_int(x), CTRL, 0xF, 0xF, false); return x + __int_as_float(v); }
__device__ __forceinline__ void edge_rows(const Frame& F, const Args& a) {
    const float* EB = (const float*)(a.ws + WS_EB); bf16* RB = (bf16*)(a.ws + WS_R); bf16* KB = (bf16*)(a.ws + WS_K); bf16* VB = (bf16*)(a.ws + WS_V); bf16* AL = (bf16*)a.out;
    const int gw = F.vcu * NWAVES + F.wave, lane = F.lane;
    if (gw >= 8 * (MT / 256)) return;
    const int tile = gw >> 3, last = (gw >> 2) & 1, j = gw & 3, col = 512 * j + 8 * lane;
    if (col >= RCOLS) return;
    const bool lat = tile < MX / 256, s0 = lat ? (tile & 7) == 0 : true, s1 = lat ? (tile & 7) == 7 : true;
    const int m = tile * 256 + (last ? 255 : 0);
    const float* cp = EB + ((size_t)tile * 4 + (last ? 3 : 0)) * 2048 + col;
    const float* pp = (last ? EB + ((size_t)tile * 4 + 2) * 2048 : EB + ((size_t)(tile > 0 ? tile - 1 : 0) * 4 + 3) * 2048) + col;
    const float* np = (last ? EB + ((size_t)(tile + 1 < MT / 256 ? tile + 1 : tile) * 4 + 0) * 2048 : EB + ((size_t)tile * 4 + 1) * 2048) + col;
    const bool hp = last ? true : !s0, hn = last ? !s1 : true;
    const f32x4 z = {0.f, 0.f, 0.f, 0.f};
    f32x4 c4[2], p4[2], n4[2], mp4[2], mn4[2];
#pragma unroll
    for (int h = 0; h < 2; ++h) { c4[h] = ((const f32x4*)cp)[h]; p4[h] = hp ? ((const f32x4*)pp)[h] : z; n4[h] = hn ? ((const f32x4*)np)[h] : z; mp4[h] = ((const f32x4*)(a.in[I_MUP] + col))[h]; mn4[h] = ((const f32x4*)(a.in[I_MUN] + col))[h]; }
    float u[8];
#pragma unroll
    for (int e = 0; e < 8; ++e) { const float c = c4[e >> 2][e & 3]; u[e] = c + mp4[e >> 2][e & 3] * (p4[e >> 2][e & 3] - c) + mn4[e >> 2][e & 3] * (n4[e >> 2][e & 3] - c); }
    if (j == 0) *(GAS v4u*)(RB + (size_t)m * RW + 8 * lane) = pk8(u);
    else if (j == 1) *(GAS v4u*)(KB + (size_t)m * RW + 8 * lane) = pk8(u);
    else if (j == 2) *(GAS v4u*)(VB + (size_t)m * RW + 8 * lane) = pk8(u);
    else {
        if (lane < 16) {
#pragma unroll
            for (int e = 0; e < 8; ++e) u[e] = 2.0f * sigf(2.0f * u[e]) - 1.0f;
        } else if (lane >= 32) {
#pragma unroll
            for (int e = 0; e < 8; ++e) u[e] = sigf(u[e]);
        }
        *(GAS v4u*)(AL + (size_t)m * LK + 8 * lane) = pk8(u);
    }
}
__device__ __forceinline__ int scan_row(int s, int b, int dir) { if (s < CTXL) { const int t = dir ? (CTXL - 1 - s) : s; return MX + b * CTXL + t; } const int s2 = s - CTXL; const int t = dir ? (SEQ - 1 - s2) : s2; return b * SEQ + t; }
__device__ __forceinline__ float red16(float x) { x = dpp_add<0xB1>(x); x = dpp_add<0x4E>(x); x = dpp_add<0x141>(x); x = dpp_add<0x140>(x); return x; }
typedef float f32x2 __attribute__((ext_vector_type(2)));
__device__ __forceinline__ float fm_(float a, float b, float c) { float d; asm("v_fma_f32 %0, %1, %2, %3" : "=v"(d) : "v"(a), "v"(b), "v"(c)); return d; }
__device__ __forceinline__ float ml_(float a, float b) { float d; asm("v_mul_f32 %0, %1, %2" : "=v"(d) : "v"(a), "v"(b)); return d; }
__device__ __forceinline__ void red16x2(float& a, float& b) {
    asm volatile("s_nop 1\n\t"
        "v_add_f32_dpp %0, %0, %0 quad_perm:[1,0,3,2] row_mask:0xf bank_mask:0xf\n\tv_add_f32_dpp %1, %1, %1 quad_perm:[1,0,3,2] row_mask:0xf bank_mask:0xf\n\ts_nop 0\n\t"
        "v_add_f32_dpp %0, %0, %0 quad_perm:[2,3,0,1] row_mask:0xf bank_mask:0xf\n\tv_add_f32_dpp %1, %1, %1 quad_perm:[2,3,0,1] row_mask:0xf bank_mask:0xf\n\ts_nop 0\n\t"
        "v_add_f32_dpp %0, %0, %0 row_half_mirror row_mask:0xf bank_mask:0xf\n\tv_add_f32_dpp %1, %1, %1 row_half_mirror row_mask:0xf bank_mask:0xf\n\ts_nop 0\n\t"
        "v_add_f32_dpp %0, %0, %0 row_mirror row_mask:0xf bank_mask:0xf\n\tv_add_f32_dpp %1, %1, %1 row_mirror row_mask:0xf bank_mask:0xf\n\ts_nop 0"
        : "+v"(a), "+v"(b));
}
typedef short bf16x8v_ __attribute__((ext_vector_type(8)));
namespace sc {
constexpr int C = 16, NCHUNK = (CTXL + SEQ) / C, CTXCHUNK = CTXL / C, NSLOT = 5;
constexpr int RS = 144, ARR = 16 * RS, ES = 272;
constexpr int O_P = 0, O_RT = ARR, O_NPT = 2 * ARR, O_DPT = 3 * ARR, O_VT = 4 * ARR, O_DM = 5 * ARR, O_NR = O_DM + 512, O_DR = O_NR + 512, O_LINV = O_DR + 512, O_LC = O_LINV + 512, SLOT_B = O_LC + 256;
constexpr int PRIVP = NSLOT * SLOT_B, O_NN = 0, O_DD = ARR, O_EW = 2 * ARR, O_NF = O_EW + 16 * ES, PRIVP_B = O_NF + 1024;
constexpr int ZERO_OFF = PRIVP + 4 * PRIVP_B;
constexpr int FLAG_OFF = ZERO_OFF + 1024;
constexpr int KC_OFF = FLAG_OFF + 64;
static_assert(SLOT_B % 16 == 0 && PRIVP_B % 16 == 0 && KC_OFF + 1024 <= RING_BYTES, "scan LDS map");
}
__device__ __forceinline__ unsigned cvtpk(float lo, float hi) { unsigned r; asm volatile("v_cvt_pk_bf16_f32 %0, %1, %2" : "=v"(r) : "v"(lo), "v"(hi)); return r; }
__device__ __forceinline__ float bf1(unsigned short x) { return __uint_as_float((unsigned)x << 16); }
__device__ __forceinline__ unsigned short tobf(float f) { return (unsigned short)f2bf(f); }
__device__ __forceinline__ unsigned short tobf1(float f) { return (unsigned short)cvtpk(f, f); }
__device__ __forceinline__ bf16x8v_ tr_frag1(unsigned a) { v2u r0, r1;
    asm volatile("ds_read_b64_tr_b16 %0, %2\n\tds_read_b64_tr_b16 %1, %2 offset:512\n\ts_waitcnt lgkmcnt(0)" : "=&v"(r0), "=&v"(r1) : "v"(a) : "memory"); return mk_b(r0, r1); }
__device__ __forceinline__ void tr_frag4(unsigned a, bf16x8v_ (&f)[4]) { v2u r[8];
    asm volatile("ds_read_b64_tr_b16 %0, %8\n\tds_read_b64_tr_b16 %1, %8 offset:512\n\tds_read_b64_tr_b16 %2, %8 offset:32\n\tds_read_b64_tr_b16 %3, %8 offset:544\n\t"
                 "ds_read_b64_tr_b16 %4, %8 offset:64\n\tds_read_b64_tr_b16 %5, %8 offset:576\n\tds_read_b64_tr_b16 %6, %8 offset:96\n\tds_read_b64_tr_b16 %7, %8 offset:608\n\ts_waitcnt lgkmcnt(0)"
                 : "=&v"(r[0]), "=&v"(r[1]), "=&v"(r[2]), "=&v"(r[3]), "=&v"(r[4]), "=&v"(r[5]), "=&v"(r[6]), "=&v"(r[7]) : "v"(a) : "memory");
    f[0] = mk_b(r[0], r[1]); f[1] = mk_b(r[2], r[3]); f[2] = mk_b(r[4], r[5]); f[3] = mk_b(r[6], r[7]); }
__device__ __forceinline__ void scan_phase(const Frame& F, const Args& a) {
    using namespace sc;
    const bf16* RB = (const bf16*)(a.ws + WS_R); const bf16* KB = (const bf16*)(a.ws + WS_K); const bf16* VB = (const bf16*)(a.ws + WS_V); const bf16* LP = (const bf16*)(a.ws + WS_LP);
    LAS unsigned char* L = F.lds + RING_OFF;
    const int l = F.lane, lr = l & 15, g = l >> 4;
    for (int chain = blockIdx.x; chain < 256; chain += F.G) {
        const int b = chain >> 4, h = (chain >> 1) & 7, dir = chain & 1;
        bf16* Yg = (bf16*)a.out + (dir ? (size_t)MX * RW : 0);
        float* SBTg = (float*)(a.ws + WS_SBT);
        if (F.tid < 256 + 16) ((LAS unsigned*)(L + ZERO_OFF))[F.tid] = 0u;
        if (F.tid >= 64 && F.tid < 320) { const int i_ = F.tid - 64, k_ = h * 64 + (i_ & 63);
            ((LAS float*)(L + KC_OFF))[i_] = i_ < 64 ? a.in[I_KK][k_] : i_ < 128 ? a.in[I_KA][k_] : i_ < 192 ? a.in[I_RK][k_] * a.in[I_KA][k_] : (dir == 0 ? a.in[I_RK][k_] * (2.0f - 2.0f * a.in[I_KA][k_]) : 0.f); }
        __syncthreads();
        if (F.wave >= 4) {
            const int p = F.wave - 4;
            LAS unsigned char* PV = L + PRIVP + p * PRIVP_B;
            const int t1 = l >> 2, kq = l & 3, hc1 = h * 64 + 16 * kq;
            v4u raw[10];
#define SC_PREFETCH(cc) do { const int m_ = scan_row((cc) * C + t1, b, dir); const GAS v4u* q0 = (const GAS v4u*)(RB + (size_t)m_ * RW + hc1); const GAS v4u* q1 = (const GAS v4u*)(KB + (size_t)m_ * RW + hc1); const GAS v4u* q2 = (const GAS v4u*)(VB + (size_t)m_ * RW + hc1); \
                const GAS v4u* q3 = (const GAS v4u*)(LP + (size_t)m_ * LN + dir * 512 + hc1); const GAS v4u* q4 = (const GAS v4u*)(LP + (size_t)m_ * LN + 1024 + dir * 512 + hc1); \
                raw[0] = __builtin_nontemporal_load(q0); raw[1] = __builtin_nontemporal_load(q0 + 1); raw[2] = __builtin_nontemporal_load(q1); raw[3] = __builtin_nontemporal_load(q1 + 1); raw[4] = __builtin_nontemporal_load(q2); raw[5] = __builtin_nontemporal_load(q2 + 1); \
                raw[6] = __builtin_nontemporal_load(q3); raw[7] = __builtin_nontemporal_load(q3 + 1); raw[8] = __builtin_nontemporal_load(q4); raw[9] = __builtin_nontemporal_load(q4 + 1); } while (0)
            if (p < NCHUNK) SC_PREFETCH(p);
            volatile LAS unsigned* RDY = (volatile LAS unsigned*)(L + FLAG_OFF); volatile LAS unsigned* DONE = RDY + NSLOT;
            for (int c = p; c < NCHUNK; c += 4) {
                if (c >= NSLOT) { unsigned spins = 0; while (*DONE < 4u * (unsigned)(c - NSLOT + 1)) { __builtin_amdgcn_s_sleep(2); if (++spins > (1u << 22)) break; } asm volatile("" ::: "memory"); }
#pragma unroll 1
                for (int f = 1; f <= 3; ++f) {
                {
                    LAS unsigned char* SL = L + (c % NSLOT) * SLOT_B;
                    if (f == 1) {
                        float r16[16], k16[16], e16[16], a16[16];
                        { float t8[8]; unpk8(raw[0], t8); for (int e = 0; e < 8; ++e) r16[e] = t8[e]; unpk8(raw[1], t8); for (int e = 0; e < 8; ++e) r16[8 + e] = t8[e];
                          unpk8(raw[2], t8); for (int e = 0; e < 8; ++e) k16[e] = t8[e]; unpk8(raw[3], t8); for (int e = 0; e < 8; ++e) k16[8 + e] = t8[e];
                          unpk8(raw[6], t8); for (int e = 0; e < 8; ++e) e16[e] = t8[e]; unpk8(raw[7], t8); for (int e = 0; e < 8; ++e) e16[8 + e] = t8[e];
                          unpk8(raw[8], t8); for (int e = 0; e < 8; ++e) a16[e] = t8[e]; unpk8(raw[9], t8); for (int e = 0; e < 8; ++e) a16[8 + e] = t8[e]; }
                        const int ro = t1 * RS + kq * 32;
                        *(LAS v4u*)(SL + O_VT + ro) = raw[4]; *(LAS v4u*)(SL + O_VT + ro + 16) = raw[5];
#pragma unroll
                        for (int e4 = 0; e4 < 4; ++e4) *(LAS f32x4*)(PV + O_EW + t1 * ES + kq * 64 + e4 * 16) = (f32x4){e16[4 * e4], e16[4 * e4 + 1], e16[4 * e4 + 2], e16[4 * e4 + 3]};
                        if (c + 4 < NCHUNK) SC_PREFETCH(c + 4);
                        float kkc[16], kac[16];
#pragma unroll
                        for (int e4 = 0; e4 < 4; ++e4) { const f32x4 q0 = *(const LAS f32x4*)(L + KC_OFF + (16 * kq + 4 * e4) * 4), q1 = *(const LAS f32x4*)(L + KC_OFF + 256 + (16 * kq + 4 * e4) * 4);
#pragma unroll
                            for (int e = 0; e < 4; ++e) { kkc[4 * e4 + e] = q0[e]; kac[4 * e4 + e] = q1[e]; } }
                        float kk16[16], nb16[16], kd16[16]; float ss = 0.f;
#pragma unroll
                        for (int e = 0; e < 16; ++e) { kk16[e] = k16[e] * kkc[e]; ss += kk16[e] * kk16[e]; }
                        ss = dpp_add<0xB1>(ss); ss = dpp_add<0x4E>(ss);
                        const float rn = 1.0f / sqrtf(fmaxf(ss, 1e-24f));
#pragma unroll
                        for (int e = 0; e < 16; ++e) { kk16[e] *= rn; nb16[e] = -kk16[e] * a16[e]; }
                        { float sb = 0.f;
#pragma unroll
                          for (int e4 = 0; e4 < 4; ++e4) { const f32x4 q2 = *(const LAS f32x4*)(L + KC_OFF + 512 + (16 * kq + 4 * e4) * 4), q3 = *(const LAS f32x4*)(L + KC_OFF + 768 + (16 * kq + 4 * e4) * 4);
#pragma unroll
                              for (int e = 0; e < 4; ++e) { const int x = 4 * e4 + e; const float ka_ = k16[x] * a16[x]; kd16[x] = k16[x] + (ka_ - k16[x]) * kac[x]; sb += (r16[x] * k16[x]) * (q2[e] * a16[x] + q3[e]); } }
                          sb = dpp_add<0xB1>(sb); sb = dpp_add<0x4E>(sb);
                          if (c >= CTXCHUNK && kq == 0) SBTg[((size_t)scan_row(c * C + t1, b, dir) * 8 + h) * 4 + 1 + dir] = sb; }
                        asm volatile("s_waitcnt lgkmcnt(0)" ::: "memory");
                        {
                          LAS float* Ep = (LAS float*)(PV + O_EW) + l; float cs = 0.f;
#pragma unroll
                          for (int t = 0; t < 16; ++t) { cs += Ep[t * (ES / 4)]; Ep[t * (ES / 4)] = cs; }
                          ((LAS float*)(SL + O_LC))[l] = __expf(cs); }
                        asm volatile("s_waitcnt lgkmcnt(0)" ::: "memory");
                        unsigned pP[8], pR[8], pN[8], pD[8], pNP[8], pDP[8];
#pragma unroll
                        for (int e4 = 0; e4 < 4; ++e4) { const f32x4 cs4 = *(const LAS f32x4*)(PV + O_EW + t1 * ES + kq * 64 + e4 * 16);
                            const f32x4 cm4 = *(const LAS f32x4*)(L + (t1 > 0 ? PRIVP + p * PRIVP_B + O_EW + (t1 - 1) * ES + kq * 64 + e4 * 16 : ZERO_OFF)); const f32x4 lc4 = *(const LAS f32x4*)(SL + O_LC + kq * 64 + e4 * 16);
                            float vP[4], vR[4], vN[4], vD[4], vNP[4], vDP[4];
#pragma unroll
                            for (int e = 0; e < 4; ++e) { const int x = 4 * e4 + e; const float pc = __expf(cs4[e]), pm = __expf(cm4[e]), ic = __builtin_amdgcn_rcpf(pc);
                                vP[e] = kk16[x] * pm; vR[e] = r16[x] * pc; vN[e] = nb16[x] * ic; vD[e] = kd16[x] * ic; vNP[e] = vN[e] * lc4[e]; vDP[e] = vD[e] * lc4[e]; }
                            pP[2 * e4] = cvtpk(vP[0], vP[1]); pP[2 * e4 + 1] = cvtpk(vP[2], vP[3]); pR[2 * e4] = cvtpk(vR[0], vR[1]); pR[2 * e4 + 1] = cvtpk(vR[2], vR[3]);
                            pN[2 * e4] = cvtpk(vN[0], vN[1]); pN[2 * e4 + 1] = cvtpk(vN[2], vN[3]); pD[2 * e4] = cvtpk(vD[0], vD[1]); pD[2 * e4 + 1] = cvtpk(vD[2], vD[3]);
                            pNP[2 * e4] = cvtpk(vNP[0], vNP[1]); pNP[2 * e4 + 1] = cvtpk(vNP[2], vNP[3]); pDP[2 * e4] = cvtpk(vDP[0], vDP[1]); pDP[2 * e4 + 1] = cvtpk(vDP[2], vDP[3]); }
                        *(LAS v4u*)(SL + O_P + ro) = (v4u){pP[0], pP[1], pP[2], pP[3]}; *(LAS v4u*)(SL + O_P + ro + 16) = (v4u){pP[4], pP[5], pP[6], pP[7]};
                        *(LAS v4u*)(SL + O_RT + ro) = (v4u){pR[0], pR[1], pR[2], pR[3]}; *(LAS v4u*)(SL + O_RT + ro + 16) = (v4u){pR[4], pR[5], pR[6], pR[7]};
                        *(LAS v4u*)(PV + O_NN + ro) = (v4u){pN[0], pN[1], pN[2], pN[3]}; *(LAS v4u*)(PV + O_NN + ro + 16) = (v4u){pN[4], pN[5], pN[6], pN[7]};
                        *(LAS v4u*)(PV + O_DD + ro) = (v4u){pD[0], pD[1], pD[2], pD[3]}; *(LAS v4u*)(PV + O_DD + ro + 16) = (v4u){pD[4], pD[5], pD[6], pD[7]};
                        *(LAS v4u*)(SL + O_NPT + ro) = (v4u){pNP[0], pNP[1], pNP[2], pNP[3]}; *(LAS v4u*)(SL + O_NPT + ro + 16) = (v4u){pNP[4], pNP[5], pNP[6], pNP[7]};
                        *(LAS v4u*)(SL + O_DPT + ro) = (v4u){pDP[0], pDP[1], pDP[2], pDP[3]}; *(LAS v4u*)(SL + O_DPT + ro + 16) = (v4u){pDP[4], pDP[5], pDP[6], pDP[7]};
                    } else if (f == 2) {
                        bf16x8v_ ap[2], ar[2], bn[2], bd[2];
#pragma unroll
                        for (int ks = 0; ks < 2; ++ks) { const int o = lr * RS + ks * 64 + g * 16; ap[ks] = *(const LAS bf16x8v_*)(SL + O_P + o); ar[ks] = *(const LAS bf16x8v_*)(SL + O_RT + o); bn[ks] = *(const LAS bf16x8v_*)(PV + O_NN + o); bd[ks] = *(const LAS bf16x8v_*)(PV + O_DD + o); }
                        f32x4 cN = {0.f, 0.f, 0.f, 0.f}, cDm = cN, cNr = cN, cDr = cN;
#pragma unroll
                        for (int ks = 0; ks < 2; ++ks) { cN = __builtin_amdgcn_mfma_f32_16x16x32_bf16(ap[ks], bn[ks], cN, 0, 0, 0); cDm = __builtin_amdgcn_mfma_f32_16x16x32_bf16(ap[ks], bd[ks], cDm, 0, 0, 0);
                            cNr = __builtin_amdgcn_mfma_f32_16x16x32_bf16(ar[ks], bn[ks], cNr, 0, 0, 0); cDr = __builtin_amdgcn_mfma_f32_16x16x32_bf16(ar[ks], bd[ks], cDr, 0, 0, 0); }
                        *(LAS f32x4*)(PV + O_NF + (lr * 16 + 4 * g) * 4) = (f32x4){lr < 4 * g ? cN[0] : 0.f, lr < 4 * g + 1 ? cN[1] : 0.f, lr < 4 * g + 2 ? cN[2] : 0.f, lr < 4 * g + 3 ? cN[3] : 0.f};
#pragma unroll
                        for (int r = 0; r < 4; ++r) { const int t = 4 * g + r, j = lr; const bool lo = j < t, le = j <= t;
                            ((LAS unsigned short*)(SL + O_DM))[t * 16 + j] = tobf1(lo ? cDm[r] : 0.f); ((LAS unsigned short*)(SL + O_NR))[t * 16 + j] = tobf1(le ? cNr[r] : 0.f); ((LAS unsigned short*)(SL + O_DR))[t * 16 + j] = tobf1(le ? cDr[r] : 0.f); }
                    } else {
                        const LAS f32x4* NFTp = (const LAS f32x4*)(PV + O_NF); float acc[16];
#pragma unroll
                        for (int t = 0; t < 16; ++t) acc[t] = (t == lr) ? 1.0f : 0.0f;
                        f32x4 col[4];
#pragma unroll
                        for (int q4 = 0; q4 < 4; ++q4) col[q4] = NFTp[q4];
#pragma unroll
                        for (int j = 0; j < 16; ++j) { const float Lj = acc[j]; ((LAS unsigned short*)(SL + O_LINV))[j * 16 + lr] = tobf1(Lj);
                            f32x4 nxt[4];
                            if (j + 1 < 16) {
#pragma unroll
                                for (int q4 = 0; q4 < 4; ++q4) nxt[q4] = NFTp[(j + 1) * 4 + q4]; }
#pragma unroll
                            for (int t = j + 1; t < 16; ++t) acc[t] += col[t >> 2][t & 3] * Lj;
                            if (j + 1 < 16) {
#pragma unroll
                                for (int q4 = 0; q4 < 4; ++q4) col[q4] = nxt[q4]; } }
                    }
                }
                asm volatile("s_waitcnt lgkmcnt(0)" ::: "memory");
                }
                if (l == 0) RDY[c % NSLOT] = (unsigned)(c + 1);
            }
#undef SC_PREFETCH
        } else {
            const int w = F.wave, irow = 16 * w + lr, q = lr >> 2, pp = l & 3;
            f32x4 S[4];
#pragma unroll
            for (int kt = 0; kt < 4; ++kt) S[kt] = (f32x4){0.f, 0.f, 0.f, 0.f};
            volatile LAS unsigned* RDY = (volatile LAS unsigned*)(L + FLAG_OFF); LAS unsigned* DONE = (LAS unsigned*)(L + FLAG_OFF) + NSLOT;
            const unsigned ldsb_ = (unsigned)(size_t)L, lanetr_ = (unsigned)((4 * g + q) * RS + 8 * pp);
            for (int c = 0; c < NCHUNK; ++c) {
                { unsigned spins = 0; while (RDY[c % NSLOT] != (unsigned)(c + 1)) { __builtin_amdgcn_s_sleep(1); if (++spins > (1u << 22)) break; } asm volatile("" ::: "memory"); }
                {
                    LAS unsigned char* SL = L + (c % NSLOT) * SLOT_B; const unsigned slb_ = ldsb_ + (unsigned)((c % NSLOT) * SLOT_B);
                    asm volatile("s_nop 7" : "+v"(S[0]), "+v"(S[1]), "+v"(S[2]), "+v"(S[3]));
                    bf16x8v_ bS[2], aP[2], aR[2];
#pragma unroll
                    for (int ks = 0; ks < 2; ++ks) { bS[ks] = __builtin_bit_cast(bf16x8v_, (v4u){cvtpk(S[2 * ks][0], S[2 * ks][1]), cvtpk(S[2 * ks][2], S[2 * ks][3]), cvtpk(S[2 * ks + 1][0], S[2 * ks + 1][1]), cvtpk(S[2 * ks + 1][2], S[2 * ks + 1][3])});
                        const int o = lr * RS + (32 * ks + 4 * g) * 2;
                        aP[ks] = mk_b(*(const LAS v2u*)(SL + O_P + o), *(const LAS v2u*)(SL + O_P + o + 32)); aR[ks] = mk_b(*(const LAS v2u*)(SL + O_RT + o), *(const LAS v2u*)(SL + O_RT + o + 32)); }
                    const v2u z2 = {0u, 0u}; const int o16 = lr * 32 + g * 8;
                    const bf16x8v_ aDm = mk_b(*(const LAS v2u*)(SL + O_DM + o16), z2), aNr = mk_b(*(const LAS v2u*)(SL + O_NR + o16), z2), aDr = mk_b(*(const LAS v2u*)(SL + O_DR + o16), z2), aLi = mk_b(*(const LAS v2u*)(SL + O_LINV + o16), z2);
                    v2u trv, trn[4], trd[4];
                    asm volatile("ds_read_b64_tr_b16 %0, %9\n\t"
                                 "ds_read_b64_tr_b16 %1, %10\n\tds_read_b64_tr_b16 %2, %10 offset:32\n\tds_read_b64_tr_b16 %3, %10 offset:64\n\tds_read_b64_tr_b16 %4, %10 offset:96\n\t"
                                 "ds_read_b64_tr_b16 %5, %11\n\tds_read_b64_tr_b16 %6, %11 offset:32\n\tds_read_b64_tr_b16 %7, %11 offset:64\n\tds_read_b64_tr_b16 %8, %11 offset:96\n\ts_waitcnt lgkmcnt(0)"
                                 : "=&v"(trv), "=&v"(trn[0]), "=&v"(trn[1]), "=&v"(trn[2]), "=&v"(trn[3]), "=&v"(trd[0]), "=&v"(trd[1]), "=&v"(trd[2]), "=&v"(trd[3])
                                 : "v"(slb_ + (unsigned)(O_VT + 32 * w) + lanetr_), "v"(slb_ + (unsigned)O_NPT + lanetr_), "v"(slb_ + (unsigned)O_DPT + lanetr_) : "memory");
                    const bf16x8v_ bV = mk_b(trv, z2);
                    f32x4 W = {0.f, 0.f, 0.f, 0.f};
                    W = __builtin_amdgcn_mfma_f32_16x16x32_bf16(aP[0], bS[0], W, 0, 0, 0); W = __builtin_amdgcn_mfma_f32_16x16x32_bf16(aP[1], bS[1], W, 0, 0, 0); W = __builtin_amdgcn_mfma_f32_16x16x32_bf16(aDm, bV, W, 0, 0, 0);
                    asm volatile("s_nop 7\n\ts_nop 7" : "+v"(W));
                    const bf16x8v_ bW = __builtin_bit_cast(bf16x8v_, (v4u){cvtpk(W[0], W[1]), cvtpk(W[2], W[3]), 0u, 0u});
                    f32x4 Z = {0.f, 0.f, 0.f, 0.f};
                    Z = __builtin_amdgcn_mfma_f32_16x16x32_bf16(aLi, bW, Z, 0, 0, 0);
                    asm volatile("s_nop 7\n\ts_nop 7" : "+v"(Z));
                    const bf16x8v_ bZ = __builtin_bit_cast(bf16x8v_, (v4u){cvtpk(Z[0], Z[1]), cvtpk(Z[2], Z[3]), 0u, 0u});
                    if (c >= CTXCHUNK) {
                        f32x4 Y = {0.f, 0.f, 0.f, 0.f};
                        Y = __builtin_amdgcn_mfma_f32_16x16x32_bf16(aR[0], bS[0], Y, 0, 0, 0); Y = __builtin_amdgcn_mfma_f32_16x16x32_bf16(aR[1], bS[1], Y, 0, 0, 0);
                        Y = __builtin_amdgcn_mfma_f32_16x16x32_bf16(aNr, bZ, Y, 0, 0, 0); Y = __builtin_amdgcn_mfma_f32_16x16x32_bf16(aDr, bV, Y, 0, 0, 0);
#pragma unroll
                        for (int r = 0; r < 4; ++r) { const int m = scan_row(c * C + 4 * g + r, b, dir); Yg[(size_t)m * RW + h * 64 + irow] = tobf(Y[r]); }
                    }
#pragma unroll
                    for (int kt = 0; kt < 4; ++kt) { const f32x4 lc = *(const LAS f32x4*)(SL + O_LC + (16 * kt + 4 * g) * 4);
                        f32x4 sv = S[kt] * lc; sv = __builtin_amdgcn_mfma_f32_16x16x32_bf16(mk_b(trn[kt], z2), bZ, sv, 0, 0, 0); sv = __builtin_amdgcn_mfma_f32_16x16x32_bf16(mk_b(trd[kt], z2), bV, sv, 0, 0, 0); S[kt] = sv; }
                }
                asm volatile("s_waitcnt lgkmcnt(0)" ::: "memory");
                if (l == 0) __hip_atomic_fetch_add(DONE, 1u, __ATOMIC_RELAXED, __HIP_MEMORY_SCOPE_WORKGROUP);
            }
        }
        __syncthreads();
    }
}
__device__ __forceinline__ void rwkv_out_phase(const Frame& F, const Args& a) {
    const bf16* RB = (const bf16*)(a.ws + WS_R); const bf16* KB = (const bf16*)(a.ws + WS_K); const bf16* VB = (const bf16*)(a.ws + WS_V); const bf16* LP = (const bf16*)(a.ws + WS_LP); bf16* O = (bf16*)(a.ws + WS_FXO) + 512;
    const bf16* YF = (const bf16*)a.out; const bf16* YBk = (const bf16*)a.out + (size_t)MX * RW;
    const int gw = F.vcu * NWAVES + F.wave, NGW = F.G * NWAVES, col = 8 * F.lane;
    float lg[8], lb[8];
#pragma unroll
    for (int e = 0; e < 8; ++e) { lg[e] = a.in[I_LNG][col + e]; lb[e] = a.in[I_LNB][col + e]; }
    const float* SBT = (const float*)(a.ws + WS_SBT);
    v4u ryf, ryb, rv, rg; f32x4 rsb;
#define RO_LOAD(m_) do { ryf = __builtin_nontemporal_load((const GAS v4u*)(YF + (size_t)(m_) * RW + col)); ryb = __builtin_nontemporal_load((const GAS v4u*)(YBk + (size_t)(m_) * RW + col)); \
        rv = __builtin_nontemporal_load((const GAS v4u*)(VB + (size_t)(m_) * RW + col)); rg = __builtin_nontemporal_load((const GAS v4u*)(LP + (size_t)(m_) * LN + 2048 + col)); \
        rsb = __builtin_nontemporal_load((const GAS f32x4*)(SBT + ((size_t)(m_) * 8 + (F.lane >> 3)) * 4)); } while (0)
    if (gw < MX) RO_LOAD(gw);
    for (int m = gw; m < MX; m += NGW) {
        float y[8], v[8], gg[8], o[8];
        { float yb8[8]; unpk8(ryf, y); unpk8(ryb, yb8);
#pragma unroll
          for (int e = 0; e < 8; ++e) y[e] += yb8[e]; }
        unpk8(rv, v); unpk8(rg, gg);
        const f32x4 sb4 = rsb;
        if (m + NGW < MX) RO_LOAD(m + NGW);
        float s = 0.f;
#pragma unroll
        for (int e = 0; e < 8; ++e) s += y[e];
        const float mean = red8(s) * (1.0f / 64.0f);
        float qv = 0.f; const float bs = sb4[1] + sb4[2];
#pragma unroll
        for (int e = 0; e < 8; ++e) { y[e] -= mean; qv += y[e] * y[e]; }
        const float rstd = 1.0f / sqrtf(red8(qv) * (1.0f / 64.0f) + GN_EPS);
#pragma unroll
        for (int e = 0; e < 8; ++e) o[e] = ((y[e] * rstd * lg[e] + lb[e]) + bs * v[e]) * gg[e];
        *(GAS v4u*)(O + (size_t)m * 1024 + col) = pk8(o);
    }
#undef RO_LOAD
}
__global__ void __launch_bounds__(NWAVES * 64, 2) mk_fwd(Args args) {
    extern __shared__ __attribute__((aligned(16))) unsigned char lds[];
    Frame F;
    F.lds = (LAS unsigned char*)lds;
    F.MISC = (volatile LAS unsigned*)(F.lds + MISC_OFF);
    F.tid = threadIdx.x; F.lane = F.tid & 63; F.wave = __builtin_amdgcn_readfirstlane(F.tid >> 6);
    F.G = gridDim.x; { const int bx = blockIdx.x; F.vcu = (F.G % 8 == 0) ? (bx % 8) * (F.G / 8) + bx / 8 : bx; }
    F.ctl = (gu32*)(args.ws + WS_CTL);
    for (int u = F.tid; u < (LDS_BYTES - LDSCTL_OFF) / 4; u += NWAVES * 64) ((LAS unsigned*)(F.lds + LDSCTL_OFF))[u] = 0u;
    __syncthreads();
    XcdBarrier bar; bar.bar = (unsigned*)(F.ctl + CW_BAR); bar.x = 0; bar.st = nullptr;
    if (N_LAUNCHES == 1) bar = xcd_barrier_post((unsigned*)(F.ctl + CW_BAR), F.MISC + 8);
    if (N_LAUNCHES == 1 && threadIdx.x == 0 && (bar.x != (blockIdx.x & 7u) || (gridDim.x & 7u) != 0u)) (void)xb_add((unsigned*)(F.ctl + CW_BADMAP), 1u);
#define GRID_BAR() do { if (N_LAUNCHES == 1) xcd_barrier(bar); } while (0)
    const int lo = args.ph_lo, hi = args.ph_hi;
#define IN(k) (refresh_tid(F), lo <= (k) && (k) < hi)
#define INP(k) (lo <= (k) && (k) < hi)
#define SEAM(k) do { if (INP(k) && INP((k) + 1)) GRID_BAR(); } while (0)
#define SEAM_L(k) do { if (INP(k) && INP((k) + 1)) { if (N_LAUNCHES == 1) { if (F.MISC[10]) xcd_barrier_local(bar); else xcd_barrier(bar); } } } while (0)
#define WSP(T, off) ((T*)(args.ws + (off)))
#define MOD WSP(float, WS_MOD)
#define Win_t WSP(bf16, WS_WIN)
#define Wlora_t WSP(bf16, WS_WLORA)
#define Wupf_t WSP(bf16, WS_WUPF)
#define Wupr_t WSP(bf16, WS_WUPR)
#define Wout_t WSP(bf16, WS_WOUT)
#define Wgu_t WSP(bf16, WS_WGU)
#define Wdown_t WSP(bf16, WS_WDOWN)
#define HX WSP(bf16, WS_HX)
#define PXR WSP(bf16, WS_PXR)
#define Z3 WSP(bf16, WS_Z3)
#define GF WSP(bf16, WS_GF)
#define GR WSP(bf16, WS_GR)
#define Y2 ((bf16*)((unsigned char*)args.out + 32 * MiB))
#define FX WSP(bf16, WS_FXO)
#define AL ((bf16*)args.out)
#define LP WSP(bf16, WS_LP)
#define MB WSP(bf16, WS_MB)
#define HX2 WSP(bf16, WS_HX2)
#define ACT WSP(bf16, WS_ACT)
    const int gw = F.vcu * NWAVES + F.wave, NGW = F.G * NWAVES;
    using EpiIn1 = pg8::EpiIn<WS_Z3, WS_GF, WS_GR, WS_R, WS_EB>;

    for (int rep_ = 0; rep_ < 1 + ((MK_REPEAT >> 0) & 1); ++rep_)
    if (IN(0)) { p0_weights(F, args); } SEAM(0);
    if (N_LAUNCHES == 1) {
        if (threadIdx.x == 0) F.MISC[10] = (xb_ld((unsigned*)(F.ctl + CW_BADMAP)) == 0u) ? 1u : 0u;
        __syncthreads(); }
    for (int rep_ = 0; rep_ < 1 + ((MK_REPEAT >> 1) & 1); ++rep_)
    if (IN(1)) {
        { constexpr int RPW = (MT + 2047) / 2048; const int rpw = (MT + NGW - 1) / NGW; (void)RPW; const int m0 = gw * rpw, m1 = (m0 + rpw < MT) ? m0 + rpw : MT; norm_mod_rows<0>(args, m0, m1, args.in[I_N1G], HX, F.lane); }
    } SEAM(1);
    for (int rep_ = 0; rep_ < 1 + ((MK_REPEAT >> 2) & 1); ++rep_)
    if (IN(2)) {
        { pg8::Gemm g{HX, Win_t, MX, NIN, D}; pg8::StaticOrder S; S.init(MX, NIN, F.G, (int)blockIdx.x); EpiIn1 E{args.ws, (bf16*)args.out, args.in[I_MUP], args.in[I_MUN], (LAS float*)(F.lds + XB_OFF), 0};
          pg8::gemm_phase<EpiIn1, pg8::StaticOrder, true, true>(F.lds + RING_OFF, g, S, E); }
        { pg8::Gemm g{HX + (size_t)MX * D, Win_t, MC, RPAD, D}; pg8::StaticOrder S; S.init(MC, RPAD, F.G, (int)blockIdx.x); EpiIn1 E{args.ws, (bf16*)args.out, args.in[I_MUP], args.in[I_MUN], (LAS float*)(F.lds + XB_OFF), MX};
          pg8::gemm_phase<EpiIn1, pg8::StaticOrder, true, true>(F.lds + RING_OFF, g, S, E); }
    } SEAM(2);
    for (int rep_ = 0; rep_ < 1 + ((MK_REPEAT >> 3) & 1); ++rep_)
    if (IN(3)) { edge_rows(F, args); dft_pass_a(F, Z3, Y2); } SEAM(3);
    for (int rep_ = 0; rep_ < 1 + ((MK_REPEAT >> 7) & 1); ++rep_)
    if (IN(7)) { dft_pass_b(F, Y2, FX); __syncthreads();
        pg8::Gemm g{AL, Wlora_t, MT, LN, LK}; pg8::StaticOrder S; S.init(MT, LN, F.G, (int)blockIdx.x); pg8::EpiLora E{LP, WSP(const float, WS_LB), (LAS float*)(F.lds + XB_OFF) + 2048};
        pg8::gemm_phase<pg8::EpiLora, pg8::StaticOrder, true, true>(F.lds + RING_OFF, g, S, E); } SEAM(7);
    for (int rep_ = 0; rep_ < 1 + ((MK_REPEAT >> 8) & 1); ++rep_)
    if (IN(8)) { scan_phase(F, args); } SEAM(8);
    for (int rep_ = 0; rep_ < 1 + ((MK_REPEAT >> 9) & 1); ++rep_)
    if (IN(9)) { rwkv_out_phase(F, args); } SEAM(9);
    for (int rep_ = 0; rep_ < 1 + ((MK_REPEAT >> 10) & 1); ++rep_)
    if (IN(10)) { pg8::Gemm g{FX, Wupf_t, MX, D, D}; pg8::StaticOrder S; S.init(MX, D, F.G, (int)blockIdx.x); pg8::EpiMerge2 E{MB, GF, GR};
        pg8::gemm_phase<pg8::EpiMerge2, pg8::StaticOrder, true, true>(F.lds + RING_OFF, g, S, E); } SEAM_L(10);
    for (int rep_ = 0; rep_ < 1 + ((MK_REPEAT >> 11) & 1); ++rep_)
    if (IN(11)) { pg8::Gemm g{MB, Wout_t, MX, D, D}; pg8::StaticOrder S; S.init(MX, D, F.G, (int)blockIdx.x); pg8::EpiDelta E{WSP(bf16, WS_D1), MOD + 2048, (LAS float*)(F.lds + XB_OFF) + 2048};
        pg8::gemm_phase<pg8::EpiDelta, pg8::StaticOrder, true, true>(F.lds + RING_OFF, g, S, E); } SEAM_L(11);
    for (int rep_ = 0; rep_ < 1 + ((MK_REPEAT >> 12) & 1); ++rep_)
    if (IN(12)) {
        p_weights2(F, args);
        { const int rpw = (MX + NGW - 1) / NGW; const int m0 = gw * rpw, m1 = (m0 + rpw < MX) ? m0 + rpw : MX; norm_mod_rows<1>(args, m0, m1, args.in[I_N2G], HX2, F.lane); }
    } SEAM(12);
    for (int rep_ = 0; rep_ < 1 + ((MK_REPEAT >> 13) & 1); ++rep_)
    if (IN(13)) { pg8::Gemm g{HX2, Wgu_t, MX, 2 * DFF, D}; pg8::StaticOrder S; S.init(MX, 2 * DFF, F.G, (int)blockIdx.x); pg8::EpiSwiglu E{ACT};
        pg8::gemm_phase<pg8::EpiSwiglu, pg8::StaticOrder, true, true>(F.lds + RING_OFF, g, S, E); } SEAM_L(13);
    for (int rep_ = 0; rep_ < 1 + ((MK_REPEAT >> 14) & 1); ++rep_)
    if (IN(14)) { pg8::Gemm g{ACT, Wdown_t, MX, D, DFF}; pg8::StaticOrder S; S.init(MX, D, F.G, (int)blockIdx.x); pg8::EpiDelta E{WSP(bf16, WS_D2), MOD + 5120, (LAS float*)(F.lds + XB_OFF) + 2048};
        pg8::gemm_phase<pg8::EpiDelta, pg8::StaticOrder, true, true>(F.lds + RING_OFF, g, S, E); } SEAM_L(14);
    for (int rep_ = 0; rep_ < 1 + ((MK_REPEAT >> 15) & 1); ++rep_)
    if (IN(15)) {
        const int wpx = (F.G % 8 == 0) ? NGW / 8 : NGW, rpx = (F.G % 8 == 0) ? MX / 8 : MX, xg = gw / wpx, lw = gw % wpx;
        f32x4 px[4]; v2u pd1[4], pd2[4];
#define FN_LOAD(m_) do { const GAS f32x4* xin = (const GAS f32x4*)(args.in[I_X] + (size_t)(m_) * D) + F.lane; const GAS v2u* dr = (const GAS v2u*)(WSP(bf16, WS_D2) + (size_t)(m_) * D) + F.lane; \
            const GAS v2u* d1r = (const GAS v2u*)(WSP(bf16, WS_D1) + (size_t)(m_) * D) + F.lane; \
            _Pragma("unroll") for (int j = 0; j < 4; ++j) { px[j] = __builtin_nontemporal_load(xin + 64 * j); pd1[j] = __builtin_nontemporal_load(d1r + 64 * j); pd2[j] = __builtin_nontemporal_load(dr + 64 * j); } } while (0)
        const int mbeg = xg * rpx + lw, mend = (xg + 1) * rpx;
        if (mbeg < mend) FN_LOAD(mbeg);
        f32x4 fng[4];
#pragma unroll
        for (int j = 0; j < 4; ++j) fng[j] = ((const f32x4*)args.in[I_FNG])[F.lane + 64 * j];
        for (int m = mbeg; m < mend; m += wpx) {
            GAS f32x4* xr = (GAS f32x4*)(args.out + (size_t)m * D) + F.lane; f32x4 v[4]; float s2 = 0.f;
#pragma unroll
            for (int j = 0; j < 4; ++j) { const v2u dd = pd2[j], d1 = pd1[j]; v[j] = (px[j] + (f32x4){bflo(d1.x), bfhi(d1.x), bflo(d1.y), bfhi(d1.y)}) + (f32x4){bflo(dd.x), bfhi(dd.x), bflo(dd.y), bfhi(dd.y)}; s2 += (v[j].x * v[j].x + v[j].y * v[j].y) + (v[j].z * v[j].z + v[j].w * v[j].w); }
            if (m + wpx < mend) FN_LOAD(m + wpx);
            const float rstd = 1.0f / sqrtf(wave_sum(s2) * (1.f / D) + NORM_EPS);
#pragma unroll
            for (int j = 0; j < 4; ++j) xr[64 * j] = (v[j] * rstd) * fng[j];
        }
#undef FN_LOAD
    }
#undef IN
#undef SEAM
#undef GRID_BAR
}

extern "C" void kernel_launch(void* const* d_in, const int* in_sizes, int n_in, void* d_out, int out_size, void* d_ws, size_t ws_size, hipStream_t stream) {
    static int grid = 0;
    if (grid == 0) {
        if (n_in != 31 || in_sizes[0] != MX * D || out_size != MX * D || ws_size < WS_END) { fprintf(stderr, "kernel_launch: shape/workspace mismatch (n_in %d, in0 %d, out %d, ws %zu); nothing launched\n", n_in, n_in > 0 ? in_sizes[0] : -1, out_size, ws_size); grid = -1; return; }
        int dev = 0, cus = 0;
        if (hipGetDevice(&dev) != hipSuccess || hipDeviceGetAttribute(&cus, hipDeviceAttributeMultiprocessorCount, dev) != hipSuccess) { grid = -1; return; }
        if (hipFuncSetAttribute((const void*)mk_fwd, hipFuncAttributeMaxDynamicSharedMemorySize, LDS_BYTES) != hipSuccess) { fprintf(stderr, "kernel_launch: hipFuncSetAttribute failed\n"); grid = -1; return; }
        (void)hipGetLastError();
        grid = cus;
    }
    if (grid < 0) return;
    if (hipMemsetAsync((char*)d_ws + WS_CTL, 0, CTL_ZERO_BYTES, stream) != hipSuccess) return;
    Args a{};
    for (int i = 0; i < 31; ++i) a.in[i] = (const float*)d_in[i];
    a.out = (float*)d_out; a.ws = (unsigned char*)d_ws;
    if (N_LAUNCHES == 1) { a.ph_lo = 0; a.ph_hi = NPH; a.li = 0; hipLaunchKernelGGL(mk_fwd, dim3(grid), dim3(NWAVES * 64), LDS_BYTES, stream, a); }
    else for (int p = 0; p < NPH; ++p) { a.ph_lo = p; a.ph_hi = p + 1; a.li = p; hipLaunchKernelGGL(mk_fwd, dim3(grid), dim3(NWAVES * 64), LDS_BYTES, stream, a); }
}
```

```cpp
#include <hip/hip_runtime.h>
#include <cstdio>
#include <cstdint>
#ifndef MK_REPEAT
#define MK_REPEAT 0x0
#endif
#ifndef MK_N_LAUNCHES
#define MK_N_LAUNCHES 1
#endif
namespace pg8 {
#define PG8_LAS __attribute__((address_space(3)))
typedef unsigned short bf16_t;
typedef short bf16x8 __attribute__((ext_vector_type(8)));
typedef float f32x4 __attribute__((ext_vector_type(4)));
typedef unsigned u32x4 __attribute__((ext_vector_type(4)));
constexpr int BM = 256, BK = 64, HALF = 128, HTB = HALF * BK * 2  , STAGE_BYTES = 8 * HTB, NXCD = 8, WGM = 8;

__host__ __device__ __forceinline__ int lds_byte(int r, int c) { const int st = (r >> 4) * 2 + (c >> 5), rr = r & 15, cc = c & 31, ob = rr * 64 + cc * 2; return st * 1024 + (ob ^ (((ob >> 9) & 1) << 5)); }
__host__ __device__ __forceinline__ void stage_rc(int b, int& R, int& C) { const int st = b / 1024, sb = b % 1024, swz = sb ^ (((sb >> 9) & 1) << 5); R = (st >> 1) * 16 + swz / 64; C = (st & 1) * 32 + (swz % 64) / 2; }
__host__ __device__ __forceinline__ int perm32(int rho) { const int n = rho >> 4, i = rho & 15; return 8 * (i >> 2) + 4 * n + (i & 3); }

struct Unit { int pm, pn; };
struct Gemm { const bf16_t* A; const bf16_t* Bt; int M, N, K; };

struct StaticOrder {
    int nM, nN, nwg, G, c;
    __host__ __device__ void init(int M, int N, int G_, int c_) { nM = M / BM; nN = N / BM; nwg = nM * nN; G = G_; c = c_; }
    __host__ __device__ bool next(int i, Unit& u) const {
        const long L = (long)i * G + c; if (L >= nwg) return false;
        int wgid = (int)L; { const int q = nwg / NXCD, r = nwg % NXCD, xcd = wgid % NXCD, off = wgid / NXCD; wgid = (xcd < r ? xcd * (q + 1) : r * (q + 1) + (xcd - r) * q) + off; }
        const int nig = WGM * nN, gid = wgid / nig, fm = gid * WGM, gsz = (nM - fm) < WGM ? (nM - fm) : WGM;
        u.pm = fm + ((wgid % nig) % gsz); u.pn = (wgid % nig) / gsz; return true;
    }
    __device__ __forceinline__ void a_ready(const Unit&) const {}
    __device__ __forceinline__ void done(const Unit&) const {}
};

__device__ __forceinline__ unsigned cvt_pk_bf16(float lo, float hi) { unsigned r; asm volatile("v_cvt_pk_bf16_f32 %0, %1, %2" : "=v"(r) : "v"(lo), "v"(hi)); return r; }
__device__ __forceinline__ float bf_lo(unsigned w) { return __uint_as_float(w << 16); }
__device__ __forceinline__ float bf_hi(unsigned w) { return __uint_as_float(w & 0xffff0000u); }
__device__ __forceinline__ float sigm(float x) { return __builtin_amdgcn_rcpf(1.0f + __expf(-x)); }
__device__ __forceinline__ f32x4 sigm4(f32x4 v) { return (f32x4){sigm(v[0]), sigm(v[1]), sigm(v[2]), sigm(v[3])}; }
__device__ __forceinline__ u32x4 pack8(f32x4 v0, f32x4 v1) { u32x4 w; w.x = cvt_pk_bf16(v0[0], v0[1]); w.y = cvt_pk_bf16(v0[2], v0[3]); w.z = cvt_pk_bf16(v1[0], v1[1]); w.w = cvt_pk_bf16(v1[2], v1[3]); return w; }
__device__ __forceinline__ void unpack8(u32x4 w, f32x4& v0, f32x4& v1) { v0 = (f32x4){bf_lo(w.x), bf_hi(w.x), bf_lo(w.y), bf_hi(w.y)}; v1 = (f32x4){bf_lo(w.z), bf_hi(w.z), bf_lo(w.w), bf_hi(w.w)}; }
template <int CTRL> __device__ __forceinline__ float dpp_rot(float src) { return __int_as_float(__builtin_amdgcn_mov_dpp(__float_as_int(src), CTRL, 0xF, 0xF, true)); }
template <size_t O_Z3, size_t O_GF, size_t O_GR, size_t O_R, size_t O_EB> struct EpiIn {
    static constexpr bool PERM = true, AFTER_DRAIN = false, HAS_MID = false; static constexpr int KSLICE = 0; static constexpr bool SKIP_B1 = true, HAS_PRE = true;
    static __device__ __forceinline__ bool skip_b1(int pn) { return pn == 7; }
    static constexpr size_t RKV_STRIDE = (size_t)36 * 1024 * 1024 / 2;
    unsigned char* ws; bf16_t* al; const float* mup; const float* mun; PG8_LAS float* xb; int row_off;
    __device__ __forceinline__ void pre(const Unit& u, int ui, int wid, int lane) const {
        if (u.pn >= 8) return;
        const int t = wid * 64 + lane, col = 256 * u.pn + (t & 255);
        const float* src = (t < 256 ? mup : mun) + (col < 1920 ? col : 0);
        __builtin_amdgcn_global_load_lds((const unsigned*)src, (PG8_LAS unsigned*)(xb + 2048 + (ui & 1) * 512 + wid * 64), 4, 0, 0);
    }
    __device__ __forceinline__ void operator()(const f32x4 (&acc)[2][2][4][2], const Unit& u, int wr, int wc, int fr, int fq, int ui) const {
        const int pn = u.pn;
        if (pn >= 8) {
            const int row0 = row_off + u.pm * BM + wr * 64 + fr;
            if (pn < 10) {
                bf16_t* base = (bf16_t*)(ws + O_Z3); const int col0 = (pn - 8) * 256 + wc * 32 + 8 * fq;
#pragma unroll
                for (int ai = 0; ai < 2; ++ai)
#pragma unroll
                    for (int m = 0; m < 4; ++m) { bf16_t* rowp = base + (size_t)(row0 + ai * HALF + m * 16) * 512 + col0;
#pragma unroll
                        for (int bj = 0; bj < 2; ++bj) *(u32x4*)(rowp + bj * HALF) = pack8(acc[ai][bj][m][0], acc[ai][bj][m][1]); }
            } else {
                bf16_t* gq = (bf16_t*)(ws + O_GF); bf16_t* gr = (bf16_t*)(ws + O_GR); const int col0 = (pn - 10) * 128 + wc * 32 + 8 * fq;
#pragma unroll
                for (int ai = 0; ai < 2; ++ai)
#pragma unroll
                    for (int m = 0; m < 4; ++m) { const size_t off = (size_t)(row0 + ai * HALF + m * 16) * 1024 + col0;
                        f32x4 qv[2], sv[2];
#pragma unroll
                        for (int n = 0; n < 2; ++n)
#pragma unroll
                            for (int e = 0; e < 4; ++e) { const float ef = __expf(-acc[ai][0][m][n][e]), er1 = 1.0f + __expf(-acc[ai][1][m][n][e]);
                                sv[n][e] = __builtin_amdgcn_rcpf(er1); qv[n][e] = __builtin_amdgcn_rcpf(1.0f + ef) * fminf(er1, 1e20f); }
                        *(u32x4*)(gq + off) = pack8(qv[0], qv[1]); *(u32x4*)(gr + off) = pack8(sv[0], sv[1]); }
            }
            return;
        }
        asm volatile("" : "+v"(fr), "+v"(fq));
        const int cw = wc * 32 + 8 * fq, tile = (row_off >> 8) + u.pm;
        float* eb = (float*)(ws + O_EB); bf16_t* rkv = (bf16_t*)(ws + O_R);
#pragma unroll
        for (int ai = 0; ai < 2; ++ai)
#pragma unroll
            for (int bj = 0; bj < 2; ++bj)
#pragma unroll
                for (int n = 0; n < 2; ++n) { PG8_LAS float* p0 = xb + ((2 * ai + wr) * 2) * 256 + 128 * bj + cw + 4 * n;
                    if (fr == 0) *(PG8_LAS f32x4*)p0 = acc[ai][bj][0][n];
                    if (fr == 15) *(PG8_LAS f32x4*)(p0 + 256) = acc[ai][bj][3][n]; }
        if (wr == 0 && fr < 2) {
#pragma unroll
            for (int bj = 0; bj < 2; ++bj)
#pragma unroll
                for (int n = 0; n < 2; ++n) *(f32x4*)(eb + ((size_t)tile * 4 + fr) * 2048 + 256 * pn + 128 * bj + cw + 4 * n) = acc[0][bj][0][n]; }
        if (wr == 1 && fr >= 14) {
#pragma unroll
            for (int bj = 0; bj < 2; ++bj)
#pragma unroll
                for (int n = 0; n < 2; ++n) *(f32x4*)(eb + ((size_t)tile * 4 + 2 + (fr - 14)) * 2048 + 256 * pn + 128 * bj + cw + 4 * n) = acc[1][bj][3][n]; }
        asm volatile("s_waitcnt lgkmcnt(0)" ::: "memory"); __builtin_amdgcn_s_barrier(); asm volatile("" ::: "memory");
        bf16_t* dst; int ldd, dcol;
        if (pn < 6) { dst = rkv + (size_t)(pn >> 1) * RKV_STRIDE; ldd = 512; dcol = (pn & 1) * 256; } else { dst = al; ldd = 384; dcol = (pn - 6) * 256; }
#pragma unroll
        for (int bj = 0; bj < 2; ++bj) {
            if (pn == 7 && bj == 1) continue;
            const int act = (pn == 6 && bj == 0) ? 1 : (pn == 7) ? 2 : 0;
            const PG8_LAS float* tab = xb + 2048 + (ui & 1) * 512 + 128 * bj + cw;
            const bool f0 = fr == 0, f15 = fr == 15; const f32x4 z4 = {0.f, 0.f, 0.f, 0.f};
#pragma unroll
            for (int ai = 0; ai < 2; ++ai) { const int q = 2 * ai + wr;
                unsigned pk[4][2][2];
#pragma unroll
                for (int n = 0; n < 2; ++n) {
                    const f32x4 mp = *(const PG8_LAS f32x4*)(tab + 4 * n), mn = *(const PG8_LAS f32x4*)(tab + 256 + 4 * n);
                    const f32x4 w0 = 1.0f - mp - mn, mpA = f0 ? z4 : mp, mpB = f0 ? mp : z4, mnA = f15 ? z4 : mn, mnB = f15 ? mn : z4;
                    f32x4 xp = z4, xn = z4;
                    if (q > 0) xp = *(const PG8_LAS f32x4*)(xb + ((q - 1) * 2 + 1) * 256 + 128 * bj + cw + 4 * n);
                    if (q < 3) xn = *(const PG8_LAS f32x4*)(xb + ((q + 1) * 2) * 256 + 128 * bj + cw + 4 * n);
                    f32x4 R1[4], L1[4];
#pragma unroll
                    for (int m = 0; m < 4; ++m)
#pragma unroll
                        for (int e = 0; e < 4; ++e) { R1[m][e] = dpp_rot<0x121>(acc[ai][bj][m][n][e]); L1[m][e] = dpp_rot<0x12F>(acc[ai][bj][m][n][e]); }
#pragma unroll
                    for (int m = 0; m < 4; ++m) {
                        f32x4 uu = w0 * acc[ai][bj][m][n] + mpA * R1[m] + mpB * (m > 0 ? R1[m > 0 ? m - 1 : 0] : xp) + mnA * L1[m] + mnB * (m < 3 ? L1[m < 3 ? m + 1 : 3] : xn);
                        if (act == 1) uu = 2.0f * sigm4(2.0f * uu) - 1.0f; else if (act == 2) uu = sigm4(uu);
                        pk[m][n][0] = cvt_pk_bf16(uu[0], uu[1]); pk[m][n][1] = cvt_pk_bf16(uu[2], uu[3]); }
                }
#pragma unroll
                for (int m = 0; m < 4; ++m) *(u32x4*)(dst + (size_t)(row_off + u.pm * BM + 128 * ai + 64 * wr + 16 * m + fr) * ldd + dcol + 128 * bj + cw) = (u32x4){pk[m][0][0], pk[m][0][1], pk[m][1][0], pk[m][1][1]};
            }
        }
    }
};
struct EpiLora {
    static constexpr bool PERM = true, AFTER_DRAIN = false, HAS_MID = false; static constexpr int KSLICE = 128; static constexpr bool SKIP_B1 = false, HAS_PRE = true;
    bf16_t* lp; const float* bias; PG8_LAS float* tab;
    __device__ __forceinline__ void pre(const Unit& u, int ui, int wid, int lane) const {
        if (wid < 4) __builtin_amdgcn_global_load_lds((const unsigned*)(bias + 256 * u.pn + wid * 64 + lane), (PG8_LAS unsigned*)(tab + (ui & 1) * 256 + wid * 64), 4, 0, 0);
    }
    static __device__ __forceinline__ int koff(int pn) { const int t = pn >> 1; return t >= 4 ? 256 : (t >= 2 ? 128 : 0); }
    __device__ __forceinline__ void operator()(const f32x4 (&acc)[2][2][4][2], const Unit& u, int wr, int wc, int fr, int fq, int ui) const {
        const int pn = u.pn, t = pn >> 1;
        const PG8_LAS float* tb = tab + (ui & 1) * 256 + wc * 32 + 8 * fq;
        const int row0 = u.pm * BM + wr * 64 + fr, col0 = pn * 256 + wc * 32 + 8 * fq;
        const float sc = t < 2 ? -0.6065306597f : 1.0f;
#pragma unroll
        for (int bj = 0; bj < 2; ++bj) { const f32x4 b0 = *(const PG8_LAS f32x4*)(tb + bj * HALF), b1 = *(const PG8_LAS f32x4*)(tb + bj * HALF + 4);
#pragma unroll
            for (int ai = 0; ai < 2; ++ai)
#pragma unroll
                for (int m = 0; m < 4; ++m) { f32x4 v0 = acc[ai][bj][m][0] + b0, v1 = acc[ai][bj][m][1] + b1;
                    if (t < 4) { v0 = sigm4(v0) * sc; v1 = sigm4(v1) * sc; }
                    *(u32x4*)(lp + (size_t)(row0 + ai * HALF + m * 16) * 2560 + col0 + bj * HALF) = pack8(v0, v1); } }
    }
};
struct EpiMerge2 {
    static constexpr bool PERM = true, AFTER_DRAIN = false, HAS_MID = true; static constexpr int KSLICE = 0; static constexpr bool SKIP_B1 = false, HAS_PRE = false;
    bf16_t* mb; const bf16_t* gf; const bf16_t* gr;
    __device__ __forceinline__ void mid(f32x4 (&acc)[2][2][4][2], const Unit& u, int wr, int wc, int fr, int fq) const {
        asm volatile("" : "+v"(fr), "+v"(fq));
        const int row0 = u.pm * BM + wr * 64 + fr, col0 = u.pn * BM + wc * 32 + 8 * fq;
        constexpr int DEPTH = 8;
        u32x4 fw[DEPTH];
#define PG8_GOFF(it_) ((size_t)(row0 + ((it_) >> 3) * HALF + (((it_) >> 1) & 3) * 16) * 1024 + col0 + ((it_) & 1) * HALF)
#pragma unroll
        for (int d = 0; d < DEPTH; ++d) fw[d] = *(const u32x4*)(gf + PG8_GOFF(d));
#pragma unroll
        for (int it = 0; it < 16; ++it) { const int ai = it >> 3, m = (it >> 1) & 3, bj = it & 1, sl = it % DEPTH;
            const u32x4 fwc = fw[sl];
            asm volatile("" ::: "memory");
            if (it + DEPTH < 16) fw[sl] = *(const u32x4*)(gf + PG8_GOFF(it + DEPTH));
            asm volatile("" ::: "memory");
            acc[ai][bj][m][0][0] *= bf_lo(fwc.x); acc[ai][bj][m][0][1] *= bf_hi(fwc.x); acc[ai][bj][m][0][2] *= bf_lo(fwc.y); acc[ai][bj][m][0][3] *= bf_hi(fwc.y);
            acc[ai][bj][m][1][0] *= bf_lo(fwc.z); acc[ai][bj][m][1][1] *= bf_hi(fwc.z); acc[ai][bj][m][1][2] *= bf_lo(fwc.w); acc[ai][bj][m][1][3] *= bf_hi(fwc.w); }
    }
    __device__ __forceinline__ void operator()(const f32x4 (&acc)[2][2][4][2], const Unit& u, int wr, int wc, int fr, int fq) const {
        const int row0 = u.pm * BM + wr * 64 + fr, col0 = u.pn * BM + wc * 32 + 8 * fq;
        constexpr int DEPTH = 8;
        u32x4 rw[DEPTH];
#pragma unroll
        for (int d = 0; d < DEPTH; ++d) rw[d] = *(const u32x4*)(gr + PG8_GOFF(d));
#pragma unroll
        for (int it = 0; it < 16; ++it) { const int ai = it >> 3, m = (it >> 1) & 3, bj = it & 1, sl = it % DEPTH;
            const u32x4 rwc = rw[sl];
            asm volatile("" ::: "memory");
            if (it + DEPTH < 16) rw[sl] = *(const u32x4*)(gr + PG8_GOFF(it + DEPTH));
            asm volatile("" ::: "memory");
            f32x4 g0, g1; unpack8(rwc, g0, g1);
#pragma unroll
            for (int e = 0; e < 4; ++e) { g0[e] = fmaxf(g0[e], 1e-20f); g1[e] = fmaxf(g1[e], 1e-20f); }
            *(u32x4*)(mb + PG8_GOFF(it)) = pack8(g0 * acc[ai][bj][m][0], g1 * acc[ai][bj][m][1]); }
#undef PG8_GOFF
    }
};
struct EpiResid {
    static constexpr bool PERM = false, AFTER_DRAIN = false, HAS_MID = false; static constexpr int KSLICE = 0; static constexpr bool SKIP_B1 = false, HAS_PRE = false;
    const float* base; float* out; const float* gate;
    __device__ __forceinline__ void operator()(const f32x4 (&acc)[2][2][4][2], const Unit& u, int wr, int wc, int fr, int fq) const {
        const int row0 = u.pm * BM + wr * 64 + fr, col0 = u.pn * BM + wc * 32 + 4 * fq; const float* gp = gate + (size_t)(u.pm >> 3) * 6144 + col0;
        f32x4 gv[2][2];
#pragma unroll
        for (int bj = 0; bj < 2; ++bj)
#pragma unroll
            for (int n = 0; n < 2; ++n) gv[bj][n] = *(const f32x4*)(gp + bj * HALF + n * 16);
        f32x4 cur[2][2], nxt[2][2];
#pragma unroll
        for (int bj = 0; bj < 2; ++bj)
#pragma unroll
            for (int n = 0; n < 2; ++n) cur[bj][n] = *(const f32x4*)(base + (size_t)row0 * 1024 + col0 + bj * HALF + n * 16);
#pragma unroll
        for (int g8 = 0; g8 < 8; ++g8) { const int ai = g8 >> 2, m = g8 & 3; const size_t off = (size_t)(row0 + ai * HALF + m * 16) * 1024 + col0;
            if (g8 + 1 < 8) { const int ai2 = (g8 + 1) >> 2, m2 = (g8 + 1) & 3; const size_t off2 = (size_t)(row0 + ai2 * HALF + m2 * 16) * 1024 + col0;
#pragma unroll
                for (int bj = 0; bj < 2; ++bj)
#pragma unroll
                    for (int n = 0; n < 2; ++n) nxt[bj][n] = *(const f32x4*)(base + off2 + bj * HALF + n * 16); }
            asm volatile("" ::: "memory");
#pragma unroll
            for (int bj = 0; bj < 2; ++bj)
#pragma unroll
                for (int n = 0; n < 2; ++n) *(f32x4*)(out + off + bj * HALF + n * 16) = cur[bj][n] + gv[bj][n] * acc[ai][bj][m][n];
            asm volatile("" ::: "memory");
#pragma unroll
            for (int bj = 0; bj < 2; ++bj)
#pragma unroll
                for (int n = 0; n < 2; ++n) cur[bj][n] = nxt[bj][n];
        }
    }
};
struct EpiDelta {
    static constexpr bool PERM = true, AFTER_DRAIN = false, HAS_MID = false; static constexpr int KSLICE = 0; static constexpr bool SKIP_B1 = false, HAS_PRE = true;
    bf16_t* dlt; const float* gate; PG8_LAS float* tab;
    __device__ __forceinline__ void pre(const Unit& u, int ui, int wid, int lane) const {
        if (wid < 4) __builtin_amdgcn_global_load_lds((const unsigned*)(gate + (size_t)(u.pm >> 3) * 6144 + 256 * u.pn + wid * 64 + lane), (PG8_LAS unsigned*)(tab + (ui & 1) * 256 + wid * 64), 4, 0, 0);
    }
    __device__ __forceinline__ void operator()(const f32x4 (&acc)[2][2][4][2], const Unit& u, int wr, int wc, int fr, int fq, int ui) const {
        const int row0 = u.pm * BM + wr * 64 + fr, col0 = u.pn * BM + wc * 32 + 8 * fq; const PG8_LAS float* gp = tab + (ui & 1) * 256 + wc * 32 + 8 * fq;
        f32x4 gv[2][2];
#pragma unroll
        for (int bj = 0; bj < 2; ++bj)
#pragma unroll
            for (int n = 0; n < 2; ++n) gv[bj][n] = *(const PG8_LAS f32x4*)(gp + bj * HALF + 4 * n);
#pragma unroll
        for (int ai = 0; ai < 2; ++ai)
#pragma unroll
            for (int m = 0; m < 4; ++m) { bf16_t* rowp = dlt + (size_t)(row0 + ai * HALF + m * 16) * 1024 + col0;
#pragma unroll
                for (int bj = 0; bj < 2; ++bj) *(u32x4*)(rowp + bj * HALF) = pack8(acc[ai][bj][m][0] * gv[bj][0], acc[ai][bj][m][1] * gv[bj][1]); }
    }
};
struct EpiSwiglu {
    static constexpr bool PERM = true, AFTER_DRAIN = false, HAS_MID = false; static constexpr int KSLICE = 0; static constexpr bool SKIP_B1 = false, HAS_PRE = false;
    bf16_t* act;
    __device__ __forceinline__ void operator()(const f32x4 (&acc)[2][2][4][2], const Unit& u, int wr, int wc, int fr, int fq) const {
        const int row0 = u.pm * BM + wr * 64 + fr, col0 = u.pn * 128 + wc * 32 + 8 * fq;
#pragma unroll
        for (int ai = 0; ai < 2; ++ai)
#pragma unroll
            for (int m = 0; m < 4; ++m) { const f32x4 g0 = acc[ai][0][m][0], g1 = acc[ai][0][m][1];
                *(u32x4*)(act + (size_t)(row0 + ai * HALF + m * 16) * 2816 + col0) = pack8(g0 * sigm4(g0) * acc[ai][1][m][0], g1 * sigm4(g1) * acc[ai][1][m][1]); }
    }
};

template <class Epi, class Sched, bool ALIGN_EPI = false, bool SP2 = false>
__device__ __forceinline__ void gemm_phase(PG8_LAS unsigned char* lds, const Gemm g, const Sched& S, const Epi& E) {
    int tid_ = threadIdx.x; asm volatile("" : "+v"(tid_));
    const int tid = tid_, wid = __builtin_amdgcn_readfirstlane(tid >> 6), lane = tid & 63, wr = wid >> 2, wc = wid & 3, fr = lane & 15, fq = lane >> 4;
    int nt_ = Epi::KSLICE ? Epi::KSLICE / BK : g.K / BK; asm volatile("" : "+s"(nt_));
    const int K = g.K, nt = nt_;
    unsigned voffA[2], voffB[2];
#pragma unroll
    for (int i = 0; i < 2; ++i) { int R, C; stage_rc(tid * 16 + i * 8192, R, C); const int Rb = Epi::PERM ? ((R & ~31) + perm32(R & 31)) : R;
        voffA[i] = (unsigned)(R * K + C) * 2u; voffB[i] = (unsigned)(Rb * K + C) * 2u; }
    const size_t kstep = (size_t)(BK * 2);
    const size_t hstep = (size_t)HALF * K * 2;
    const size_t tstep = 2 * hstep;
    const unsigned ldsw = (unsigned)wid * 1024u;
    const int aoff = lds_byte(wr * 64 + fr, fq * 8), boff = lds_byte(wc * 32 + fr, fq * 8);
#define PG8_SA(b, h) (((b) * 2 + (h)) * HTB)
#define PG8_SB(b, h) ((4 + (b) * 2 + (h)) * HTB)
#define PG8_STAGE(bufoff, gbase, voff) do { _Pragma("unroll") for (int _i = 0; _i < 2; ++_i) \
        __builtin_amdgcn_global_load_lds((const unsigned*)((const char*)(gbase) + (voff)[_i]), (PG8_LAS unsigned*)(lds + (bufoff) + ldsw + _i * 8192), 16, 0, 0); } while (0)
#define PG8_LDA(dst, b, h) do { _Pragma("unroll") for (int m = 0; m < 4; ++m) _Pragma("unroll") for (int k = 0; k < 2; ++k) dst[m][k] = *(const PG8_LAS bf16x8*)(lds + PG8_SA(b, h) + aoff + m * 2048 + k * 1024); } while (0)
#define PG8_LDB(dst, b, h) do { _Pragma("unroll") for (int n = 0; n < 2; ++n) _Pragma("unroll") for (int k = 0; k < 2; ++k) dst[n][k] = *(const PG8_LAS bf16x8*)(lds + PG8_SB(b, h) + boff + n * 2048 + k * 1024); } while (0)
#define PG8_MMA(ai, bj, At, Bt) do { __builtin_amdgcn_s_setprio(1); _Pragma("unroll") for (int m = 0; m < 4; ++m) _Pragma("unroll") for (int n = 0; n < 2; ++n) _Pragma("unroll") for (int k = 0; k < 2; ++k) \
        acc[ai][bj][m][n] = __builtin_amdgcn_mfma_f32_16x16x32_bf16(Bt[n][k], At[m][k], acc[ai][bj][m][n], 0, 0, 0); __builtin_amdgcn_s_setprio(0); } while (0)
#define PG8_MMA1(ai, At) do { if constexpr (Epi::SKIP_B1) { if (!skb) PG8_MMA(ai, 1, At, B1); } else PG8_MMA(ai, 1, At, B1); } while (0)
#define PG8_WAIT_V(n) asm volatile("s_waitcnt vmcnt(" #n ")" ::: "memory")
#define PG8_WAIT_L(n) asm volatile("s_waitcnt lgkmcnt(" #n ")" ::: "memory")
#define PG8_BAR __builtin_amdgcn_s_barrier()
#define PG8_SCHED __builtin_amdgcn_sched_barrier(0)
    Unit cur, nxt; int ui = 0;
    if (!S.next(0, cur)) return;
    bool skb = false; if constexpr (Epi::SKIP_B1) skb = Epi::skip_b1(cur.pn);
    if constexpr (Epi::HAS_PRE) E.pre(cur, 0, wid, lane);
    f32x4 acc[2][2][4][2];
#pragma unroll
    for (int a = 0; a < 2; ++a)
#pragma unroll
        for (int b = 0; b < 2; ++b)
#pragma unroll
            for (int m = 0; m < 4; ++m)
#pragma unroll
                for (int n = 0; n < 2; ++n) acc[a][b][m][n] = (f32x4){0.f, 0.f, 0.f, 0.f};
    bf16x8 At[4][2], B0[2][2], B1[2][2];
    const char* cA = (const char*)g.A + (size_t)cur.pm * tstep; const char* cB = (const char*)g.Bt + (size_t)cur.pn * tstep;
    if constexpr (Epi::KSLICE != 0) { const int ko = Epi::koff(cur.pn) * 2; cA += ko; cB += ko; }
    S.a_ready(cur);
    if constexpr (SP2) {
        PG8_STAGE(PG8_SB(0, 0), cB, voffB); PG8_STAGE(PG8_SB(0, 1), cB + hstep, voffB); PG8_STAGE(PG8_SA(0, 0), cA, voffA); PG8_STAGE(PG8_SA(0, 1), cA + hstep, voffA);
        if (wr == 1) PG8_BAR;
        PG8_WAIT_V(2); PG8_BAR;
        PG8_STAGE(PG8_SB(1, 0), cB + kstep, voffB); PG8_STAGE(PG8_SA(1, 0), cA + kstep, voffA); PG8_STAGE(PG8_SB(1, 1), cB + hstep + kstep, voffB);
        PG8_WAIT_V(6); PG8_BAR;
    } else {
        PG8_STAGE(PG8_SB(0, 0), cB, voffB); PG8_STAGE(PG8_SA(0, 0), cA, voffA); PG8_STAGE(PG8_SB(0, 1), cB + hstep, voffB); PG8_STAGE(PG8_SA(0, 1), cA + hstep, voffA);
        if (wr == 1) PG8_BAR;
        PG8_WAIT_V(4); PG8_BAR;
        PG8_STAGE(PG8_SB(1, 0), cB + kstep, voffB); PG8_STAGE(PG8_SA(1, 0), cA + kstep, voffA); PG8_STAGE(PG8_SB(1, 1), cB + hstep + kstep, voffB);
        PG8_WAIT_V(6); PG8_BAR;
    }
    for (;;) {
        const bool has_next = S.next(ui + 1, nxt);
        const char* nA = has_next ? (const char*)g.A + (size_t)nxt.pm * tstep : cA; const char* nB = has_next ? (const char*)g.Bt + (size_t)nxt.pn * tstep : cB;
        if constexpr (Epi::KSLICE != 0) { if (has_next) { const int ko = Epi::koff(nxt.pn) * 2; nA += ko; nB += ko; } }
#pragma unroll 1
        for (int t = 0; t < nt; t += 2) {
            const bool last = (t == nt - 2);
            const char* a1 = cA + (size_t)(t + 1) * kstep;
            const char* a2 = last ? nA : cA + (size_t)(t + 2) * kstep; const char* b2 = last ? nB : cB + (size_t)(t + 2) * kstep;
            const char* a3 = a2 + kstep; const char* b3 = b2 + kstep;
            if (last && has_next) S.a_ready(nxt);
            if constexpr (SP2) {
            PG8_LDB(B0, 0, 0); PG8_LDB(B1, 0, 1); PG8_SCHED; PG8_LDA(At, 0, 0); PG8_STAGE(PG8_SA(1, 1), a1 + hstep, voffA);
            PG8_WAIT_V(8); PG8_WAIT_L(0); PG8_BAR; PG8_MMA(0, 0, At, B0); PG8_MMA1(0, At); PG8_BAR; PG8_SCHED;
            PG8_LDA(At, 0, 1); PG8_STAGE(PG8_SB(0, 0), b2, voffB); PG8_STAGE(PG8_SB(0, 1), b2 + hstep, voffB); PG8_STAGE(PG8_SA(0, 0), a2, voffA);
            PG8_WAIT_V(8); PG8_WAIT_L(0); PG8_BAR; PG8_MMA(1, 0, At, B0); PG8_MMA1(1, At); PG8_BAR; PG8_SCHED;
            PG8_LDB(B0, 1, 0); PG8_LDB(B1, 1, 1); PG8_SCHED; PG8_LDA(At, 1, 0); PG8_STAGE(PG8_SA(0, 1), a2 + hstep, voffA);
            PG8_WAIT_V(8); PG8_WAIT_L(0); PG8_BAR; PG8_MMA(0, 0, At, B0); PG8_MMA1(0, At); PG8_BAR; PG8_SCHED;
            PG8_LDA(At, 1, 1); PG8_STAGE(PG8_SB(1, 0), b3, voffB); PG8_STAGE(PG8_SB(1, 1), b3 + hstep, voffB); PG8_STAGE(PG8_SA(1, 0), a3, voffA);
            PG8_WAIT_V(8); PG8_WAIT_L(0); PG8_BAR; PG8_MMA(1, 0, At, B0); PG8_MMA1(1, At); PG8_BAR; PG8_SCHED;
            } else {
            PG8_LDB(B0, 0, 0); PG8_SCHED; PG8_LDA(At, 0, 0); PG8_STAGE(PG8_SA(1, 1), a1 + hstep, voffA);
            PG8_WAIT_L(8); PG8_BAR; PG8_WAIT_L(0); PG8_MMA(0, 0, At, B0); PG8_BAR; PG8_SCHED;
            PG8_LDB(B1, 0, 1); PG8_STAGE(PG8_SB(0, 0), b2, voffB);
            PG8_BAR; PG8_WAIT_L(0); PG8_MMA(0, 1, At, B1); PG8_BAR;
            PG8_LDA(At, 0, 1); PG8_STAGE(PG8_SA(0, 0), a2, voffA);
            PG8_BAR; PG8_WAIT_L(0); PG8_MMA(1, 0, At, B0); PG8_BAR; PG8_SCHED;
            PG8_STAGE(PG8_SB(0, 1), b2 + hstep, voffB);
            PG8_WAIT_V(6); PG8_BAR; PG8_MMA(1, 1, At, B1); PG8_BAR;
            PG8_LDB(B0, 1, 0); PG8_SCHED; PG8_LDA(At, 1, 0); PG8_STAGE(PG8_SA(0, 1), a2 + hstep, voffA);
            PG8_WAIT_L(8); PG8_BAR; PG8_WAIT_L(0); PG8_MMA(0, 0, At, B0); PG8_BAR; PG8_SCHED;
            PG8_LDB(B1, 1, 1); PG8_STAGE(PG8_SB(1, 0), b3, voffB);
            PG8_BAR; PG8_WAIT_L(0); PG8_MMA(0, 1, At, B1); PG8_BAR;
            PG8_LDA(At, 1, 1); PG8_STAGE(PG8_SA(1, 0), a3, voffA);
            PG8_BAR; PG8_WAIT_L(0); PG8_MMA(1, 0, At, B0); PG8_BAR; PG8_SCHED;
            PG8_STAGE(PG8_SB(1, 1), b3 + hstep, voffB);
            PG8_WAIT_V(6); PG8_BAR; PG8_MMA(1, 1, At, B1); PG8_BAR;
            }
            if constexpr (Epi::HAS_MID) { if (t == (nt >> 1) - 2) {
                if constexpr (ALIGN_EPI) { if (wr == 0) PG8_BAR; }
                E.mid(acc, cur, wr, wc, fr, fq);
                if constexpr (ALIGN_EPI) { if (wr == 1) PG8_BAR; } } }
        }
        if constexpr (ALIGN_EPI) { if (wr == 0) PG8_BAR; }
        if constexpr (!Epi::AFTER_DRAIN) { if constexpr (Epi::HAS_PRE) E(acc, cur, wr, wc, fr, fq, ui); else E(acc, cur, wr, wc, fr, fq); S.done(cur); }
        if (!has_next) break;
#pragma unroll
        for (int a = 0; a < 2; ++a)
#pragma unroll
            for (int b = 0; b < 2; ++b)
#pragma unroll
                for (int m = 0; m < 4; ++m)
#pragma unroll
                    for (int n = 0; n < 2; ++n) acc[a][b][m][n] = (f32x4){0.f, 0.f, 0.f, 0.f};
        cur = nxt; cA = nA; cB = nB; ++ui; if constexpr (Epi::SKIP_B1) skb = Epi::skip_b1(cur.pn);
        if constexpr (Epi::HAS_PRE) E.pre(cur, ui, wid, lane);
        if constexpr (ALIGN_EPI) { if (wr == 1) PG8_BAR; }
    }
    PG8_WAIT_V(0);
    if constexpr (!ALIGN_EPI) { if (wr == 0) PG8_BAR; }
    PG8_BAR;
    if constexpr (Epi::AFTER_DRAIN) { E.fused(acc, cur, wr, wc, fr, fq, lds, wid, lane); S.done(cur); }
#undef PG8_SA
#undef PG8_SB
#undef PG8_STAGE
#undef PG8_LDA
#undef PG8_LDB
#undef PG8_MMA
#undef PG8_MMA1
#undef PG8_WAIT_V
#undef PG8_WAIT_L
#undef PG8_BAR
#undef PG8_SCHED
}
}
constexpr int NWAVES = 8;
constexpr int N_LAUNCHES = MK_N_LAUNCHES;
constexpr int NPH = 16;
constexpr int D = 1024, NB = 16, SEQ = 2048, CTXL = 256, MX = NB * SEQ, MC = NB * CTXL, MT = MX + MC;
constexpr int RW = 512, NH = 8, HD = 64, RCOLS = 1920, RPAD = 2048, INCOLS = 4480, NIN = 4608, DFF = 2816, LK = 384, LN = 2560, MODW = 6144;
constexpr float NORM_EPS = 1e-6f, GN_EPS = 64e-5f;
constexpr size_t MiB = 1u << 20;
constexpr size_t WS_CTL = 0, CTL_ZERO_BYTES = 64 * 1024;
constexpr size_t WS_MOD = 1 * MiB, WS_LB = WS_MOD + 512 * 1024;
constexpr size_t WS_WIN = 2 * MiB, WS_WLORA = 12 * MiB, WS_WUPF = 14 * MiB, WS_WUPR = 15 * MiB, WS_WOUT = 16 * MiB;
constexpr size_t WS_A = 18 * MiB, WS_B = 82 * MiB, WS_C = 146 * MiB, WS_D = 210 * MiB, WS_E = 390 * MiB, WS_END = 512 * MiB;
constexpr size_t WS_GF = WS_A, WS_HX2 = WS_A, WS_GR = WS_B, WS_WGU = WS_E, WS_WDOWN = WS_E + 11 * MiB, WS_D1 = WS_B, WS_D2 = WS_A;
constexpr size_t WS_Z3 = WS_C, WS_FXO = WS_C;
constexpr size_t WS_PXR = WS_D, WS_LP = WS_D, WS_MB = WS_D, WS_ACT = WS_D;
constexpr size_t WS_EB = WS_E + 114 * MiB;
constexpr size_t WS_HX = WS_D, WS_Y2 = WS_E, WS_R = WS_E, WS_K = WS_E + 36 * MiB, WS_V = WS_E + 72 * MiB, WS_SBT = WS_E + 110 * MiB;
static_assert(WS_K - WS_R == 36 * MiB && WS_V - WS_K == 36 * MiB, "EpiIn::RKV_STRIDE");
static_assert(WS_LP + (size_t)MT * LN * 2 <= WS_E && WS_ACT + (size_t)MX * DFF * 2 <= WS_E && WS_V + (size_t)MT * RW * 2 <= WS_END && WS_HX + (size_t)MT * D * 2 <= WS_END, "d_ws map");
constexpr int CW_TMO = 0, CW_BAR = 4096, CW_BADMAP = 8192;
constexpr int RING_OFF = 0, RING_BYTES = 131072, LDSCTL_OFF = RING_BYTES, MISC_OFF = LDSCTL_OFF + 320, LDS_BYTES = 147456;
constexpr int XB_OFF = RING_BYTES + 4096;

#define GAS __attribute__((address_space(1)))
#define LAS __attribute__((address_space(3)))
typedef unsigned short bf16;
typedef unsigned v4u __attribute__((ext_vector_type(4)));
typedef unsigned v2u __attribute__((ext_vector_type(2)));
typedef float f32x4 __attribute__((ext_vector_type(4)));
typedef GAS unsigned gu32;
#define RLX_AGENT __ATOMIC_RELAXED, __HIP_MEMORY_SCOPE_AGENT
#define LDS_WAIT() asm volatile("s_waitcnt lgkmcnt(0)" ::: "memory")
#define VM_WAIT() asm volatile("s_waitcnt vmcnt(0)" ::: "memory")
__device__ __forceinline__ unsigned f2bf(float f) { unsigned u = __builtin_bit_cast(unsigned, f); return (u + 0x7fffu + ((u >> 16) & 1u)) >> 16; }
__device__ __forceinline__ unsigned pk2(float lo, float hi) { return f2bf(lo) | (f2bf(hi) << 16); }
__device__ __forceinline__ float bflo(unsigned w) { return __uint_as_float(w << 16); }
__device__ __forceinline__ float bfhi(unsigned w) { return __uint_as_float(w & 0xffff0000u); }
__device__ __forceinline__ float sigf(float x) { return 1.0f / (1.0f + __expf(-x)); }
__device__ __forceinline__ void unpk8(v4u w, float (&f)[8]) { f[0] = bflo(w.x); f[1] = bfhi(w.x); f[2] = bflo(w.y); f[3] = bfhi(w.y); f[4] = bflo(w.z); f[5] = bfhi(w.z); f[6] = bflo(w.w); f[7] = bfhi(w.w); }
__device__ __forceinline__ v4u pk8(const float (&f)[8]) { v4u o; o.x = pk2(f[0], f[1]); o.y = pk2(f[2], f[3]); o.z = pk2(f[4], f[5]); o.w = pk2(f[6], f[7]); return o; }

#define XB_TMO      128
#define XB_XCNT(j)  (256  + 64 * (j))
#define XB_XSUB(j)  (1280 + 64 * (j))
#define XB_XGEN(j)  (2304 + 64 * (j))
#define XB_TOP      3328
#define XB_TOPGEN   3392
#define XCD_BAR_WORDS 3456
#define XB_SPIN_CAP (1u << 18)

__device__ __forceinline__ unsigned xb_ld(unsigned* p)              { return __hip_atomic_load(p, __ATOMIC_RELAXED, __HIP_MEMORY_SCOPE_AGENT); }
__device__ __forceinline__ unsigned xb_add(unsigned* p, unsigned v) { return __hip_atomic_fetch_add(p, v, __ATOMIC_RELAXED, __HIP_MEMORY_SCOPE_AGENT); }
__device__ __forceinline__ unsigned xb_xcc_id() { return (unsigned)__builtin_amdgcn_s_getreg((3 << 11) | 20) & 0xFu; }
#define XB_SPIN(cond, bar) do { unsigned _sp = 0; while (cond) { __builtin_amdgcn_s_sleep(1); \
    if ((++_sp & 255u) == 0u) { if (xb_ld(&(bar)[XB_TMO])) break; if (_sp > XB_SPIN_CAP) { atomicAdd(&(bar)[XB_TMO], 1u); break; } } } } while (0)

struct XcdBarrier {
    unsigned* bar; unsigned x;
    volatile LAS unsigned* st;
};

__device__ __forceinline__ XcdBarrier xcd_barrier_post(unsigned* bar, volatile LAS unsigned* st) {
    XcdBarrier b; b.bar = bar; b.x = xb_xcc_id(); b.st = st;
    if (threadIdx.x == 0) (void)xb_add(&bar[XB_XCNT(b.x)], 1u);
    return b;
}
__device__ __forceinline__ void xcd_barrier_complete(unsigned* bar, unsigned x, unsigned& nloc, unsigned& nx) {
    const unsigned G = gridDim.x * gridDim.y * gridDim.z;
    unsigned sum, cnt, mine, sp = 0u;
    for (;;) {
        sum = 0u; cnt = 0u; mine = 0u;
#pragma unroll
        for (unsigned j = 0; j < 16; ++j) { const unsigned c = xb_ld(&bar[XB_XCNT(j)]); sum += c; cnt += (c > 0u) ? 1u : 0u; mine = (j == x) ? c : mine; }
        if (sum == G) break;
        __builtin_amdgcn_s_sleep(1);
        if ((++sp & 255u) == 0u) { if (xb_ld(&bar[XB_TMO])) break; if (sp > XB_SPIN_CAP) { atomicAdd(&bar[XB_TMO], 1u); break; } }
    }
    nloc = mine > 0u ? mine : 1u; nx = cnt > 0u ? cnt : 1u;
}

__device__ __forceinline__ void xcd_barrier(const XcdBarrier& b) {
    asm volatile("s_waitcnt vmcnt(0)" ::: "memory");
    __syncthreads();
    if (threadIdx.x == 0) {
        unsigned* bar = b.bar;
        __builtin_amdgcn_s_waitcnt(0);
        unsigned nloc = b.st[0], nx = b.st[1];
        if (nloc == 0u) { xcd_barrier_complete(bar, b.x, nloc, nx); b.st[0] = nloc; b.st[1] = nx; }
        const unsigned old = xb_add(&bar[XB_XSUB(b.x)], 1u);
        const unsigned gen = old / nloc;
        if (old + 1u == (gen + 1u) * nloc) {
            __builtin_amdgcn_fence(__ATOMIC_RELEASE, "agent");
            asm volatile("s_waitcnt vmcnt(0)" ::: "memory");
            const unsigned og = xb_add(&bar[XB_TOP], 1u);
            const unsigned tg = og / nx;
            if (og + 1u == (tg + 1u) * nx) xb_add(&bar[XB_TOPGEN], 1u);
            else XB_SPIN(xb_ld(&bar[XB_TOPGEN]) == tg, bar);
            __builtin_amdgcn_fence(__ATOMIC_ACQUIRE, "agent");
            xb_add(&bar[XB_XGEN(b.x)], 1u);
            asm volatile("s_waitcnt vmcnt(0)" ::: "memory");
        } else {
            XB_SPIN(xb_ld(&bar[XB_XGEN(b.x)]) == gen, bar);
            __builtin_amdgcn_fence(__ATOMIC_ACQUIRE, "agent");
            asm volatile("s_waitcnt vmcnt(0)" ::: "memory");
        }
    }
    __syncthreads();
}
__device__ __forceinline__ void xcd_barrier_local(const XcdBarrier& b) {
    asm volatile("s_waitcnt vmcnt(0)" ::: "memory");
    __syncthreads();
    if (threadIdx.x == 0) {
        unsigned* bar = b.bar;
        __builtin_amdgcn_s_waitcnt(0);
        const unsigned nloc = b.st[0] ? b.st[0] : 1u;
        const unsigned old = xb_add(&bar[XB_XSUB(b.x)], 1u);
        const unsigned gen = old / nloc;
        if (old + 1u == (gen + 1u) * nloc) (void)xb_add(&bar[XB_XGEN(b.x)], 1u);
        else XB_SPIN(xb_ld(&bar[XB_XGEN(b.x)]) == gen, bar);
        __builtin_amdgcn_fence(__ATOMIC_ACQUIRE, "agent");
        asm volatile("s_waitcnt vmcnt(0)" ::: "memory");
    }
    __syncthreads();
}
struct Args { const float* in[31]; float* out; unsigned char* ws; int ph_lo, ph_hi, li, pad; };
enum In { I_X = 0, I_C, I_CTX, I_CCTX, I_N1G, I_N2G, I_WADA, I_BADA, I_WIN, I_MUP, I_MUN, I_W0F, I_W2F, I_A0F, I_A2F, I_W0B, I_W2B, I_A0B, I_A2B, I_G2, I_KK, I_KA, I_RK, I_LNG, I_LNB, I_WUPR, I_WUPF, I_WOUT, I_WGU, I_WDOWN, I_FNG };
struct Frame { LAS unsigned char* lds; volatile LAS unsigned* MISC; gu32* ctl; int tid, lane, wave, vcu, G; };

__device__ __forceinline__ void refresh_tid(Frame& F) { int t = threadIdx.x; asm volatile("" : "+v"(t)); F.tid = t; F.lane = t & 63; }
__device__ __forceinline__ float wave_sum(float v) {
#pragma unroll
    for (int o = 1; o < 64; o <<= 1) v += __shfl_xor(v, o);
    return v;
}
__device__ __forceinline__ float red8(float v) { v += __shfl_xor(v, 1); v += __shfl_xor(v, 2); v += __shfl_xor(v, 4); return v; }

__device__ __forceinline__ void tr_item(const float* W, int ldw, int k0, int n0, bf16* WTrow0, int ldk, LAS float* scr, int lane) {
    float tv[32];
#pragma unroll
    for (int i = 0; i < 32; ++i) tv[i] = __builtin_nontemporal_load(W + (size_t)(k0 + 2 * i + (lane >> 5)) * ldw + n0 + (lane & 31));
#pragma unroll
    for (int i = 0; i < 32; ++i) scr[(2 * i + (lane >> 5)) * 33 + (lane & 31)] = tv[i];
    LDS_WAIT(); asm volatile("" ::: "memory");
    const int c = lane & 7;
#pragma unroll
    for (int j = 0; j < 4; ++j) { const int n = (lane >> 3) + 8 * j; const LAS float* s = scr + (8 * c) * 33 + n;
        v4u o; o.x = pk2(s[0 * 33], s[1 * 33]); o.y = pk2(s[2 * 33], s[3 * 33]); o.z = pk2(s[4 * 33], s[5 * 33]); o.w = pk2(s[6 * 33], s[7 * 33]);
        *(GAS v4u*)(WTrow0 + (size_t)n * ldk + k0 + 8 * c) = o; }
    LDS_WAIT(); asm volatile("" ::: "memory");
}

__device__ __forceinline__ void p0_weights(const Frame& F, const Args& a) {
    unsigned char* ws = a.ws;
    bf16* Win_t = (bf16*)(ws + WS_WIN); bf16* Wlora_t = (bf16*)(ws + WS_WLORA); bf16* Wupf_t = (bf16*)(ws + WS_WUPF); bf16* Wupr_t = (bf16*)(ws + WS_WUPR); bf16* Wout_t = (bf16*)(ws + WS_WOUT);
    LAS float* scr = (LAS float*)(F.lds + RING_OFF + F.wave * 16384);
    const int gw = F.vcu * NWAVES + F.wave, NGW = F.G * NWAVES, lane = F.lane;
    constexpr int E0 = 960, E1 = E0 + 1280, E2 = E1 + 256, E3 = E2 + 256, E4 = E3 + 512, E5 = E4 + 128, E6 = E5 + 2560;
    for (int it = gw; it < E6; it += NGW) {
        if (it < E0) { const int kb = it / 60, nb = it % 60; tr_item(a.in[I_WIN], INCOLS, 64 * kb, 32 * nb, Win_t + (size_t)(32 * nb) * D, D, scr, lane); }
        else if (it < E1) { const int r = it - E0, kb = r / 80, nb = r % 80;
            int drow = 2048 + 32 * nb; if (nb >= 16) { const int gj = 32 * ((nb - 16) & 31); drow = 2560 + (gj >> 7) * 256 + (gj & 127) + (nb >= 48 ? 128 : 0); }
            tr_item(a.in[I_WIN] + 1920, INCOLS, 64 * kb, 32 * nb, Win_t + (size_t)drow * D, D, scr, lane); }
        else if (it < E2) { const int r = it - E1, kb = r >> 5, nb = r & 31; tr_item(a.in[I_WUPF], D, 64 * kb, 32 * nb, Wupf_t + (size_t)(32 * nb) * 1024, 1024, scr, lane); }
        else if (it < E3) { const int r = it - E2, kb = r >> 5, nb = r & 31; tr_item(a.in[I_WUPR], D, 64 * kb, 32 * nb, Wupf_t + (size_t)(32 * nb) * 1024 + 512, 1024, scr, lane); }
        else if (it < E4) { const int r = it - E3, kb = r >> 5, nb = r & 31; tr_item(a.in[I_WOUT], D, 64 * kb, 32 * nb, Wout_t + (size_t)(32 * nb) * D, D, scr, lane); }
        else if (it < E5) { const int row = RCOLS + (it - E4); GAS v4u* p = (GAS v4u*)(Win_t + (size_t)row * D + 16 * lane); p[0] = (v4u){0u, 0u, 0u, 0u}; p[1] = (v4u){0u, 0u, 0u, 0u}; }
        else { const int n = it - E5, t = n >> 9, nn = n & 511, koff = t < 4 ? 64 * t : 256, klen = t < 4 ? 64 : 128;
            const float* src = t == 0 ? a.in[I_W2F] : t == 1 ? a.in[I_W2B] : t == 2 ? a.in[I_A2F] : t == 3 ? a.in[I_A2B] : a.in[I_G2];
            float v[6];
#pragma unroll
            for (int e = 0; e < 6; ++e) { const int kk = 6 * lane + e - koff; v[e] = (kk >= 0 && kk < klen) ? src[(size_t)kk * 512 + nn] : 0.f; }
            GAS unsigned* p = (GAS unsigned*)(Wlora_t + (size_t)n * LK + 6 * lane); p[0] = pk2(v[0], v[1]); p[1] = pk2(v[2], v[3]); p[2] = pk2(v[4], v[5]); }
    }
    { constexpr int NPIECE = (LN + NWAVES * 64 - 1) / (NWAVES * 64); const bool spread = F.G >= 192 + NPIECE;
      const int p0 = spread ? (int)blockIdx.x - 192 : 0, p1 = spread ? p0 + 1 : (blockIdx.x == 0 ? NPIECE : 0);
      if (p0 >= 0 && p0 < NPIECE) { float* LB = (float*)(a.ws + WS_LB);
          for (int i = p0 * NWAVES * 64 + F.tid; i < LN && i < p1 * NWAVES * 64; i += NWAVES * 64) { const int t = i >> 9, nn = i & 511; LB[i] = t == 0 ? a.in[I_W0F][nn] : t == 1 ? a.in[I_W0B][nn] : t == 2 ? a.in[I_A0F][nn] : t == 3 ? a.in[I_A0B][nn] : 0.f; } } }
    __syncthreads();
    LAS float* L = (LAS float*)(F.lds + RING_OFF);
    for (int it = blockIdx.x; it < 192; it += F.G) {
        {
            const int n0 = it * 32;
            LAS float* sc = L; LAS float* red = L + 17 * 1024;
            { float cvv[34];
#pragma unroll
              for (int i = 0; i < 34; ++i) { const int idx = F.tid + 512 * i, b = idx >> 10, k = idx & 1023; cvv[i] = b < 16 ? a.in[I_C][b * 1024 + k] : a.in[I_CCTX][k]; }
#pragma unroll
              for (int i = 0; i < 34; ++i) sc[F.tid + 512 * i] = cvv[i] * sigf(cvv[i]); }
            __syncthreads();
            const int col = F.tid & 31, ks = F.tid >> 5;
            float acc[17];
#pragma unroll
            for (int b = 0; b < 17; ++b) acc[b] = 0.f;
            for (int k8 = 0; k8 < 64; k8 += 32) { float wv[32];
#pragma unroll
                for (int j = 0; j < 32; ++j) wv[j] = __builtin_nontemporal_load(a.in[I_WADA] + (size_t)(ks * 64 + k8 + j) * MODW + n0 + col);
#pragma unroll
                for (int j = 0; j < 32; ++j) { const int k = ks * 64 + k8 + j;
#pragma unroll
                    for (int b = 0; b < 17; ++b) acc[b] += sc[b * 1024 + k] * wv[j]; } }
#pragma unroll
            for (int b = 0; b < 17; ++b) red[(ks * 17 + b) * 32 + col] = acc[b];
            __syncthreads();
            for (int o = F.tid; o < 17 * 32; o += NWAVES * 64) { const int b = o >> 5, c2 = o & 31; float s = a.in[I_BADA][n0 + c2];
                for (int k2 = 0; k2 < 16; ++k2) s += red[(k2 * 17 + b) * 32 + c2];
                ((float*)(a.ws + WS_MOD))[b * MODW + n0 + c2] = s; }
            __syncthreads();
        }
    }
}
__device__ __forceinline__ void p_weights2(const Frame& F, const Args& a) {
    bf16* Wgu_t = (bf16*)(a.ws + WS_WGU); bf16* Wdown_t = (bf16*)(a.ws + WS_WDOWN);
    LAS float* scr = (LAS float*)(F.lds + RING_OFF + F.wave * 16384);
    const int gw = F.vcu * NWAVES + F.wave, NGW = F.G * NWAVES;
    for (int it = gw; it < 2816 + 1408; it += NGW) {
        if (it < 2816) { const int kb = it / 176, nb = it % 176, n0 = 32 * nb; const int np = n0 < DFF ? n0 : n0 - DFF; const int drow = (np >> 7) * 256 + (np & 127) + (n0 < DFF ? 0 : 128);
            tr_item(a.in[I_WGU], 2 * DFF, 64 * kb, n0, Wgu_t + (size_t)drow * D, D, scr, F.lane); }
        else { const int r = it - 2816, kb = r >> 5, nb = r & 31; tr_item(a.in[I_WDOWN], D, 64 * kb, 32 * nb, Wdown_t + (size_t)(32 * nb) * DFF, DFF, scr, F.lane); }
    }
}
template <int KIND> __device__ __forceinline__ void norm_mod_rows(const Args& a, int m0, int m1, const float* g, bf16* O, int lane) {
    if (m0 >= m1) return;
    const float* MODp = (const float*)(a.ws + WS_MOD);
    f32x4 gg[4];
#pragma unroll
    for (int j = 0; j < 4; ++j) gg[j] = ((const f32x4*)g)[lane + 64 * j];
    auto rowp = [&](int m) -> const GAS f32x4* { const float* p = (KIND == 1 || m < MX) ? a.in[I_X] + (size_t)m * D : a.in[I_CTX] + (size_t)(m - MX) * D; return (const GAS f32x4*)p + lane; };
    const bf16* D1 = (const bf16*)(a.ws + WS_D1);
    f32x4 cur[4], nxt[4], ss[4], cc[4]; v2u cd[4], nd[4]; int bcur = -1;
    { const GAS f32x4* p = rowp(m0);
#pragma unroll
      for (int j = 0; j < 4; ++j) { cur[j] = __builtin_nontemporal_load(p + 64 * j); if (KIND == 1) cd[j] = __builtin_nontemporal_load((const GAS v2u*)(D1 + (size_t)m0 * D) + lane + 64 * j); } }
    for (int m = m0; m < m1; ++m) {
        if (m + 1 < m1) { const GAS f32x4* p = rowp(m + 1);
#pragma unroll
            for (int j = 0; j < 4; ++j) { nxt[j] = __builtin_nontemporal_load(p + 64 * j); if (KIND == 1) nd[j] = __builtin_nontemporal_load((const GAS v2u*)(D1 + (size_t)(m + 1) * D) + lane + 64 * j); } }
        if (KIND == 1) {
#pragma unroll
            for (int j = 0; j < 4; ++j) cur[j] = cur[j] + (f32x4){bflo(cd[j].x), bfhi(cd[j].x), bflo(cd[j].y), bfhi(cd[j].y)}; }
        const int b = KIND == 0 ? (m < MX ? (m >> 11) : 16) : (m >> 11);
        if (b != bcur) { bcur = b; const float* md = MODp + (size_t)b * MODW + (KIND == 0 ? 0 : 3072);
#pragma unroll
            for (int j = 0; j < 4; ++j) { ss[j] = ((const f32x4*)md)[lane + 64 * j]; cc[j] = ((const f32x4*)(md + 1024))[lane + 64 * j] + 1.0f; } }
        float s2 = 0.f;
#pragma unroll
        for (int j = 0; j < 4; ++j) s2 += (cur[j].x * cur[j].x + cur[j].y * cur[j].y) + (cur[j].z * cur[j].z + cur[j].w * cur[j].w);
        const float rstd = 1.0f / sqrtf(wave_sum(s2) * (1.f / D) + NORM_EPS);
        GAS v2u* o8 = (GAS v2u*)(O + (size_t)m * D) + lane;
#pragma unroll
        for (int j = 0; j < 4; ++j) { const f32x4 o = (cur[j] * rstd) * gg[j] * cc[j] + ss[j]; v2u w; w.x = pk2(o.x, o.y); w.y = pk2(o.z, o.w); o8[64 * j] = w; }
#pragma unroll
        for (int j = 0; j < 4; ++j) { cur[j] = nxt[j]; cd[j] = nd[j]; }
    }
}
typedef short bf16x8v __attribute__((ext_vector_type(8)));
__device__ __forceinline__ unsigned offb(unsigned row, unsigned ch) { return 256u * row + 16u * (ch ^ (((row & 3u) << 2) | ((row >> 2) & 3u))); }
__device__ __forceinline__ void tr_read8(unsigned a0, unsigned a1, v2u (&r0)[4], v2u (&r1)[4]) {
    asm volatile("ds_read_b64_tr_b16 %0, %8\n\tds_read_b64_tr_b16 %1, %8 offset:8192\n\tds_read_b64_tr_b16 %2, %8 offset:16384\n\tds_read_b64_tr_b16 %3, %8 offset:24576\n\t"
                 "ds_read_b64_tr_b16 %4, %9\n\tds_read_b64_tr_b16 %5, %9 offset:8192\n\tds_read_b64_tr_b16 %6, %9 offset:16384\n\tds_read_b64_tr_b16 %7, %9 offset:24576\n\ts_waitcnt lgkmcnt(0)"
                 : "=&v"(r0[0]), "=&v"(r0[1]), "=&v"(r0[2]), "=&v"(r0[3]), "=&v"(r1[0]), "=&v"(r1[1]), "=&v"(r1[2]), "=&v"(r1[3]) : "v"(a0), "v"(a1) : "memory");
}
__device__ __forceinline__ void tr_read4(unsigned a0, unsigned a1, v2u (&r0)[2], v2u (&r1)[2]) {
    asm volatile("ds_read_b64_tr_b16 %0, %4\n\tds_read_b64_tr_b16 %1, %4 offset:8192\n\tds_read_b64_tr_b16 %2, %5\n\tds_read_b64_tr_b16 %3, %5 offset:8192\n\ts_waitcnt lgkmcnt(0)"
                 : "=&v"(r0[0]), "=&v"(r0[1]), "=&v"(r1[0]), "=&v"(r1[1]) : "v"(a0), "v"(a1) : "memory");
}
__device__ __forceinline__ bf16x8v mk_b(v2u lo, v2u hi) { v4u w = {lo.x, lo.y, hi.x, hi.y}; return __builtin_bit_cast(bf16x8v, w); }
__device__ __forceinline__ void dft_pass_a(const Frame& F, const bf16* PXF, bf16* Y2) {
    constexpr int RSW = 272;
    const int w = F.wave, l = F.lane, lr = l & 15, g4 = l >> 4, q = (l & 15) >> 2, p = l & 3;
    const unsigned ldsb = (unsigned)(size_t)(F.lds + RING_OFF);
    LAS unsigned char* IN = F.lds + RING_OFF; LAS bf16* OUT = (LAS bf16*)(F.lds + RING_OFF + 32768); LAS unsigned char* RAW = F.lds + RING_OFF + 32768 + 128 * 272;
    constexpr int OST = 136;
    bf16x8v afr[4], af0[2][4];
    { const int m = 16 * w + lr, ri = m >> 6, k2 = m & 63;
#pragma unroll
      for (int ks = 0; ks < 4; ++ks) { unsigned pk[4];
#pragma unroll
          for (int e2 = 0; e2 < 4; ++e2) { float vv[2];
#pragma unroll
              for (int h = 0; h < 2; ++h) { const int k = 32 * ks + 8 * g4 + 2 * e2 + h, rj = k >> 6, n2 = k & 63, idx = (k2 * n2) & 63; const float rev = (float)idx * (1.0f / 64.0f), sn = __builtin_amdgcn_sinf(rev), cs = __builtin_amdgcn_cosf(rev); vv[h] = (ri == rj) ? cs : (ri == 0 ? sn : -sn); }
              pk[e2] = pk2(vv[0], vv[1]); }
          afr[ks] = __builtin_bit_cast(bf16x8v, (v4u){pk[0], pk[1], pk[2], pk[3]}); } }
#pragma unroll
    for (int mt = 0; mt < 2; ++mt) { const int m = 32 * w + 16 * mt + lr, ri = m >> 7, k3 = m & 127;
#pragma unroll
      for (int ks = 0; ks < 4; ++ks) { unsigned pk[4];
#pragma unroll
          for (int e2 = 0; e2 < 4; ++e2) { float vv[2];
#pragma unroll
              for (int h = 0; h < 2; ++h) { const int n3 = 32 * ks + 8 * g4 + 2 * e2 + h, idx = (k3 * n3) & 127; const float rev = (float)idx * (1.0f / 128.0f), sn = __builtin_amdgcn_sinf(rev), cs = __builtin_amdgcn_cosf(rev); vv[h] = ri == 0 ? cs : -sn; }
              pk[e2] = pk2(vv[0], vv[1]); }
          af0[mt][ks] = __builtin_bit_cast(bf16x8v, (v4u){pk[0], pk[1], pk[2], pk[3]}); } }
    unsigned rb[2], mk[2];
#pragma unroll
    for (int t = 0; t < 2; ++t) { const unsigned row = 8 * g4 + 4 * t + q; rb[t] = ldsb + 256u * row + 8u * (p & 1); mk[t] = ((row & 3u) << 2) | ((row >> 2) & 3u); }
    const unsigned hb = p >> 1;
    v4u pre[2];
    { const int it = blockIdx.x; if (it < 2048) { const int jc = it & 3, n1 = (it >> 2) & 31, b = it >> 7;
#pragma unroll
        for (int i = 0; i < 2; ++i) { const int cid = F.tid + 512 * i, row = cid >> 4, ch = cid & 15; pre[i] = __builtin_nontemporal_load((const GAS v4u*)(PXF + (size_t)(b * 2048 + n1 * 64 + row) * 512 + jc * 128 + ch * 8)); } } }
    for (int it = blockIdx.x; it < 2048; it += F.G) {
        const int jc = it & 3, n1 = (it >> 2) & 31, b = it >> 7;
        __syncthreads();
#pragma unroll
        for (int i = 0; i < 2; ++i) { const int cid = F.tid + 512 * i, row = cid >> 4, ch = cid & 15; *(LAS v4u*)(RAW + row * RSW + ch * 16) = pre[i]; }
        { const int itn = it + F.G; if (itn < 2048) { const int jcn = itn & 3, n1n = (itn >> 2) & 31, bn = itn >> 7;
#pragma unroll
            for (int i = 0; i < 2; ++i) { const int cid = F.tid + 512 * i, row = cid >> 4, ch = cid & 15; pre[i] = __builtin_nontemporal_load((const GAS v4u*)(PXF + (size_t)(bn * 2048 + n1n * 64 + row) * 512 + jcn * 128 + ch * 8)); } } }
        __syncthreads();
#pragma unroll
        for (int nt = 0; nt < 4; ++nt) {
            bf16x8v bx[4];
#pragma unroll
            for (int ks = 0; ks < 4; ++ks) bx[ks] = *(const LAS bf16x8v*)(RAW + (16 * nt + lr) * RSW + (32 * ks + 8 * g4) * 2);
#pragma unroll
            for (int mt = 0; mt < 2; ++mt) { f32x4 acc = {0.f, 0.f, 0.f, 0.f};
#pragma unroll
                for (int ks = 0; ks < 4; ++ks) acc = __builtin_amdgcn_mfma_f32_16x16x32_bf16(af0[mt][ks], bx[ks], acc, 0, 0, 0);
                const int m0 = 32 * w + 16 * mt + 4 * g4, ri = m0 >> 7, c0 = m0 & 127, row = ri * 64 + 16 * nt + lr;
                *(LAS v2u*)(IN + offb(row, c0 >> 3) + 8 * ((c0 >> 2) & 1)) = (v2u){pk2(acc[0], acc[1]), pk2(acc[2], acc[3])}; }
        }
        __syncthreads();
#pragma unroll 2
        for (int c = 0; c < 8; ++c) {
            v2u r0[4], r1[4];
            tr_read8(rb[0] + 16u * ((2u * c + hb) ^ mk[0]), rb[1] + 16u * ((2u * c + hb) ^ mk[1]), r0, r1);
            f32x4 acc = {0.f, 0.f, 0.f, 0.f};
#pragma unroll
            for (int ks = 0; ks < 4; ++ks) acc = __builtin_amdgcn_mfma_f32_16x16x32_bf16(mk_b(r0[ks], r1[ks]), afr[ks], acc, 0, 0, 0);
            *(LAS v2u*)(OUT + (16 * w + lr) * OST + 16 * c + 4 * g4) = (v2u){pk2(acc[0], acc[1]), pk2(acc[2], acc[3])};
        }
        __syncthreads();
#pragma unroll
        for (int i = 0; i < 4; ++i) { const int cid = F.tid + 512 * i, row = cid >> 4, ch = cid & 15, ri = row >> 6, k2 = row & 63;
            *(GAS v4u*)(Y2 + (size_t)(b * 2048 + n1 * 64 + k2) * 1024 + ri * 512 + jc * 128 + ch * 8) = *(const LAS v4u*)(OUT + row * OST + ch * 8); }
    }
}
__device__ __forceinline__ void dft_pass_b(const Frame& F, const bf16* Y2, bf16* FX) {
    const int w = F.wave, l = F.lane, lr = l & 15, g4 = l >> 4, q = (l & 15) >> 2, p = l & 3;
    const int g = w >> 1, c0 = (w & 1) * 4;
    const unsigned ldsb = (unsigned)(size_t)(F.lds + RING_OFF) + 16384u * g;
    LAS unsigned char* IN = F.lds + RING_OFF; LAS bf16* OUT = (LAS bf16*)(F.lds + RING_OFF + 65536);
    constexpr int OSB = 520;
    bf16x8v afr[2][2];
#pragma unroll
    for (int mt = 0; mt < 2; ++mt) { const int k1 = 16 * mt + lr;
#pragma unroll
      for (int ks = 0; ks < 2; ++ks) { unsigned pk[4];
#pragma unroll
          for (int e2 = 0; e2 < 4; ++e2) { float vv[2];
#pragma unroll
              for (int h = 0; h < 2; ++h) { const int k = 32 * ks + 8 * g4 + 2 * e2 + h, ri = k >> 5, n1 = k & 31, idx = (k1 * n1) & 31; const float rev = (float)idx * (1.0f / 32.0f), sn = __builtin_amdgcn_sinf(rev), cs = __builtin_amdgcn_cosf(rev); vv[h] = (ri == 0 ? cs : sn); }
              pk[e2] = pk2(vv[0], vv[1]); }
          afr[mt][ks] = __builtin_bit_cast(bf16x8v, (v4u){pk[0], pk[1], pk[2], pk[3]}); } }
    unsigned rb[2], mk[2];
#pragma unroll
    for (int t = 0; t < 2; ++t) { const unsigned row = 8 * g4 + 4 * t + q; rb[t] = ldsb + 256u * row + 8u * (p & 1); mk[t] = ((row & 3u) << 2) | ((row >> 2) & 3u); }
    const unsigned hb = p >> 1;
    v4u pre[8];
    { const int it = blockIdx.x; if (it < 1024) { const int k2 = it & 63, b = it >> 6;
#pragma unroll
        for (int i = 0; i < 8; ++i) { const int cid = F.tid + 512 * i, row = cid >> 6, c64 = cid & 63; pre[i] = __builtin_nontemporal_load((const GAS v4u*)(Y2 + (size_t)(b * 2048 + (row & 31) * 64 + k2) * 1024 + (row >> 5) * 512 + c64 * 8)); } } }
    for (int it = blockIdx.x; it < 1024; it += F.G) {
        const int k2 = it & 63, b = it >> 6;
        __syncthreads();
#pragma unroll
        for (int i = 0; i < 8; ++i) { const int cid = F.tid + 512 * i, row = cid >> 6, c64 = cid & 63, gg = c64 >> 4, ch = c64 & 15; *(LAS v4u*)(IN + 16384 * gg + offb(row, ch)) = pre[i]; }
        { const int itn = it + F.G; if (itn < 1024) { const int k2n = itn & 63, bn = itn >> 6;
#pragma unroll
            for (int i = 0; i < 8; ++i) { const int cid = F.tid + 512 * i, row = cid >> 6, c64 = cid & 63; pre[i] = __builtin_nontemporal_load((const GAS v4u*)(Y2 + (size_t)(bn * 2048 + (row & 31) * 64 + k2n) * 1024 + (row >> 5) * 512 + c64 * 8)); } } }
        __syncthreads();
#pragma unroll
        for (int cc = 0; cc < 4; ++cc) { const int c = c0 + cc;
            v2u r0[2], r1[2];
            tr_read4(rb[0] + 16u * ((2u * c + hb) ^ mk[0]), rb[1] + 16u * ((2u * c + hb) ^ mk[1]), r0, r1);
#pragma unroll
            for (int mt = 0; mt < 2; ++mt) { f32x4 acc = {0.f, 0.f, 0.f, 0.f};
#pragma unroll
                for (int ks = 0; ks < 2; ++ks) acc = __builtin_amdgcn_mfma_f32_16x16x32_bf16(mk_b(r0[ks], r1[ks]), afr[mt][ks], acc, 0, 0, 0);
                *(LAS v2u*)(OUT + (16 * mt + lr) * OSB + g * 128 + 16 * c + 4 * g4) = (v2u){pk2(acc[0] * (1.0f / 512.0f), acc[1] * (1.0f / 512.0f)), pk2(acc[2] * (1.0f / 512.0f), acc[3] * (1.0f / 512.0f))}; }
        }
        __syncthreads();
#pragma unroll
        for (int i = 0; i < 4; ++i) { const int cid = F.tid + 512 * i, row = cid >> 6, ch = cid & 63;
            *(GAS v4u*)(FX + (size_t)(b * 2048 + row * 64 + k2) * 1024 + ch * 8) = *(const LAS v4u*)(OUT + row * OSB + ch * 8); }
    }
}
template <int CTRL> __device__ __forceinline__ float dpp_add(float x) { const int v = __builtin_amdgcn_update_dpp(__float_as_int(x), __float_as_int(x), CTRL, 0xF, 0xF, false); return x + __int_as_float(v); }
__device__ __forceinline__ void edge_rows(const Frame& F, const Args& a) {
    const float* EB = (const float*)(a.ws + WS_EB); bf16* RB = (bf16*)(a.ws + WS_R); bf16* KB = (bf16*)(a.ws + WS_K); bf16* VB = (bf16*)(a.ws + WS_V); bf16* AL = (bf16*)a.out;
    const int gw = F.vcu * NWAVES + F.wave, lane = F.lane;
    if (gw >= 8 * (MT / 256)) return;
    const int tile = gw >> 3, last = (gw >> 2) & 1, j = gw & 3, col = 512 * j + 8 * lane;
    if (col >= RCOLS) return;
    const bool lat = tile < MX / 256, s0 = lat ? (tile & 7) == 0 : true, s1 = lat ? (tile & 7) == 7 : true;
    const int m = tile * 256 + (last ? 255 : 0);
    const float* cp = EB + ((size_t)tile * 4 + (last ? 3 : 0)) * 2048 + col;
    const float* pp = (last ? EB + ((size_t)tile * 4 + 2) * 2048 : EB + ((size_t)(tile > 0 ? tile - 1 : 0) * 4 + 3) * 2048) + col;
    const float* np = (last ? EB + ((size_t)(tile + 1 < MT / 256 ? tile + 1 : tile) * 4 + 0) * 2048 : EB + ((size_t)tile * 4 + 1) * 2048) + col;
    const bool hp = last ? true : !s0, hn = last ? !s1 : true;
    const f32x4 z = {0.f, 0.f, 0.f, 0.f};
    f32x4 c4[2], p4[2], n4[2], mp4[2], mn4[2];
#pragma unroll
    for (int h = 0; h < 2; ++h) { c4[h] = ((const f32x4*)cp)[h]; p4[h] = hp ? ((const f32x4*)pp)[h] : z; n4[h] = hn ? ((const f32x4*)np)[h] : z; mp4[h] = ((const f32x4*)(a.in[I_MUP] + col))[h]; mn4[h] = ((const f32x4*)(a.in[I_MUN] + col))[h]; }
    float u[8];
#pragma unroll
    for (int e = 0; e < 8; ++e) { const float c = c4[e >> 2][e & 3]; u[e] = c + mp4[e >> 2][e & 3] * (p4[e >> 2][e & 3] - c) + mn4[e >> 2][e & 3] * (n4[e >> 2][e & 3] - c); }
    if (j == 0) *(GAS v4u*)(RB + (size_t)m * RW + 8 * lane) = pk8(u);
    else if (j == 1) *(GAS v4u*)(KB + (size_t)m * RW + 8 * lane) = pk8(u);
    else if (j == 2) *(GAS v4u*)(VB + (size_t)m * RW + 8 * lane) = pk8(u);
    else {
        if (lane < 16) {
#pragma unroll
            for (int e = 0; e < 8; ++e) u[e] = 2.0f * sigf(2.0f * u[e]) - 1.0f;
        } else if (lane >= 32) {
#pragma unroll
            for (int e = 0; e < 8; ++e) u[e] = sigf(u[e]);
        }
        *(GAS v4u*)(AL + (size_t)m * LK + 8 * lane) = pk8(u);
    }
}
__device__ __forceinline__ int scan_row(int s, int b, int dir) { if (s < CTXL) { const int t = dir ? (CTXL - 1 - s) : s; return MX + b * CTXL + t; } const int s2 = s - CTXL; const int t = dir ? (SEQ - 1 - s2) : s2; return b * SEQ + t; }
__device__ __forceinline__ float red16(float x) { x = dpp_add<0xB1>(x); x = dpp_add<0x4E>(x); x = dpp_add<0x141>(x); x = dpp_add<0x140>(x); return x; }
typedef float f32x2 __attribute__((ext_vector_type(2)));
__device__ __forceinline__ float fm_(float a, float b, float c) { float d; asm("v_fma_f32 %0, %1, %2, %3" : "=v"(d) : "v"(a), "v"(b), "v"(c)); return d; }
__device__ __forceinline__ float ml_(float a, float b) { float d; asm("v_mul_f32 %0, %1, %2" : "=v"(d) : "v"(a), "v"(b)); return d; }
__device__ __forceinline__ void red16x2(float& a, float& b) {
    asm volatile("s_nop 1\n\t"
        "v_add_f32_dpp %0, %0, %0 quad_perm:[1,0,3,2] row_mask:0xf bank_mask:0xf\n\tv_add_f32_dpp %1, %1, %1 quad_perm:[1,0,3,2] row_mask:0xf bank_mask:0xf\n\ts_nop 0\n\t"
        "v_add_f32_dpp %0, %0, %0 quad_perm:[2,3,0,1] row_mask:0xf bank_mask:0xf\n\tv_add_f32_dpp %1, %1, %1 quad_perm:[2,3,0,1] row_mask:0xf bank_mask:0xf\n\ts_nop 0\n\t"
        "v_add_f32_dpp %0, %0, %0 row_half_mirror row_mask:0xf bank_mask:0xf\n\tv_add_f32_dpp %1, %1, %1 row_half_mirror row_mask:0xf bank_mask:0xf\n\ts_nop 0\n\t"
        "v_add_f32_dpp %0, %0, %0 row_mirror row_mask:0xf bank_mask:0xf\n\tv_add_f32_dpp %1, %1, %1 row_mirror row_mask:0xf bank_mask:0xf\n\ts_nop 0"
        : "+v"(a), "+v"(b));
}
typedef short bf16x8v_ __attribute__((ext_vector_type(8)));
namespace sc {
constexpr int C = 16, NCHUNK = (CTXL + SEQ) / C, CTXCHUNK = CTXL / C, NSLOT = 5;
constexpr int RS = 144, ARR = 16 * RS, ES = 272;
constexpr int O_P = 0, O_RT = ARR, O_NPT = 2 * ARR, O_DPT = 3 * ARR, O_VT = 4 * ARR, O_DM = 5 * ARR, O_NR = O_DM + 512, O_DR = O_NR + 512, O_LINV = O_DR + 512, O_LC = O_LINV + 512, SLOT_B = O_LC + 256;
constexpr int PRIVP = NSLOT * SLOT_B, O_NN = 0, O_DD = ARR, O_EW = 2 * ARR, O_NF = O_EW + 16 * ES, PRIVP_B = O_NF + 1024;
constexpr int ZERO_OFF = PRIVP + 4 * PRIVP_B;
constexpr int FLAG_OFF = ZERO_OFF + 1024;
constexpr int KC_OFF = FLAG_OFF + 64;
static_assert(SLOT_B % 16 == 0 && PRIVP_B % 16 == 0 && KC_OFF + 1024 <= RING_BYTES, "scan LDS map");
}
__device__ __forceinline__ unsigned cvtpk(float lo, float hi) { unsigned r; asm volatile("v_cvt_pk_bf16_f32 %0, %1, %2" : "=v"(r) : "v"(lo), "v"(hi)); return r; }
__device__ __forceinline__ float bf1(unsigned short x) { return __uint_as_float((unsigned)x << 16); }
__device__ __forceinline__ unsigned short tobf(float f) { return (unsigned short)f2bf(f); }
__device__ __forceinline__ unsigned short tobf1(float f) { return (unsigned short)cvtpk(f, f); }
__device__ __forceinline__ bf16x8v_ tr_frag1(unsigned a) { v2u r0, r1;
    asm volatile("ds_read_b64_tr_b16 %0, %2\n\tds_read_b64_tr_b16 %1, %2 offset:512\n\ts_waitcnt lgkmcnt(0)" : "=&v"(r0), "=&v"(r1) : "v"(a) : "memory"); return mk_b(r0, r1); }
__device__ __forceinline__ void tr_frag4(unsigned a, bf16x8v_ (&f)[4]) { v2u r[8];
    asm volatile("ds_read_b64_tr_b16 %0, %8\n\tds_read_b64_tr_b16 %1, %8 offset:512\n\tds_read_b64_tr_b16 %2, %8 offset:32\n\tds_read_b64_tr_b16 %3, %8 offset:544\n\t"
                 "ds_read_b64_tr_b16 %4, %8 offset:64\n\tds_read_b64_tr_b16 %5, %8 offset:576\n\tds_read_b64_tr_b16 %6, %8 offset:96\n\tds_read_b64_tr_b16 %7, %8 offset:608\n\ts_waitcnt lgkmcnt(0)"
                 : "=&v"(r[0]), "=&v"(r[1]), "=&v"(r[2]), "=&v"(r[3]), "=&v"(r[4]), "=&v"(r[5]), "=&v"(r[6]), "=&v"(r[7]) : "v"(a) : "memory");
    f[0] = mk_b(r[0], r[1]); f[1] = mk_b(r[2], r[3]); f[2] = mk_b(r[4], r[5]); f[3] = mk_b(r[6], r[7]); }
__device__ __forceinline__ void scan_phase(const Frame& F, const Args& a) {
    using namespace sc;
    const bf16* RB = (const bf16*)(a.ws + WS_R); const bf16* KB = (const bf16*)(a.ws + WS_K); const bf16* VB = (const bf16*)(a.ws + WS_V); const bf16* LP = (const bf16*)(a.ws + WS_LP);
    LAS unsigned char* L = F.lds + RING_OFF;
    const int l = F.lane, lr = l & 15, g = l >> 4;
    for (int chain = blockIdx.x; chain < 256; chain += F.G) {
        const int b = chain >> 4, h = (chain >> 1) & 7, dir = chain & 1;
        bf16* Yg = (bf16*)a.out + (dir ? (size_t)MX * RW : 0);
        float* SBTg = (float*)(a.ws + WS_SBT);
        if (F.tid < 256 + 16) ((LAS unsigned*)(L + ZERO_OFF))[F.tid] = 0u;
        if (F.tid >= 64 && F.tid < 320) { const int i_ = F.tid - 64, k_ = h * 64 + (i_ & 63);
            ((LAS float*)(L + KC_OFF))[i_] = i_ < 64 ? a.in[I_KK][k_] : i_ < 128 ? a.in[I_KA][k_] : i_ < 192 ? a.in[I_RK][k_] * a.in[I_KA][k_] : (dir == 0 ? a.in[I_RK][k_] * (2.0f - 2.0f * a.in[I_KA][k_]) : 0.f); }
        __syncthreads();
        if (F.wave >= 4) {
            const int p = F.wave - 4;
            LAS unsigned char* PV = L + PRIVP + p * PRIVP_B;
            const int t1 = l >> 2, kq = l & 3, hc1 = h * 64 + 16 * kq;
            v4u raw[10];
#define SC_PREFETCH(cc) do { const int m_ = scan_row((cc) * C + t1, b, dir); const GAS v4u* q0 = (const GAS v4u*)(RB + (size_t)m_ * RW + hc1); const GAS v4u* q1 = (const GAS v4u*)(KB + (size_t)m_ * RW + hc1); const GAS v4u* q2 = (const GAS v4u*)(VB + (size_t)m_ * RW + hc1); \
                const GAS v4u* q3 = (const GAS v4u*)(LP + (size_t)m_ * LN + dir * 512 + hc1); const GAS v4u* q4 = (const GAS v4u*)(LP + (size_t)m_ * LN + 1024 + dir * 512 + hc1); \
                raw[0] = __builtin_nontemporal_load(q0); raw[1] = __builtin_nontemporal_load(q0 + 1); raw[2] = __builtin_nontemporal_load(q1); raw[3] = __builtin_nontemporal_load(q1 + 1); raw[4] = __builtin_nontemporal_load(q2); raw[5] = __builtin_nontemporal_load(q2 + 1); \
                raw[6] = __builtin_nontemporal_load(q3); raw[7] = __builtin_nontemporal_load(q3 + 1); raw[8] = __builtin_nontemporal_load(q4); raw[9] = __builtin_nontemporal_load(q4 + 1); } while (0)
            if (p < NCHUNK) SC_PREFETCH(p);
            volatile LAS unsigned* RDY = (volatile LAS unsigned*)(L + FLAG_OFF); volatile LAS unsigned* DONE = RDY + NSLOT;
            for (int c = p; c < NCHUNK; c += 4) {
                if (c >= NSLOT) { unsigned spins = 0; while (*DONE < 4u * (unsigned)(c - NSLOT + 1)) { __builtin_amdgcn_s_sleep(2); if (++spins > (1u << 22)) break; } asm volatile("" ::: "memory"); }
#pragma unroll 1
                for (int f = 1; f <= 3; ++f) {
                {
                    LAS unsigned char* SL = L + (c % NSLOT) * SLOT_B;
                    if (f == 1) {
                        float r16[16], k16[16], e16[16], a16[16];
                        { float t8[8]; unpk8(raw[0], t8); for (int e = 0; e < 8; ++e) r16[e] = t8[e]; unpk8(raw[1], t8); for (int e = 0; e < 8; ++e) r16[8 + e] = t8[e];
                          unpk8(raw[2], t8); for (int e = 0; e < 8; ++e) k16[e] = t8[e]; unpk8(raw[3], t8); for (int e = 0; e < 8; ++e) k16[8 + e] = t8[e];
                          unpk8(raw[6], t8); for (int e = 0; e < 8; ++e) e16[e] = t8[e]; unpk8(raw[7], t8); for (int e = 0; e < 8; ++e) e16[8 + e] = t8[e];
                          unpk8(raw[8], t8); for (int e = 0; e < 8; ++e) a16[e] = t8[e]; unpk8(raw[9], t8); for (int e = 0; e < 8; ++e) a16[8 + e] = t8[e]; }
                        const int ro = t1 * RS + kq * 32;
                        *(LAS v4u*)(SL + O_VT + ro) = raw[4]; *(LAS v4u*)(SL + O_VT + ro + 16) = raw[5];
#pragma unroll
                        for (int e4 = 0; e4 < 4; ++e4) *(LAS f32x4*)(PV + O_EW + t1 * ES + kq * 64 + e4 * 16) = (f32x4){e16[4 * e4], e16[4 * e4 + 1], e16[4 * e4 + 2], e16[4 * e4 + 3]};
                        if (c + 4 < NCHUNK) SC_PREFETCH(c + 4);
                        float kkc[16], kac[16];
#pragma unroll
                        for (int e4 = 0; e4 < 4; ++e4) { const f32x4 q0 = *(const LAS f32x4*)(L + KC_OFF + (16 * kq + 4 * e4) * 4), q1 = *(const LAS f32x4*)(L + KC_OFF + 256 + (16 * kq + 4 * e4) * 4);
#pragma unroll
                            for (int e = 0; e < 4; ++e) { kkc[4 * e4 + e] = q0[e]; kac[4 * e4 + e] = q1[e]; } }
                        float kk16[16], nb16[16], kd16[16]; float ss = 0.f;
#pragma unroll
                        for (int e = 0; e < 16; ++e) { kk16[e] = k16[e] * kkc[e]; ss += kk16[e] * kk16[e]; }
                        ss = dpp_add<0xB1>(ss); ss = dpp_add<0x4E>(ss);
                        const float rn = 1.0f / sqrtf(fmaxf(ss, 1e-24f));
#pragma unroll
                        for (int e = 0; e < 16; ++e) { kk16[e] *= rn; nb16[e] = -kk16[e] * a16[e]; }
                        { float sb = 0.f;
#pragma unroll
                          for (int e4 = 0; e4 < 4; ++e4) { const f32x4 q2 = *(const LAS f32x4*)(L + KC_OFF + 512 + (16 * kq + 4 * e4) * 4), q3 = *(const LAS f32x4*)(L + KC_OFF + 768 + (16 * kq + 4 * e4) * 4);
#pragma unroll
                              for (int e = 0; e < 4; ++e) { const int x = 4 * e4 + e; const float ka_ = k16[x] * a16[x]; kd16[x] = k16[x] + (ka_ - k16[x]) * kac[x]; sb += (r16[x] * k16[x]) * (q2[e] * a16[x] + q3[e]); } }
                          sb = dpp_add<0xB1>(sb); sb = dpp_add<0x4E>(sb);
                          if (c >= CTXCHUNK && kq == 0) SBTg[((size_t)scan_row(c * C + t1, b, dir) * 8 + h) * 4 + 1 + dir] = sb; }
                        asm volatile("s_waitcnt lgkmcnt(0)" ::: "memory");
                        {
                          LAS float* Ep = (LAS float*)(PV + O_EW) + l; float cs = 0.f;
#pragma unroll
                          for (int t = 0; t < 16; ++t) { cs += Ep[t * (ES / 4)]; Ep[t * (ES / 4)] = cs; }
                          ((LAS float*)(SL + O_LC))[l] = __expf(cs); }
                        asm volatile("s_waitcnt lgkmcnt(0)" ::: "memory");
                        unsigned pP[8], pR[8], pN[8], pD[8], pNP[8], pDP[8];
#pragma unroll
                        for (int e4 = 0; e4 < 4; ++e4) { const f32x4 cs4 = *(const LAS f32x4*)(PV + O_EW + t1 * ES + kq * 64 + e4 * 16);
                            const f32x4 cm4 = *(const LAS f32x4*)(L + (t1 > 0 ? PRIVP + p * PRIVP_B + O_EW + (t1 - 1) * ES + kq * 64 + e4 * 16 : ZERO_OFF)); const f32x4 lc4 = *(const LAS f32x4*)(SL + O_LC + kq * 64 + e4 * 16);
                            float vP[4], vR[4], vN[4], vD[4], vNP[4], vDP[4];
#pragma unroll
                            for (int e = 0; e < 4; ++e) { const int x = 4 * e4 + e; const float pc = __expf(cs4[e]), pm = __expf(cm4[e]), ic = __builtin_amdgcn_rcpf(pc);
                                vP[e] = kk16[x] * pm; vR[e] = r16[x] * pc; vN[e] = nb16[x] * ic; vD[e] = kd16[x] * ic; vNP[e] = vN[e] * lc4[e]; vDP[e] = vD[e] * lc4[e]; }
                            pP[2 * e4] = cvtpk(vP[0], vP[1]); pP[2 * e4 + 1] = cvtpk(vP[2], vP[3]); pR[2 * e4] = cvtpk(vR[0], vR[1]); pR[2 * e4 + 1] = cvtpk(vR[2], vR[3]);
                            pN[2 * e4] = cvtpk(vN[0], vN[1]); pN[2 * e4 + 1] = cvtpk(vN[2], vN[3]); pD[2 * e4] = cvtpk(vD[0], vD[1]); pD[2 * e4 + 1] = cvtpk(vD[2], vD[3]);
                            pNP[2 * e4] = cvtpk(vNP[0], vNP[1]); pNP[2 * e4 + 1] = cvtpk(vNP[2], vNP[3]); pDP[2 * e4] = cvtpk(vDP[0], vDP[1]); pDP[2 * e4 + 1] = cvtpk(vDP[2], vDP[3]); }
                        *(LAS v4u*)(SL + O_P + ro) = (v4u){pP[0], pP[1], pP[2], pP[3]}; *(LAS v4u*)(SL + O_P + ro + 16) = (v4u){pP[4], pP[5], pP[6], pP[7]};
                        *(LAS v4u*)(SL + O_RT + ro) = (v4u){pR[0], pR[1], pR[2], pR[3]}; *(LAS v4u*)(SL + O_RT + ro + 16) = (v4u){pR[4], pR[5], pR[6], pR[7]};
                        *(LAS v4u*)(PV + O_NN + ro) = (v4u){pN[0], pN[1], pN[2], pN[3]}; *(LAS v4u*)(PV + O_NN + ro + 16) = (v4u){pN[4], pN[5], pN[6], pN[7]};
                        *(LAS v4u*)(PV + O_DD + ro) = (v4u){pD[0], pD[1], pD[2], pD[3]}; *(LAS v4u*)(PV + O_DD + ro + 16) = (v4u){pD[4], pD[5], pD[6], pD[7]};
                        *(LAS v4u*)(SL + O_NPT + ro) = (v4u){pNP[0], pNP[1], pNP[2], pNP[3]}; *(LAS v4u*)(SL + O_NPT + ro + 16) = (v4u){pNP[4], pNP[5], pNP[6], pNP[7]};
                        *(LAS v4u*)(SL + O_DPT + ro) = (v4u){pDP[0], pDP[1], pDP[2], pDP[3]}; *(LAS v4u*)(SL + O_DPT + ro + 16) = (v4u){pDP[4], pDP[5], pDP[6], pDP[7]};
                    } else if (f == 2) {
                        bf16x8v_ ap[2], ar[2], bn[2], bd[2];
#pragma unroll
                        for (int ks = 0; ks < 2; ++ks) { const int o = lr * RS + ks * 64 + g * 16; ap[ks] = *(const LAS bf16x8v_*)(SL + O_P + o); ar[ks] = *(const LAS bf16x8v_*)(SL + O_RT + o); bn[ks] = *(const LAS bf16x8v_*)(PV + O_NN + o); bd[ks] = *(const LAS bf16x8v_*)(PV + O_DD + o); }
                        f32x4 cN = {0.f, 0.f, 0.f, 0.f}, cDm = cN, cNr = cN, cDr = cN;
#pragma unroll
                        for (int ks = 0; ks < 2; ++ks) { cN = __builtin_amdgcn_mfma_f32_16x16x32_bf16(ap[ks], bn[ks], cN, 0, 0, 0); cDm = __builtin_amdgcn_mfma_f32_16x16x32_bf16(ap[ks], bd[ks], cDm, 0, 0, 0);
                            cNr = __builtin_amdgcn_mfma_f32_16x16x32_bf16(ar[ks], bn[ks], cNr, 0, 0, 0); cDr = __builtin_amdgcn_mfma_f32_16x16x32_bf16(ar[ks], bd[ks], cDr, 0, 0, 0); }
                        *(LAS f32x4*)(PV + O_NF + (lr * 16 + 4 * g) * 4) = (f32x4){lr < 4 * g ? cN[0] : 0.f, lr < 4 * g + 1 ? cN[1] : 0.f, lr < 4 * g + 2 ? cN[2] : 0.f, lr < 4 * g + 3 ? cN[3] : 0.f};
#pragma unroll
                        for (int r = 0; r < 4; ++r) { const int t = 4 * g + r, j = lr; const bool lo = j < t, le = j <= t;
                            ((LAS unsigned short*)(SL + O_DM))[t * 16 + j] = tobf1(lo ? cDm[r] : 0.f); ((LAS unsigned short*)(SL + O_NR))[t * 16 + j] = tobf1(le ? cNr[r] : 0.f); ((LAS unsigned short*)(SL + O_DR))[t * 16 + j] = tobf1(le ? cDr[r] : 0.f); }
                    } else {
                        const LAS f32x4* NFTp = (const LAS f32x4*)(PV + O_NF); float acc[16];
#pragma unroll
                        for (int t = 0; t < 16; ++t) acc[t] = (t == lr) ? 1.0f : 0.0f;
                        f32x4 col[4];
#pragma unroll
                        for (int q4 = 0; q4 < 4; ++q4) col[q4] = NFTp[q4];
#pragma unroll
                        for (int j = 0; j < 16; ++j) { const float Lj = acc[j]; ((LAS unsigned short*)(SL + O_LINV))[j * 16 + lr] = tobf1(Lj);
                            f32x4 nxt[4];
                            if (j + 1 < 16) {
#pragma unroll
                                for (int q4 = 0; q4 < 4; ++q4) nxt[q4] = NFTp[(j + 1) * 4 + q4]; }
#pragma unroll
                            for (int t = j + 1; t < 16; ++t) acc[t] += col[t >> 2][t & 3] * Lj;
                            if (j + 1 < 16) {
#pragma unroll
                                for (int q4 = 0; q4 < 4; ++q4) col[q4] = nxt[q4]; } }
                    }
                }
                asm volatile("s_waitcnt lgkmcnt(0)" ::: "memory");
                }
                if (l == 0) RDY[c % NSLOT] = (unsigned)(c + 1);
            }
#undef SC_PREFETCH
        } else {
            const int w = F.wave, irow = 16 * w + lr, q = lr >> 2, pp = l & 3;
            f32x4 S[4];
#pragma unroll
            for (int kt = 0; kt < 4; ++kt) S[kt] = (f32x4){0.f, 0.f, 0.f, 0.f};
            volatile LAS unsigned* RDY = (volatile LAS unsigned*)(L + FLAG_OFF); LAS unsigned* DONE = (LAS unsigned*)(L + FLAG_OFF) + NSLOT;
            const unsigned ldsb_ = (unsigned)(size_t)L, lanetr_ = (unsigned)((4 * g + q) * RS + 8 * pp);
            for (int c = 0; c < NCHUNK; ++c) {
                { unsigned spins = 0; while (RDY[c % NSLOT] != (unsigned)(c + 1)) { __builtin_amdgcn_s_sleep(1); if (++spins > (1u << 22)) break; } asm volatile("" ::: "memory"); }
                {
                    LAS unsigned char* SL = L + (c % NSLOT) * SLOT_B; const unsigned slb_ = ldsb_ + (unsigned)((c % NSLOT) * SLOT_B);
                    asm volatile("s_nop 7" : "+v"(S[0]), "+v"(S[1]), "+v"(S[2]), "+v"(S[3]));
                    bf16x8v_ bS[2], aP[2], aR[2];
#pragma unroll
                    for (int ks = 0; ks < 2; ++ks) { bS[ks] = __builtin_bit_cast(bf16x8v_, (v4u){cvtpk(S[2 * ks][0], S[2 * ks][1]), cvtpk(S[2 * ks][2], S[2 * ks][3]), cvtpk(S[2 * ks + 1][0], S[2 * ks + 1][1]), cvtpk(S[2 * ks + 1][2], S[2 * ks + 1][3])});
                        const int o = lr * RS + (32 * ks + 4 * g) * 2;
                        aP[ks] = mk_b(*(const LAS v2u*)(SL + O_P + o), *(const LAS v2u*)(SL + O_P + o + 32)); aR[ks] = mk_b(*(const LAS v2u*)(SL + O_RT + o), *(const LAS v2u*)(SL + O_RT + o + 32)); }
                    const v2u z2 = {0u, 0u}; const int o16 = lr * 32 + g * 8;
                    const bf16x8v_ aDm = mk_b(*(const LAS v2u*)(SL + O_DM + o16), z2), aNr = mk_b(*(const LAS v2u*)(SL + O_NR + o16), z2), aDr = mk_b(*(const LAS v2u*)(SL + O_DR + o16), z2), aLi = mk_b(*(const LAS v2u*)(SL + O_LINV + o16), z2);
                    v2u trv, trn[4], trd[4];
                    asm volatile("ds_read_b64_tr_b16 %0, %9\n\t"
                                 "ds_read_b64_tr_b16 %1, %10\n\tds_read_b64_tr_b16 %2, %10 offset:32\n\tds_read_b64_tr_b16 %3, %10 offset:64\n\tds_read_b64_tr_b16 %4, %10 offset:96\n\t"
                                 "ds_read_b64_tr_b16 %5, %11\n\tds_read_b64_tr_b16 %6, %11 offset:32\n\tds_read_b64_tr_b16 %7, %11 offset:64\n\tds_read_b64_tr_b16 %8, %11 offset:96\n\ts_waitcnt lgkmcnt(0)"
                                 : "=&v"(trv), "=&v"(trn[0]), "=&v"(trn[1]), "=&v"(trn[2]), "=&v"(trn[3]), "=&v"(trd[0]), "=&v"(trd[1]), "=&v"(trd[2]), "=&v"(trd[3])
                                 : "v"(slb_ + (unsigned)(O_VT + 32 * w) + lanetr_), "v"(slb_ + (unsigned)O_NPT + lanetr_), "v"(slb_ + (unsigned)O_DPT + lanetr_) : "memory");
                    const bf16x8v_ bV = mk_b(trv, z2);
                    f32x4 W = {0.f, 0.f, 0.f, 0.f};
                    W = __builtin_amdgcn_mfma_f32_16x16x32_bf16(aP[0], bS[0], W, 0, 0, 0); W = __builtin_amdgcn_mfma_f32_16x16x32_bf16(aP[1], bS[1], W, 0, 0, 0); W = __builtin_amdgcn_mfma_f32_16x16x32_bf16(aDm, bV, W, 0, 0, 0);
                    asm volatile("s_nop 7\n\ts_nop 7" : "+v"(W));
                    const bf16x8v_ bW = __builtin_bit_cast(bf16x8v_, (v4u){cvtpk(W[0], W[1]), cvtpk(W[2], W[3]), 0u, 0u});
                    f32x4 Z = {0.f, 0.f, 0.f, 0.f};
                    Z = __builtin_amdgcn_mfma_f32_16x16x32_bf16(aLi, bW, Z, 0, 0, 0);
                    asm volatile("s_nop 7\n\ts_nop 7" : "+v"(Z));
                    const bf16x8v_ bZ = __builtin_bit_cast(bf16x8v_, (v4u){cvtpk(Z[0], Z[1]), cvtpk(Z[2], Z[3]), 0u, 0u});
                    if (c >= CTXCHUNK) {
                        f32x4 Y = {0.f, 0.f, 0.f, 0.f};
                        Y = __builtin_amdgcn_mfma_f32_16x16x32_bf16(aR[0], bS[0], Y, 0, 0, 0); Y = __builtin_amdgcn_mfma_f32_16x16x32_bf16(aR[1], bS[1], Y, 0, 0, 0);
                        Y = __builtin_amdgcn_mfma_f32_16x16x32_bf16(aNr, bZ, Y, 0, 0, 0); Y = __builtin_amdgcn_mfma_f32_16x16x32_bf16(aDr, bV, Y, 0, 0, 0);
#pragma unroll
                        for (int r = 0; r < 4; ++r) { const int m = scan_row(c * C + 4 * g + r, b, dir); Yg[(size_t)m * RW + h * 64 + irow] = tobf(Y[r]); }
                    }
#pragma unroll
                    for (int kt = 0; kt < 4; ++kt) { const f32x4 lc = *(const LAS f32x4*)(SL + O_LC + (16 * kt + 4 * g) * 4);
                        f32x4 sv = S[kt] * lc; sv = __builtin_amdgcn_mfma_f32_16x16x32_bf16(mk_b(trn[kt], z2), bZ, sv, 0, 0, 0); sv = __builtin_amdgcn_mfma_f32_16x16x32_bf16(mk_b(trd[kt], z2), bV, sv, 0, 0, 0); S[kt] = sv; }
                }
                asm volatile("s_waitcnt lgkmcnt(0)" ::: "memory");
                if (l == 0) __hip_atomic_fetch_add(DONE, 1u, __ATOMIC_RELAXED, __HIP_MEMORY_SCOPE_WORKGROUP);
            }
        }
        __syncthreads();
    }
}
__device__ __forceinline__ void rwkv_out_phase(const Frame& F, const Args& a) {
    const bf16* RB = (const bf16*)(a.ws + WS_R); const bf16* KB = (const bf16*)(a.ws + WS_K); const bf16* VB = (const bf16*)(a.ws + WS_V); const bf16* LP = (const bf16*)(a.ws + WS_LP); bf16* O = (bf16*)(a.ws + WS_FXO) + 512;
    const bf16* YF = (const bf16*)a.out; const bf16* YBk = (const bf16*)a.out + (size_t)MX * RW;
    const int gw = F.vcu * NWAVES + F.wave, NGW = F.G * NWAVES, col = 8 * F.lane;
    float lg[8], lb[8];
#pragma unroll
    for (int e = 0; e < 8; ++e) { lg[e] = a.in[I_LNG][col + e]; lb[e] = a.in[I_LNB][col + e]; }
    const float* SBT = (const float*)(a.ws + WS_SBT);
    v4u ryf, ryb, rv, rg; f32x4 rsb;
#define RO_LOAD(m_) do { ryf = __builtin_nontemporal_load((const GAS v4u*)(YF + (size_t)(m_) * RW + col)); ryb = __builtin_nontemporal_load((const GAS v4u*)(YBk + (size_t)(m_) * RW + col)); \
        rv = __builtin_nontemporal_load((const GAS v4u*)(VB + (size_t)(m_) * RW + col)); rg = __builtin_nontemporal_load((const GAS v4u*)(LP + (size_t)(m_) * LN + 2048 + col)); \
        rsb = __builtin_nontemporal_load((const GAS f32x4*)(SBT + ((size_t)(m_) * 8 + (F.lane >> 3)) * 4)); } while (0)
    if (gw < MX) RO_LOAD(gw);
    for (int m = gw; m < MX; m += NGW) {
        float y[8], v[8], gg[8], o[8];
        { float yb8[8]; unpk8(ryf, y); unpk8(ryb, yb8);
#pragma unroll
          for (int e = 0; e < 8; ++e) y[e] += yb8[e]; }
        unpk8(rv, v); unpk8(rg, gg);
        const f32x4 sb4 = rsb;
        if (m + NGW < MX) RO_LOAD(m + NGW);
        float s = 0.f;
#pragma unroll
        for (int e = 0; e < 8; ++e) s += y[e];
        const float mean = red8(s) * (1.0f / 64.0f);
        float qv = 0.f; const float bs = sb4[1] + sb4[2];
#pragma unroll
        for (int e = 0; e < 8; ++e) { y[e] -= mean; qv += y[e] * y[e]; }
        const float rstd = 1.0f / sqrtf(red8(qv) * (1.0f / 64.0f) + GN_EPS);
#pragma unroll
        for (int e = 0; e < 8; ++e) o[e] = ((y[e] * rstd * lg[e] + lb[e]) + bs * v[e]) * gg[e];
        *(GAS v4u*)(O + (size_t)m * 1024 + col) = pk8(o);
    }
#undef RO_LOAD
}
__global__ void __launch_bounds__(NWAVES * 64, 2) mk_fwd(Args args) {
    extern __shared__ __attribute__((aligned(16))) unsigned char lds[];
    Frame F;
    F.lds = (LAS unsigned char*)lds;
    F.MISC = (volatile LAS unsigned*)(F.lds + MISC_OFF);
    F.tid = threadIdx.x; F.lane = F.tid & 63; F.wave = __builtin_amdgcn_readfirstlane(F.tid >> 6);
    F.G = gridDim.x; { const int bx = blockIdx.x; F.vcu = (F.G % 8 == 0) ? (bx % 8) * (F.G / 8) + bx / 8 : bx; }
    F.ctl = (gu32*)(args.ws + WS_CTL);
    for (int u = F.tid; u < (LDS_BYTES - LDSCTL_OFF) / 4; u += NWAVES * 64) ((LAS unsigned*)(F.lds + LDSCTL_OFF))[u] = 0u;
    __syncthreads();
    XcdBarrier bar; bar.bar = (unsigned*)(F.ctl + CW_BAR); bar.x = 0; bar.st = nullptr;
    if (N_LAUNCHES == 1) bar = xcd_barrier_post((unsigned*)(F.ctl + CW_BAR), F.MISC + 8);
    if (N_LAUNCHES == 1 && threadIdx.x == 0 && (bar.x != (blockIdx.x & 7u) || (gridDim.x & 7u) != 0u)) (void)xb_add((unsigned*)(F.ctl + CW_BADMAP), 1u);
#define GRID_BAR() do { if (N_LAUNCHES == 1) xcd_barrier(bar); } while (0)
    const int lo = args.ph_lo, hi = args.ph_hi;
#define IN(k) (refresh_tid(F), lo <= (k) && (k) < hi)
#define INP(k) (lo <= (k) && (k) < hi)
#define SEAM(k) do { if (INP(k) && INP((k) + 1)) GRID_BAR(); } while (0)
#define SEAM_L(k) do { if (INP(k) && INP((k) + 1)) { if (N_LAUNCHES == 1) { if (F.MISC[10]) xcd_barrier_local(bar); else xcd_barrier(bar); } } } while (0)
#define WSP(T, off) ((T*)(args.ws + (off)))
#define MOD WSP(float, WS_MOD)
#define Win_t WSP(bf16, WS_WIN)
#define Wlora_t WSP(bf16, WS_WLORA)
#define Wupf_t WSP(bf16, WS_WUPF)
#define Wupr_t WSP(bf16, WS_WUPR)
#define Wout_t WSP(bf16, WS_WOUT)
#define Wgu_t WSP(bf16, WS_WGU)
#define Wdown_t WSP(bf16, WS_WDOWN)
#define HX WSP(bf16, WS_HX)
#define PXR WSP(bf16, WS_PXR)
#define Z3 WSP(bf16, WS_Z3)
#define GF WSP(bf16, WS_GF)
#define GR WSP(bf16, WS_GR)
#define Y2 ((bf16*)((unsigned char*)args.out + 32 * MiB))
#define FX WSP(bf16, WS_FXO)
#define AL ((bf16*)args.out)
#define LP WSP(bf16, WS_LP)
#define MB WSP(bf16, WS_MB)
#define HX2 WSP(bf16, WS_HX2)
#define ACT WSP(bf16, WS_ACT)
    const int gw = F.vcu * NWAVES + F.wave, NGW = F.G * NWAVES;
    using EpiIn1 = pg8::EpiIn<WS_Z3, WS_GF, WS_GR, WS_R, WS_EB>;

    for (int rep_ = 0; rep_ < 1 + ((MK_REPEAT >> 0) & 1); ++rep_)
    if (IN(0)) { p0_weights(F, args); } SEAM(0);
    if (N_LAUNCHES == 1) {
        if (threadIdx.x == 0) F.MISC[10] = (xb_ld((unsigned*)(F.ctl + CW_BADMAP)) == 0u) ? 1u : 0u;
        __syncthreads(); }
    for (int rep_ = 0; rep_ < 1 + ((MK_REPEAT >> 1) & 1); ++rep_)
    if (IN(1)) {
        { constexpr int RPW = (MT + 2047) / 2048; const int rpw = (MT + NGW - 1) / NGW; (void)RPW; const int m0 = gw * rpw, m1 = (m0 + rpw < MT) ? m0 + rpw : MT; norm_mod_rows<0>(args, m0, m1, args.in[I_N1G], HX, F.lane); }
    } SEAM(1);
    for (int rep_ = 0; rep_ < 1 + ((MK_REPEAT >> 2) & 1); ++rep_)
    if (IN(2)) {
        { pg8::Gemm g{HX, Win_t, MX, NIN, D}; pg8::StaticOrder S; S.init(MX, NIN, F.G, (int)blockIdx.x); EpiIn1 E{args.ws, (bf16*)args.out, args.in[I_MUP], args.in[I_MUN], (LAS float*)(F.lds + XB_OFF), 0};
          pg8::gemm_phase<EpiIn1, pg8::StaticOrder, true, true>(F.lds + RING_OFF, g, S, E); }
        { pg8::Gemm g{HX + (size_t)MX * D, Win_t, MC, RPAD, D}; pg8::StaticOrder S; S.init(MC, RPAD, F.G, (int)blockIdx.x); EpiIn1 E{args.ws, (bf16*)args.out, args.in[I_MUP], args.in[I_MUN], (LAS float*)(F.lds + XB_OFF), MX};
          pg8::gemm_phase<EpiIn1, pg8::StaticOrder, true, true>(F.lds + RING_OFF, g, S, E); }
    } SEAM(2);
    for (int rep_ = 0; rep_ < 1 + ((MK_REPEAT >> 3) & 1); ++rep_)
    if (IN(3)) { edge_rows(F, args); dft_pass_a(F, Z3, Y2); } SEAM(3);
    for (int rep_ = 0; rep_ < 1 + ((MK_REPEAT >> 7) & 1); ++rep_)
    if (IN(7)) { dft_pass_b(F, Y2, FX); __syncthreads();
        pg8::Gemm g{AL, Wlora_t, MT, LN, LK}; pg8::StaticOrder S; S.init(MT, LN, F.G, (int)blockIdx.x); pg8::EpiLora E{LP, WSP(const float, WS_LB), (LAS float*)(F.lds + XB_OFF) + 2048};
        pg8::gemm_phase<pg8::EpiLora, pg8::StaticOrder, true, true>(F.lds + RING_OFF, g, S, E); } SEAM(7);
    for (int rep_ = 0; rep_ < 1 + ((MK_REPEAT >> 8) & 1); ++rep_)
    if (IN(8)) { scan_phase(F, args); } SEAM(8);
    for (int rep_ = 0; rep_ < 1 + ((MK_REPEAT >> 9) & 1); ++rep_)
    if (IN(9)) { rwkv_out_phase(F, args); } SEAM(9);
    for (int rep_ = 0; rep_ < 1 + ((MK_REPEAT >> 10) & 1); ++rep_)
    if (IN(10)) { pg8::Gemm g{FX, Wupf_t, MX, D, D}; pg8::StaticOrder S; S.init(MX, D, F.G, (int)blockIdx.x); pg8::EpiMerge2 E{MB, GF, GR};
        pg8::gemm_phase<pg8::EpiMerge2, pg8::StaticOrder, true, true>(F.lds + RING_OFF, g, S, E); } SEAM_L(10);
    for (int rep_ = 0; rep_ < 1 + ((MK_REPEAT >> 11) & 1); ++rep_)
    if (IN(11)) { pg8::Gemm g{MB, Wout_t, MX, D, D}; pg8::StaticOrder S; S.init(MX, D, F.G, (int)blockIdx.x); pg8::EpiDelta E{WSP(bf16, WS_D1), MOD + 2048, (LAS float*)(F.lds + XB_OFF) + 2048};
        pg8::gemm_phase<pg8::EpiDelta, pg8::StaticOrder, true, true>(F.lds + RING_OFF, g, S, E); } SEAM_L(11);
    for (int rep_ = 0; rep_ < 1 + ((MK_REPEAT >> 12) & 1); ++rep_)
    if (IN(12)) {
        p_weights2(F, args);
        { const int rpw = (MX + NGW - 1) / NGW; const int m0 = gw * rpw, m1 = (m0 + rpw < MX) ? m0 + rpw : MX; norm_mod_rows<1>(args, m0, m1, args.in[I_N2G], HX2, F.lane); }
    } SEAM(12);
    for (int rep_ = 0; rep_ < 1 + ((MK_REPEAT >> 13) & 1); ++rep_)
    if (IN(13)) { pg8::Gemm g{HX2, Wgu_t, MX, 2 * DFF, D}; pg8::StaticOrder S; S.init(MX, 2 * DFF, F.G, (int)blockIdx.x); pg8::EpiSwiglu E{ACT};
        pg8::gemm_phase<pg8::EpiSwiglu, pg8::StaticOrder, true, true>(F.lds + RING_OFF, g, S, E); } SEAM_L(13);
    for (int rep_ = 0; rep_ < 1 + ((MK_REPEAT >> 14) & 1); ++rep_)
    if (IN(14)) { pg8::Gemm g{ACT, Wdown_t, MX, D, DFF}; pg8::StaticOrder S; S.init(MX, D, F.G, (int)blockIdx.x); pg8::EpiDelta E{WSP(bf16, WS_D2), MOD + 5120, (LAS float*)(F.lds + XB_OFF) + 2048};
        pg8::gemm_phase<pg8::EpiDelta, pg8::StaticOrder, true, true>(F.lds + RING_OFF, g, S, E); } SEAM_L(14);
    for (int rep_ = 0; rep_ < 1 + ((MK_REPEAT >> 15) & 1); ++rep_)
    if (IN(15)) {
        const int wpx = (F.G % 8 == 0) ? NGW / 8 : NGW, rpx = (F.G % 8 == 0) ? MX / 8 : MX, xg = gw / wpx, lw = gw % wpx;
        f32x4 px[4]; v2u pd1[4], pd2[4];
#define FN_LOAD(m_) do { const GAS f32x4* xin = (const GAS f32x4*)(args.in[I_X] + (size_t)(m_) * D) + F.lane; const GAS v2u* dr = (const GAS v2u*)(WSP(bf16, WS_D2) + (size_t)(m_) * D) + F.lane; \
            const GAS v2u* d1r = (const GAS v2u*)(WSP(bf16, WS_D1) + (size_t)(m_) * D) + F.lane; \
            _Pragma("unroll") for (int j = 0; j < 4; ++j) { px[j] = __builtin_nontemporal_load(xin + 64 * j); pd1[j] = __builtin_nontemporal_load(d1r + 64 * j); pd2[j] = __builtin_nontemporal_load(dr + 64 * j); } } while (0)
        const int mbeg = xg * rpx + lw, mend = (xg + 1) * rpx;
        if (mbeg < mend) FN_LOAD(mbeg);
        f32x4 fng[4];
#pragma unroll
        for (int j = 0; j < 4; ++j) fng[j] = ((const f32x4*)args.in[I_FNG])[F.lane + 64 * j];
        for (int m = mbeg; m < mend; m += wpx) {
            GAS f32x4* xr = (GAS f32x4*)(args.out + (size_t)m * D) + F.lane; f32x4 v[4]; float s2 = 0.f;
#pragma unroll
            for (int j = 0; j < 4; ++j) { const v2u dd = pd2[j], d1 = pd1[j]; v[j] = (px[j] + (f32x4){bflo(d1.x), bfhi(d1.x), bflo(d1.y), bfhi(d1.y)}) + (f32x4){bflo(dd.x), bfhi(dd.x), bflo(dd.y), bfhi(dd.y)}; s2 += (v[j].x * v[j].x + v[j].y * v[j].y) + (v[j].z * v[j].z + v[j].w * v[j].w); }
            if (m + wpx < mend) FN_LOAD(m + wpx);
            const float rstd = 1.0f / sqrtf(wave_sum(s2) * (1.f / D) + NORM_EPS);
#pragma unroll
            for (int j = 0; j < 4; ++j) xr[64 * j] = (v[j] * rstd) * fng[j];
        }
#undef FN_LOAD
    }
#undef IN
#undef SEAM
#undef GRID_BAR
}

extern "C" void kernel_launch(void* const* d_in, const int* in_sizes, int n_in, void* d_out, int out_size, void* d_ws, size_t ws_size, hipStream_t stream) {
    static int grid = 0;
    if (grid == 0) {
        if (n_in != 31 || in_sizes[0] != MX * D || out_size != MX * D || ws_size < WS_END) { fprintf(stderr, "kernel_launch: shape/workspace mismatch (n_in %d, in0 %d, out %d, ws %zu); nothing launched\n", n_in, n_in > 0 ? in_sizes[0] : -1, out_size, ws_size); grid = -1; return; }
        int dev = 0, cus = 0;
        if (hipGetDevice(&dev) != hipSuccess || hipDeviceGetAttribute(&cus, hipDeviceAttributeMultiprocessorCount, dev) != hipSuccess) { grid = -1; return; }
        if (hipFuncSetAttribute((const void*)mk_fwd, hipFuncAttributeMaxDynamicSharedMemorySize, LDS_BYTES) != hipSuccess) { fprintf(stderr, "kernel_launch: hipFuncSetAttribute failed\n"); grid = -1; return; }
        (void)hipGetLastError();
        grid = cus;
    }
    if (grid < 0) return;
    if (hipMemsetAsync((char*)d_ws + WS_CTL, 0, CTL_ZERO_BYTES, stream) != hipSuccess) return;
    Args a{};
    for (int i = 0; i < 31; ++i) a.in[i] = (const float*)d_in[i];
    a.out = (float*)d_out; a.ws = (unsigned char*)d_ws;
    if (N_LAUNCHES == 1) { a.ph_lo = 0; a.ph_hi = NPH; a.li = 0; hipLaunchKernelGGL(mk_fwd, dim3(grid), dim3(NWAVES * 64), LDS_BYTES, stream, a); }
    else for (int p = 0; p < NPH; ++p) { a.ph_lo = p; a.ph_hi = p + 1; a.li = p; hipLaunchKernelGGL(mk_fwd, dim3(grid), dim3(NWAVES * 64), LDS_BYTES, stream, a); }
}
```
